# Optimizing an MI355X kernel written in HIP

```python
import jax, jax.numpy as jnp
from jax import lax
import numpy as np

D_MODEL = 2048
BATCH = 2
SEQ = 16384
DEPTH = 1

HEAD_DIM = 128
NSA_WIDTH = D_MODEL // 2
NSA_HEADS = NSA_WIDTH // HEAD_DIM
NSA_KV_GROUPS = 2
NSA_REP = NSA_HEADS // NSA_KV_GROUPS
KV_WIDTH = NSA_KV_GROUPS * HEAD_DIM
N_BRANCH = 3
CMP_LEN = 32
CMP_STRIDE = 16
SEL_LEN = 64
SEL_TOPK = 16
WINDOW = 512
FORCE_SCORE = 1e4
GMLP_WIDTH = D_MODEL - NSA_WIDTH
GMLP_GROUP_DIM = 128
GMLP_GROUPS = GMLP_WIDTH // GMLP_GROUP_DIM
GMLP_CHUNK = 128
D_FF = 5632
CONV_WIDTH = 3
ROPE_THETA = 10000.0
EPS = 1e-6
Q_BLOCK = 128
NEG_INF = -1e30
Q_END = NSA_WIDTH
KV_END = Q_END + 6 * KV_WIDTH
GATE_END = KV_END + NSA_HEADS * N_BRANCH
U_END = GATE_END + GMLP_WIDTH
D_IN = U_END + GMLP_WIDTH

kernel_name = "hybrid_nsa_gmlp_convglu_layer"


def rms_norm(x, g):
    x32 = x.astype(jnp.float32)
    y = x32 * lax.rsqrt(jnp.mean(x32 * x32, axis=-1, keepdims=True) + EPS)
    return (y * g.astype(jnp.float32)).astype(x.dtype)


def rope(x, pos):
    half = HEAD_DIM // 2
    inv = ROPE_THETA ** (-2.0 * jnp.arange(half, dtype=jnp.float32) / HEAD_DIM)
    ang = pos.astype(jnp.float32)[..., None] * inv
    cos = jnp.cos(ang)[:, :, None, :]
    sin = jnp.sin(ang)[:, :, None, :]
    x32 = x.astype(jnp.float32)
    x1, x2 = x32[..., :half], x32[..., half:]
    return jnp.concatenate([x1 * cos - x2 * sin, x2 * cos + x1 * sin], axis=-1).astype(x.dtype)


def masked_softmax(s, mask):
    p = jax.nn.softmax(jnp.where(mask, s, NEG_INF), axis=-1)
    return jnp.where(mask, p, 0.0)


def compress_blocks(k, blk_idx, pe, w):
    kb = k[:, blk_idx] + pe[None, None, :, None, :]
    return jnp.einsum('bnlgd,lde->bnge', kb, w)


def nsa_mixer(q, k_cmp, v_cmp, k_sel, v_sel, k_win, v_win, gates, positions,
              cmp_pe_k, cmp_w_k, cmp_pe_v, cmp_w_v):
    B, S, H, Dh = q.shape
    G, R = NSA_KV_GROUPS, NSA_REP
    n_cmp = (S - CMP_LEN) // CMP_STRIDE + 1
    n_sel = S // SEL_LEN
    top_k = min(SEL_TOPK, n_sel)
    n_qb = S // Q_BLOCK
    scale = HEAD_DIM ** -0.5

    q = rope(q, positions)
    c_start = jnp.arange(n_cmp) * CMP_STRIDE
    c_end = c_start + CMP_LEN - 1
    blk_idx = c_start[:, None] + jnp.arange(CMP_LEN)[None, :]
    kc = rope(compress_blocks(k_cmp, blk_idx, cmp_pe_k, cmp_w_k), positions[:, c_end])
    vc = compress_blocks(v_cmp, blk_idx, cmp_pe_v, cmp_w_v)
    js = jnp.arange(n_sel)[None, :] * SEL_LEN
    agg = ((c_start[:, None] < js + SEL_LEN) & (c_start[:, None] + CMP_LEN > js)).astype(jnp.float32)
    ksr = rope(k_sel, positions).reshape(B, n_sel, SEL_LEN, G, Dh).transpose(0, 3, 1, 2, 4)
    vsr = v_sel.reshape(B, n_sel, SEL_LEN, G, Dh).transpose(0, 3, 1, 2, 4)
    pad = ((0, 0), (WINDOW, 0), (0, 0), (0, 0))
    kwp = jnp.pad(rope(k_win, positions), pad)
    vwp = jnp.pad(v_win, pad)

    q_blocks = q.reshape(B, n_qb, Q_BLOCK, G, R, Dh).transpose(1, 0, 2, 3, 4, 5)
    g_blocks = gates.reshape(B, n_qb, Q_BLOCK, H, N_BRANCH).transpose(1, 0, 2, 3, 4)
    b_ix = jnp.arange(B)[:, None, None, None]
    g_ix = jnp.arange(G)[None, :, None, None]
    sel_tok = jnp.arange(SEL_LEN)
    win_off = jnp.arange(Q_BLOCK + WINDOW)
    sel_j = jnp.arange(n_sel)

    def block(args):
        qb, qblk, gblk = args
        t = qb * Q_BLOCK + jnp.arange(Q_BLOCK)
        s = jnp.einsum('bqgrd,bngd->bgrqn', qblk, kc).astype(jnp.float32) * scale
        p_c = masked_softmax(s, c_end[None, :] <= t[:, None])
        o_c = jnp.einsum('bgrqn,bngd->bqgrd', p_c.astype(vc.dtype), vc)
        imp = jnp.einsum('bgrqn,nj->bgqj', p_c, agg)
        cur = (t // SEL_LEN)[:, None]
        forced = (sel_j[None, :] == 0) | (sel_j[None, :] == cur) | (sel_j[None, :] == cur - 1)
        imp = jnp.where(forced, FORCE_SCORE, jnp.where(sel_j[None, :] <= cur, imp, -1.0))
        _, idx = lax.top_k(imp, top_k)
        ks = ksr[b_ix, g_ix, idx]
        vs = vsr[b_ix, g_ix, idx]
        s = jnp.einsum('bqgrd,bgqkld->bgrqkl', qblk, ks).astype(jnp.float32) * scale
        tok = idx[..., None] * SEL_LEN + sel_tok
        m = (tok <= t[None, None, :, None, None]).reshape(B, G, 1, Q_BLOCK, top_k * SEL_LEN)
        p_s = masked_softmax(s.reshape(B, G, R, Q_BLOCK, top_k * SEL_LEN), m)
        o_s = jnp.einsum('bgrqm,bgqmd->bqgrd', p_s.astype(vs.dtype),
                         vs.reshape(B, G, Q_BLOCK, top_k * SEL_LEN, Dh))
        kw = lax.dynamic_slice_in_dim(kwp, qb * Q_BLOCK, Q_BLOCK + WINDOW, axis=1)
        vw = lax.dynamic_slice_in_dim(vwp, qb * Q_BLOCK, Q_BLOCK + WINDOW, axis=1)
        kpos = qb * Q_BLOCK - WINDOW + win_off
        diff = t[:, None] - kpos[None, :]
        m = (kpos[None, :] >= 0) & (diff >= 0) & (diff < WINDOW)
        s = jnp.einsum('bqgrd,bkgd->bgrqk', qblk, kw).astype(jnp.float32) * scale
        p_w = masked_softmax(s, m)
        o_w = jnp.einsum('bgrqk,bkgd->bqgrd', p_w.astype(vw.dtype), vw)
        gg = jax.nn.sigmoid(gblk.astype(jnp.float32)).reshape(B, Q_BLOCK, G, R, N_BRANCH)
        o = gg[..., 0:1] * o_c + gg[..., 1:2] * o_s + gg[..., 2:3] * o_w
        return o.astype(qblk.dtype)

    out = lax.map(block, (jnp.arange(n_qb), q_blocks, g_blocks))
    return out.transpose(1, 0, 2, 3, 4, 5).reshape(B, S, H * Dh)


def gmlp_mixer(u, v, v_norm_g, w_s, b_s):
    B, S, _ = u.shape
    n_ch = S // GMLP_CHUNK
    u = jax.nn.gelu(u, approximate=False)
    v = jax.nn.gelu(v, approximate=False)
    vg = rms_norm(v.reshape(B, S, GMLP_GROUPS, GMLP_GROUP_DIM), v_norm_g)
    vg = vg.reshape(B, n_ch, GMLP_CHUNK, GMLP_GROUPS, GMLP_GROUP_DIM)
    tril = jnp.tril(jnp.ones((GMLP_CHUNK, GMLP_CHUNK), dtype=bool))
    ws = jnp.where(tril[None], w_s, 0.0).astype(vg.dtype)
    mixed = jnp.einsum('hts,bnshc->bnthc', ws, vg) + b_s.T[None, None, :, :, None]
    ug = u.reshape(B, n_ch, GMLP_CHUNK, GMLP_GROUPS, GMLP_GROUP_DIM)
    return (ug * mixed).reshape(B, S, GMLP_WIDTH)


def conv_glu_ffn(y, w_up, conv_w, conv_b, w_down):
    a = y @ w_up
    S = a.shape[1]
    c = conv_b
    for i in range(CONV_WIDTH):
        shift = CONV_WIDTH - 1 - i
        tap = a if shift == 0 else jnp.pad(a[:, :S - shift], ((0, 0), (shift, 0), (0, 0)))
        c = c + conv_w[i] * tap
    gate, up = jnp.split(c, 2, axis=-1)
    return (jax.nn.silu(gate) * up) @ w_down


def setup_inputs(seed: int = 0) -> dict:
    key = jax.random.key(seed)
    ks = jax.random.split(key, 24)
    f32 = jnp.float32
    nrm = lambda k, shape, s: jax.random.normal(k, shape, f32) * s
    L = DEPTH
    return {
        "x": jax.random.normal(ks[0], (BATCH, SEQ, D_MODEL), f32),
        "positions": jnp.broadcast_to(jnp.arange(SEQ, dtype=jnp.int32), (BATCH, SEQ)),
        "norm1_g": 1.0 + nrm(ks[1], (L, D_MODEL), 0.02),
        "w_in": nrm(ks[2], (L, D_MODEL, D_IN), D_MODEL ** -0.5),
        "cmp_pe_k": nrm(ks[3], (L, CMP_LEN, HEAD_DIM), 0.1),
        "cmp_w_k": nrm(ks[4], (L, CMP_LEN, HEAD_DIM, HEAD_DIM), (CMP_LEN * HEAD_DIM) ** -0.5),
        "cmp_pe_v": nrm(ks[5], (L, CMP_LEN, HEAD_DIM), 0.1),
        "cmp_w_v": nrm(ks[6], (L, CMP_LEN, HEAD_DIM, HEAD_DIM), (CMP_LEN * HEAD_DIM) ** -0.5),
        "gmlp_norm_g": 1.0 + nrm(ks[7], (L, GMLP_GROUPS, GMLP_GROUP_DIM), 0.02),
        "gmlp_w_s": nrm(ks[8], (L, GMLP_GROUPS, GMLP_CHUNK, GMLP_CHUNK), GMLP_CHUNK ** -0.5),
        "gmlp_b_s": 1.0 + nrm(ks[9], (L, GMLP_GROUPS, GMLP_CHUNK), 0.1),
        "nsa_out_g": 1.0 + nrm(ks[10], (L, NSA_WIDTH), 0.02),
        "gmlp_out_g": 1.0 + nrm(ks[11], (L, GMLP_WIDTH), 0.02),
        "w_out": nrm(ks[12], (L, NSA_WIDTH + GMLP_WIDTH, D_MODEL), (NSA_WIDTH + GMLP_WIDTH) ** -0.5),
        "norm2_g": 1.0 + nrm(ks[13], (L, D_MODEL), 0.02),
        "w_up": nrm(ks[14], (L, D_MODEL, 2 * D_FF), D_MODEL ** -0.5),
        "conv_w": nrm(ks[15], (L, CONV_WIDTH, 2 * D_FF), CONV_WIDTH ** -0.5),
        "conv_b": nrm(ks[16], (L, 2 * D_FF), 0.02),
        "w_down": nrm(ks[17], (L, D_FF, D_MODEL), D_FF ** -0.5),
        "final_g": 1.0 + nrm(ks[18], (D_MODEL,), 0.02),
    }


def reference(x, positions, norm1_g, w_in, cmp_pe_k, cmp_w_k, cmp_pe_v, cmp_w_v,
              gmlp_norm_g, gmlp_w_s, gmlp_b_s, nsa_out_g, gmlp_out_g, w_out,
              norm2_g, w_up, conv_w, conv_b, w_down, final_g):
    B, S, _ = x.shape
    h = x
    for l in range(DEPTH):
        xn = rms_norm(h, norm1_g[l])
        proj = xn @ w_in[l]
        q = proj[..., :Q_END].reshape(B, S, NSA_HEADS, HEAD_DIM)
        kv = proj[..., Q_END:KV_END].reshape(B, S, 6, NSA_KV_GROUPS, HEAD_DIM)
        gates = proj[..., KV_END:GATE_END].reshape(B, S, NSA_HEADS, N_BRANCH)
        u = proj[..., GATE_END:U_END]
        v = proj[..., U_END:]
        o_nsa = nsa_mixer(q, kv[:, :, 0], kv[:, :, 1], kv[:, :, 2], kv[:, :, 3],
                          kv[:, :, 4], kv[:, :, 5], gates, positions,
                          cmp_pe_k[l], cmp_w_k[l], cmp_pe_v[l], cmp_w_v[l])
        o_gmlp = gmlp_mixer(u, v, gmlp_norm_g[l], gmlp_w_s[l], gmlp_b_s[l])
        mix = jnp.concatenate([rms_norm(o_nsa, nsa_out_g[l]), rms_norm(o_gmlp, gmlp_out_g[l])], axis=-1)
        h = h + mix @ w_out[l]
        h = h + conv_glu_ffn(rms_norm(h, norm2_g[l]), w_up[l], conv_w[l], conv_b[l], w_down[l])
    return rms_norm(h, final_g)
```

```cpp
#include <hip/hip_runtime.h>
#include <cstdio>
#include <cstdint>

namespace pg8 {
#define PG8_LAS __attribute__((address_space(3)))
typedef unsigned short bf16_t;
typedef short bf16x8 __attribute__((ext_vector_type(8)));
typedef float f32x4 __attribute__((ext_vector_type(4)));
typedef unsigned u32x4 __attribute__((ext_vector_type(4)));
constexpr int BM = 256, BK = 64, HALF = 128, HTB = HALF * BK * 2  , STAGE_BYTES = 8 * HTB, NXCD = 8, WGM = 8;

__host__ __device__ __forceinline__ int lds_byte(int r, int c) { const int st = (r >> 4) * 2 + (c >> 5), rr = r & 15, cc = c & 31, ob = rr * 64 + cc * 2; return st * 1024 + (ob ^ (((ob >> 9) & 1) << 5)); }
__host__ __device__ __forceinline__ void stage_rc(int b, int& R, int& C) { const int st = b / 1024, sb = b % 1024, swz = sb ^ (((sb >> 9) & 1) << 5); R = (st >> 1) * 16 + swz / 64; C = (st & 1) * 32 + (swz % 64) / 2; }
__host__ __device__ __forceinline__ int perm32(int rho) { const int n = rho >> 4, i = rho & 15; return 8 * (i >> 2) + 4 * n + (i & 3); }

struct Unit { int pm, pn; };
struct Gemm { const bf16_t* A; const bf16_t* Bt; int M, N, K; };

struct StaticOrder {
    int nM, nN, nwg, G, c;
    __host__ __device__ void init(int M, int N, int G_, int c_) { nM = M / BM; nN = N / BM; nwg = nM * nN; G = G_; c = c_; }
    __host__ __device__ bool next(int i, Unit& u) const {
        const long L = (long)i * G + c; if (L >= nwg) return false;
        int wgid = (int)L; { const int q = nwg / NXCD, r = nwg % NXCD, xcd = wgid % NXCD, off = wgid / NXCD; wgid = (xcd < r ? xcd * (q + 1) : r * (q + 1) + (xcd - r) * q) + off; }
        const int nig = WGM * nN, gid = wgid / nig, fm = gid * WGM, gsz = (nM - fm) < WGM ? (nM - fm) : WGM;
        u.pm = fm + ((wgid % nig) % gsz); u.pn = (wgid % nig) / gsz; return true;
    }
    __device__ __forceinline__ void a_ready(const Unit&) const {}
    __device__ __forceinline__ void done(const Unit&) const {}
};

__device__ __forceinline__ unsigned cvt_pk_bf16(float lo, float hi) { unsigned r; asm volatile("v_cvt_pk_bf16_f32 %0, %1, %2" : "=v"(r) : "v"(lo), "v"(hi)); return r; }
typedef float f32x2 __attribute__((ext_vector_type(2)));
__device__ __forceinline__ f32x2 gelu_pk(f32x2 v) {
    const f32x2 av = __builtin_elementwise_abs(v), d = av * 0.2316418882f + 1.0f;
    f32x2 t; t.x = __builtin_amdgcn_rcpf(d.x); t.y = __builtin_amdgcn_rcpf(d.y);
    f32x2 q = t * 0.5307027145f + (-0.7265760135f); q = q * t + 0.7107068705f; q = q * t + (-0.142248368f); q = q * t + 0.127414796f; q = q * t;
    const f32x2 s = (v * v) * (-0.72134752044f);
    f32x2 e; e.x = __builtin_amdgcn_exp2f(s.x); e.y = __builtin_amdgcn_exp2f(s.y);
    const f32x2 m = v * (q * e), r = v - m;
    f32x2 o; o.x = v.x < 0.f ? m.x : r.x; o.y = v.y < 0.f ? m.y : r.y; return o;
}

template <int ACT  , bool BJ = false  > struct EpiBf16 {
    static constexpr bool PERM = true, AFTER_DRAIN = false; static constexpr bool BJ16 = BJ; static_assert(ACT == 0 || ACT == 1, "EpiBf16: ACT is 0 (none) or 1 (gelu_pk)");
    bf16_t* O; int ldc; const float* bias; int split_cols; size_t split_stride; float scale0;
    __device__ __forceinline__ void operator()(const f32x4 (&acc)[2][2][4][2], const Unit& u, int wr, int wc, int fr, int fq) const {
        const int row0 = u.pm * BM + wr * 64 + fr; int colt = u.pn * BM; bf16_t* base = O;
        float sc = 1.f; if (split_cols) { const int t = colt / split_cols; base += (size_t)t * split_stride; colt -= t * split_cols; if (t == 0) sc = scale0; }
        const int lc0 = BJ ? wc * 64 + 16 * fq : wc * 32 + 8 * fq, col0 = colt + lc0, bcol0 = u.pn * BM + lc0; constexpr int BJS = BJ ? 8 : HALF;
        f32x4 bv[2][2];
#pragma unroll
        for (int bj = 0; bj < 2; ++bj)
#pragma unroll
            for (int n = 0; n < 2; ++n) bv[bj][n] = bias ? *(const f32x4*)(bias + bcol0 + bj * BJS + 4 * n) : (f32x4){0.f, 0.f, 0.f, 0.f};
#pragma unroll
        for (int ai = 0; ai < 2; ++ai)
#pragma unroll
            for (int m = 0; m < 4; ++m) { bf16_t* rowp = base + (size_t)(row0 + ai * HALF + m * 16) * ldc + col0;
#pragma unroll
                for (int bj = 0; bj < 2; ++bj) { f32x4 v0 = acc[ai][bj][m][0] + bv[bj][0], v1 = acc[ai][bj][m][1] + bv[bj][1];
                    if (ACT == 1) { f32x2 a = gelu_pk((f32x2){v0[0], v0[1]}), b = gelu_pk((f32x2){v0[2], v0[3]}), c = gelu_pk((f32x2){v1[0], v1[1]}), d = gelu_pk((f32x2){v1[2], v1[3]});
                        v0 = (f32x4){a.x, a.y, b.x, b.y}; v1 = (f32x4){c.x, c.y, d.x, d.y}; }
                    v0 = v0 * sc; v1 = v1 * sc; u32x4 w; w.x = cvt_pk_bf16(v0[0], v0[1]); w.y = cvt_pk_bf16(v0[2], v0[3]); w.z = cvt_pk_bf16(v1[0], v1[1]); w.w = cvt_pk_bf16(v1[2], v1[3]);
                    *(u32x4*)(rowp + bj * BJS) = w; } }
    }
};

typedef int v8i32 __attribute__((ext_vector_type(8)));
typedef int v4i32 __attribute__((ext_vector_type(4)));
__device__ __forceinline__ v8i32 cat8(bf16x8 lo, bf16x8 hi) { const v4i32 a = __builtin_bit_cast(v4i32, lo), b = __builtin_bit_cast(v4i32, hi); return __builtin_shufflevector(a, b, 0, 1, 2, 3, 4, 5, 6, 7); }
__device__ __forceinline__ unsigned pk4_fp8(float a, float b, float c, float d) { int p = 0; p = __builtin_amdgcn_cvt_pk_fp8_f32(a, b, p, false); p = __builtin_amdgcn_cvt_pk_fp8_f32(c, d, p, true); return (unsigned)p; }
template <class Epi, class Sched, bool ALIGN_EPI = false, bool SP2 = false, bool FP8 = false>
__device__ __forceinline__ void gemm_phase(PG8_LAS unsigned char* lds, const Gemm g, const Sched& S, const Epi& E) {
    const int tid = threadIdx.x, wid = __builtin_amdgcn_readfirstlane(tid >> 6), lane = tid & 63, wr = wid >> 2, wc = wid & 3, fr = lane & 15, fq = lane >> 4;
    const int K = g.K, nt = K / BK;
    unsigned voffA[2], voffB[2];
#pragma unroll
    for (int i = 0; i < 2; ++i) { int R, C; stage_rc(tid * 16 + i * 8192, R, C); const int Rp = Epi::PERM ? ((R & ~31) + perm32(R & 31)) : R, Rb = Epi::BJ16 ? (16 * (Rp >> 3) + (Rp & 7)) : Rp;
        voffA[i] = (unsigned)(R * K + C) * 2u; voffB[i] = (unsigned)(Rb * K + C) * 2u; }
    const size_t kstep = (size_t)(BK * 2);
    const size_t hstep = (size_t)HALF * K * 2;
    const size_t hstepB = Epi::BJ16 ? (size_t)8 * K * 2 : hstep;
    const size_t tstep = 2 * hstep;
    const unsigned ldsw = (unsigned)wid * 1024u;
    const int aoff = lds_byte(wr * 64 + fr, fq * 8), boff = lds_byte(wc * 32 + fr, fq * 8);
    constexpr int akd = 1024, bkd = 1024;
#define PG8_SA(b, h) (((b) * 2 + (h)) * HTB)
#define PG8_SB(b, h) ((4 + (b) * 2 + (h)) * HTB)
#define PG8_STAGE(bufoff, gbase, voff) do { _Pragma("unroll") for (int _i = 0; _i < 2; ++_i) \
        __builtin_amdgcn_global_load_lds((const unsigned*)((const char*)(gbase) + (voff)[_i]), (PG8_LAS unsigned*)(lds + (bufoff) + ldsw + _i * 8192), 16, 0, 0); } while (0)
#define PG8_LDA(dst, b, h) do { if constexpr (FP8) { _Pragma("unroll") for (int m = 0; m < 4; ++m) dst##8[m] = cat8(*(const PG8_LAS bf16x8*)(lds + PG8_SA(b, h) + aoff + m * 2048), *(const PG8_LAS bf16x8*)(lds + PG8_SA(b, h) + aoff + m * 2048 + akd)); } \
    else { _Pragma("unroll") for (int m = 0; m < 4; ++m) _Pragma("unroll") for (int k = 0; k < 2; ++k) dst[m][k] = *(const PG8_LAS bf16x8*)(lds + PG8_SA(b, h) + aoff + m * 2048 + k * 1024); } } while (0)
#define PG8_LDB(dst, b, h) do { if constexpr (FP8) { _Pragma("unroll") for (int n = 0; n < 2; ++n) dst##8[n] = cat8(*(const PG8_LAS bf16x8*)(lds + PG8_SB(b, h) + boff + n * 2048), *(const PG8_LAS bf16x8*)(lds + PG8_SB(b, h) + boff + n * 2048 + bkd)); } \
    else { _Pragma("unroll") for (int n = 0; n < 2; ++n) _Pragma("unroll") for (int k = 0; k < 2; ++k) dst[n][k] = *(const PG8_LAS bf16x8*)(lds + PG8_SB(b, h) + boff + n * 2048 + k * 1024); } } while (0)
#define PG8_MMA(ai, bj, At, Bt) do { __builtin_amdgcn_s_setprio(1); _Pragma("unroll") for (int m = 0; m < 4; ++m) _Pragma("unroll") for (int n = 0; n < 2; ++n) { \
        if constexpr (FP8) { asm volatile("v_mfma_scale_f32_16x16x128_f8f6f4 %0, %1, %2, %0, %3, %3 op_sel_hi:[0,0,0]" : "+v"(acc[ai][bj][m][n]) : "v"(Bt##8[n]), "v"(At##8[m]), "v"(0x7f7f7f7f)); }   \
        else { _Pragma("unroll") for (int k = 0; k < 2; ++k) acc[ai][bj][m][n] = __builtin_amdgcn_mfma_f32_16x16x32_bf16(Bt[n][k], At[m][k], acc[ai][bj][m][n], 0, 0, 0); } } __builtin_amdgcn_s_setprio(0); } while (0)
#define PG8_WAIT_V(n) asm volatile("s_waitcnt vmcnt(" #n ")" ::: "memory")
#define PG8_WAIT_L(n) asm volatile("s_waitcnt lgkmcnt(" #n ")" ::: "memory")
#define PG8_BAR __builtin_amdgcn_s_barrier()
#define PG8_SCHED __builtin_amdgcn_sched_barrier(0)
    Unit cur, nxt; int ui = 0;
    if (!S.next(0, cur)) return;
    f32x4 acc[2][2][4][2];
#pragma unroll
    for (int a = 0; a < 2; ++a)
#pragma unroll
        for (int b = 0; b < 2; ++b)
#pragma unroll
            for (int m = 0; m < 4; ++m)
#pragma unroll
                for (int n = 0; n < 2; ++n) acc[a][b][m][n] = (f32x4){0.f, 0.f, 0.f, 0.f};
    bf16x8 At[4][2], B0[2][2], B1[2][2]; v8i32 At8[4], B08[2], B18[2];
    const char* cA = (const char*)g.A + (size_t)cur.pm * tstep; const char* cB = (const char*)g.Bt + (size_t)cur.pn * tstep;
    S.a_ready(cur);
    if constexpr (SP2) {
        PG8_STAGE(PG8_SB(0, 0), cB, voffB); PG8_STAGE(PG8_SB(0, 1), cB + hstepB, voffB); PG8_STAGE(PG8_SA(0, 0), cA, voffA); PG8_STAGE(PG8_SA(0, 1), cA + hstep, voffA);
        if (wr == 1) PG8_BAR;
        PG8_WAIT_V(2); PG8_BAR;
        PG8_STAGE(PG8_SB(1, 0), cB + kstep, voffB); PG8_STAGE(PG8_SA(1, 0), cA + kstep, voffA); PG8_STAGE(PG8_SB(1, 1), cB + hstepB + kstep, voffB);
        PG8_WAIT_V(6); PG8_BAR;
    } else {
        PG8_STAGE(PG8_SB(0, 0), cB, voffB); PG8_STAGE(PG8_SA(0, 0), cA, voffA); PG8_STAGE(PG8_SB(0, 1), cB + hstepB, voffB); PG8_STAGE(PG8_SA(0, 1), cA + hstep, voffA);
        if (wr == 1) PG8_BAR;
        PG8_WAIT_V(4); PG8_BAR;
        PG8_STAGE(PG8_SB(1, 0), cB + kstep, voffB); PG8_STAGE(PG8_SA(1, 0), cA + kstep, voffA); PG8_STAGE(PG8_SB(1, 1), cB + hstepB + kstep, voffB);
        PG8_WAIT_V(6); PG8_BAR;
    }
    for (;;) {
        const bool has_next = S.next(ui + 1, nxt);
        const char* nA = has_next ? (const char*)g.A + (size_t)nxt.pm * tstep : cA; const char* nB = has_next ? (const char*)g.Bt + (size_t)nxt.pn * tstep : cB;
        for (int t = 0; t < nt; t += 2) {
            const bool last = (t == nt - 2);
            const char* a1 = cA + (size_t)(t + 1) * kstep;
            const char* a2 = last ? nA : cA + (size_t)(t + 2) * kstep; const char* b2 = last ? nB : cB + (size_t)(t + 2) * kstep;
            const char* a3 = a2 + kstep; const char* b3 = b2 + kstep;
            if (last && has_next) S.a_ready(nxt);
            if constexpr (SP2) {
            PG8_LDB(B0, 0, 0); PG8_LDB(B1, 0, 1); PG8_SCHED; PG8_LDA(At, 0, 0); PG8_STAGE(PG8_SA(1, 1), a1 + hstep, voffA);
            PG8_WAIT_V(8); PG8_WAIT_L(0); PG8_BAR; PG8_MMA(0, 0, At, B0); PG8_MMA(0, 1, At, B1); PG8_BAR; PG8_SCHED;
            PG8_LDA(At, 0, 1); PG8_STAGE(PG8_SB(0, 0), b2, voffB); PG8_STAGE(PG8_SB(0, 1), b2 + hstepB, voffB); PG8_STAGE(PG8_SA(0, 0), a2, voffA);
            PG8_WAIT_V(8); PG8_WAIT_L(0); PG8_BAR; PG8_MMA(1, 0, At, B0); PG8_MMA(1, 1, At, B1); PG8_BAR; PG8_SCHED;
            PG8_LDB(B0, 1, 0); PG8_LDB(B1, 1, 1); PG8_SCHED; PG8_LDA(At, 1, 0); PG8_STAGE(PG8_SA(0, 1), a2 + hstep, voffA);
            PG8_WAIT_V(8); PG8_WAIT_L(0); PG8_BAR; PG8_MMA(0, 0, At, B0); PG8_MMA(0, 1, At, B1); PG8_BAR; PG8_SCHED;
            PG8_LDA(At, 1, 1); PG8_STAGE(PG8_SB(1, 0), b3, voffB); PG8_STAGE(PG8_SB(1, 1), b3 + hstepB, voffB); PG8_STAGE(PG8_SA(1, 0), a3, voffA);
            PG8_WAIT_V(8); PG8_WAIT_L(0); PG8_BAR; PG8_MMA(1, 0, At, B0); PG8_MMA(1, 1, At, B1); PG8_BAR; PG8_SCHED;
            } else {
            PG8_LDB(B0, 0, 0); PG8_SCHED; PG8_LDA(At, 0, 0); PG8_STAGE(PG8_SA(1, 1), a1 + hstep, voffA);
            PG8_WAIT_L(8); PG8_BAR; PG8_WAIT_L(0); PG8_MMA(0, 0, At, B0); PG8_BAR; PG8_SCHED;
            PG8_LDB(B1, 0, 1); PG8_STAGE(PG8_SB(0, 0), b2, voffB);
            PG8_BAR; PG8_WAIT_L(0); PG8_MMA(0, 1, At, B1); PG8_BAR;
            PG8_LDA(At, 0, 1); PG8_STAGE(PG8_SA(0, 0), a2, voffA);
            PG8_BAR; PG8_WAIT_L(0); PG8_MMA(1, 0, At, B0); PG8_BAR; PG8_SCHED;
            PG8_STAGE(PG8_SB(0, 1), b2 + hstepB, voffB);
            PG8_WAIT_V(6); PG8_BAR; PG8_MMA(1, 1, At, B1); PG8_BAR;
            PG8_LDB(B0, 1, 0); PG8_SCHED; PG8_LDA(At, 1, 0); PG8_STAGE(PG8_SA(0, 1), a2 + hstep, voffA);
            PG8_WAIT_L(8); PG8_BAR; PG8_WAIT_L(0); PG8_MMA(0, 0, At, B0); PG8_BAR; PG8_SCHED;
            PG8_LDB(B1, 1, 1); PG8_STAGE(PG8_SB(1, 0), b3, voffB);
            PG8_BAR; PG8_WAIT_L(0); PG8_MMA(0, 1, At, B1); PG8_BAR;
            PG8_LDA(At, 1, 1); PG8_STAGE(PG8_SA(1, 0), a3, voffA);
            PG8_BAR; PG8_WAIT_L(0); PG8_MMA(1, 0, At, B0); PG8_BAR; PG8_SCHED;
            PG8_STAGE(PG8_SB(1, 1), b3 + hstepB, voffB);
            PG8_WAIT_V(6); PG8_BAR; PG8_MMA(1, 1, At, B1); PG8_BAR;
            }
        }
        if constexpr (ALIGN_EPI) { if (wr == 0) PG8_BAR; }
        if constexpr (FP8) asm volatile("s_nop 15\n\ts_nop 15" ::: "memory");
        if constexpr (!Epi::AFTER_DRAIN) { E(acc, cur, wr, wc, fr, fq); S.done(cur); }
        if (!has_next) break;
#pragma unroll
        for (int a = 0; a < 2; ++a)
#pragma unroll
            for (int b = 0; b < 2; ++b)
#pragma unroll
                for (int m = 0; m < 4; ++m)
#pragma unroll
                    for (int n = 0; n < 2; ++n) acc[a][b][m][n] = (f32x4){0.f, 0.f, 0.f, 0.f};
        cur = nxt; cA = nA; cB = nB; ++ui;
        if constexpr (ALIGN_EPI) { if (wr == 1) PG8_BAR; }
    }
    PG8_WAIT_V(0);
    if constexpr (!ALIGN_EPI) { if (wr == 0) PG8_BAR; }
    PG8_BAR;
    if constexpr (Epi::AFTER_DRAIN) { E.fused(acc, cur, wr, wc, fr, fq, lds, wid, lane); S.done(cur); }
#undef PG8_SA
#undef PG8_SB
#undef PG8_STAGE
#undef PG8_LDA
#undef PG8_LDB
#undef PG8_MMA
#undef PG8_WAIT_V
#undef PG8_WAIT_L
#undef PG8_BAR
#undef PG8_SCHED
}
}

namespace pg8 {
typedef unsigned u32x2 __attribute__((ext_vector_type(2)));
template <int BF  , bool SS> struct EpiResid {
    static constexpr bool PERM = false, AFTER_DRAIN = false; static constexpr bool BJ16 = false;
    const float* res; float* out; bf16_t* ob; float* rowss; int ld; float ascale;
    __device__ __forceinline__ void operator()(const f32x4 (&acc)[2][2][4][2], const Unit& u, int wr, int wc, int fr, int fq) const {
        const int row0 = u.pm * BM + wr * 64 + fr, col0 = u.pn * BM + wc * 32 + 4 * fq;
#pragma unroll
        for (int ai = 0; ai < 2; ++ai)
#pragma unroll
            for (int m = 0; m < 4; ++m) { const int row = row0 + ai * HALF + m * 16; const size_t ro = (size_t)row * ld + col0; float ss = 0.f;
#pragma unroll
                for (int bj = 0; bj < 2; ++bj)
#pragma unroll
                    for (int n = 0; n < 2; ++n) { const size_t o = ro + bj * HALF + n * 16; const f32x4 r4 = *(const f32x4*)(res + o); const f32x4 v = acc[ai][bj][m][n] * ascale + r4;
                        *(f32x4*)(out + o) = v;
                        if (BF == 1) { u32x2 w; w.x = cvt_pk_bf16(v[0], v[1]); w.y = cvt_pk_bf16(v[2], v[3]); *(u32x2*)(ob + o) = w; }
                        if (BF == 2) { *(unsigned*)((unsigned char*)ob + o) = pk4_fp8(v[0], v[1], v[2], v[3]); }
                        if (SS) ss += (v[0] * v[0] + v[1] * v[1]) + (v[2] * v[2] + v[3] * v[3]); }
                if (SS) { ss += __shfl_xor(ss, 16); ss += __shfl_xor(ss, 32); if (fq == 0) atomicAdd(rowss + row, ss); } }
    }
};
struct EpiNull { static constexpr bool PERM = true, AFTER_DRAIN = false; static constexpr bool BJ16 = false; float* O;
    __device__ __forceinline__ void operator()(const f32x4 (&acc)[2][2][4][2], const Unit& u, int wr, int wc, int fr, int fq) const {
#pragma unroll
      for (int a = 0; a < 2; ++a)
#pragma unroll
        for (int b = 0; b < 2; ++b)
#pragma unroll
          for (int m = 0; m < 4; ++m)
#pragma unroll
            for (int n = 0; n < 2; ++n) asm volatile("" :: "v"(acc[a][b][m][n])); } };
template <bool RES_F32, bool F8, bool SS> struct EpiStream {
    static constexpr bool PERM = true, AFTER_DRAIN = false; static constexpr bool BJ16 = true;
    const float* resf; const bf16_t* resb; bf16_t* ob; unsigned char* o8; float* rowss; int ld; float ascale;
    __device__ __forceinline__ void operator()(const f32x4 (&acc)[2][2][4][2], const Unit& u, int wr, int wc, int fr, int fq) const {
        const int row0 = u.pm * BM + wr * 64 + fr, col0 = u.pn * BM + wc * 64 + 16 * fq;
#pragma unroll
        for (int ai = 0; ai < 2; ++ai)
#pragma unroll
            for (int m = 0; m < 4; ++m) { const int row = row0 + ai * HALF + m * 16; const size_t ro = (size_t)row * ld + col0; float ss = 0.f; f32x4 r4[4];
                if (RES_F32) {
#pragma unroll
                    for (int q = 0; q < 4; ++q) r4[q] = *(const f32x4*)(resf + ro + 4 * q); }
                else { const u32x4 ra = *(const u32x4*)(resb + ro), rb = *(const u32x4*)(resb + ro + 8); const unsigned rw[8] = {ra.x, ra.y, ra.z, ra.w, rb.x, rb.y, rb.z, rb.w};
#pragma unroll
                    for (int q = 0; q < 4; ++q) r4[q] = (f32x4){__builtin_bit_cast(float, rw[2 * q] << 16), __builtin_bit_cast(float, rw[2 * q] & 0xffff0000u), __builtin_bit_cast(float, rw[2 * q + 1] << 16), __builtin_bit_cast(float, rw[2 * q + 1] & 0xffff0000u)}; }
                f32x4 v[4];
#pragma unroll
                for (int q = 0; q < 4; ++q) { v[q] = acc[ai][q >> 1][m][q & 1] * ascale + r4[q]; if (SS) ss += (v[q][0] * v[q][0] + v[q][1] * v[q][1]) + (v[q][2] * v[q][2] + v[q][3] * v[q][3]); }
                u32x4 wa, wb; wa.x = cvt_pk_bf16(v[0][0], v[0][1]); wa.y = cvt_pk_bf16(v[0][2], v[0][3]); wa.z = cvt_pk_bf16(v[1][0], v[1][1]); wa.w = cvt_pk_bf16(v[1][2], v[1][3]);
                wb.x = cvt_pk_bf16(v[2][0], v[2][1]); wb.y = cvt_pk_bf16(v[2][2], v[2][3]); wb.z = cvt_pk_bf16(v[3][0], v[3][1]); wb.w = cvt_pk_bf16(v[3][2], v[3][3]);
                *(u32x4*)(ob + ro) = wa; *(u32x4*)(ob + ro + 8) = wb;
                if (F8) { u32x4 w8; w8.x = pk4_fp8(v[0][0], v[0][1], v[0][2], v[0][3]); w8.y = pk4_fp8(v[1][0], v[1][1], v[1][2], v[1][3]); w8.z = pk4_fp8(v[2][0], v[2][1], v[2][2], v[2][3]); w8.w = pk4_fp8(v[3][0], v[3][1], v[3][2], v[3][3]); *(u32x4*)(o8 + ro) = w8; }
                if (SS) { ss += __shfl_xor(ss, 16); ss += __shfl_xor(ss, 32); if (fq == 0) atomicAdd(rowss + row, ss); } }
    }
};
template <bool F8OUT> struct EpiScaleT {
    static constexpr bool PERM = true, AFTER_DRAIN = false; static constexpr bool BJ16 = F8OUT;
    bf16_t* O; int ldc; const float* rowss; float inv_n, eps, oscale;
    __device__ __forceinline__ void operator()(const f32x4 (&acc)[2][2][4][2], const Unit& u, int wr, int wc, int fr, int fq) const {
        const int row0 = u.pm * BM + wr * 64 + fr, col0 = u.pn * BM + wc * 32 + 8 * fq;
#pragma unroll
        for (int ai = 0; ai < 2; ++ai)
#pragma unroll
            for (int m = 0; m < 4; ++m) { const int row = row0 + ai * HALF + m * 16; const float rs = __builtin_amdgcn_rsqf(rowss[row] * inv_n + eps) * oscale;
                bf16_t* rowp = O + (size_t)row * ldc + col0;
                if (F8OUT) { const f32x4 v0 = acc[ai][0][m][0] * rs, v1 = acc[ai][0][m][1] * rs, v2 = acc[ai][1][m][0] * rs, v3 = acc[ai][1][m][1] * rs; u32x4 w;
                    w.x = pk4_fp8(v0[0], v0[1], v0[2], v0[3]); w.y = pk4_fp8(v1[0], v1[1], v1[2], v1[3]); w.z = pk4_fp8(v2[0], v2[1], v2[2], v2[3]); w.w = pk4_fp8(v3[0], v3[1], v3[2], v3[3]);
                    *(u32x4*)((unsigned char*)O + (size_t)row * ldc + u.pn * BM + wc * 64 + 16 * fq) = w; }
                else
#pragma unroll
                for (int bj = 0; bj < 2; ++bj) { const f32x4 v0 = acc[ai][bj][m][0] * rs, v1 = acc[ai][bj][m][1] * rs;
                    if (F8OUT) { }
                    else { u32x4 w; w.x = cvt_pk_bf16(v0[0], v0[1]); w.y = cvt_pk_bf16(v0[2], v0[3]); w.z = cvt_pk_bf16(v1[0], v1[1]); w.w = cvt_pk_bf16(v1[2], v1[3]);
                        *(u32x4*)(rowp + bj * HALF) = w; } } }
    }
};
typedef EpiScaleT<false> EpiScaleBf16;
}

constexpr int BATCH = 2, SEQ = 16384, DM = 2048, MTOK = BATCH * SEQ;
constexpr int DIN = 4632, NP1 = 4608;
constexpr int NP1A = 1536;
constexpr int HD = 128, NH = 8;
constexpr int COL_KCMP = 1024, COL_VCMP = 1280, COL_KSEL = 1536, COL_VSEL = 1792, COL_KWIN = 2048, COL_VWIN = 2304, WCOL_GATE = 2560  , COL_U = 2560, COL_V = 3584;
constexpr int DFF = 5632, DFF2 = 11264;
constexpr float EPS = 1e-6f;
constexpr float W8SCALE = 64.0f;
constexpr float C2 = 0.08838834764831845f * 1.4426950408889634f;
constexpr int NWAVES = 8, NTHR = 512;

constexpr size_t MiB = 1u << 20;
constexpr size_t WS_CTL = 0, CTL_ZERO_BYTES = 1 * MiB;
constexpr size_t WS_WIN = 1 * MiB, WS_WOUT = 20 * MiB, WS_WUP = 28 * MiB, WS_WDN = 72 * MiB, WS_WCK = 94 * MiB, WS_WCV = 95 * MiB, WS_WM = 96 * MiB;
constexpr size_t WS_KC8 = 123 * MiB  ;
constexpr size_t WS_COS = 97 * MiB, WS_SIN = 105 * MiB, WS_KC = 113 * MiB, WS_VCT = 114 * MiB, WS_KSEL = 115 * MiB, WS_KWIN = 131 * MiB, WS_VSELT = 147 * MiB, WS_VWINT = 163 * MiB;
constexpr size_t WS_TMASK = 179 * MiB, WS_H1B = 181 * MiB;
constexpr size_t WS_Q8 = 309 * MiB  ;
constexpr size_t WS_XN = 309 * MiB  , WS_QR = 373 * MiB  , WS_PROJ = 437 * MiB, WS_OC = 741 * MiB, WS_OS = 805 * MiB, WS_OW = 869 * MiB;
constexpr size_t WS_AH = 309 * MiB  , WS_HMID = 661 * MiB, WS_END = 1013 * MiB;
constexpr size_t WS_H1BF = 837 * MiB  , WS_H2BF = 309 * MiB  ;
constexpr size_t WS_WIN8 = 9 * MiB  , WS_XN8 = 741 * MiB  ;
constexpr size_t WS_WG = 96 * MiB + 512 * 1024  , WS_GATES = 1013 * MiB  , WS_END2 = 1015 * MiB;
static_assert(WS_PROJ + (size_t)MTOK * NP1 * 2 <= WS_OC && WS_AH + (size_t)MTOK * DFF2 <= WS_HMID && WS_HMID + (size_t)MTOK * DFF <= WS_END, "ws map");
constexpr int CW_BAR = 4096;
constexpr int CW_CCONST = 65536;
constexpr int CW_ROWSS = 131072;
static_assert(CW_BAR + 16 * 3456 <= CW_CCONST && (CW_ROWSS + MTOK) * 4 <= (int)CTL_ZERO_BYTES, "ctl map");
constexpr int LDS_BYTES = 147456;
constexpr int MISC_OFF = LDS_BYTES - 256;

#define GAS __attribute__((address_space(1)))
#define LAS __attribute__((address_space(3)))
typedef unsigned short bf16;
typedef unsigned v4u __attribute__((ext_vector_type(4)));
typedef unsigned v2u __attribute__((ext_vector_type(2)));
typedef float f32x4 __attribute__((ext_vector_type(4)));
typedef short bf16x8 __attribute__((ext_vector_type(8)));
__device__ __forceinline__ float bf2f(unsigned v) { return __builtin_bit_cast(float, v << 16); }
__device__ __forceinline__ float bflo(unsigned w) { return __builtin_bit_cast(float, w << 16); }
__device__ __forceinline__ float bfhi(unsigned w) { return __builtin_bit_cast(float, w & 0xffff0000u); }
__device__ __forceinline__ unsigned pk2(float lo, float hi) { return pg8::cvt_pk_bf16(lo, hi); }
__device__ __forceinline__ unsigned f2bf(float f) { return pg8::cvt_pk_bf16(f, 0.f) & 0xffffu; }
__device__ __forceinline__ float wave_sum(float v) {
#pragma unroll
    for (int o = 1; o < 64; o <<= 1) v += __shfl_xor(v, o);
    return v;
}
__device__ __forceinline__ float gelu_exact(float x) { return 0.5f * x * (1.0f + erff(x * 0.70710678118654752f)); }
__device__ __forceinline__ float sigmoidf(float x) { return __builtin_amdgcn_rcpf(1.0f + __builtin_amdgcn_exp2f(x * -1.4426950408889634f)); }
__device__ __forceinline__ f32x4 mfma16(bf16x8 a, bf16x8 b, f32x4 c) { return __builtin_amdgcn_mfma_f32_16x16x32_bf16(a, b, c, 0, 0, 0); }
__device__ __forceinline__ bf16x8 pack8(f32x4 a, f32x4 b) { v4u w; w.x = pk2(a[0], a[1]); w.y = pk2(a[2], a[3]); w.z = pk2(b[0], b[1]); w.w = pk2(b[2], b[3]); return __builtin_bit_cast(bf16x8, w); }
__device__ __forceinline__ int kpos_of(int k) { return (k & 32) | (((k >> 2) & 3) << 3) | (((k >> 4) & 1) << 2) | (k & 3); }


#define XB_TMO      128
#define XB_XCNT(j)  (256  + 64 * (j))
#define XB_XSUB(j)  (1280 + 64 * (j))
#define XB_XGEN(j)  (2304 + 64 * (j))
#define XB_TOP      3328
#define XB_TOPGEN   3392
#define XCD_BAR_WORDS 3456
#define XB_SPIN_CAP (1u << 18)

__device__ __forceinline__ unsigned xb_ld(unsigned* p)              { return __hip_atomic_load(p, __ATOMIC_RELAXED, __HIP_MEMORY_SCOPE_AGENT); }
__device__ __forceinline__ unsigned xb_add(unsigned* p, unsigned v) { return __hip_atomic_fetch_add(p, v, __ATOMIC_RELAXED, __HIP_MEMORY_SCOPE_AGENT); }
__device__ __forceinline__ unsigned xb_xcc_id() { return (unsigned)__builtin_amdgcn_s_getreg((3 << 11) | 20) & 0xFu; }
#define XB_SPIN(cond, bar) do { unsigned _sp = 0; while (cond) { __builtin_amdgcn_s_sleep(1); \
    if ((++_sp & 255u) == 0u) { if (xb_ld(&(bar)[XB_TMO])) break; if (_sp > XB_SPIN_CAP) { atomicAdd(&(bar)[XB_TMO], 1u); break; } } } } while (0)

struct XcdBarrier {
    unsigned* bar; unsigned x;
    volatile LAS unsigned* st;
};

__device__ __forceinline__ XcdBarrier xcd_barrier_post(unsigned* bar, volatile LAS unsigned* st) {
    XcdBarrier b; b.bar = bar; b.x = xb_xcc_id(); b.st = st;
    if (threadIdx.x == 0) (void)xb_add(&bar[XB_XCNT(b.x)], 1u);
    return b;
}
__device__ __forceinline__ void xcd_barrier_complete(unsigned* bar, unsigned x, unsigned& nloc, unsigned& nx) {
    const unsigned G = gridDim.x * gridDim.y * gridDim.z;
    unsigned sum, cnt, mine, sp = 0u;
    for (;;) {
        sum = 0u; cnt = 0u; mine = 0u;
#pragma unroll
        for (unsigned j = 0; j < 16; ++j) { const unsigned c = xb_ld(&bar[XB_XCNT(j)]); sum += c; cnt += (c > 0u) ? 1u : 0u; mine = (j == x) ? c : mine; }
        if (sum == G) break;
        __builtin_amdgcn_s_sleep(1);
        if ((++sp & 255u) == 0u) { if (xb_ld(&bar[XB_TMO])) break; if (sp > XB_SPIN_CAP) { atomicAdd(&bar[XB_TMO], 1u); break; } }
    }
    nloc = mine > 0u ? mine : 1u; nx = cnt > 0u ? cnt : 1u;
}

__device__ __forceinline__ void xcd_barrier(const XcdBarrier& b) {
    asm volatile("s_waitcnt vmcnt(0)" ::: "memory");
    __syncthreads();
    if (threadIdx.x == 0) {
        unsigned* bar = b.bar;
        __builtin_amdgcn_s_waitcnt(0);
        unsigned nloc = b.st[0], nx = b.st[1];
        if (nloc == 0u) { xcd_barrier_complete(bar, b.x, nloc, nx); b.st[0] = nloc; b.st[1] = nx; }
        const unsigned old = xb_add(&bar[XB_XSUB(b.x)], 1u);
        const unsigned gen = old / nloc;
        if (old + 1u == (gen + 1u) * nloc) {
            __builtin_amdgcn_fence(__ATOMIC_RELEASE, "agent");
            asm volatile("s_waitcnt vmcnt(0)" ::: "memory");
            const unsigned og = xb_add(&bar[XB_TOP], 1u);
            const unsigned tg = og / nx;
            if (og + 1u == (tg + 1u) * nx) xb_add(&bar[XB_TOPGEN], 1u);
            else XB_SPIN(xb_ld(&bar[XB_TOPGEN]) == tg, bar);
            __builtin_amdgcn_fence(__ATOMIC_ACQUIRE, "agent");
            xb_add(&bar[XB_XGEN(b.x)], 1u);
            asm volatile("s_waitcnt vmcnt(0)" ::: "memory");
        } else {
            XB_SPIN(xb_ld(&bar[XB_XGEN(b.x)]) == gen, bar);
            __builtin_amdgcn_fence(__ATOMIC_ACQUIRE, "agent");
            asm volatile("s_waitcnt vmcnt(0)" ::: "memory");
        }
    }
    __syncthreads();
}


struct Args { const void* in[20]; float* out; unsigned char* ws; int ph_lo, ph_hi, li, pad; };

__device__ __forceinline__ void transpose_unit(const float* W, int K, int ldw, int N, const float* ksc, bf16* WT, int kt, int nt, LAS float* tile, bool f8) {
    const int tid = threadIdx.x; f32x4 v[8]; float sc[8];
#pragma unroll
    for (int i = 0; i < 8; ++i) { const int idx = tid + NTHR * i, k = idx >> 6, n = 256 * nt + 4 * (idx & 63);
        v[i] = (f32x4){0.f, 0.f, 0.f, 0.f}; if (n < N) v[i] = *(const f32x4*)(W + (size_t)(64 * kt + k) * ldw + n); sc[i] = ksc ? ksc[64 * kt + k] : 1.f; }
#pragma unroll
    for (int i = 0; i < 8; ++i) { const int idx = tid + NTHR * i, k = idx >> 6; LAS float* t = tile + k * 257 + 4 * (idx & 63); t[0] = v[i][0] * sc[i]; t[1] = v[i][1] * sc[i]; t[2] = v[i][2] * sc[i]; t[3] = v[i][3] * sc[i]; }
    __syncthreads();
#pragma unroll
    for (int i = 0; i < 4; ++i) { const int idx = tid + NTHR * i, n = idx >> 3, kc = idx & 7; const LAS float* t = tile + (8 * kc) * 257 + n;
        if (256 * nt + n < N) {
            if (f8) { v2u o; o.x = pg8::pk4_fp8(t[0] * W8SCALE, t[257] * W8SCALE, t[514] * W8SCALE, t[771] * W8SCALE); o.y = pg8::pk4_fp8(t[1028] * W8SCALE, t[1285] * W8SCALE, t[1542] * W8SCALE, t[1799] * W8SCALE);
                *(v2u*)((unsigned char*)WT + (size_t)(256 * nt + n) * K + 64 * kt + 8 * kc) = o; }
            else { v4u o; o.x = pk2(t[0], t[257]); o.y = pk2(t[514], t[771]); o.z = pk2(t[1028], t[1285]); o.w = pk2(t[1542], t[1799]);
                *(v4u*)(WT + (size_t)(256 * nt + n) * K + 64 * kt + 8 * kc) = o; } } }
    __syncthreads();
}
__device__ __forceinline__ void p0_prologue(const Args& a, LAS unsigned char* lds, int wg, int G) {
    const int tid = threadIdx.x, lane = tid & 63, wave = tid >> 6;
    unsigned char* ws = a.ws;
    LAS float* tile = (LAS float*)lds;
    const float* w_in = (const float*)a.in[3]; const float* w_out = (const float*)a.in[13]; const float* w_up = (const float*)a.in[15]; const float* w_dn = (const float*)a.in[18];
    const float* wck = (const float*)a.in[5]; const float* wcv = (const float*)a.in[7]; const float* g2 = (const float*)a.in[14];
    constexpr int U_IN = 32 * 18, U_OUT = 32 * 8, U_UP = 32 * 44, U_DN = 88 * 8, U_C = 64;
    constexpr int NT = U_IN + U_OUT + U_UP + U_DN + 2 * U_C;
    for (int it = wg; it < NT; it += G) {
        int r = it; const float* W; int K, ldw, N, kt, nt; const float* ksc = nullptr; bf16* WT; bool f8 = false;
        if (r < U_IN) { kt = r / 18; nt = r % 18; K = DM; ldw = DIN;
            if (nt < 6) { W = w_in; N = NP1A; WT = (bf16*)(ws + WS_WIN); }
            else if (nt < 10) { W = w_in + NP1A; N = 1024; WT = (bf16*)(ws + WS_WIN8); nt -= 6; f8 = true; }
            else { W = w_in + 2584; N = 2048; WT = (bf16*)(ws + WS_WIN8 + (size_t)1024 * DM); nt -= 10; f8 = true; } }
        else if ((r -= U_IN) < U_UP) { W = w_up; K = DM; ldw = DFF2; N = DFF2; ksc = g2; WT = (bf16*)(ws + WS_WUP); kt = r / 44; nt = r % 44; f8 = true; }
        else if ((r -= U_UP) < U_DN) { W = w_dn; K = DFF; ldw = DM; N = DM; WT = (bf16*)(ws + WS_WDN); kt = r / 8; nt = r % 8; f8 = true; }
        else if ((r -= U_DN) < U_OUT) { W = w_out; K = DM; ldw = DM; N = DM; WT = (bf16*)(ws + WS_WOUT); kt = r / 8; nt = r % 8; f8 = true; }
        else if ((r -= U_OUT) < U_C) { W = wck; K = 4096; ldw = 128; N = 128; WT = (bf16*)(ws + WS_WCK); kt = r; nt = 0; }
        else { r -= U_C; W = wcv; K = 4096; ldw = 128; N = 128; WT = (bf16*)(ws + WS_WCV); kt = r; nt = 0; }
        transpose_unit(W, K, ldw, N, ksc, WT, kt, nt, tile, f8);
    }
    const int gt = wg * NTHR + tid, NGT = G * NTHR;
    { bf16* wgt = (bf16*)(ws + WS_WG); for (int i = gt; i < 32 * DM; i += NGT) { const int r = i >> 11, k = i & (DM - 1); wgt[i] = (bf16)f2bf(r < 24 ? w_in[(size_t)k * DIN + WCOL_GATE + r] : 0.f); } }
    { const float* wsp = (const float*)a.in[9]; bf16* wm = (bf16*)(ws + WS_WM);
      for (int i = gt; i < 8 * 128 * 128; i += NGT) { const int s = i & 127, t = (i >> 7) & 127; wm[i] = (bf16)f2bf(s <= t ? wsp[i] : 0.f); } }
    { const int* pos = (const int*)a.in[1]; float* ct = (float*)(ws + WS_COS); float* st = (float*)(ws + WS_SIN);
      for (int i = gt; i < MTOK * 64; i += NGT) { const int m = i >> 6, f = i & 63;
          const float inv = powf(10000.0f, -2.0f * (float)f / 128.0f); const float ang = (float)pos[m] * inv;
          const double ad = (double)ang; const double n = rint(ad * 0.15915494309189535); const float r = (float)(ad - n * 6.283185307179586);
          ct[i] = cosf(r); st[i] = sinf(r); } }
    for (int u = wg; u < 32; u += G) { const int kv = u >> 4, sl = u & 15; const float* pe = (const float*)a.in[kv ? 6 : 4]; const float* w = kv ? wcv : wck;
        const int e = tid & 127, sub = tid >> 7; const int k0 = sl * 256 + sub * 64; float s0 = 0.f, s1 = 0.f, s2 = 0.f, s3 = 0.f;
#pragma unroll 4
        for (int k = k0; k < k0 + 64; k += 4) { s0 += pe[k] * w[(size_t)k * 128 + e]; s1 += pe[k + 1] * w[(size_t)(k + 1) * 128 + e]; s2 += pe[k + 2] * w[(size_t)(k + 2) * 128 + e]; s3 += pe[k + 3] * w[(size_t)(k + 3) * 128 + e]; }
        __syncthreads(); tile[tid] = (s0 + s1) + (s2 + s3); __syncthreads();
        if (tid < 128) ((float*)(ws + WS_CTL) + CW_CCONST + (kv * 16 + sl) * 128)[tid] = (tile[tid] + tile[tid + 128]) + (tile[tid + 256] + tile[tid + 384]);
        __syncthreads(); }
    { const float* x = (const float*)a.in[0]; const float* g1 = (const float*)a.in[2]; bf16* xn = (bf16*)(ws + WS_XN);
      for (int m = wg * NWAVES + wave; m < MTOK; m += G * NWAVES) { const f32x4* xr = (const f32x4*)(x + (size_t)m * DM) + lane; f32x4 v[8]; float s = 0.f;
#pragma unroll
          for (int j = 0; j < 8; ++j) { v[j] = xr[64 * j]; s += (v[j][0] * v[j][0] + v[j][1] * v[j][1]) + (v[j][2] * v[j][2] + v[j][3] * v[j][3]); }
          const float rs = 1.0f / sqrtf(wave_sum(s) * (1.0f / DM) + EPS); v2u* o = (v2u*)(xn + (size_t)m * DM) + lane; unsigned* o8 = (unsigned*)(ws + WS_XN8 + (size_t)m * DM) + lane;
#pragma unroll
          for (int j = 0; j < 8; ++j) { const f32x4 gg = *((const f32x4*)g1 + lane + 64 * j); const float y0 = v[j][0] * rs * gg[0], y1 = v[j][1] * rs * gg[1], y2 = v[j][2] * rs * gg[2], y3 = v[j][3] * rs * gg[3];
              v2u w; w.x = pk2(y0, y1); w.y = pk2(y2, y3); o[64 * j] = w; o8[64 * j] = pg8::pk4_fp8(y0, y1, y2, y3); } } }
}

__device__ __forceinline__ void p1_gates(const Args& a, int wg, int G) {
    const int lane = threadIdx.x & 63, wave = __builtin_amdgcn_readfirstlane(threadIdx.x >> 6), c = lane & 15, g = lane >> 4;
    unsigned char* ws = a.ws; const bf16* xn = (const bf16*)(ws + WS_XN); const bf16* wgt = (const bf16*)(ws + WS_WG); bf16* gates = (bf16*)(ws + WS_GATES);
    for (int t = wg * NWAVES + wave; t < MTOK / 16; t += G * NWAVES) {
        const bf16* ap = xn + (size_t)(16 * t + c) * DM + 8 * g; const bf16* bp = wgt + (size_t)c * DM + 8 * g;
        f32x4 acc0 = (f32x4){0.f, 0.f, 0.f, 0.f}, acc1 = acc0;
#pragma unroll 4
        for (int ks = 0; ks < 64; ++ks) { const bf16x8 af = *(const bf16x8*)(ap + 32 * ks), b0 = *(const bf16x8*)(bp + 32 * ks), b1 = *(const bf16x8*)(bp + (size_t)16 * DM + 32 * ks);
            acc0 = mfma16(af, b0, acc0); acc1 = mfma16(af, b1, acc1); }
#pragma unroll
        for (int i = 0; i < 4; ++i) { bf16* o = gates + (size_t)(16 * t + 4 * g + i) * 32; o[c] = (bf16)f2bf(acc0[i]); o[16 + c] = (bf16)f2bf(acc1[i]); }
    }
}

__device__ __forceinline__ void rope8(v4u x1, v4u x2, const float* cs, const float* sn, v4u& o1, v4u& o2) {
    const f32x4 c0 = *(const f32x4*)cs, c1 = *(const f32x4*)(cs + 4), s0 = *(const f32x4*)sn, s1 = *(const f32x4*)(sn + 4);
    const float c[8] = {c0[0], c0[1], c0[2], c0[3], c1[0], c1[1], c1[2], c1[3]}, s[8] = {s0[0], s0[1], s0[2], s0[3], s1[0], s1[1], s1[2], s1[3]};
    float a[8], b[8];
#pragma unroll
    for (int j = 0; j < 4; ++j) { a[2 * j] = bflo(x1[j]); a[2 * j + 1] = bfhi(x1[j]); b[2 * j] = bflo(x2[j]); b[2 * j + 1] = bfhi(x2[j]); }
#pragma unroll
    for (int j = 0; j < 4; ++j) { o1[j] = pk2(a[2 * j] * c[2 * j] - b[2 * j] * s[2 * j], a[2 * j + 1] * c[2 * j + 1] - b[2 * j + 1] * s[2 * j + 1]);
        o2[j] = pk2(b[2 * j] * c[2 * j] + a[2 * j] * s[2 * j], b[2 * j + 1] * c[2 * j + 1] + a[2 * j + 1] * s[2 * j + 1]); }
}
__device__ __forceinline__ void rope8r(v4u x1, v4u x2, f32x4 c0, f32x4 c1, f32x4 s0, f32x4 s1, v4u& o1, v4u& o2) {
    const float c[8] = {c0[0], c0[1], c0[2], c0[3], c1[0], c1[1], c1[2], c1[3]}, s[8] = {s0[0], s0[1], s0[2], s0[3], s1[0], s1[1], s1[2], s1[3]};
    float a[8], b[8];
#pragma unroll
    for (int j = 0; j < 4; ++j) { a[2 * j] = bflo(x1[j]); a[2 * j + 1] = bfhi(x1[j]); b[2 * j] = bflo(x2[j]); b[2 * j + 1] = bfhi(x2[j]); }
#pragma unroll
    for (int j = 0; j < 4; ++j) { o1[j] = pk2(a[2 * j] * c[2 * j] - b[2 * j] * s[2 * j], a[2 * j + 1] * c[2 * j + 1] - b[2 * j + 1] * s[2 * j + 1]);
        o2[j] = pk2(b[2 * j] * c[2 * j] + a[2 * j] * s[2 * j], b[2 * j + 1] * c[2 * j + 1] + a[2 * j + 1] * s[2 * j + 1]); }
}
__device__ __forceinline__ void rope8rf(v4u x1, v4u x2, f32x4 c0, f32x4 c1, f32x4 s0, f32x4 s1, v4u& o1, v4u& o2, v2u& e1, v2u& e2, float fs) {
    const float c[8] = {c0[0], c0[1], c0[2], c0[3], c1[0], c1[1], c1[2], c1[3]}, s[8] = {s0[0], s0[1], s0[2], s0[3], s1[0], s1[1], s1[2], s1[3]};
    float a[8], b[8], ra[8], rb[8];
#pragma unroll
    for (int j = 0; j < 4; ++j) { a[2 * j] = bflo(x1[j]); a[2 * j + 1] = bfhi(x1[j]); b[2 * j] = bflo(x2[j]); b[2 * j + 1] = bfhi(x2[j]); }
#pragma unroll
    for (int j = 0; j < 8; ++j) { ra[j] = a[j] * c[j] - b[j] * s[j]; rb[j] = b[j] * c[j] + a[j] * s[j]; }
#pragma unroll
    for (int j = 0; j < 4; ++j) { o1[j] = pk2(ra[2 * j], ra[2 * j + 1]); o2[j] = pk2(rb[2 * j], rb[2 * j + 1]); }
#pragma unroll
    for (int j = 0; j < 8; ++j) { ra[j] *= fs; rb[j] *= fs; }
    e1.x = pg8::pk4_fp8(ra[0], ra[1], ra[2], ra[3]); e1.y = pg8::pk4_fp8(ra[4], ra[5], ra[6], ra[7]); e2.x = pg8::pk4_fp8(rb[0], rb[1], rb[2], rb[3]); e2.y = pg8::pk4_fp8(rb[4], rb[5], rb[6], rb[7]);
}
__device__ __forceinline__ int kpos8_of(int k) { return (((k >> 2) & 3) << 4) | ((k >> 4) << 2) | (k & 3); }
__device__ __forceinline__ void p2_prep(const Args& a, LAS unsigned char* lds, int wg, int G) {
    const int tid = threadIdx.x, lane = tid & 63, wave = __builtin_amdgcn_readfirstlane(tid >> 6), c = lane & 15, g = lane >> 4;
    unsigned char* ws = a.ws; const bf16* proj = (const bf16*)(ws + WS_PROJ);
    const float* COS = (const float*)(ws + WS_COS); const float* SIN = (const float*)(ws + WS_SIN);
    constexpr int NCU = 256, NPU = 512;
    for (int u = wg; u < NCU + NPU; u += G) {
        if (u < NCU) {
            const int kv = u >> 7, bg = (u >> 5) & 3, np = u & 31, b = bg >> 1, gk = bg & 1;
            const bf16* src = proj + (size_t)b * SEQ * NP1 + (kv ? COL_VCMP : COL_KCMP) + gk * 128 + 8 * g;
            const bf16* wt = (const bf16*)(ws + (kv ? WS_WCV : WS_WCK)) + (size_t)c * 4096 + 8 * g;
            f32x4 acc[2][8];
#pragma unroll
            for (int i = 0; i < 2; ++i)
#pragma unroll
                for (int e = 0; e < 8; ++e) acc[i][e] = (f32x4){0.f, 0.f, 0.f, 0.f};
#pragma unroll 4
            for (int kk = 0; kk < 16; ++kk) { const int ks = 16 * wave + kk, l = ks >> 2, d0 = 32 * (ks & 3); bf16x8 af[2];
#pragma unroll
                for (int i = 0; i < 2; ++i) { int tok = 16 * (32 * np + 16 * i + c) + l; tok = tok < SEQ ? tok : SEQ - 1; af[i] = *(const bf16x8*)(src + (size_t)tok * NP1 + d0); }
#pragma unroll
                for (int e = 0; e < 8; ++e) { const bf16x8 bfr = *(const bf16x8*)(wt + (size_t)(16 * e) * 4096 + 32 * ks);
                    acc[0][e] = mfma16(af[0], bfr, acc[0][e]); acc[1][e] = mfma16(af[1], bfr, acc[1][e]); } }
            LAS float* red = (LAS float*)lds;
#pragma unroll
            for (int i = 0; i < 2; ++i)
#pragma unroll
                for (int e = 0; e < 8; ++e)
#pragma unroll
                    for (int ii = 0; ii < 4; ++ii) red[(((wave * 2 + i) * 8 + e) * 4 + ii) * 64 + lane] = acc[i][e][ii];
            __syncthreads();
            { const int ls = tid & 63, ii = (tid >> 6) & 3, i = tid >> 8, gs = ls >> 4, cs_ = ls & 15; float val[8];
#pragma unroll
              for (int e = 0; e < 8; ++e) { float v = 0.f;
#pragma unroll
                  for (int w = 0; w < 8; ++w) v += red[(((w * 2 + i) * 8 + e) * 4 + ii) * 64 + ls];
                  val[e] = v; }
              const float* ccp = (const float*)(ws + WS_CTL) + CW_CCONST + kv * 16 * 128; float cc[128 / 16 * 0 + 8];
#pragma unroll
              for (int e = 0; e < 8; ++e) { float t = 0.f;
#pragma unroll
                  for (int sl = 0; sl < 16; ++sl) t += ccp[sl * 128 + 16 * e + cs_];
                  cc[e] = t; }
              bf16* kc = (bf16*)(ws + WS_KC) + (size_t)bg * 1024 * 128; bf16* vct = (bf16*)(ws + WS_VCT) + (size_t)bg * 16 * 8192;
              const int n = 32 * np + 16 * i + 4 * gs + ii; const bool ok = n < 1023;
              if (kv == 0) { const int mt = b * SEQ + (ok ? 16 * n + 31 : 0);
#pragma unroll
                  for (int e = 0; e < 4; ++e) { const int f = 16 * e + cs_; const float x1 = val[e] + cc[e], x2 = val[e + 4] + cc[e + 4], cs = COS[(size_t)mt * 64 + f], sn = SIN[(size_t)mt * 64 + f];
                      const float r1 = ok ? x1 * cs - x2 * sn : 0.f, r2 = ok ? x2 * cs + x1 * sn : 0.f; kc[(size_t)n * 128 + f] = (bf16)f2bf(r1); kc[(size_t)n * 128 + f + 64] = (bf16)f2bf(r2);
                      unsigned char* k8 = ws + WS_KC8 + (size_t)bg * 1024 * 128 + (size_t)n * 128 + f; k8[0] = (unsigned char)pg8::pk4_fp8(r1, 0.f, 0.f, 0.f); k8[64] = (unsigned char)pg8::pk4_fp8(r2, 0.f, 0.f, 0.f); } }
              else {
#pragma unroll
                  for (int e = 0; e < 8; ++e) { const int f = 16 * e + cs_; vct[(size_t)(n >> 6) * 8192 + f * 64 + kpos_of(n & 63)] = (bf16)f2bf(ok ? val[e] + cc[e] : 0.f); } } }
            __syncthreads();
        } else {
            const int pu = u - NCU, b = pu >> 8, kb = pu & 255; const size_t m0 = (size_t)b * SEQ + 64 * kb;
#pragma unroll
            for (int bt = 0; bt < 2; ++bt) { v4u x1[4], x2[4]; f32x4 cs[4][2], sn[4][2];
#pragma unroll
                for (int k = 0; k < 4; ++k) { const int it = tid + NTHR * (4 * bt + k), tk = it >> 6, h = (it >> 3) & 7, ch = it & 7;
                    const bf16* p = proj + (m0 + tk) * NP1 + h * 128 + 8 * ch; x1[k] = *(const v4u*)p; x2[k] = *(const v4u*)(p + 64);
                    const float* cp = COS + (m0 + tk) * 64 + 8 * ch; const float* sp = SIN + (m0 + tk) * 64 + 8 * ch;
                    cs[k][0] = *(const f32x4*)cp; cs[k][1] = *(const f32x4*)(cp + 4); sn[k][0] = *(const f32x4*)sp; sn[k][1] = *(const f32x4*)(sp + 4); }
#pragma unroll
                for (int k = 0; k < 4; ++k) { const int it = tid + NTHR * (4 * bt + k), tk = it >> 6, h = (it >> 3) & 7, ch = it & 7; v4u o1, o2;
                    v2u e1, e2; rope8rf(x1[k], x2[k], cs[k][0], cs[k][1], sn[k][0], sn[k][1], o1, o2, e1, e2, 8.0f * C2); bf16* q = (bf16*)(ws + WS_QR) + (m0 + tk) * 1024 + h * 128 + 8 * ch; *(v4u*)q = o1; *(v4u*)(q + 64) = o2;
                    unsigned char* q8 = ws + WS_Q8 + (m0 + tk) * 1024 + h * 128 + 8 * ch; *(v2u*)q8 = e1; *(v2u*)(q8 + 64) = e2; } }
            { v4u x1[4], x2[4]; f32x4 cs[4][2], sn[4][2];
#pragma unroll
                for (int k = 0; k < 4; ++k) { const int it = tid + NTHR * k, tk = it >> 5, wh = (it >> 4) & 1, gk = (it >> 3) & 1, ch = it & 7;
                    const bf16* p = proj + (m0 + tk) * NP1 + (wh ? COL_KWIN : COL_KSEL) + gk * 128 + 8 * ch; x1[k] = *(const v4u*)p; x2[k] = *(const v4u*)(p + 64);
                    const float* cp = COS + (m0 + tk) * 64 + 8 * ch; const float* sp = SIN + (m0 + tk) * 64 + 8 * ch;
                    cs[k][0] = *(const f32x4*)cp; cs[k][1] = *(const f32x4*)(cp + 4); sn[k][0] = *(const f32x4*)sp; sn[k][1] = *(const f32x4*)(sp + 4); }
#pragma unroll
                for (int k = 0; k < 4; ++k) { const int it = tid + NTHR * k, tk = it >> 5, wh = (it >> 4) & 1, gk = (it >> 3) & 1, ch = it & 7; v4u o1, o2;
                    v2u e1, e2; rope8rf(x1[k], x2[k], cs[k][0], cs[k][1], sn[k][0], sn[k][1], o1, o2, e1, e2, 1.0f);
                    unsigned char* d = ws + (wh ? WS_KWIN : WS_KSEL) + ((size_t)(b * 2 + gk) * SEQ + 64 * kb + tk) * 128 + 8 * ch; *(v2u*)d = e1; *(v2u*)(d + 64) = e2; } }
            LAS unsigned char* T8 = lds;
            { v4u v[8];
#pragma unroll
                for (int k = 0; k < 8; ++k) { const int it = tid + NTHR * k, q = it >> 10, tk = (it >> 4) & 63, ch = it & 15, wh = q >> 1, gk = q & 1;
                    v[k] = *(const v4u*)(proj + (m0 + tk) * NP1 + (wh ? COL_VWIN : COL_VSEL) + gk * 128 + 8 * ch); }
#pragma unroll
                for (int k = 0; k < 8; ++k) { const int it = tid + NTHR * k, q = it >> 10, tk = (it >> 4) & 63, ch = it & 15;
                    LAS unsigned char* t = T8 + q * (128 * 80) + (8 * ch) * 80 + kpos8_of(tk);
                    const unsigned w0 = pg8::pk4_fp8(bflo(v[k][0]), bfhi(v[k][0]), bflo(v[k][1]), bfhi(v[k][1])), w1 = pg8::pk4_fp8(bflo(v[k][2]), bfhi(v[k][2]), bflo(v[k][3]), bfhi(v[k][3]));
#pragma unroll
                    for (int j = 0; j < 4; ++j) { t[j * 80] = (unsigned char)(w0 >> (8 * j)); t[(4 + j) * 80] = (unsigned char)(w1 >> (8 * j)); } } }
            __syncthreads();
#pragma unroll
            for (int k = 0; k < 4; ++k) { const int it = tid + NTHR * k, q = it >> 9, d = (it >> 2) & 127, ch = it & 3, wh = q >> 1, gk = q & 1;
                *(v4u*)(ws + (wh ? WS_VWINT : WS_VSELT) + ((size_t)(b * 2 + gk) * 256 + kb) * 8192 + d * 64 + 16 * ch) = *(const LAS v4u*)(T8 + q * (128 * 80) + d * 80 + 16 * ch); }
            __syncthreads();
        }
    }
}

constexpr int KL_STRIDE = 272, VL_STRIDE = 144, KL_BYTES = 64 * KL_STRIDE, VL_BYTES = 128 * VL_STRIDE;
__device__ __forceinline__ void stage_load(const bf16* src, v4u (&r)[2]) {
#pragma unroll
    for (int i = 0; i < 2; ++i) r[i] = *(const v4u*)((const char*)src + (size_t)(threadIdx.x + 512 * i) * 16);
}
__device__ __forceinline__ void stage_write_k(LAS unsigned char* Kl, const v4u (&r)[2]) {
#pragma unroll
    for (int i = 0; i < 2; ++i) { const int id = threadIdx.x + 512 * i; *(LAS v4u*)(Kl + (id >> 4) * KL_STRIDE + (id & 15) * 16) = r[i]; }
}
__device__ __forceinline__ void stage_write_v(LAS unsigned char* Vl, const v4u (&r)[2]) {
#pragma unroll
    for (int i = 0; i < 2; ++i) { const int id = threadIdx.x + 512 * i; *(LAS v4u*)(Vl + (id >> 3) * VL_STRIDE + (id & 7) * 16) = r[i]; }
}
__device__ __forceinline__ void qk_tile(const LAS unsigned char* Kl, const bf16x8 (&qf)[4], f32x4 (&s)[4], int c, int g) {
#pragma unroll
    for (int kt = 0; kt < 4; ++kt) { s[kt] = (f32x4){0.f, 0.f, 0.f, 0.f};
#pragma unroll
        for (int ks = 0; ks < 4; ++ks) { const bf16x8 kf = *(const LAS bf16x8*)(Kl + (16 * kt + c) * KL_STRIDE + (32 * ks + 8 * g) * 2); s[kt] = mfma16(kf, qf[ks], s[kt]); } }
}
__device__ __forceinline__ void pv_tile(const LAS unsigned char* Vl, const f32x4 (&p)[4], f32x4 (&o)[8], int c, int g) {
#pragma unroll
    for (int s2 = 0; s2 < 2; ++s2) { const bf16x8 pf = pack8(p[2 * s2], p[2 * s2 + 1]);
#pragma unroll
        for (int dt = 0; dt < 8; ++dt) { const bf16x8 vf = *(const LAS bf16x8*)(Vl + (16 * dt + c) * VL_STRIDE + (32 * s2 + 8 * g) * 2); o[dt] = mfma16(vf, pf, o[dt]); } }
}
__device__ __forceinline__ void online_sm(f32x4 (&s)[4], float& m, float& l, float& alpha) {
    float tm = fmaxf(fmaxf(s[0][0], s[0][1]), fmaxf(s[0][2], s[0][3]));
#pragma unroll
    for (int kt = 1; kt < 4; ++kt) tm = fmaxf(tm, fmaxf(fmaxf(s[kt][0], s[kt][1]), fmaxf(s[kt][2], s[kt][3])));
    tm = fmaxf(tm, __shfl_xor(tm, 16)); tm = fmaxf(tm, __shfl_xor(tm, 32));
    const float mn = fmaxf(m, tm); alpha = __builtin_amdgcn_exp2f((m - mn) * C2); m = mn; float ls = 0.f;
#pragma unroll
    for (int kt = 0; kt < 4; ++kt)
#pragma unroll
        for (int i = 0; i < 4; ++i) { const float p = __builtin_amdgcn_exp2f((s[kt][i] - mn) * C2); s[kt][i] = p; ls += p; }
    l = l * alpha + ls;
}
__device__ __forceinline__ void load_qf(const bf16* qr, size_t mrow, int head, int g, bf16x8 (&qf)[4]) {
#pragma unroll
    for (int ks = 0; ks < 4; ++ks) qf[ks] = *(const bf16x8*)(qr + mrow * 1024 + head * 128 + 32 * ks + 8 * g);
}
__device__ __forceinline__ void pin_qf(bf16x8 (&qf)[2][4]) {
#pragma unroll
    for (int cs = 0; cs < 2; ++cs)
#pragma unroll
        for (int ks = 0; ks < 4; ++ks) asm volatile("" : "+v"(qf[cs][ks]));
}
__device__ __forceinline__ void store_o(bf16* O, size_t mrow, int head, int g, const f32x4 (&o)[8], float inv) {
#pragma unroll
    for (int dt = 0; dt < 8; ++dt) { v2u w; w.x = pk2(o[dt][0] * inv, o[dt][1] * inv); w.y = pk2(o[dt][2] * inv, o[dt][3] * inv); *(v2u*)(O + mrow * 1024 + head * 128 + 16 * dt + 4 * g) = w; }
}
__device__ __forceinline__ void unit_bq(int u, int& bg, int& qt) { bg = u >> 8; const int x = u & 255; qt = (bg & 1) ? 255 - x : x; }


constexpr int SLOT_BYTES = 32768, TMK_OFF = 132096;
#define WAITV(n) asm volatile("s_waitcnt vmcnt(" #n ")" ::: "memory")
#define RAWBAR() do { asm volatile("" ::: "memory"); __builtin_amdgcn_s_barrier(); asm volatile("" ::: "memory"); } while (0)
__device__ __forceinline__ void dma_k(LAS unsigned char* slot, const bf16* ksrc, int wave, int lane) {
#pragma unroll
    for (int r = 0; r < 2; ++r) { const int row = 4 * wave + (lane >> 4) + 32 * r, pos = lane & 15;
        __builtin_amdgcn_global_load_lds((const unsigned*)(ksrc + row * 128 + ((pos ^ (row & 15)) * 8)), (LAS unsigned*)(slot + wave * 1024 + r * 8192), 16, 0, 0); }
}
__device__ __forceinline__ void dma_v(LAS unsigned char* slot, const bf16* vsrc, int wave, int lane) {
#pragma unroll
    for (int r = 0; r < 2; ++r) { const int d = 8 * wave + (lane >> 3) + 64 * r, pos = lane & 7;
        __builtin_amdgcn_global_load_lds((const unsigned*)(vsrc + d * 64 + ((pos ^ ((d >> 1) & 7)) * 8)), (LAS unsigned*)(slot + 16384 + wave * 1024 + r * 8192), 16, 0, 0); }
}
__device__ __forceinline__ void qk_tile_sw(const LAS unsigned char* slot, const bf16x8 (&qf)[4], f32x4 (&s)[4], const int (&kx)[4]) {
#pragma unroll
    for (int kt = 0; kt < 4; ++kt) { s[kt] = (f32x4){0.f, 0.f, 0.f, 0.f};
#pragma unroll
        for (int ks = 0; ks < 4; ++ks) { const bf16x8 kf = *(const LAS bf16x8*)(slot + kt * 4096 + kx[ks]); s[kt] = mfma16(kf, qf[ks], s[kt]); } }
}
__device__ __forceinline__ void pv_tile_sw(const LAS unsigned char* slot, const f32x4 (&p)[4], f32x4 (&o)[8], const int (&vx)[2]) {
#pragma unroll
    for (int s2 = 0; s2 < 2; ++s2) { const bf16x8 pf = pack8(p[2 * s2], p[2 * s2 + 1]);
#pragma unroll
        for (int dt = 0; dt < 8; ++dt) { const bf16x8 vf = *(const LAS bf16x8*)(slot + 16384 + dt * 2048 + vx[s2]); o[dt] = mfma16(vf, pf, o[dt]); } }
}
__device__ __forceinline__ float lmax16(float x) { const unsigned u = __builtin_bit_cast(unsigned, x); auto r = __builtin_amdgcn_permlane16_swap(u, u, false, false); unsigned r0 = r[0], r1 = r[1]; asm volatile("" : "+v"(r1)); return fmaxf(__builtin_bit_cast(float, r0), __builtin_bit_cast(float, r1)); }
__device__ __forceinline__ float lmax32(float x) { const unsigned u = __builtin_bit_cast(unsigned, x); auto r = __builtin_amdgcn_permlane32_swap(u, u, false, false); unsigned r0 = r[0], r1 = r[1]; asm volatile("" : "+v"(r1)); return fmaxf(__builtin_bit_cast(float, r0), __builtin_bit_cast(float, r1)); }
__device__ __forceinline__ float ladd16(float x) { const unsigned u = __builtin_bit_cast(unsigned, x); auto r = __builtin_amdgcn_permlane16_swap(u, u, false, false); unsigned r0 = r[0], r1 = r[1]; asm volatile("" : "+v"(r1)); return __builtin_bit_cast(float, r0) + __builtin_bit_cast(float, r1); }
__device__ __forceinline__ float ladd32(float x) { const unsigned u = __builtin_bit_cast(unsigned, x); auto r = __builtin_amdgcn_permlane32_swap(u, u, false, false); unsigned r0 = r[0], r1 = r[1]; asm volatile("" : "+v"(r1)); return __builtin_bit_cast(float, r0) + __builtin_bit_cast(float, r1); }
__device__ __forceinline__ void online_sm2(f32x4 (&s)[4], float& m, float& l, float& alpha) {
    float tm = fmaxf(fmaxf(s[0][0], s[0][1]), fmaxf(s[0][2], s[0][3]));
#pragma unroll
    for (int kt = 1; kt < 4; ++kt) tm = fmaxf(tm, fmaxf(fmaxf(s[kt][0], s[kt][1]), fmaxf(s[kt][2], s[kt][3])));
    tm = lmax16(tm); tm = lmax32(tm);
    const float mn = fmaxf(m, tm); alpha = __builtin_amdgcn_exp2f((m - mn) * C2); m = mn; float ls = 0.f;
#pragma unroll
    for (int kt = 0; kt < 4; ++kt)
#pragma unroll
        for (int i = 0; i < 4; ++i) { const float p = __builtin_amdgcn_exp2f((s[kt][i] - mn) * C2); s[kt][i] = p; ls += p; }
    l = l * alpha + ls;
}

__device__ __forceinline__ void qk2(const LAS unsigned char* slot, const bf16x8 (&qf)[2][4], f32x4 (&s)[2][4], const int (&kx)[4]) {
    bf16x8 kf[4][4];
#pragma unroll
    for (int kt = 0; kt < 4; ++kt)
#pragma unroll
        for (int ks = 0; ks < 4; ++ks) kf[kt][ks] = *(const LAS bf16x8*)(slot + kt * 4096 + kx[ks]);
    __builtin_amdgcn_sched_barrier(0);
#pragma unroll
    for (int kt = 0; kt < 4; ++kt) { s[0][kt] = (f32x4){0.f, 0.f, 0.f, 0.f}; s[1][kt] = (f32x4){0.f, 0.f, 0.f, 0.f};
#pragma unroll
        for (int ks = 0; ks < 4; ++ks) { s[0][kt] = mfma16(kf[kt][ks], qf[0][ks], s[0][kt]); s[1][kt] = mfma16(kf[kt][ks], qf[1][ks], s[1][kt]); } }
}
__device__ __forceinline__ void pv2(const LAS unsigned char* slot, const f32x4 (&p)[2][4], f32x4 (&o)[2][8], const int (&vx)[2]) {
#pragma unroll
    for (int s2 = 0; s2 < 2; ++s2) { const bf16x8 pf0 = pack8(p[0][2 * s2], p[0][2 * s2 + 1]), pf1 = pack8(p[1][2 * s2], p[1][2 * s2 + 1]);
#pragma unroll
        for (int dt = 0; dt < 8; ++dt) { const bf16x8 vf = *(const LAS bf16x8*)(slot + 16384 + dt * 2048 + vx[s2]); o[0][dt] = mfma16(vf, pf0, o[0][dt]); o[1][dt] = mfma16(vf, pf1, o[1][dt]); } }
}
__device__ __forceinline__ void pv2l(const LAS unsigned char* slot, const f32x4 (&p)[2][4], f32x4 (&o)[2][8], f32x4 (&lacc)[2], const int (&vx)[2]) {
    const bf16x8 ones8 = __builtin_bit_cast(bf16x8, (v4u){0x3f803f80u, 0x3f803f80u, 0x3f803f80u, 0x3f803f80u});
#pragma unroll
    for (int s2 = 0; s2 < 2; ++s2) { const bf16x8 pf0 = pack8(p[0][2 * s2], p[0][2 * s2 + 1]), pf1 = pack8(p[1][2 * s2], p[1][2 * s2 + 1]);
        lacc[0] = mfma16(ones8, pf0, lacc[0]); lacc[1] = mfma16(ones8, pf1, lacc[1]);
#pragma unroll
        for (int dt = 0; dt < 8; ++dt) { const bf16x8 vf = *(const LAS bf16x8*)(slot + 16384 + dt * 2048 + vx[s2]); o[0][dt] = mfma16(vf, pf0, o[0][dt]); o[1][dt] = mfma16(vf, pf1, o[1][dt]); } }
}
__device__ __forceinline__ float quad_sum(float x) {
    const float y = x + __builtin_bit_cast(float, __builtin_amdgcn_mov_dpp(__builtin_bit_cast(int, x), 0xB1, 0xf, 0xf, true));
    return y + __builtin_bit_cast(float, __builtin_amdgcn_mov_dpp(__builtin_bit_cast(int, y), 0x4E, 0xf, 0xf, true));
}
template <bool HAS_O> __device__ __forceinline__ void sm_lean(f32x4 (&s)[4], float& m, float& l, f32x4 (&o)[8], bool rowok) {
    float tm = fmaxf(fmaxf(s[0][0], s[0][1]), fmaxf(s[0][2], s[0][3]));
#pragma unroll
    for (int kt = 1; kt < 4; ++kt) tm = fmaxf(tm, fmaxf(fmaxf(s[kt][0], s[kt][1]), fmaxf(s[kt][2], s[kt][3])));
    tm = lmax16(tm); tm = lmax32(tm);
    tm = rowok ? tm : -__builtin_inff();
    const float mn = fmaxf(m, tm), alpha = __builtin_amdgcn_exp2f((m - mn) * C2); m = mn;
    const float mb = rowok ? mn * C2 : __builtin_inff(); float ls = 0.f;
#pragma unroll
    for (int kt = 0; kt < 4; ++kt)
#pragma unroll
        for (int i = 0; i < 4; ++i) { const float p = __builtin_amdgcn_exp2f(__builtin_fmaf(s[kt][i], C2, -mb)); s[kt][i] = p; ls += p; }
    l = l * alpha + ls;
    if (HAS_O) { if (!__all(alpha == 1.0f)) {
#pragma unroll
        for (int dt = 0; dt < 8; ++dt) o[dt] = o[dt] * alpha; } }
}
__device__ __forceinline__ float row16_sum(float x) {
    x = quad_sum(x);
    x += __builtin_bit_cast(float, __builtin_amdgcn_mov_dpp(__builtin_bit_cast(int, x), 0x141, 0xf, 0xf, true));
    x += __builtin_bit_cast(float, __builtin_amdgcn_mov_dpp(__builtin_bit_cast(int, x), 0x140, 0xf, 0xf, true));
    return x;
}
__device__ __forceinline__ float wave_sum_v(float x) { return ladd32(ladd16(row16_sum(x))); }
__device__ __forceinline__ float amax3(float a, float b, float c) { float r; asm("v_max3_f32 %0, %1, %2, %3" : "=v"(r) : "v"(a), "v"(b), "v"(c)); return r; }
__device__ __forceinline__ float amax2(float a, float b) { float r; asm("v_max_f32 %0, %1, %2" : "=v"(r) : "v"(a), "v"(b)); return r; }
__device__ __forceinline__ float xmax16(float x) { const unsigned u = __builtin_bit_cast(unsigned, x); auto r = __builtin_amdgcn_permlane16_swap(u, u, false, false); unsigned r0 = r[0], r1 = r[1]; asm volatile("" : "+v"(r1)); return amax2(__builtin_bit_cast(float, r0), __builtin_bit_cast(float, r1)); }
__device__ __forceinline__ float xmax32(float x) { const unsigned u = __builtin_bit_cast(unsigned, x); auto r = __builtin_amdgcn_permlane32_swap(u, u, false, false); unsigned r0 = r[0], r1 = r[1]; asm volatile("" : "+v"(r1)); return amax2(__builtin_bit_cast(float, r0), __builtin_bit_cast(float, r1)); }
constexpr float SM_THR = 10.0f;
__device__ __forceinline__ void sm_fast(f32x4 (&s)[4], float& m, f32x4& lacc, f32x4 (&o)[8], bool rowok) {
    float tm = amax3(amax3(s[0][0], s[0][1], s[0][2]), amax3(s[0][3], s[1][0], s[1][1]), amax3(s[1][2], s[1][3], s[2][0]));
    tm = amax3(tm, amax3(s[2][1], s[2][2], s[2][3]), amax3(s[3][0], s[3][1], s[3][2])); tm = amax2(tm, s[3][3]);
    tm = xmax16(tm); tm = xmax32(tm);
    tm = rowok ? tm : -__builtin_inff();
    if (__any((tm - m) * C2 > SM_THR)) { const float mn = amax2(m, tm), alpha = __builtin_amdgcn_exp2f((m - mn) * C2); m = mn; lacc = lacc * alpha;
#pragma unroll
        for (int dt = 0; dt < 8; ++dt) o[dt] = o[dt] * alpha; }
    const float mb = rowok ? m * C2 : __builtin_inff();
#pragma unroll
    for (int kt = 0; kt < 4; ++kt)
#pragma unroll
        for (int i = 0; i < 4; ++i) s[kt][i] = __builtin_amdgcn_exp2f(__builtin_fmaf(s[kt][i], C2, -mb));
}
#define SWZ_OFFSETS() int kx[4], vx[2]; \
    _Pragma("unroll") for (int ks_ = 0; ks_ < 4; ++ks_) kx[ks_] = c * 256 + ((((g ^ c) & 15) << 4) ^ (ks_ << 6)); \
    _Pragma("unroll") for (int s2_ = 0; s2_ < 2; ++s2_) vx[s2_] = c * 128 + ((((g ^ (c >> 1)) & 7) << 4) ^ (s2_ << 6))

__device__ __forceinline__ void unit_sel(int wg, int r, int G, int& bg, int& qt) {
    if (G == 256) { const int x = wg & 7, i = wg >> 3, k = (r & 1) ? (96 - 32 * r + i) : (127 - 32 * r - i); bg = x >> 1; qt = (x & 1) + 2 * k; }
    else unit_bq(wg + r * G, bg, qt);
}

using pg8::v8i32; using pg8::f32x2;
constexpr int SLOT8 = 16384, SELB = 4;
static_assert(2 * SELB * SLOT8 <= TMK_OFF, "sel ring");
constexpr float SM_THR8 = 8.0f;
__device__ __forceinline__ void dma_k8(LAS unsigned char* slot, const unsigned char* ksrc, int wave, int lane) {
    const unsigned row = 8u * wave + (lane >> 3), pos = lane & 7, off = row * 128u + ((pos ^ ((row >> 1) & 7u)) * 16u);
    __builtin_amdgcn_global_load_lds((const unsigned*)(ksrc + off), (LAS unsigned*)(slot + wave * 1024), 16, 0, 0);
}
__device__ __forceinline__ void dma_v8(LAS unsigned char* slot, const unsigned char* vsrc, int wave, int lane) {
    const unsigned d = 16u * wave + (lane >> 2), pos = lane & 3, off = d * 64u + ((pos ^ ((d >> 2) & 3u)) * 16u);
    __builtin_amdgcn_global_load_lds((const unsigned*)(vsrc + off), (LAS unsigned*)(slot + 8192 + wave * 1024), 16, 0, 0);
}
#define MFMA8_B(acc, A, B) acc = __builtin_amdgcn_mfma_scale_f32_16x16x128_f8f6f4(A, B, acc, 0, 0, 0, 0x7f7f7f7f, 0, 0x7f7f7f7f)
#define SEL_GAP() __builtin_amdgcn_sched_barrier(0)
#define MFMA8_ACC(acc, A, B) asm volatile("v_mfma_scale_f32_16x16x128_f8f6f4 %0, %1, %2, %0, %3, %3 op_sel_hi:[0,0,0]" : "+v"(acc) : "v"(A), "v"(B), "v"(0x7f7f7f7f))
constexpr int TOPK_LSB = 10; constexpr unsigned TOPK_LOWMASK = (1u << TOPK_LSB) - 1u;
constexpr int IMP_OFF = 65536;
static_assert(IMP_OFF + 64 * 260 * 4 <= TMK_OFF && TMK_OFF + 2048 <= MISC_OFF, "cmp LDS map");
template <int CM  > __device__ __forceinline__ void p3_cmp(const Args& a, LAS unsigned char* lds, int wg, int G) {
    const int tid = threadIdx.x, lane = tid & 63, wave = __builtin_amdgcn_readfirstlane(tid >> 6), c = lane & 15, g = lane >> 4;
    unsigned char* ws = a.ws; const bf16* qr = (const bf16*)(ws + WS_QR); bf16* OC = (bf16*)(ws + WS_OC);
    LAS float* imp = (LAS float*)(lds + IMP_OFF); LAS unsigned* tmk = (LAS unsigned*)(lds + TMK_OFF);
    SWZ_OFFSETS();
    for (int u = wg; u < 1024; u += G) {
        int bg, qt; unit_bq(u, bg, qt); const int b = bg >> 1, gk = bg & 1, t0 = 64 * qt;
        const bf16* kc = (const bf16*)(ws + WS_KC) + (size_t)bg * 1024 * 128; const bf16* vct = (const bf16*)(ws + WS_VCT) + (size_t)bg * 16 * 8192;
        const int ntile = (4 * qt + 66) >> 6;
        __syncthreads();
        tmk[tid] = 0u;
        bf16x8 qf[2][4]; int nmax[2];
#pragma unroll
        for (int cs = 0; cs < 2; ++cs) { const int ql = 8 * wave + 4 * cs + (c >> 2), t = t0 + ql; load_qf(qr, (size_t)b * SEQ + t, 4 * gk + (c & 3), g, qf[cs]);
            nmax[cs] = t >= 31 ? (t - 31) >> 4 : -1; }
        pin_qf(qf);
        __syncthreads();
        v8i32 q8f[2]; float nmb[2] = {0.f, 0.f}, thr[2] = {-__builtin_inff(), -__builtin_inff()}; f32x2 lp[2] = {{0.f, 0.f}, {0.f, 0.f}};
        { const unsigned char* q8 = ws + WS_Q8;
#pragma unroll
          for (int cs = 0; cs < 2; ++cs) { const int ql = 8 * wave + 4 * cs + (c >> 2); q8f[cs] = *(const v8i32*)(q8 + ((size_t)b * SEQ + t0 + ql) * 1024 + (4 * gk + (c & 3)) * 128 + 32 * g); }
          asm volatile("" : "+v"(q8f[0])); asm volatile("" : "+v"(q8f[1])); }
        const unsigned char* kc8 = ws + WS_KC8 + (size_t)bg * 1024 * 128;
        const int ky8 = (c >> 1) & 7, kxa8 = c * 128 + (((2 * g) ^ ky8) << 4), kxb8 = c * 128 + (((2 * g + 1) ^ ky8) << 4);
        const float NINF = -__builtin_inff();
        if (CM != 2) { dma_k8(lds, kc8, wave, lane); if (ntile > 1) dma_k8(lds + 8192, kc8 + 8192, wave, lane); }
        for (int i0 = 0; i0 < (CM == 2 ? 0 : ntile); i0 += 2) {
            WAITV(0); RAWBAR();
            if (i0 + 2 < ntile) dma_k8(lds + ((i0 + 2) & 3) * 8192, kc8 + (size_t)(i0 + 2) * 8192, wave, lane);
            if (i0 + 3 < ntile) dma_k8(lds + ((i0 + 3) & 3) * 8192, kc8 + (size_t)(i0 + 3) * 8192, wave, lane);
            for (int i = i0; i < i0 + 2 && i < ntile; ++i) { const LAS unsigned char* slot = lds + (i & 3) * 8192;
                f32x4 s0[4], s1[4];
                { v8i32 kf[4];
#pragma unroll
                  for (int kt = 0; kt < 4; ++kt) kf[kt] = pg8::cat8(*(const LAS bf16x8*)(slot + kt * 2048 + kxa8), *(const LAS bf16x8*)(slot + kt * 2048 + kxb8));
                  const f32x4 c0 = {nmb[0], nmb[0], nmb[0], nmb[0]}, c1 = {nmb[1], nmb[1], nmb[1], nmb[1]};
                  __builtin_amdgcn_sched_barrier(0);
#pragma unroll
                  for (int kt = 0; kt < 4; ++kt) s0[kt] = __builtin_amdgcn_mfma_scale_f32_16x16x128_f8f6f4(kf[kt], q8f[0], c0, 0, 0, 0, 0x7f7f7f7f, 0, 0x7c7c7c7c);
#pragma unroll
                  for (int kt = 0; kt < 4; ++kt) s1[kt] = __builtin_amdgcn_mfma_scale_f32_16x16x128_f8f6f4(kf[kt], q8f[1], c1, 0, 0, 0, 0x7f7f7f7f, 0, 0x7c7c7c7c); }
                if (64 * i + 63 > 4 * qt - 2) {
#pragma unroll
                    for (int kt = 0; kt < 4; ++kt)
#pragma unroll
                        for (int ii = 0; ii < 4; ++ii) { const int n = 64 * i + 16 * kt + 4 * g + ii; s0[kt][ii] = n <= nmax[0] ? s0[kt][ii] : NINF; s1[kt][ii] = n <= nmax[1] ? s1[kt][ii] : NINF; } }
#define CMP1_SM(S, CS) do { float tm_ = fmaxf(fmaxf(fmaxf(S[0][0], S[0][1]), fmaxf(S[0][2], S[0][3])), fmaxf(fmaxf(S[1][0], S[1][1]), fmaxf(S[1][2], S[1][3]))); \
        tm_ = fmaxf(tm_, fmaxf(fmaxf(fmaxf(S[2][0], S[2][1]), fmaxf(S[2][2], S[2][3])), fmaxf(fmaxf(S[3][0], S[3][1]), fmaxf(S[3][2], S[3][3])))); \
        if (__any(tm_ > thr[CS])) { const float tr_ = lmax32(lmax16(tm_)); const bool un_ = thr[CS] == NINF, live_ = tr_ > NINF; const float d_ = un_ ? (live_ ? tr_ : 0.f) : fmaxf(tr_, 0.f), al_ = __builtin_amdgcn_exp2f(-d_); \
            thr[CS] = (un_ && !live_) ? NINF : SM_THR8; nmb[CS] -= d_; lp[CS] = lp[CS] * al_; \
            _Pragma("unroll") for (int kt_ = 0; kt_ < 4; ++kt_) _Pragma("unroll") for (int ii_ = 0; ii_ < 4; ++ii_) S[kt_][ii_] -= d_; } \
        _Pragma("unroll") for (int kt_ = 0; kt_ < 4; ++kt_) { _Pragma("unroll") for (int ii_ = 0; ii_ < 4; ++ii_) S[kt_][ii_] = __builtin_amdgcn_exp2f(S[kt_][ii_]); \
            lp[CS] += (f32x2){S[kt_][0], S[kt_][1]}; lp[CS] += (f32x2){S[kt_][2], S[kt_][3]}; } } while (0)
                CMP1_SM(s0, 0); CMP1_SM(s1, 1);
            }
        }
        float mb[2];
#pragma unroll
        for (int cs = 0; cs < 2; ++cs) { float lt = lp[cs].x + lp[cs].y; lt = ladd16(lt); lt = ladd32(lt); mb[cs] = lt > 0.f ? __builtin_amdgcn_logf(lt) - nmb[cs] : __builtin_inff(); }
        __syncthreads();
        f32x4 o[2][8];
#pragma unroll
        for (int cs = 0; cs < 2; ++cs)
#pragma unroll
            for (int dt = 0; dt < 8; ++dt) o[cs][dt] = (f32x4){0.f, 0.f, 0.f, 0.f};
        float wrap[2] = {0.f, 0.f};
        if (CM < 2) { dma_k(lds, kc, wave, lane); dma_v(lds, vct, wave, lane); }
        for (int i = 0; i < (CM >= 2 ? 0 : ntile); ++i) {
            WAITV(0); RAWBAR();
            if (i + 1 < ntile) { LAS unsigned char* sl = lds + ((i + 1) & 1) * SLOT_BYTES; dma_k(sl, kc + (size_t)(i + 1) * 64 * 128, wave, lane); dma_v(sl, vct + (size_t)(i + 1) * 8192, wave, lane); }
            const LAS unsigned char* slot = lds + (i & 1) * SLOT_BYTES;
            const bool bnd = 64 * i + 63 > 4 * qt - 2;
            f32x4 s0[4], s1[4];
            { bf16x8 kf[4][4];
#pragma unroll
              for (int kt = 0; kt < 4; ++kt)
#pragma unroll
                  for (int ks = 0; ks < 4; ++ks) kf[kt][ks] = *(const LAS bf16x8*)(slot + kt * 4096 + kx[ks]);
              __builtin_amdgcn_sched_barrier(0);
#pragma unroll
              for (int kt = 0; kt < 4; ++kt) { s0[kt] = (f32x4){0.f, 0.f, 0.f, 0.f};
#pragma unroll
                  for (int ks = 0; ks < 4; ++ks) s0[kt] = mfma16(kf[kt][ks], qf[0][ks], s0[kt]); }
              __builtin_amdgcn_sched_barrier(0);
#define CMP_PIMP(S, CS, kt_) do { const int ql_ = 8 * wave + 4 * CS + (c >> 2); \
        _Pragma("unroll") for (int ii_ = 0; ii_ < 4; ++ii_) { const int n_ = 64 * i + 16 * kt_ + 4 * g + ii_; const float p_ = __builtin_amdgcn_exp2f(__builtin_fmaf(S[kt_][ii_], C2, -mb[CS])); S[kt_][ii_] = (!bnd || n_ <= nmax[CS]) ? p_ : 0.f; } \
        const float s4_ = quad_sum((S[kt_][0] + S[kt_][1]) + (S[kt_][2] + S[kt_][3])), p3_ = quad_sum(S[kt_][3]); \
        const float up_ = __shfl(p3_, (lane + 48) & 63); const float cin_ = g > 0 ? up_ : wrap[CS]; wrap[CS] = up_; \
        if ((c & 3) == 0) imp[ql_ * 260 + 16 * i + 4 * kt_ + g] = s4_ + cin_; } while (0)
#define CMP_QK1B(kt_) do { s1[kt_] = (f32x4){0.f, 0.f, 0.f, 0.f}; bf16x8 kr_[4]; _Pragma("unroll") for (int ks_ = 0; ks_ < 4; ++ks_) kr_[ks_] = *(const LAS bf16x8*)(slot + (kt_) * 4096 + kx[ks_]);     \
        _Pragma("unroll") for (int ks_ = 0; ks_ < 4; ++ks_) s1[kt_] = mfma16(kr_[ks_], qf[1][ks_], s1[kt_]); } while (0)
              CMP_QK1B(0); CMP_PIMP(s0, 0, 0); __builtin_amdgcn_sched_barrier(0);
              CMP_QK1B(1); CMP_PIMP(s0, 0, 1); __builtin_amdgcn_sched_barrier(0);
              CMP_QK1B(2); CMP_PIMP(s0, 0, 2); __builtin_amdgcn_sched_barrier(0);
              CMP_QK1B(3); CMP_PIMP(s0, 0, 3); __builtin_amdgcn_sched_barrier(0); }
            { const bf16x8 pa = pack8(s0[0], s0[1]), pb = pack8(s0[2], s0[3]); bf16x8 vf[8];
#pragma unroll
              for (int dt = 0; dt < 8; ++dt) vf[dt] = *(const LAS bf16x8*)(slot + 16384 + dt * 2048 + vx[0]);
              __builtin_amdgcn_sched_barrier(0);
#pragma unroll
              for (int dt = 0; dt < 4; ++dt) o[0][dt] = mfma16(vf[dt], pa, o[0][dt]);
              CMP_PIMP(s1, 1, 0); __builtin_amdgcn_sched_barrier(0);
#pragma unroll
              for (int dt = 4; dt < 8; ++dt) o[0][dt] = mfma16(vf[dt], pa, o[0][dt]);
              CMP_PIMP(s1, 1, 1); __builtin_amdgcn_sched_barrier(0);
#pragma unroll
              for (int dt = 0; dt < 8; ++dt) vf[dt] = *(const LAS bf16x8*)(slot + 16384 + dt * 2048 + vx[1]);
              __builtin_amdgcn_sched_barrier(0);
#pragma unroll
              for (int dt = 0; dt < 4; ++dt) o[0][dt] = mfma16(vf[dt], pb, o[0][dt]);
              CMP_PIMP(s1, 1, 2); __builtin_amdgcn_sched_barrier(0);
#pragma unroll
              for (int dt = 4; dt < 8; ++dt) o[0][dt] = mfma16(vf[dt], pb, o[0][dt]);
              CMP_PIMP(s1, 1, 3); __builtin_amdgcn_sched_barrier(0);
              const bf16x8 qa = pack8(s1[0], s1[1]), qb = pack8(s1[2], s1[3]);
#pragma unroll
              for (int dt = 0; dt < 8; ++dt) o[1][dt] = mfma16(vf[dt], qb, o[1][dt]);
              __builtin_amdgcn_sched_barrier(0);
#pragma unroll
              for (int dt = 0; dt < 8; ++dt) vf[dt] = *(const LAS bf16x8*)(slot + 16384 + dt * 2048 + vx[0]);
#pragma unroll
              for (int dt = 0; dt < 8; ++dt) o[1][dt] = mfma16(vf[dt], qa, o[1][dt]); }
        }
#pragma unroll
        for (int cs = 0; cs < 2; ++cs) { const int ql = 8 * wave + 4 * cs + (c >> 2); store_o(OC, (size_t)b * SEQ + t0 + ql, 4 * gk + (c & 3), g, o[cs], 1.0f); }
        __syncthreads();
        const int cur = qt;
        for (int q0 = 0; q0 < ((CM == 1 || CM == 3) ? 0 : 8); q0 += 4) { unsigned key[4][4], prefix[4] = {0u, 0u, 0u, 0u};
#pragma unroll
            for (int u4 = 0; u4 < 4; ++u4) { const int ql = 8 * wave + q0 + u4;
#pragma unroll
                for (int k = 0; k < 4; ++k) { const int j = 64 * k + lane; const bool forced = (j == 0) | (j == cur) | (j == cur - 1);
                    key[u4][k] = forced ? 0xffffffffu : (j <= cur ? __builtin_bit_cast(unsigned, imp[ql * 260 + j]) + 1u : 0u); } }
            const int nk = (cur >> 6) + 1;
#define TOPK_SEARCH(NK) for (int bit = 30; bit >= TOPK_LSB; --bit) { \
                _Pragma("unroll") for (int u4 = 0; u4 < 4; ++u4) { const unsigned trial = prefix[u4] | (1u << bit); int cnt = 0; \
                    _Pragma("unroll") for (int k = 0; k < NK; ++k) cnt += __popcll(__ballot(key[u4][k] >= trial)); \
                    if (cnt >= 16) prefix[u4] = trial; } }
            if (nk == 1) { TOPK_SEARCH(1) } else if (nk == 2) { TOPK_SEARCH(2) } else if (nk == 3) { TOPK_SEARCH(3) } else { TOPK_SEARCH(4) }
#undef TOPK_SEARCH
#pragma unroll
            for (int u4 = 0; u4 < 4; ++u4) { const int ql = 8 * wave + q0 + u4; int cgt = 0; const unsigned hi = prefix[u4] | TOPK_LOWMASK;
#pragma unroll
                for (int k = 0; k < 4; ++k) cgt += __popcll(__ballot(key[u4][k] > hi));
                int need = 16 - cgt, before = 0;
#pragma unroll
                for (int k = 0; k < 4; ++k) { const bool ineq = key[u4][k] >= prefix[u4] && key[u4][k] <= hi; const unsigned long long eq = __ballot(ineq); const int rank = before + __popcll(eq & ((1ull << lane) - 1ull)); before += __popcll(eq);
                    const bool sel = (key[u4][k] > hi) || (ineq && rank < need); const int j = 64 * k + lane;
                    if (sel && j <= cur) __hip_atomic_fetch_or(tmk + 2 * j + (ql >> 5), 1u << (ql & 31), __ATOMIC_RELAXED, __HIP_MEMORY_SCOPE_WORKGROUP); } }
        }
        __syncthreads();
        if (tid < 256) { v2u w; w.x = tmk[2 * tid]; w.y = tmk[2 * tid + 1]; *((v2u*)(ws + WS_TMASK) + ((size_t)(bg * 256 + qt) * 256 + tid)) = w; }
    }
}

__device__ __forceinline__ float max16(const f32x4 (&s)[4]) {
    float t0, t1, t2;
    asm("v_max3_f32 %0, %3, %4, %5\n v_max3_f32 %1, %6, %7, %8\n v_max3_f32 %2, %9, %10, %11\n v_max3_f32 %0, %0, %1, %2\n v_max3_f32 %1, %12, %13, %14\n v_max3_f32 %2, %15, %16, %17\n v_max3_f32 %0, %0, %1, %2\n v_max_f32 %0, %0, %18"
        : "=&v"(t0), "=&v"(t1), "=&v"(t2)
        : "v"(s[0][0]), "v"(s[0][1]), "v"(s[0][2]), "v"(s[0][3]), "v"(s[1][0]), "v"(s[1][1]), "v"(s[1][2]), "v"(s[1][3]), "v"(s[2][0]), "v"(s[2][1]), "v"(s[2][2]), "v"(s[2][3]), "v"(s[3][0]), "v"(s[3][1]), "v"(s[3][2]), "v"(s[3][3]));
    return t0;
}
template <int MODE  > __device__ __forceinline__ void p4_sel(const Args& a, LAS unsigned char* lds, int wg, int G) {
    const int tid = threadIdx.x, lane = tid & 63, wave = __builtin_amdgcn_readfirstlane(tid >> 6), c = lane & 15, g = lane >> 4;
    unsigned char* ws = a.ws; const unsigned char* q8 = ws + WS_Q8; bf16* OS = (bf16*)(ws + WS_OS);
    LAS unsigned* tmk = (LAS unsigned*)(lds + TMK_OFF);
    const int ky = (c >> 1) & 7, kxa = c * 128 + (((2 * g) ^ ky) << 4), kxb = c * 128 + (((2 * g + 1) ^ ky) << 4), vxo = c * 64 + ((g ^ ((c >> 2) & 3)) << 4);
    const float NINF = -__builtin_inff();
    for (int r = 0; r * G + wg < 1024; ++r) {
        int bg, qt; unit_sel(wg, r, G, bg, qt); const int b = bg >> 1, gk = bg & 1, t0 = 64 * qt, cur = qt;
        const unsigned char* ks = ws + WS_KSEL + (size_t)bg * SEQ * 128; const unsigned char* vst = ws + WS_VSELT + (size_t)bg * 256 * 8192;
        __syncthreads();
        tmk[tid] = *((const unsigned*)(ws + WS_TMASK) + ((size_t)(bg * 256 + qt) * 512 + tid));
        v8i32 qf[2]; float nmb[2], thr[2]; f32x2 lsum[2]; f32x4 o[2][8]; int tq[2];
        v8i32 pLo = {0, 0, 0, 0, 0, 0, 0, 0}, pHi = {0, 0, 0, 0, 0, 0, 0, 0}; asm volatile("" : "+v"(pLo), "+v"(pHi));
#pragma unroll
        for (int cs = 0; cs < 2; ++cs) { const int ql = 8 * wave + 4 * cs + (c >> 2); tq[cs] = t0 + ql; qf[cs] = *(const v8i32*)(q8 + ((size_t)b * SEQ + tq[cs]) * 1024 + (4 * gk + (c & 3)) * 128 + 32 * g); nmb[cs] = 0.f; thr[cs] = NINF; lsum[cs] = (f32x2){0.f, 0.f};
#pragma unroll
            for (int dt = 0; dt < 8; ++dt) o[cs][dt] = (f32x4){0.f, 0.f, 0.f, 0.f}; }
        asm volatile("" : "+v"(qf[0])); asm volatile("" : "+v"(qf[1]));
        __syncthreads();
#pragma unroll
        for (int jp = 0; jp < SELB; ++jp) if (MODE != 2 && jp <= cur) { dma_k8(lds + jp * SLOT8, ks + (size_t)jp * 64 * 128, wave, lane); dma_v8(lds + jp * SLOT8, vst + (size_t)jp * 8192, wave, lane); }
        for (int js = 0; js <= cur; js += SELB) {
            WAITV(0); RAWBAR();
#pragma unroll
            for (int jp = SELB; jp < 2 * SELB; ++jp) if (MODE != 2 && js + jp <= cur) { LAS unsigned char* sl = lds + ((js + jp) & (2 * SELB - 1)) * SLOT8; dma_k8(sl, ks + (size_t)(js + jp) * 64 * 128, wave, lane); dma_v8(sl, vst + (size_t)(js + jp) * 8192, wave, lane); }
            unsigned mws[SELB];
#pragma unroll
            for (int jj = 0; jj < SELB; ++jj) mws[jj] = tmk[2 * (js + jj) + (wave >> 2)];
            unsigned m8s[SELB];
#pragma unroll
            for (int jj = 0; jj < SELB; ++jj) { const unsigned mw = __builtin_amdgcn_readfirstlane(mws[jj]); m8s[jj] = (MODE == 1 || js + jj > cur) ? 0u : ((mw >> (8 * (wave & 3))) & 0xffu); }
#pragma unroll
          for (int jj = 0; jj < SELB; ++jj) { const int j = js + jj;
            if (m8s[jj] != 0u) {
            const LAS unsigned char* slot = lds + (j & (2 * SELB - 1)) * SLOT8; const unsigned m8 = m8s[jj];
            v8i32 kf[4];
#pragma unroll
            for (int kt = 0; kt < 4; ++kt) kf[kt] = pg8::cat8(*(const LAS bf16x8*)(slot + kt * 2048 + kxa), *(const LAS bf16x8*)(slot + kt * 2048 + kxb));
#pragma unroll
            for (int cs = 0; cs < 2; ++cs) { const unsigned nib = (m8 >> (4 * cs)) & 0xfu;
                if (nib != 0u) {
                    const bool selq = (nib >> (c >> 2)) & 1u; f32x4 s[4];
                    { const float cv = selq ? nmb[cs] : NINF; const f32x4 cacc = {cv, cv, cv, cv};
#pragma unroll
                      for (int kt = 0; kt < 4; ++kt) s[kt] = __builtin_amdgcn_mfma_scale_f32_16x16x128_f8f6f4(kf[kt], qf[cs], cacc, 0, 0, 0, 0x7f7f7f7f, 0, 0x7c7c7c7c); }
                    v8i32 vf[4];
#pragma unroll
                    for (int j2 = 0; j2 < 4; ++j2) vf[j2] = pg8::cat8(*(const LAS bf16x8*)(slot + 8192 + j2 * 2048 + vxo), *(const LAS bf16x8*)(slot + 8192 + j2 * 2048 + 1024 + vxo));
                    __builtin_amdgcn_sched_barrier(0);
                    if (j == cur) {
#pragma unroll
                        for (int kt = 0; kt < 4; ++kt)
#pragma unroll
                            for (int ii = 0; ii < 4; ++ii) { const int kp = 64 * j + 16 * kt + 4 * g + ii; s[kt][ii] = kp <= tq[cs] ? s[kt][ii] : NINF; } }
                    const float tm = max16(s);
                    if (__any(tm > thr[cs])) {
                        const float tr = xmax32(xmax16(tm)); const bool un = thr[cs] == NINF, live = tr > NINF;
                        const float d = un ? (live ? tr : 0.f) : fmaxf(tr, 0.f), alpha = __builtin_amdgcn_exp2f(-d);
                        thr[cs] = (un && !live) ? NINF : SM_THR8; nmb[cs] -= d; lsum[cs] = lsum[cs] * alpha;
#pragma unroll
                        for (int dt = 0; dt < 8; ++dt) o[cs][dt] = o[cs][dt] * alpha;
#pragma unroll
                        for (int kt = 0; kt < 4; ++kt)
#pragma unroll
                            for (int i = 0; i < 4; ++i) s[kt][i] -= d; }
#pragma unroll
                    for (int kt = 0; kt < 4; ++kt) {
#pragma unroll
                        for (int i = 0; i < 4; ++i) s[kt][i] = __builtin_amdgcn_exp2f(s[kt][i]);
                        lsum[cs] += (f32x2){s[kt][0], s[kt][1]}; lsum[cs] += (f32x2){s[kt][2], s[kt][3]};
                        int w = pLo[kt]; w = __builtin_amdgcn_cvt_pk_fp8_f32(s[kt][0], s[kt][1], w, false); w = __builtin_amdgcn_cvt_pk_fp8_f32(s[kt][2], s[kt][3], w, true); pLo[kt] = w; pHi[4 + kt] = w; }
#pragma unroll
                    for (int j2 = 0; j2 < 4; ++j2) { MFMA8_ACC(o[cs][2 * j2], vf[j2], pLo); MFMA8_ACC(o[cs][2 * j2 + 1], vf[j2], pHi); } } }
          } }
        }
        asm volatile("s_nop 15\n s_nop 15" ::: "memory");
#pragma unroll
        for (int cs = 0; cs < 2; ++cs) { const float lt = ladd32(ladd16(lsum[cs].x + lsum[cs].y)); const float inv = lt > 0.f ? 1.0f / lt : 0.f;
            if (MODE == 0) store_o(OS, (size_t)b * SEQ + tq[cs], 4 * gk + (c & 3), g, o[cs], inv); else { asm volatile("" :: "v"(inv), "v"(o[cs][0]), "v"(o[cs][7])); } }
    }
}

__device__ __forceinline__ void waitv_dyn(int n) {
    switch (n) { case 0: WAITV(0); break; case 2: WAITV(2); break; case 4: WAITV(4); break; case 6: WAITV(6); break; case 8: WAITV(8); break; case 10: WAITV(10); break; case 12: WAITV(12); break; default: WAITV(14); break; }
}
#define WIN_EXP2(S, kt_, h_) do { S[kt_][2 * (h_)] = __builtin_amdgcn_exp2f(S[kt_][2 * (h_)]); S[kt_][2 * (h_) + 1] = __builtin_amdgcn_exp2f(S[kt_][2 * (h_) + 1]); } while (0)
#define WIN_CVT(S, PN, LS, kt_, h_) do { PN[kt_] = __builtin_amdgcn_cvt_pk_fp8_f32(S[kt_][2 * (h_)], S[kt_][2 * (h_) + 1], PN[kt_], (h_) != 0); LS += (f32x2){S[kt_][2 * (h_)], S[kt_][2 * (h_) + 1]}; } while (0)
#define WIN_RARE(S, TM, CS) do { const float tr_ = xmax32(xmax16(TM)); const bool un_ = thr[CS] == NINF, live_ = tr_ > NINF; \
    const float d_ = un_ ? (live_ ? tr_ : 0.f) : fmaxf(tr_, 0.f), alpha_ = __builtin_amdgcn_exp2f(-d_); thr[CS] = (un_ && !live_) ? NINF : SM_THR8; nmb[CS] -= d_; lsum[CS] = lsum[CS] * alpha_; \
    _Pragma("unroll") for (int dt_ = 0; dt_ < 8; ++dt_) o[CS][dt_] = o[CS][dt_] * alpha_; \
    _Pragma("unroll") for (int kt_ = 0; kt_ < 4; ++kt_) _Pragma("unroll") for (int i_ = 0; i_ < 4; ++i_) S[kt_][i_] -= d_; } while (0)
__device__ __forceinline__ void p5_win(const Args& a, LAS unsigned char* lds, int wg, int G) {
    const int tid = threadIdx.x, lane = tid & 63, wave = __builtin_amdgcn_readfirstlane(tid >> 6), c = lane & 15, g = lane >> 4;
    unsigned char* ws = a.ws; const unsigned char* q8 = ws + WS_Q8; bf16* OW = (bf16*)(ws + WS_OW);
    const int ky = (c >> 1) & 7, kxa = c * 128 + (((2 * g) ^ ky) << 4), kxb = c * 128 + (((2 * g + 1) ^ ky) << 4), vxo = c * 64 + ((g ^ ((c >> 2) & 3)) << 4);
    const float NINF = -__builtin_inff();
    for (int u = wg; u < 1024; u += G) {
        const int bg = u >> 8, x = u & 255, qt = (G == 256) ? ((x & 7) * 32 + (x >> 3)) : x, b = bg >> 1, gk = bg & 1, t0 = 64 * qt;
        const unsigned char* kw = ws + WS_KWIN + (size_t)bg * SEQ * 128; const unsigned char* vwt = ws + WS_VWINT + (size_t)bg * 256 * 8192;
        v8i32 qf[2]; float nmb[2], thr[2]; f32x2 lsum[2]; f32x4 o[2][8]; int tq[2];
        v8i32 pLo0 = {0, 0, 0, 0, 0, 0, 0, 0}, pHi0 = {0, 0, 0, 0, 0, 0, 0, 0}, pLo1 = {0, 0, 0, 0, 0, 0, 0, 0}, pHi1 = {0, 0, 0, 0, 0, 0, 0, 0};
        asm volatile("" : "+v"(pLo0), "+v"(pHi0)); asm volatile("" : "+v"(pLo1), "+v"(pHi1));
#pragma unroll
        for (int cs = 0; cs < 2; ++cs) { const int ql = 8 * wave + 4 * cs + (c >> 2); tq[cs] = t0 + ql; qf[cs] = *(const v8i32*)(q8 + ((size_t)b * SEQ + tq[cs]) * 1024 + (4 * gk + (c & 3)) * 128 + 32 * g); nmb[cs] = 0.f; thr[cs] = NINF; lsum[cs] = (f32x2){0.f, 0.f};
#pragma unroll
            for (int dt = 0; dt < 8; ++dt) o[cs][dt] = (f32x4){0.f, 0.f, 0.f, 0.f}; }
        const int j0 = qt >= 8 ? qt - 8 : 0, nb = qt - j0 + 1, nfirst = nb < 8 ? nb : 8;
        asm volatile("" : "+v"(qf[0])); asm volatile("" : "+v"(qf[1]));
        __syncthreads();
        for (int i = 0; i < nfirst; ++i) { LAS unsigned char* sl = lds + ((j0 + i) & 7) * SLOT8; dma_k8(sl, kw + (size_t)(j0 + i) * 64 * 128, wave, lane); dma_v8(sl, vwt + (size_t)(j0 + i) * 8192, wave, lane); }
        int nissued = nfirst;
        for (int i0 = 0; i0 < nb; i0 += 3) {
            const int iend = i0 + 3 < nb ? i0 + 3 : nb, left = nissued - iend;
            waitv_dyn(left > 0 ? 2 * left : 0); RAWBAR();
            if (i0 == 3 && nb == 9) { LAS unsigned char* sl = lds + ((j0 + 8) & 7) * SLOT8; dma_k8(sl, kw + (size_t)(j0 + 8) * 64 * 128, wave, lane); dma_v8(sl, vwt + (size_t)(j0 + 8) * 8192, wave, lane); nissued = 9; }
            for (int i = i0; i < iend; ++i) { const int j = j0 + i;
                const LAS unsigned char* slot = lds + (j & 7) * SLOT8;
                f32x4 s0[4], s1[4];
                { v8i32 kf[4];
#pragma unroll
                  for (int kt = 0; kt < 4; ++kt) kf[kt] = pg8::cat8(*(const LAS bf16x8*)(slot + kt * 2048 + kxa), *(const LAS bf16x8*)(slot + kt * 2048 + kxb));
                  const f32x4 c0 = {nmb[0], nmb[0], nmb[0], nmb[0]}, c1 = {nmb[1], nmb[1], nmb[1], nmb[1]};
                  __builtin_amdgcn_sched_barrier(0);
#pragma unroll
                  for (int kt = 0; kt < 4; ++kt) s0[kt] = __builtin_amdgcn_mfma_scale_f32_16x16x128_f8f6f4(kf[kt], qf[0], c0, 0, 0, 0, 0x7f7f7f7f, 0, 0x7c7c7c7c);
#pragma unroll
                  for (int kt = 0; kt < 4; ++kt) s1[kt] = __builtin_amdgcn_mfma_scale_f32_16x16x128_f8f6f4(kf[kt], qf[1], c1, 0, 0, 0, 0x7f7f7f7f, 0, 0x7c7c7c7c); }
                v8i32 vf[4];
#pragma unroll
                for (int j2 = 0; j2 < 4; ++j2) vf[j2] = pg8::cat8(*(const LAS bf16x8*)(slot + 8192 + j2 * 2048 + vxo), *(const LAS bf16x8*)(slot + 8192 + j2 * 2048 + 1024 + vxo));
                __builtin_amdgcn_sched_barrier(0);
                if (j == qt || j + 8 == qt) {
                    int l0 = tq[0] - 64 * j - 4 * g, l1 = tq[1] - 64 * j - 4 * g; asm volatile("" : "+v"(l0), "+v"(l1));
#pragma unroll
                    for (int kt = 0; kt < 4; ++kt)
#pragma unroll
                        for (int ii = 0; ii < 4; ++ii) { s0[kt][ii] = ((unsigned)(l0 - (16 * kt + ii)) < 512u) ? s0[kt][ii] : NINF; s1[kt][ii] = ((unsigned)(l1 - (16 * kt + ii)) < 512u) ? s1[kt][ii] : NINF; } }
                int pn0[4] = {0, 0, 0, 0}, pn1[4] = {0, 0, 0, 0}; f32x2 ls0 = {0.f, 0.f}, ls1 = {0.f, 0.f};
                { const float tm = __builtin_fmaxf(__builtin_fmaxf(__builtin_fmaxf(__builtin_fmaxf(s0[0][0], s0[0][1]), __builtin_fmaxf(s0[0][2], s0[0][3])), __builtin_fmaxf(__builtin_fmaxf(s0[1][0], s0[1][1]), __builtin_fmaxf(s0[1][2], s0[1][3]))),
                                                     __builtin_fmaxf(__builtin_fmaxf(__builtin_fmaxf(s0[2][0], s0[2][1]), __builtin_fmaxf(s0[2][2], s0[2][3])), __builtin_fmaxf(__builtin_fmaxf(s0[3][0], s0[3][1]), __builtin_fmaxf(s0[3][2], s0[3][3]))));
                  if (__any(tm > thr[0])) WIN_RARE(s0, tm, 0); }
#pragma unroll
                for (int kt = 0; kt < 4; ++kt) { WIN_EXP2(s0, kt, 0); WIN_EXP2(s0, kt, 1); WIN_CVT(s0, pn0, ls0, kt, 0); WIN_CVT(s0, pn0, ls0, kt, 1); }
#pragma unroll
                for (int kt = 0; kt < 4; ++kt) { pLo0[kt] = pn0[kt]; pHi0[4 + kt] = pn0[kt]; }
                lsum[0] += ls0;
                { const float tm = __builtin_fmaxf(__builtin_fmaxf(__builtin_fmaxf(__builtin_fmaxf(s1[0][0], s1[0][1]), __builtin_fmaxf(s1[0][2], s1[0][3])), __builtin_fmaxf(__builtin_fmaxf(s1[1][0], s1[1][1]), __builtin_fmaxf(s1[1][2], s1[1][3]))),
                                                     __builtin_fmaxf(__builtin_fmaxf(__builtin_fmaxf(s1[2][0], s1[2][1]), __builtin_fmaxf(s1[2][2], s1[2][3])), __builtin_fmaxf(__builtin_fmaxf(s1[3][0], s1[3][1]), __builtin_fmaxf(s1[3][2], s1[3][3]))));
                  if (__any(tm > thr[1])) WIN_RARE(s1, tm, 1); }
                __builtin_amdgcn_sched_barrier(0);
                MFMA8_B(o[0][0], vf[0], pLo0); WIN_EXP2(s1, 0, 0); SEL_GAP();
                MFMA8_B(o[0][1], vf[0], pHi0); WIN_EXP2(s1, 0, 1); WIN_CVT(s1, pn1, ls1, 0, 0); SEL_GAP();
                MFMA8_B(o[0][2], vf[1], pLo0); WIN_EXP2(s1, 1, 0); WIN_CVT(s1, pn1, ls1, 0, 1); SEL_GAP();
                MFMA8_B(o[0][3], vf[1], pHi0); WIN_EXP2(s1, 1, 1); WIN_CVT(s1, pn1, ls1, 1, 0); SEL_GAP();
                MFMA8_B(o[0][4], vf[2], pLo0); WIN_EXP2(s1, 2, 0); WIN_CVT(s1, pn1, ls1, 1, 1); SEL_GAP();
                MFMA8_B(o[0][5], vf[2], pHi0); WIN_EXP2(s1, 2, 1); WIN_CVT(s1, pn1, ls1, 2, 0); SEL_GAP();
                MFMA8_B(o[0][6], vf[3], pLo0); WIN_EXP2(s1, 3, 0); WIN_CVT(s1, pn1, ls1, 2, 1); SEL_GAP();
                MFMA8_B(o[0][7], vf[3], pHi0); WIN_EXP2(s1, 3, 1); WIN_CVT(s1, pn1, ls1, 3, 0); SEL_GAP();
                WIN_CVT(s1, pn1, ls1, 3, 1);
#pragma unroll
                for (int kt = 0; kt < 4; ++kt) { pLo1[kt] = pn1[kt]; pHi1[4 + kt] = pn1[kt]; }
                lsum[1] += ls1;
#pragma unroll
                for (int j2 = 0; j2 < 4; ++j2) { MFMA8_B(o[1][2 * j2], vf[j2], pLo1); MFMA8_B(o[1][2 * j2 + 1], vf[j2], pHi1); }
            }
        }
#pragma unroll
        for (int cs = 0; cs < 2; ++cs) { const float lt = ladd32(ladd16(lsum[cs].x + lsum[cs].y)); const float inv = lt > 0.f ? 1.0f / lt : 0.f;
            store_o(OW, (size_t)b * SEQ + tq[cs], 4 * gk + (c & 3), g, o[cs], inv); }
    }
}

__device__ __forceinline__ void gelu4(v2u w, float (&o)[4]) {
    const pg8::f32x2 a = pg8::gelu_pk((pg8::f32x2){bflo(w.x), bfhi(w.x)}), b = pg8::gelu_pk((pg8::f32x2){bflo(w.y), bfhi(w.y)}); o[0] = a.x; o[1] = a.y; o[2] = b.x; o[3] = b.y;
}
__device__ __forceinline__ void p6_mix(const Args& a, LAS unsigned char* lds, int wg, int G) {
    const int tid = threadIdx.x, lane = tid & 63, wave = __builtin_amdgcn_readfirstlane(tid >> 6), c = lane & 15, g = lane >> 4;
    unsigned char* ws = a.ws; const bf16* proj = (const bf16*)(ws + WS_PROJ); bf16* STG = (bf16*)(ws + WS_XN)  ; unsigned char* MIX = (unsigned char*)(ws + WS_QR)  ;
    { const float* gn = (const float*)a.in[8]; const float* bs = (const float*)a.in[10]; const float* og = (const float*)a.in[12]; const bf16* wm = (const bf16*)(ws + WS_WM);
      for (int u = wg; u < 256; u += G) { const size_t m0 = (size_t)(u >> 7) * SEQ + 128 * (u & 127); const int t = 16 * wave + c; float ssum = 0.f;
        const int sr = tid >> 4, c0 = 8 * (tid & 15);
        v4u vv[4];
#pragma unroll
        for (int ps = 0; ps < 4; ++ps) vv[ps] = *(const v4u*)(proj + (m0 + 32 * ps + sr) * NP1 + COL_V + c0);
        for (int hg = 0; hg < 8; ++hg) { LAS bf16* buf = (LAS bf16*)lds + (hg & 1) * (128 * 136);
            const f32x4 gna = *(const f32x4*)(gn + hg * 128 + c0), gnb = *(const f32x4*)(gn + hg * 128 + c0 + 4);
            v4u uq[4]; bf16x8 bfr[4];
#pragma unroll
            for (int q = 0; q < 4; ++q) uq[q] = *(const v4u*)(proj + (m0 + t) * NP1 + COL_U + hg * 128 + 32 * g + 8 * q);
#pragma unroll
            for (int ks = 0; ks < 4; ++ks) bfr[ks] = *(const bf16x8*)(wm + ((size_t)hg * 128 + t) * 128 + 32 * ks + 8 * g);
            const float bst = bs[hg * 128 + t];
#pragma unroll
            for (int ps = 0; ps < 4; ++ps) { const int s = 32 * ps + sr; float x[8]; float xa[4], xb[4];
                gelu4((v2u){vv[ps].x, vv[ps].y}, xa); gelu4((v2u){vv[ps].z, vv[ps].w}, xb);
#pragma unroll
                for (int j = 0; j < 4; ++j) { x[j] = xa[j]; x[4 + j] = xb[j]; }
                float ss = 0.f;
#pragma unroll
                for (int j = 0; j < 8; ++j) ss += x[j] * x[j];
                ss = row16_sum(ss);
                const float rs = __builtin_amdgcn_rsqf(ss * (1.0f / 128.0f) + EPS);
#pragma unroll
                for (int j = 0; j < 8; ++j) buf[(c0 + j) * 136 + (s ^ c0)] = (bf16)f2bf(x[j] * rs * (j < 4 ? gna[j] : gnb[j - 4])); }
            if (hg < 7) {
#pragma unroll
                for (int ps = 0; ps < 4; ++ps) vv[ps] = *(const v4u*)(proj + (m0 + 32 * ps + sr) * NP1 + COL_V + (hg + 1) * 128 + c0); }
            __syncthreads();
            f32x4 acc[8];
#pragma unroll
            for (int ct = 0; ct < 8; ++ct) acc[ct] = (f32x4){0.f, 0.f, 0.f, 0.f};
#pragma unroll
            for (int ks = 0; ks < 4; ++ks) { if (ks <= (wave >> 1)) {
#pragma unroll
                for (int ct = 0; ct < 8; ++ct) { const int row = 32 * (c >> 2) + 4 * ct + (c & 3); const bf16x8 af = *(const LAS bf16x8*)(buf + row * 136 + ((32 * ks + 8 * g) ^ (8 * ((row >> 3) & 15)))); acc[ct] = mfma16(af, bfr[ks], acc[ct]); } } }
#pragma unroll
            for (int q = 0; q < 4; ++q) { v4u w4;
#pragma unroll
                for (int hf = 0; hf < 2; ++hf) { const int ct = 2 * q + hf; float gu[4]; gelu4(hf ? (v2u){uq[q].z, uq[q].w} : (v2u){uq[q].x, uq[q].y}, gu);
                    const float o0 = gu[0] * (acc[ct][0] + bst), o1 = gu[1] * (acc[ct][1] + bst), o2 = gu[2] * (acc[ct][2] + bst), o3 = gu[3] * (acc[ct][3] + bst);
                    ssum += (o0 * o0 + o1 * o1) + (o2 * o2 + o3 * o3); if (hf) { w4.z = pk2(o0, o1); w4.w = pk2(o2, o3); } else { w4.x = pk2(o0, o1); w4.y = pk2(o2, o3); } }
                *(v4u*)(STG + (m0 + t) * 1024 + hg * 128 + 32 * g + 8 * q) = w4; } }
        ssum = ladd32(ladd16(ssum));
        LAS float* rsl = (LAS float*)lds + 2 * 128 * 136 / 2;
        if (g == 0) rsl[t] = __builtin_amdgcn_rsqf(ssum * (1.0f / 1024.0f) + EPS);
        asm volatile("s_waitcnt vmcnt(0)" ::: "memory");
        __syncthreads();
        { const int tr = tid >> 2, q4 = tid & 3; const float rs = rsl[tr];
#pragma unroll 4
          for (int st = 0; st < 16; ++st) { const int ch = 64 * st + 16 * q4; const bf16* sp = STG + (m0 + tr) * 1024 + ch; const v4u xa = *(const v4u*)sp, xb = *(const v4u*)(sp + 8);
              const f32x4 g0 = *(const f32x4*)(og + ch), g1 = *(const f32x4*)(og + ch + 4), g2 = *(const f32x4*)(og + ch + 8), g3 = *(const f32x4*)(og + ch + 12); v4u w;
              w.x = pg8::pk4_fp8(bflo(xa.x) * rs * g0[0], bfhi(xa.x) * rs * g0[1], bflo(xa.y) * rs * g0[2], bfhi(xa.y) * rs * g0[3]); w.y = pg8::pk4_fp8(bflo(xa.z) * rs * g1[0], bfhi(xa.z) * rs * g1[1], bflo(xa.w) * rs * g1[2], bfhi(xa.w) * rs * g1[3]);
              w.z = pg8::pk4_fp8(bflo(xb.x) * rs * g2[0], bfhi(xb.x) * rs * g2[1], bflo(xb.y) * rs * g2[2], bfhi(xb.y) * rs * g2[3]); w.w = pg8::pk4_fp8(bflo(xb.z) * rs * g3[0], bfhi(xb.z) * rs * g3[1], bflo(xb.w) * rs * g3[2], bfhi(xb.w) * rs * g3[3]);
              *(v4u*)(MIX + (m0 + tr) * DM + 1024 + ch) = w; } }
        __syncthreads(); } }
    { const bf16* OC = (const bf16*)(ws + WS_OC); const bf16* OS = (const bf16*)(ws + WS_OS); const bf16* OW = (const bf16*)(ws + WS_OW); const float* ng = (const float*)a.in[11];
      const int h = lane >> 3, d0 = (lane & 7) * 16;
      const f32x4 gA = *(const f32x4*)(ng + h * 128 + d0), gB = *(const f32x4*)(ng + h * 128 + d0 + 4), gC = *(const f32x4*)(ng + h * 128 + d0 + 8), gD = *(const f32x4*)(ng + h * 128 + d0 + 12);
      const int NW2 = G * NWAVES;
      for (int m = wg * NWAVES + wave; m < MTOK; m += 2 * NW2) { v4u x[2][2], y[2][2], z[2][2]; unsigned gw[2][3];
#pragma unroll
        for (int q = 0; q < 2; ++q) { const int mm = m + q * NW2; const size_t off = (size_t)mm * 1024 + h * 128 + d0; const bf16* gp = (const bf16*)(ws + WS_GATES) + (size_t)mm * 32 + h * 3;
            gw[q][0] = gp[0]; gw[q][1] = gp[1]; gw[q][2] = gp[2];
#pragma unroll
            for (int hf = 0; hf < 2; ++hf) { x[q][hf] = *(const v4u*)(OC + off + 8 * hf); y[q][hf] = *(const v4u*)(OS + off + 8 * hf); z[q][hf] = *(const v4u*)(OW + off + 8 * hf); } }
#pragma unroll
        for (int q = 0; q < 2; ++q) { const int mm = m + q * NW2; const float g0 = sigmoidf(bf2f(gw[q][0])), g1 = sigmoidf(bf2f(gw[q][1])), g2 = sigmoidf(bf2f(gw[q][2])); float o[16]; float ss = 0.f;
#pragma unroll
            for (int hf = 0; hf < 2; ++hf)
#pragma unroll
                for (int j = 0; j < 4; ++j) { const float lo = g0 * bflo(x[q][hf][j]) + g1 * bflo(y[q][hf][j]) + g2 * bflo(z[q][hf][j]), hi = g0 * bfhi(x[q][hf][j]) + g1 * bfhi(y[q][hf][j]) + g2 * bfhi(z[q][hf][j]); o[8 * hf + 2 * j] = lo; o[8 * hf + 2 * j + 1] = hi; ss += lo * lo + hi * hi; }
            const float rs = __builtin_amdgcn_rsqf(wave_sum_v(ss) * (1.0f / 1024.0f) + EPS);
            v4u w8; w8.x = pg8::pk4_fp8(o[0] * rs * gA[0], o[1] * rs * gA[1], o[2] * rs * gA[2], o[3] * rs * gA[3]); w8.y = pg8::pk4_fp8(o[4] * rs * gB[0], o[5] * rs * gB[1], o[6] * rs * gB[2], o[7] * rs * gB[3]);
            w8.z = pg8::pk4_fp8(o[8] * rs * gC[0], o[9] * rs * gC[1], o[10] * rs * gC[2], o[11] * rs * gC[3]); w8.w = pg8::pk4_fp8(o[12] * rs * gD[0], o[13] * rs * gD[1], o[14] * rs * gD[2], o[15] * rs * gD[3]);
            *(v4u*)(MIX + (size_t)mm * DM + h * 128 + d0) = w8; } } }
}

__device__ __forceinline__ void unpack8_fp8(v2u x, float (&o)[8]) {
#pragma unroll
    for (int h = 0; h < 2; ++h) { const int w = (int)(h ? x.y : x.x); const auto lo = __builtin_amdgcn_cvt_pk_f32_fp8(w, false), hi = __builtin_amdgcn_cvt_pk_f32_fp8(w, true); o[4 * h] = lo[0]; o[4 * h + 1] = lo[1]; o[4 * h + 2] = hi[0]; o[4 * h + 3] = hi[1]; }
}
__device__ __forceinline__ void p_conv(const Args& a, int wg, int G) {
    unsigned char* ws = a.ws; const unsigned char* AH = (const unsigned char*)(ws + WS_AH); unsigned char* HM = (unsigned char*)(ws + WS_HMID);
    const float* cw = (const float*)a.in[16]; const float* cb = (const float*)a.in[17];
    constexpr int TB = 32, NCG = DFF / 8, NIT = (MTOK / TB) * NCG;
    for (int it = wg * NTHR + threadIdx.x; it < NIT; it += G * NTHR) { const int tb = it / NCG, cg = it - tb * NCG, n0 = 8 * cg, t0 = tb * TB;
        f32x2 w0[2][4], w1[2][4], w2[2][4], bb[2][4], p2[2][4], p1[2][4];
#pragma unroll
        for (int hf = 0; hf < 2; ++hf)
#pragma unroll
            for (int q = 0; q < 2; ++q) { const int n = n0 + hf * DFF + 4 * q; const f32x4 a0 = *(const f32x4*)(cw + n), a1 = *(const f32x4*)(cw + DFF2 + n), a2 = *(const f32x4*)(cw + 2 * DFF2 + n), ab = *(const f32x4*)(cb + n);
                w0[hf][2 * q] = (f32x2){a0[0], a0[1]}; w0[hf][2 * q + 1] = (f32x2){a0[2], a0[3]}; w1[hf][2 * q] = (f32x2){a1[0], a1[1]}; w1[hf][2 * q + 1] = (f32x2){a1[2], a1[3]};
                w2[hf][2 * q] = (f32x2){a2[0], a2[1]}; w2[hf][2 * q + 1] = (f32x2){a2[2], a2[3]}; bb[hf][2 * q] = (f32x2){ab[0], ab[1]}; bb[hf][2 * q + 1] = (f32x2){ab[2], ab[3]}; }
#pragma unroll
        for (int hf = 0; hf < 2; ++hf) { v2u x2 = (v2u){0u, 0u}, x1 = x2;
            if ((t0 & (SEQ - 1)) >= 2) { x2 = *(const v2u*)(AH + (size_t)(t0 - 2) * DFF2 + n0 + hf * DFF); x1 = *(const v2u*)(AH + (size_t)(t0 - 1) * DFF2 + n0 + hf * DFF); }
            p2[hf][0] = __builtin_amdgcn_cvt_pk_f32_fp8((int)x2.x, false); p2[hf][1] = __builtin_amdgcn_cvt_pk_f32_fp8((int)x2.x, true); p2[hf][2] = __builtin_amdgcn_cvt_pk_f32_fp8((int)x2.y, false); p2[hf][3] = __builtin_amdgcn_cvt_pk_f32_fp8((int)x2.y, true);
            p1[hf][0] = __builtin_amdgcn_cvt_pk_f32_fp8((int)x1.x, false); p1[hf][1] = __builtin_amdgcn_cvt_pk_f32_fp8((int)x1.x, true); p1[hf][2] = __builtin_amdgcn_cvt_pk_f32_fp8((int)x1.y, false); p1[hf][3] = __builtin_amdgcn_cvt_pk_f32_fp8((int)x1.y, true); }
        for (int tbb = t0; tbb < t0 + TB; tbb += 8) {
            v2u raw[8][2];
#pragma unroll
            for (int k = 0; k < 8; ++k)
#pragma unroll
                for (int hf = 0; hf < 2; ++hf) raw[k][hf] = *(const v2u*)(AH + (size_t)(tbb + k) * DFF2 + n0 + hf * DFF);
#pragma unroll
            for (int k = 0; k < 8; ++k) { f32x2 cu[2][4], acc[2][4];
#pragma unroll
                for (int hf = 0; hf < 2; ++hf) { cu[hf][0] = __builtin_amdgcn_cvt_pk_f32_fp8((int)raw[k][hf].x, false); cu[hf][1] = __builtin_amdgcn_cvt_pk_f32_fp8((int)raw[k][hf].x, true);
                    cu[hf][2] = __builtin_amdgcn_cvt_pk_f32_fp8((int)raw[k][hf].y, false); cu[hf][3] = __builtin_amdgcn_cvt_pk_f32_fp8((int)raw[k][hf].y, true);
#pragma unroll
                    for (int p = 0; p < 4; ++p) acc[hf][p] = __builtin_elementwise_fma(w2[hf][p], cu[hf][p], __builtin_elementwise_fma(w1[hf][p], p1[hf][p], __builtin_elementwise_fma(w0[hf][p], p2[hf][p], bb[hf][p]))); }
                f32x2 r[4];
                f32x2 d[4], gu[4];
#pragma unroll
                for (int p = 0; p < 4; ++p) { const f32x2 e = acc[0][p] * -1.4426950408889634f; d[p].x = __builtin_amdgcn_exp2f(e.x); d[p].y = __builtin_amdgcn_exp2f(e.y); gu[p] = acc[0][p] * acc[1][p]; }
#pragma unroll
                for (int p = 0; p < 4; ++p) { d[p] = d[p] + 1.0f; }
#pragma unroll
                for (int p = 0; p < 4; ++p) { f32x2 sg; sg.x = __builtin_amdgcn_rcpf(d[p].x); sg.y = __builtin_amdgcn_rcpf(d[p].y); r[p] = gu[p] * sg; }
                v2u w; w.x = pg8::pk4_fp8(r[0].x, r[0].y, r[1].x, r[1].y); w.y = pg8::pk4_fp8(r[2].x, r[2].y, r[3].x, r[3].y); *(v2u*)(HM + (size_t)(tbb + k) * DFF + n0) = w;
#pragma unroll
                for (int hf = 0; hf < 2; ++hf)
#pragma unroll
                    for (int p = 0; p < 4; ++p) { p2[hf][p] = p1[hf][p]; p1[hf][p] = cu[hf][p]; } } } }
}

__device__ __forceinline__ void p_final(const Args& a, int wg, int G) {
    const int lane = threadIdx.x & 63, wave = threadIdx.x >> 6; const float* fg = (const float*)a.in[19]; const bf16* h2 = (const bf16*)(a.ws + WS_H2BF);
    const int NW = G * NWAVES;
    for (int m = wg * NWAVES + wave; m < MTOK; m += 2 * NW) {
        v4u r[2][4]; const bool two = m + NW < MTOK;
#pragma unroll
        for (int q = 0; q < 2; ++q) { const v4u* xr = (const v4u*)(h2 + (size_t)(q && two ? m + NW : m) * DM) + lane;
#pragma unroll
            for (int j = 0; j < 4; ++j) r[q][j] = xr[64 * j]; }
#pragma unroll
        for (int q = 0; q < 2; ++q) { if (q && !two) break; const int mm = m + q * NW; float v[32]; float s = 0.f;
#pragma unroll
            for (int j = 0; j < 4; ++j)
#pragma unroll
                for (int k = 0; k < 4; ++k) { v[8 * j + 2 * k] = bflo(r[q][j][k]); v[8 * j + 2 * k + 1] = bfhi(r[q][j][k]); s += v[8 * j + 2 * k] * v[8 * j + 2 * k] + v[8 * j + 2 * k + 1] * v[8 * j + 2 * k + 1]; }
            const float rs = 1.0f / sqrtf(wave_sum(s) * (1.0f / DM) + EPS);
#pragma unroll
            for (int j = 0; j < 4; ++j) { const int c0 = 8 * (lane + 64 * j); const f32x4 ga = *(const f32x4*)(fg + c0), gb = *(const f32x4*)(fg + c0 + 4); f32x4* o = (f32x4*)(a.out + (size_t)mm * DM + c0);
                o[0] = (f32x4){v[8 * j] * rs * ga[0], v[8 * j + 1] * rs * ga[1], v[8 * j + 2] * rs * ga[2], v[8 * j + 3] * rs * ga[3]};
                o[1] = (f32x4){v[8 * j + 4] * rs * gb[0], v[8 * j + 5] * rs * gb[1], v[8 * j + 6] * rs * gb[2], v[8 * j + 7] * rs * gb[3]}; } } }
}

constexpr int NPHASE = 14;
#ifndef PROBE_DUP
#define PROBE_DUP 0
#endif
#ifndef PROBE_SEL
#define PROBE_P3 0
#define PROBE_SEL 0
#endif
#ifndef PROBE_G3
#define PROBE_G3 0
#endif
__global__ void __launch_bounds__(NTHR, 2) nsa_layer_fwd(Args a) {
    extern __shared__ __attribute__((aligned(16))) unsigned char lds_raw[];
    LAS unsigned char* lds = (LAS unsigned char*)lds_raw;
    volatile LAS unsigned* MISC = (volatile LAS unsigned*)(lds + MISC_OFF);
    const int tid = threadIdx.x, G = gridDim.x, wg = blockIdx.x;
    if (tid < 32) MISC[tid] = 0u;
    __syncthreads();
    unsigned char* ws = a.ws; unsigned* ctl = (unsigned*)(ws + WS_CTL);
    const int lo = a.ph_lo, hi = a.ph_hi;
    XcdBarrier bar; bar.bar = ctl + CW_BAR + a.li * XCD_BAR_WORDS; bar.x = 0; bar.st = MISC + 8;
    if (hi - lo > 1) bar = xcd_barrier_post(ctl + CW_BAR + a.li * XCD_BAR_WORDS, MISC + 8);
#define IN(k) (lo <= (k) && (k) < hi)
#define SEAM(k) do { if ((k) != 4 && (k) != 10 && (k) != 11 && IN(k) && IN((k) + 1)) xcd_barrier(bar); } while (0)
    bf16* XN = (bf16*)(ws + WS_XN); bf16* PROJ = (bf16*)(ws + WS_PROJ); bf16* H1B = (bf16*)(ws + WS_H1B); bf16* AH = (bf16*)(ws + WS_AH); bf16* HMID = (bf16*)(ws + WS_HMID);
    float* rowss = (float*)ctl + CW_ROWSS;

#define PH(k, ...) do { if (IN(k)) { __VA_ARGS__ if ((PROBE_DUP >> (k)) & 1) { __VA_ARGS__ } } SEAM(k); } while (0)
    PH(0, { p0_prologue(a, lds, wg, G); });
    PH(1, { { pg8::Gemm gm{XN, (const bf16*)(ws + WS_WIN), MTOK, NP1A, DM}; pg8::StaticOrder S; S.init(MTOK, NP1A, G, wg);
              pg8::EpiBf16<0, true> E{PROJ, NP1, nullptr, 0, 0, 1.f}; pg8::gemm_phase<pg8::EpiBf16<0, true>, pg8::StaticOrder, true, true>(lds, gm, S, E); }
            { pg8::Gemm gm{(const bf16*)(ws + WS_XN8), (const bf16*)(ws + WS_WIN8), MTOK, NP1 - NP1A, DM / 2}; pg8::StaticOrder S; S.init(MTOK, NP1 - NP1A, G, wg);
              pg8::EpiBf16<0, true> E{PROJ + NP1A, NP1, nullptr, NP1 - NP1A, 0, 1.0f / W8SCALE}; pg8::gemm_phase<pg8::EpiBf16<0, true>, pg8::StaticOrder, true, true, true>(lds, gm, S, E); }
            p1_gates(a, wg, G); });
    PH(2, { p2_prep(a, lds, wg, G); });
    if (IN(3) && PROBE_P3) { if (PROBE_P3 == 1) p3_cmp<1>(a, lds, wg, G); else if (PROBE_P3 == 2) p3_cmp<2>(a, lds, wg, G); else if (PROBE_P3 == 3) p3_cmp<3>(a, lds, wg, G); else p5_win(a, lds, wg, G); xcd_barrier(bar); }
    PH(3, { p3_cmp<0>(a, lds, wg, G); p5_win(a, lds, wg, G); });
    PH(4, { p4_sel<0>(a, lds, wg, G); });
    if (IN(4) && PROBE_SEL) { xcd_barrier(bar); if (PROBE_SEL == 1) p4_sel<1>(a, lds, wg, G); else p4_sel<2>(a, lds, wg, G); xcd_barrier(bar); }
    if (IN(4) && IN(6)) xcd_barrier(bar);
    PH(6, { p6_mix(a, lds, wg, G); });
    PH(7, { pg8::Gemm gm{(const bf16*)(ws + WS_QR), (const bf16*)(ws + WS_WOUT), MTOK, DM, DM / 2}; pg8::StaticOrder S; S.init(MTOK, DM, G, wg);
        pg8::EpiStream<true, true, true> E{(const float*)a.in[0], nullptr, (bf16*)(ws + WS_H1BF), (unsigned char*)H1B, rowss, DM, 1.0f / W8SCALE};
        pg8::gemm_phase<pg8::EpiStream<true, true, true>, pg8::StaticOrder, true, true, true>(lds, gm, S, E); });
    PH(8, { pg8::Gemm gm{H1B, (const bf16*)(ws + WS_WUP), MTOK, DFF2, DM / 2}; pg8::StaticOrder S; S.init(MTOK, DFF2, G, wg);
        pg8::EpiScaleT<true> E{AH, DFF2, rowss, 1.0f / DM, EPS, 1.0f / W8SCALE}; pg8::gemm_phase<pg8::EpiScaleT<true>, pg8::StaticOrder, true, true, true>(lds, gm, S, E); });
    if (IN(8) && PROBE_G3) { xcd_barrier(bar); pg8::Gemm gm{H1B, (const bf16*)(ws + WS_WUP), MTOK, DFF2, DM / 2}; pg8::StaticOrder S; S.init(MTOK, DFF2, G, wg); pg8::EpiNull E{nullptr}; pg8::gemm_phase<pg8::EpiNull, pg8::StaticOrder, true, true, true>(lds, gm, S, E); xcd_barrier(bar); }
    PH(9, { p_conv(a, wg, G); });
    PH(12, { pg8::Gemm gm{HMID, (const bf16*)(ws + WS_WDN), MTOK, DM, DFF / 2}; pg8::StaticOrder S; S.init(MTOK, DM, G, wg);
        pg8::EpiStream<false, false, false> E{nullptr, (const bf16*)(ws + WS_H1BF), (bf16*)(ws + WS_H2BF), nullptr, nullptr, DM, 1.0f / W8SCALE};
        pg8::gemm_phase<pg8::EpiStream<false, false, false>, pg8::StaticOrder, true, true, true>(lds, gm, S, E); });
    PH(13, { p_final(a, wg, G); });
#undef PH
#undef IN
#undef SEAM
}

#ifndef MK_N_LAUNCHES
#define MK_N_LAUNCHES 1
#endif
extern "C" void kernel_launch(void* const* d_in, const int* in_sizes, int n_in, void* d_out, int out_size, void* d_ws, size_t ws_size, hipStream_t stream) {
    static int grid = 0;
    if (grid == 0) {
        if (n_in != 20 || out_size != MTOK * DM || ws_size < WS_END2) { fprintf(stderr, "kernel_launch: unexpected shapes (n_in %d, out %d, ws %zu)\n", n_in, out_size, ws_size); grid = -1; return; }
        int dev = 0, cus = 0, per_cu = 0;
        if (hipGetDevice(&dev) != hipSuccess || hipDeviceGetAttribute(&cus, hipDeviceAttributeMultiprocessorCount, dev) != hipSuccess) { grid = -1; return; }
        if (hipFuncSetAttribute((const void*)nsa_layer_fwd, hipFuncAttributeMaxDynamicSharedMemorySize, LDS_BYTES) != hipSuccess) { fprintf(stderr, "kernel_launch: hipFuncSetAttribute failed\n"); grid = -1; return; }
        if (hipOccupancyMaxActiveBlocksPerMultiprocessor(&per_cu, (const void*)nsa_layer_fwd, NTHR, LDS_BYTES) != hipSuccess || per_cu < 1) { fprintf(stderr, "kernel_launch: occupancy query says %d blocks per CU\n", per_cu); }
        (void)hipGetLastError();
        grid = cus;
    }
    if (grid < 0) return;
    if (hipMemsetAsync((char*)d_ws + WS_CTL, 0, CTL_ZERO_BYTES, stream) != hipSuccess) return;
    Args a{};
    for (int i = 0; i < 20; ++i) a.in[i] = d_in[i];
    a.out = (float*)d_out; a.ws = (unsigned char*)d_ws;
    constexpr int NL = MK_N_LAUNCHES;
    for (int li = 0; li < NL; ++li) {
        a.ph_lo = (NL == NPHASE) ? li : (li * NPHASE) / NL; a.ph_hi = (NL == NPHASE) ? li + 1 : ((li + 1) * NPHASE) / NL; a.li = li; a.pad = 0;
        hipLaunchKernelGGL(nsa_layer_fwd, dim3(grid), dim3(NTHR), LDS_BYTES, stream, a);
    }
}
```

```cpp
#include <hip/hip_runtime.h>
#include <cstdio>
#include <cstdint>

namespace pg8 {
#define PG8_LAS __attribute__((address_space(3)))
typedef unsigned short bf16_t;
typedef short bf16x8 __attribute__((ext_vector_type(8)));
typedef float f32x4 __attribute__((ext_vector_type(4)));
typedef unsigned u32x4 __attribute__((ext_vector_type(4)));
constexpr int BM = 256, BK = 64, HALF = 128, HTB = HALF * BK * 2  , STAGE_BYTES = 8 * HTB, NXCD = 8, WGM = 8;

__host__ __device__ __forceinline__ int lds_byte(int r, int c) { const int st = (r >> 4) * 2 + (c >> 5), rr = r & 15, cc = c & 31, ob = rr * 64 + cc * 2; return st * 1024 + (ob ^ (((ob >> 9) & 1) << 5)); }
__host__ __device__ __forceinline__ void stage_rc(int b, int& R, int& C) { const int st = b / 1024, sb = b % 1024, swz = sb ^ (((sb >> 9) & 1) << 5); R = (st >> 1) * 16 + swz / 64; C = (st & 1) * 32 + (swz % 64) / 2; }
__host__ __device__ __forceinline__ int perm32(int rho) { const int n = rho >> 4, i = rho & 15; return 8 * (i >> 2) + 4 * n + (i & 3); }

struct Unit { int pm, pn; };
struct Gemm { const bf16_t* A; const bf16_t* Bt; int M, N, K; };

struct StaticOrder {
    int nM, nN, nwg, G, c;
    __host__ __device__ void init(int M, int N, int G_, int c_) { nM = M / BM; nN = N / BM; nwg = nM * nN; G = G_; c = c_; }
    __host__ __device__ bool next(int i, Unit& u) const {
        const long L = (long)i * G + c; if (L >= nwg) return false;
        int wgid = (int)L; { const int q = nwg / NXCD, r = nwg % NXCD, xcd = wgid % NXCD, off = wgid / NXCD; wgid = (xcd < r ? xcd * (q + 1) : r * (q + 1) + (xcd - r) * q) + off; }
        const int nig = WGM * nN, gid = wgid / nig, fm = gid * WGM, gsz = (nM - fm) < WGM ? (nM - fm) : WGM;
        u.pm = fm + ((wgid % nig) % gsz); u.pn = (wgid % nig) / gsz; return true;
    }
    __device__ __forceinline__ void a_ready(const Unit&) const {}
    __device__ __forceinline__ void done(const Unit&) const {}
};

__device__ __forceinline__ unsigned cvt_pk_bf16(float lo, float hi) { unsigned r; asm volatile("v_cvt_pk_bf16_f32 %0, %1, %2" : "=v"(r) : "v"(lo), "v"(hi)); return r; }
typedef float f32x2 __attribute__((ext_vector_type(2)));
__device__ __forceinline__ f32x2 gelu_pk(f32x2 v) {
    const f32x2 av = __builtin_elementwise_abs(v), d = av * 0.2316418882f + 1.0f;
    f32x2 t; t.x = __builtin_amdgcn_rcpf(d.x); t.y = __builtin_amdgcn_rcpf(d.y);
    f32x2 q = t * 0.5307027145f + (-0.7265760135f); q = q * t + 0.7107068705f; q = q * t + (-0.142248368f); q = q * t + 0.127414796f; q = q * t;
    const f32x2 s = (v * v) * (-0.72134752044f);
    f32x2 e; e.x = __builtin_amdgcn_exp2f(s.x); e.y = __builtin_amdgcn_exp2f(s.y);
    const f32x2 m = v * (q * e), r = v - m;
    f32x2 o; o.x = v.x < 0.f ? m.x : r.x; o.y = v.y < 0.f ? m.y : r.y; return o;
}

template <int ACT  , bool BJ = false  > struct EpiBf16 {
    static constexpr bool PERM = true, AFTER_DRAIN = false; static constexpr bool BJ16 = BJ; static_assert(ACT == 0 || ACT == 1, "EpiBf16: ACT is 0 (none) or 1 (gelu_pk)");
    bf16_t* O; int ldc; const float* bias; int split_cols; size_t split_stride; float scale0;
    __device__ __forceinline__ void operator()(const f32x4 (&acc)[2][2][4][2], const Unit& u, int wr, int wc, int fr, int fq) const {
        const int row0 = u.pm * BM + wr * 64 + fr; int colt = u.pn * BM; bf16_t* base = O;
        float sc = 1.f; if (split_cols) { const int t = colt / split_cols; base += (size_t)t * split_stride; colt -= t * split_cols; if (t == 0) sc = scale0; }
        const int lc0 = BJ ? wc * 64 + 16 * fq : wc * 32 + 8 * fq, col0 = colt + lc0, bcol0 = u.pn * BM + lc0; constexpr int BJS = BJ ? 8 : HALF;
        f32x4 bv[2][2];
#pragma unroll
        for (int bj = 0; bj < 2; ++bj)
#pragma unroll
            for (int n = 0; n < 2; ++n) bv[bj][n] = bias ? *(const f32x4*)(bias + bcol0 + bj * BJS + 4 * n) : (f32x4){0.f, 0.f, 0.f, 0.f};
#pragma unroll
        for (int ai = 0; ai < 2; ++ai)
#pragma unroll
            for (int m = 0; m < 4; ++m) { bf16_t* rowp = base + (size_t)(row0 + ai * HALF + m * 16) * ldc + col0;
#pragma unroll
                for (int bj = 0; bj < 2; ++bj) { f32x4 v0 = acc[ai][bj][m][0] + bv[bj][0], v1 = acc[ai][bj][m][1] + bv[bj][1];
                    if (ACT == 1) { f32x2 a = gelu_pk((f32x2){v0[0], v0[1]}), b = gelu_pk((f32x2){v0[2], v0[3]}), c = gelu_pk((f32x2){v1[0], v1[1]}), d = gelu_pk((f32x2){v1[2], v1[3]});
                        v0 = (f32x4){a.x, a.y, b.x, b.y}; v1 = (f32x4){c.x, c.y, d.x, d.y}; }
                    v0 = v0 * sc; v1 = v1 * sc; u32x4 w; w.x = cvt_pk_bf16(v0[0], v0[1]); w.y = cvt_pk_bf16(v0[2], v0[3]); w.z = cvt_pk_bf16(v1[0], v1[1]); w.w = cvt_pk_bf16(v1[2], v1[3]);
                    *(u32x4*)(rowp + bj * BJS) = w; } }
    }
};

typedef int v8i32 __attribute__((ext_vector_type(8)));
typedef int v4i32 __attribute__((ext_vector_type(4)));
__device__ __forceinline__ v8i32 cat8(bf16x8 lo, bf16x8 hi) { const v4i32 a = __builtin_bit_cast(v4i32, lo), b = __builtin_bit_cast(v4i32, hi); return __builtin_shufflevector(a, b, 0, 1, 2, 3, 4, 5, 6, 7); }
__device__ __forceinline__ unsigned pk4_fp8(float a, float b, float c, float d) { int p = 0; p = __builtin_amdgcn_cvt_pk_fp8_f32(a, b, p, false); p = __builtin_amdgcn_cvt_pk_fp8_f32(c, d, p, true); return (unsigned)p; }
template <class Epi, class Sched, bool ALIGN_EPI = false, bool SP2 = false, bool FP8 = false>
__device__ __forceinline__ void gemm_phase(PG8_LAS unsigned char* lds, const Gemm g, const Sched& S, const Epi& E) {
    const int tid = threadIdx.x, wid = __builtin_amdgcn_readfirstlane(tid >> 6), lane = tid & 63, wr = wid >> 2, wc = wid & 3, fr = lane & 15, fq = lane >> 4;
    const int K = g.K, nt = K / BK;
    unsigned voffA[2], voffB[2];
#pragma unroll
    for (int i = 0; i < 2; ++i) { int R, C; stage_rc(tid * 16 + i * 8192, R, C); const int Rp = Epi::PERM ? ((R & ~31) + perm32(R & 31)) : R, Rb = Epi::BJ16 ? (16 * (Rp >> 3) + (Rp & 7)) : Rp;
        voffA[i] = (unsigned)(R * K + C) * 2u; voffB[i] = (unsigned)(Rb * K + C) * 2u; }
    const size_t kstep = (size_t)(BK * 2);
    const size_t hstep = (size_t)HALF * K * 2;
    const size_t hstepB = Epi::BJ16 ? (size_t)8 * K * 2 : hstep;
    const size_t tstep = 2 * hstep;
    const unsigned ldsw = (unsigned)wid * 1024u;
    const int aoff = lds_byte(wr * 64 + fr, fq * 8), boff = lds_byte(wc * 32 + fr, fq * 8);
    constexpr int akd = 1024, bkd = 1024;
#define PG8_SA(b, h) (((b) * 2 + (h)) * HTB)
#define PG8_SB(b, h) ((4 + (b) * 2 + (h)) * HTB)
#define PG8_STAGE(bufoff, gbase, voff) do { _Pragma("unroll") for (int _i = 0; _i < 2; ++_i) \
        __builtin_amdgcn_global_load_lds((const unsigned*)((const char*)(gbase) + (voff)[_i]), (PG8_LAS unsigned*)(lds + (bufoff) + ldsw + _i * 8192), 16, 0, 0); } while (0)
#define PG8_LDA(dst, b, h) do { if constexpr (FP8) { _Pragma("unroll") for (int m = 0; m < 4; ++m) dst##8[m] = cat8(*(const PG8_LAS bf16x8*)(lds + PG8_SA(b, h) + aoff + m * 2048), *(const PG8_LAS bf16x8*)(lds + PG8_SA(b, h) + aoff + m * 2048 + akd)); } \
    else { _Pragma("unroll") for (int m = 0; m < 4; ++m) _Pragma("unroll") for (int k = 0; k < 2; ++k) dst[m][k] = *(const PG8_LAS bf16x8*)(lds + PG8_SA(b, h) + aoff + m * 2048 + k * 1024); } } while (0)
#define PG8_LDB(dst, b, h) do { if constexpr (FP8) { _Pragma("unroll") for (int n = 0; n < 2; ++n) dst##8[n] = cat8(*(const PG8_LAS bf16x8*)(lds + PG8_SB(b, h) + boff + n * 2048), *(const PG8_LAS bf16x8*)(lds + PG8_SB(b, h) + boff + n * 2048 + bkd)); } \
    else { _Pragma("unroll") for (int n = 0; n < 2; ++n) _Pragma("unroll") for (int k = 0; k < 2; ++k) dst[n][k] = *(const PG8_LAS bf16x8*)(lds + PG8_SB(b, h) + boff + n * 2048 + k * 1024); } } while (0)
#define PG8_MMA(ai, bj, At, Bt) do { __builtin_amdgcn_s_setprio(1); _Pragma("unroll") for (int m = 0; m < 4; ++m) _Pragma("unroll") for (int n = 0; n < 2; ++n) { \
        if constexpr (FP8) { asm volatile("v_mfma_scale_f32_16x16x128_f8f6f4 %0, %1, %2, %0, %3, %3 op_sel_hi:[0,0,0]" : "+v"(acc[ai][bj][m][n]) : "v"(Bt##8[n]), "v"(At##8[m]), "v"(0x7f7f7f7f)); }   \
        else { _Pragma("unroll") for (int k = 0; k < 2; ++k) acc[ai][bj][m][n] = __builtin_amdgcn_mfma_f32_16x16x32_bf16(Bt[n][k], At[m][k], acc[ai][bj][m][n], 0, 0, 0); } } __builtin_amdgcn_s_setprio(0); } while (0)
#define PG8_WAIT_V(n) asm volatile("s_waitcnt vmcnt(" #n ")" ::: "memory")
#define PG8_WAIT_L(n) asm volatile("s_waitcnt lgkmcnt(" #n ")" ::: "memory")
#define PG8_BAR __builtin_amdgcn_s_barrier()
#define PG8_SCHED __builtin_amdgcn_sched_barrier(0)
    Unit cur, nxt; int ui = 0;
    if (!S.next(0, cur)) return;
    f32x4 acc[2][2][4][2];
#pragma unroll
    for (int a = 0; a < 2; ++a)
#pragma unroll
        for (int b = 0; b < 2; ++b)
#pragma unroll
            for (int m = 0; m < 4; ++m)
#pragma unroll
                for (int n = 0; n < 2; ++n) acc[a][b][m][n] = (f32x4){0.f, 0.f, 0.f, 0.f};
    bf16x8 At[4][2], B0[2][2], B1[2][2]; v8i32 At8[4], B08[2], B18[2];
    const char* cA = (const char*)g.A + (size_t)cur.pm * tstep; const char* cB = (const char*)g.Bt + (size_t)cur.pn * tstep;
    S.a_ready(cur);
    if constexpr (SP2) {
        PG8_STAGE(PG8_SB(0, 0), cB, voffB); PG8_STAGE(PG8_SB(0, 1), cB + hstepB, voffB); PG8_STAGE(PG8_SA(0, 0), cA, voffA); PG8_STAGE(PG8_SA(0, 1), cA + hstep, voffA);
        if (wr == 1) PG8_BAR;
        PG8_WAIT_V(2); PG8_BAR;
        PG8_STAGE(PG8_SB(1, 0), cB + kstep, voffB); PG8_STAGE(PG8_SA(1, 0), cA + kstep, voffA); PG8_STAGE(PG8_SB(1, 1), cB + hstepB + kstep, voffB);
        PG8_WAIT_V(6); PG8_BAR;
    } else {
        PG8_STAGE(PG8_SB(0, 0), cB, voffB); PG8_STAGE(PG8_SA(0, 0), cA, voffA); PG8_STAGE(PG8_SB(0, 1), cB + hstepB, voffB); PG8_STAGE(PG8_SA(0, 1), cA + hstep, voffA);
        if (wr == 1) PG8_BAR;
        PG8_WAIT_V(4); PG8_BAR;
        PG8_STAGE(PG8_SB(1, 0), cB + kstep, voffB); PG8_STAGE(PG8_SA(1, 0), cA + kstep, voffA); PG8_STAGE(PG8_SB(1, 1), cB + hstepB + kstep, voffB);
        PG8_WAIT_V(6); PG8_BAR;
    }
    for (;;) {
        const bool has_next = S.next(ui + 1, nxt);
        const char* nA = has_next ? (const char*)g.A + (size_t)nxt.pm * tstep : cA; const char* nB = has_next ? (const char*)g.Bt + (size_t)nxt.pn * tstep : cB;
        for (int t = 0; t < nt; t += 2) {
            const bool last = (t == nt - 2);
            const char* a1 = cA + (size_t)(t + 1) * kstep;
            const char* a2 = last ? nA : cA + (size_t)(t + 2) * kstep; const char* b2 = last ? nB : cB + (size_t)(t + 2) * kstep;
            const char* a3 = a2 + kstep; const char* b3 = b2 + kstep;
            if (last && has_next) S.a_ready(nxt);
            if constexpr (SP2) {
            PG8_LDB(B0, 0, 0); PG8_LDB(B1, 0, 1); PG8_SCHED; PG8_LDA(At, 0, 0); PG8_STAGE(PG8_SA(1, 1), a1 + hstep, voffA);
            PG8_WAIT_V(8); PG8_WAIT_L(0); PG8_BAR; PG8_MMA(0, 0, At, B0); PG8_MMA(0, 1, At, B1); PG8_BAR; PG8_SCHED;
            PG8_LDA(At, 0, 1); PG8_STAGE(PG8_SB(0, 0), b2, voffB); PG8_STAGE(PG8_SB(0, 1), b2 + hstepB, voffB); PG8_STAGE(PG8_SA(0, 0), a2, voffA);
            PG8_WAIT_V(8); PG8_WAIT_L(0); PG8_BAR; PG8_MMA(1, 0, At, B0); PG8_MMA(1, 1, At, B1); PG8_BAR; PG8_SCHED;
            PG8_LDB(B0, 1, 0); PG8_LDB(B1, 1, 1); PG8_SCHED; PG8_LDA(At, 1, 0); PG8_STAGE(PG8_SA(0, 1), a2 + hstep, voffA);
            PG8_WAIT_V(8); PG8_WAIT_L(0); PG8_BAR; PG8_MMA(0, 0, At, B0); PG8_MMA(0, 1, At, B1); PG8_BAR; PG8_SCHED;
            PG8_LDA(At, 1, 1); PG8_STAGE(PG8_SB(1, 0), b3, voffB); PG8_STAGE(PG8_SB(1, 1), b3 + hstepB, voffB); PG8_STAGE(PG8_SA(1, 0), a3, voffA);
            PG8_WAIT_V(8); PG8_WAIT_L(0); PG8_BAR; PG8_MMA(1, 0, At, B0); PG8_MMA(1, 1, At, B1); PG8_BAR; PG8_SCHED;
            } else {
            PG8_LDB(B0, 0, 0); PG8_SCHED; PG8_LDA(At, 0, 0); PG8_STAGE(PG8_SA(1, 1), a1 + hstep, voffA);
            PG8_WAIT_L(8); PG8_BAR; PG8_WAIT_L(0); PG8_MMA(0, 0, At, B0); PG8_BAR; PG8_SCHED;
            PG8_LDB(B1, 0, 1); PG8_STAGE(PG8_SB(0, 0), b2, voffB);
            PG8_BAR; PG8_WAIT_L(0); PG8_MMA(0, 1, At, B1); PG8_BAR;
            PG8_LDA(At, 0, 1); PG8_STAGE(PG8_SA(0, 0), a2, voffA);
            PG8_BAR; PG8_WAIT_L(0); PG8_MMA(1, 0, At, B0); PG8_BAR; PG8_SCHED;
            PG8_STAGE(PG8_SB(0, 1), b2 + hstepB, voffB);
            PG8_WAIT_V(6); PG8_BAR; PG8_MMA(1, 1, At, B1); PG8_BAR;
            PG8_LDB(B0, 1, 0); PG8_SCHED; PG8_LDA(At, 1, 0); PG8_STAGE(PG8_SA(0, 1), a2 + hstep, voffA);
            PG8_WAIT_L(8); PG8_BAR; PG8_WAIT_L(0); PG8_MMA(0, 0, At, B0); PG8_BAR; PG8_SCHED;
            PG8_LDB(B1, 1, 1); PG8_STAGE(PG8_SB(1, 0), b3, voffB);
            PG8_BAR; PG8_WAIT_L(0); PG8_MMA(0, 1, At, B1); PG8_BAR;
            PG8_LDA(At, 1, 1); PG8_STAGE(PG8_SA(1, 0), a3, voffA);
            PG8_BAR; PG8_WAIT_L(0); PG8_MMA(1, 0, At, B0); PG8_BAR; PG8_SCHED;
            PG8_STAGE(PG8_SB(1, 1), b3 + hstepB, voffB);
            PG8_WAIT_V(6); PG8_BAR; PG8_MMA(1, 1, At, B1); PG8_BAR;
            }
        }
        if constexpr (ALIGN_EPI) { if (wr == 0) PG8_BAR; }
        if constexpr (FP8) asm volatile("s_nop 15\n\ts_nop 15" ::: "memory");
        if constexpr (!Epi::AFTER_DRAIN) { E(acc, cur, wr, wc, fr, fq); S.done(cur); }
        if (!has_next) break;
#pragma unroll
        for (int a = 0; a < 2; ++a)
#pragma unroll
            for (int b = 0; b < 2; ++b)
#pragma unroll
                for (int m = 0; m < 4; ++m)
#pragma unroll
                    for (int n = 0; n < 2; ++n) acc[a][b][m][n] = (f32x4){0.f, 0.f, 0.f, 0.f};
        cur = nxt; cA = nA; cB = nB; ++ui;
        if constexpr (ALIGN_EPI) { if (wr == 1) PG8_BAR; }
    }
    PG8_WAIT_V(0);
    if constexpr (!ALIGN_EPI) { if (wr == 0) PG8_BAR; }
    PG8_BAR;
    if constexpr (Epi::AFTER_DRAIN) { E.fused(acc, cur, wr, wc, fr, fq, lds, wid, lane); S.done(cur); }
#undef PG8_SA
#undef PG8_SB
#undef PG8_STAGE
#undef PG8_LDA
#undef PG8_LDB
#undef PG8_MMA
#undef PG8_WAIT_V
#undef PG8_WAIT_L
#undef PG8_BAR
#undef PG8_SCHED
}
}

namespace pg8 {
typedef unsigned u32x2 __attribute__((ext_vector_type(2)));
template <int BF  , bool SS> struct EpiResid {
    static constexpr bool PERM = false, AFTER_DRAIN = false; static constexpr bool BJ16 = false;
    const float* res; float* out; bf16_t* ob; float* rowss; int ld; float ascale;
    __device__ __forceinline__ void operator()(const f32x4 (&acc)[2][2][4][2], const Unit& u, int wr, int wc, int fr, int fq) const {
        const int row0 = u.pm * BM + wr * 64 + fr, col0 = u.pn * BM + wc * 32 + 4 * fq;
#pragma unroll
        for (int ai = 0; ai < 2; ++ai)
#pragma unroll
            for (int m = 0; m < 4; ++m) { const int row = row0 + ai * HALF + m * 16; const size_t ro = (size_t)row * ld + col0; float ss = 0.f;
#pragma unroll
                for (int bj = 0; bj < 2; ++bj)
#pragma unroll
                    for (int n = 0; n < 2; ++n) { const size_t o = ro + bj * HALF + n * 16; const f32x4 r4 = *(const f32x4*)(res + o); const f32x4 v = acc[ai][bj][m][n] * ascale + r4;
                        *(f32x4*)(out + o) = v;
                        if (BF == 1) { u32x2 w; w.x = cvt_pk_bf16(v[0], v[1]); w.y = cvt_pk_bf16(v[2], v[3]); *(u32x2*)(ob + o) = w; }
                        if (BF == 2) { *(unsigned*)((unsigned char*)ob + o) = pk4_fp8(v[0], v[1], v[2], v[3]); }
                        if (SS) ss += (v[0] * v[0] + v[1] * v[1]) + (v[2] * v[2] + v[3] * v[3]); }
                if (SS) { ss += __shfl_xor(ss, 16); ss += __shfl_xor(ss, 32); if (fq == 0) atomicAdd(rowss + row, ss); } }
    }
};
struct EpiNull { static constexpr bool PERM = true, AFTER_DRAIN = false; static constexpr bool BJ16 = false; float* O;
    __device__ __forceinline__ void operator()(const f32x4 (&acc)[2][2][4][2], const Unit& u, int wr, int wc, int fr, int fq) const {
#pragma unroll
      for (int a = 0; a < 2; ++a)
#pragma unroll
        for (int b = 0; b < 2; ++b)
#pragma unroll
          for (int m = 0; m < 4; ++m)
#pragma unroll
            for (int n = 0; n < 2; ++n) asm volatile("" :: "v"(acc[a][b][m][n])); } };
template <bool RES_F32, bool F8, bool SS> struct EpiStream {
    static constexpr bool PERM = true, AFTER_DRAIN = false; static constexpr bool BJ16 = true;
    const float* resf; const bf16_t* resb; bf16_t* ob; unsigned char* o8; float* rowss; int ld; float ascale;
    __device__ __forceinline__ void operator()(const f32x4 (&acc)[2][2][4][2], const Unit& u, int wr, int wc, int fr, int fq) const {
        const int row0 = u.pm * BM + wr * 64 + fr, col0 = u.pn * BM + wc * 64 + 16 * fq;
#pragma unroll
        for (int ai = 0; ai < 2; ++ai)
#pragma unroll
            for (int m = 0; m < 4; ++m) { const int row = row0 + ai * HALF + m * 16; const size_t ro = (size_t)row * ld + col0; float ss = 0.f; f32x4 r4[4];
                if (RES_F32) {
#pragma unroll
                    for (int q = 0; q < 4; ++q) r4[q] = *(const f32x4*)(resf + ro + 4 * q); }
                else { const u32x4 ra = *(const u32x4*)(resb + ro), rb = *(const u32x4*)(resb + ro + 8); const unsigned rw[8] = {ra.x, ra.y, ra.z, ra.w, rb.x, rb.y, rb.z, rb.w};
#pragma unroll
                    for (int q = 0; q < 4; ++q) r4[q] = (f32x4){__builtin_bit_cast(float, rw[2 * q] << 16), __builtin_bit_cast(float, rw[2 * q] & 0xffff0000u), __builtin_bit_cast(float, rw[2 * q + 1] << 16), __builtin_bit_cast(float, rw[2 * q + 1] & 0xffff0000u)}; }
                f32x4 v[4];
#pragma unroll
                for (int q = 0; q < 4; ++q) { v[q] = acc[ai][q >> 1][m][q & 1] * ascale + r4[q]; if (SS) ss += (v[q][0] * v[q][0] + v[q][1] * v[q][1]) + (v[q][2] * v[q][2] + v[q][3] * v[q][3]); }
                u32x4 wa, wb; wa.x = cvt_pk_bf16(v[0][0], v[0][1]); wa.y = cvt_pk_bf16(v[0][2], v[0][3]); wa.z = cvt_pk_bf16(v[1][0], v[1][1]); wa.w = cvt_pk_bf16(v[1][2], v[1][3]);
                wb.x = cvt_pk_bf16(v[2][0], v[2][1]); wb.y = cvt_pk_bf16(v[2][2], v[2][3]); wb.z = cvt_pk_bf16(v[3][0], v[3][1]); wb.w = cvt_pk_bf16(v[3][2], v[3][3]);
                *(u32x4*)(ob + ro) = wa; *(u32x4*)(ob + ro + 8) = wb;
                if (F8) { u32x4 w8; w8.x = pk4_fp8(v[0][0], v[0][1], v[0][2], v[0][3]); w8.y = pk4_fp8(v[1][0], v[1][1], v[1][2], v[1][3]); w8.z = pk4_fp8(v[2][0], v[2][1], v[2][2], v[2][3]); w8.w = pk4_fp8(v[3][0], v[3][1], v[3][2], v[3][3]); *(u32x4*)(o8 + ro) = w8; }
                if (SS) { ss += __shfl_xor(ss, 16); ss += __shfl_xor(ss, 32); if (fq == 0) atomicAdd(rowss + row, ss); } }
    }
};
template <bool F8OUT> struct EpiScaleT {
    static constexpr bool PERM = true, AFTER_DRAIN = false; static constexpr bool BJ16 = F8OUT;
    bf16_t* O; int ldc; const float* rowss; float inv_n, eps, oscale;
    __device__ __forceinline__ void operator()(const f32x4 (&acc)[2][2][4][2], const Unit& u, int wr, int wc, int fr, int fq) const {
        const int row0 = u.pm * BM + wr * 64 + fr, col0 = u.pn * BM + wc * 32 + 8 * fq;
#pragma unroll
        for (int ai = 0; ai < 2; ++ai)
#pragma unroll
            for (int m = 0; m < 4; ++m) { const int row = row0 + ai * HALF + m * 16; const float rs = __builtin_amdgcn_rsqf(rowss[row] * inv_n + eps) * oscale;
                bf16_t* rowp = O + (size_t)row * ldc + col0;
                if (F8OUT) { const f32x4 v0 = acc[ai][0][m][0] * rs, v1 = acc[ai][0][m][1] * rs, v2 = acc[ai][1][m][0] * rs, v3 = acc[ai][1][m][1] * rs; u32x4 w;
                    w.x = pk4_fp8(v0[0], v0[1], v0[2], v0[3]); w.y = pk4_fp8(v1[0], v1[1], v1[2], v1[3]); w.z = pk4_fp8(v2[0], v2[1], v2[2], v2[3]); w.w = pk4_fp8(v3[0], v3[1], v3[2], v3[3]);
                    *(u32x4*)((unsigned char*)O + (size_t)row * ldc + u.pn * BM + wc * 64 + 16 * fq) = w; }
                else
#pragma unroll
                for (int bj = 0; bj < 2; ++bj) { const f32x4 v0 = acc[ai][bj][m][0] * rs, v1 = acc[ai][bj][m][1] * rs;
                    if (F8OUT) { }
                    else { u32x4 w; w.x = cvt_pk_bf16(v0[0], v0[1]); w.y = cvt_pk_bf16(v0[2], v0[3]); w.z = cvt_pk_bf16(v1[0], v1[1]); w.w = cvt_pk_bf16(v1[2], v1[3]);
                        *(u32x4*)(rowp + bj * HALF) = w; } } }
    }
};
typedef EpiScaleT<false> EpiScaleBf16;
}

constexpr int BATCH = 2, SEQ = 16384, DM = 2048, MTOK = BATCH * SEQ;
constexpr int DIN = 4632, NP1 = 4608;
constexpr int NP1A = 1536;
constexpr int HD = 128, NH = 8;
constexpr int COL_KCMP = 1024, COL_VCMP = 1280, COL_KSEL = 1536, COL_VSEL = 1792, COL_KWIN = 2048, COL_VWIN = 2304, WCOL_GATE = 2560  , COL_U = 2560, COL_V = 3584;
constexpr int DFF = 5632, DFF2 = 11264;
constexpr float EPS = 1e-6f;
constexpr float W8SCALE = 64.0f;
constexpr float C2 = 0.08838834764831845f * 1.4426950408889634f;
constexpr int NWAVES = 8, NTHR = 512;

constexpr size_t MiB = 1u << 20;
constexpr size_t WS_CTL = 0, CTL_ZERO_BYTES = 1 * MiB;
constexpr size_t WS_WIN = 1 * MiB, WS_WOUT = 20 * MiB, WS_WUP = 28 * MiB, WS_WDN = 72 * MiB, WS_WCK = 94 * MiB, WS_WCV = 95 * MiB, WS_WM = 96 * MiB;
constexpr size_t WS_COS = 97 * MiB, WS_SIN = 105 * MiB, WS_KC = 113 * MiB, WS_VCT = 114 * MiB, WS_KSEL = 115 * MiB, WS_KWIN = 131 * MiB, WS_VSELT = 147 * MiB, WS_VWINT = 163 * MiB;
constexpr size_t WS_TMASK = 179 * MiB, WS_H1B = 181 * MiB;
constexpr size_t WS_Q8 = 309 * MiB  ;
constexpr size_t WS_XN = 309 * MiB  , WS_QR = 373 * MiB  , WS_PROJ = 437 * MiB, WS_OC = 741 * MiB, WS_OS = 805 * MiB, WS_OW = 869 * MiB;
constexpr size_t WS_AH = 309 * MiB  , WS_HMID = 661 * MiB, WS_END = 1013 * MiB;
constexpr size_t WS_H1BF = 837 * MiB  , WS_H2BF = 309 * MiB  ;
constexpr size_t WS_WIN8 = 9 * MiB  , WS_XN8 = 741 * MiB  ;
constexpr size_t WS_WG = 96 * MiB + 512 * 1024  , WS_GATES = 1013 * MiB  , WS_END2 = 1015 * MiB;
static_assert(WS_PROJ + (size_t)MTOK * NP1 * 2 <= WS_OC && WS_AH + (size_t)MTOK * DFF2 <= WS_HMID && WS_HMID + (size_t)MTOK * DFF <= WS_END, "ws map");
constexpr int CW_BAR = 4096;
constexpr int CW_CCONST = 65536;
constexpr int CW_ROWSS = 131072;
static_assert(CW_BAR + 16 * 3456 <= CW_CCONST && (CW_ROWSS + MTOK) * 4 <= (int)CTL_ZERO_BYTES, "ctl map");
constexpr int LDS_BYTES = 147456;
constexpr int MISC_OFF = LDS_BYTES - 256;

#define GAS __attribute__((address_space(1)))
#define LAS __attribute__((address_space(3)))
typedef unsigned short bf16;
typedef unsigned v4u __attribute__((ext_vector_type(4)));
typedef unsigned v2u __attribute__((ext_vector_type(2)));
typedef float f32x4 __attribute__((ext_vector_type(4)));
typedef short bf16x8 __attribute__((ext_vector_type(8)));
__device__ __forceinline__ float bf2f(unsigned v) { return __builtin_bit_cast(float, v << 16); }
__device__ __forceinline__ float bflo(unsigned w) { return __builtin_bit_cast(float, w << 16); }
__device__ __forceinline__ float bfhi(unsigned w) { return __builtin_bit_cast(float, w & 0xffff0000u); }
__device__ __forceinline__ unsigned pk2(float lo, float hi) { return pg8::cvt_pk_bf16(lo, hi); }
__device__ __forceinline__ unsigned f2bf(float f) { return pg8::cvt_pk_bf16(f, 0.f) & 0xffffu; }
__device__ __forceinline__ float wave_sum(float v) {
#pragma unroll
    for (int o = 1; o < 64; o <<= 1) v += __shfl_xor(v, o);
    return v;
}
__device__ __forceinline__ float gelu_exact(float x) { return 0.5f * x * (1.0f + erff(x * 0.70710678118654752f)); }
__device__ __forceinline__ float sigmoidf(float x) { return __builtin_amdgcn_rcpf(1.0f + __builtin_amdgcn_exp2f(x * -1.4426950408889634f)); }
__device__ __forceinline__ f32x4 mfma16(bf16x8 a, bf16x8 b, f32x4 c) { return __builtin_amdgcn_mfma_f32_16x16x32_bf16(a, b, c, 0, 0, 0); }
__device__ __forceinline__ bf16x8 pack8(f32x4 a, f32x4 b) { v4u w; w.x = pk2(a[0], a[1]); w.y = pk2(a[2], a[3]); w.z = pk2(b[0], b[1]); w.w = pk2(b[2], b[3]); return __builtin_bit_cast(bf16x8, w); }
__device__ __forceinline__ int kpos_of(int k) { return (k & 32) | (((k >> 2) & 3) << 3) | (((k >> 4) & 1) << 2) | (k & 3); }


#define XB_TMO      128
#define XB_XCNT(j)  (256  + 64 * (j))
#define XB_XSUB(j)  (1280 + 64 * (j))
#define XB_XGEN(j)  (2304 + 64 * (j))
#define XB_TOP      3328
#define XB_TOPGEN   3392
#define XCD_BAR_WORDS 3456
#define XB_SPIN_CAP (1u << 18)

__device__ __forceinline__ unsigned xb_ld(unsigned* p)              { return __hip_atomic_load(p, __ATOMIC_RELAXED, __HIP_MEMORY_SCOPE_AGENT); }
__device__ __forceinline__ unsigned xb_add(unsigned* p, unsigned v) { return __hip_atomic_fetch_add(p, v, __ATOMIC_RELAXED, __HIP_MEMORY_SCOPE_AGENT); }
__device__ __forceinline__ unsigned xb_xcc_id() { return (unsigned)__builtin_amdgcn_s_getreg((3 << 11) | 20) & 0xFu; }
#define XB_SPIN(cond, bar) do { unsigned _sp = 0; while (cond) { __builtin_amdgcn_s_sleep(1); \
    if ((++_sp & 255u) == 0u) { if (xb_ld(&(bar)[XB_TMO])) break; if (_sp > XB_SPIN_CAP) { atomicAdd(&(bar)[XB_TMO], 1u); break; } } } } while (0)

struct XcdBarrier {
    unsigned* bar; unsigned x;
    volatile LAS unsigned* st;
};

__device__ __forceinline__ XcdBarrier xcd_barrier_post(unsigned* bar, volatile LAS unsigned* st) {
    XcdBarrier b; b.bar = bar; b.x = xb_xcc_id(); b.st = st;
    if (threadIdx.x == 0) (void)xb_add(&bar[XB_XCNT(b.x)], 1u);
    return b;
}
__device__ __forceinline__ void xcd_barrier_complete(unsigned* bar, unsigned x, unsigned& nloc, unsigned& nx) {
    const unsigned G = gridDim.x * gridDim.y * gridDim.z;
    unsigned sum, cnt, mine, sp = 0u;
    for (;;) {
        sum = 0u; cnt = 0u; mine = 0u;
#pragma unroll
        for (unsigned j = 0; j < 16; ++j) { const unsigned c = xb_ld(&bar[XB_XCNT(j)]); sum += c; cnt += (c > 0u) ? 1u : 0u; mine = (j == x) ? c : mine; }
        if (sum == G) break;
        __builtin_amdgcn_s_sleep(1);
        if ((++sp & 255u) == 0u) { if (xb_ld(&bar[XB_TMO])) break; if (sp > XB_SPIN_CAP) { atomicAdd(&bar[XB_TMO], 1u); break; } }
    }
    nloc = mine > 0u ? mine : 1u; nx = cnt > 0u ? cnt : 1u;
}

__device__ __forceinline__ void xcd_barrier(const XcdBarrier& b) {
    asm volatile("s_waitcnt vmcnt(0)" ::: "memory");
    __syncthreads();
    if (threadIdx.x == 0) {
        unsigned* bar = b.bar;
        __builtin_amdgcn_s_waitcnt(0);
        unsigned nloc = b.st[0], nx = b.st[1];
        if (nloc == 0u) { xcd_barrier_complete(bar, b.x, nloc, nx); b.st[0] = nloc; b.st[1] = nx; }
        const unsigned old = xb_add(&bar[XB_XSUB(b.x)], 1u);
        const unsigned gen = old / nloc;
        if (old + 1u == (gen + 1u) * nloc) {
            __builtin_amdgcn_fence(__ATOMIC_RELEASE, "agent");
            asm volatile("s_waitcnt vmcnt(0)" ::: "memory");
            const unsigned og = xb_add(&bar[XB_TOP], 1u);
            const unsigned tg = og / nx;
            if (og + 1u == (tg + 1u) * nx) xb_add(&bar[XB_TOPGEN], 1u);
            else XB_SPIN(xb_ld(&bar[XB_TOPGEN]) == tg, bar);
            __builtin_amdgcn_fence(__ATOMIC_ACQUIRE, "agent");
            xb_add(&bar[XB_XGEN(b.x)], 1u);
            asm volatile("s_waitcnt vmcnt(0)" ::: "memory");
        } else {
            XB_SPIN(xb_ld(&bar[XB_XGEN(b.x)]) == gen, bar);
            __builtin_amdgcn_fence(__ATOMIC_ACQUIRE, "agent");
            asm volatile("s_waitcnt vmcnt(0)" ::: "memory");
        }
    }
    __syncthreads();
}


struct Args { const void* in[20]; float* out; unsigned char* ws; int ph_lo, ph_hi, li, pad; };

struct TUnit { const float* W; int K, ldw, N, kt, nt; const float* ksc; bf16* WT; bool f8; };
__device__ __forceinline__ void tu_load(const TUnit& u, f32x4 (&v)[8], float (&sc)[8]) {
    const int tid = threadIdx.x;
#pragma unroll
    for (int i = 0; i < 8; ++i) { const int idx = tid + NTHR * i, k = idx >> 6, n = 256 * u.nt + 4 * (idx & 63);
        v[i] = (f32x4){0.f, 0.f, 0.f, 0.f}; if (n < u.N) v[i] = *(const f32x4*)(u.W + (size_t)(64 * u.kt + k) * u.ldw + n); sc[i] = u.ksc ? u.ksc[64 * u.kt + k] : 1.f; }
}
__device__ __forceinline__ void tu_store(const TUnit& u, const f32x4 (&v)[8], const float (&sc)[8], LAS float* tile) {
    const int tid = threadIdx.x;
#pragma unroll
    for (int i = 0; i < 8; ++i) { const int idx = tid + NTHR * i, k = idx >> 6; LAS float* t = tile + k * 257 + 4 * (idx & 63); t[0] = v[i][0] * sc[i]; t[1] = v[i][1] * sc[i]; t[2] = v[i][2] * sc[i]; t[3] = v[i][3] * sc[i]; }
    __syncthreads();
#pragma unroll
    for (int i = 0; i < 4; ++i) { const int idx = tid + NTHR * i, n = idx >> 3, kc = idx & 7; const LAS float* t = tile + (8 * kc) * 257 + n;
        if (256 * u.nt + n < u.N) {
            if (u.f8) { v2u o; o.x = pg8::pk4_fp8(t[0] * W8SCALE, t[257] * W8SCALE, t[514] * W8SCALE, t[771] * W8SCALE); o.y = pg8::pk4_fp8(t[1028] * W8SCALE, t[1285] * W8SCALE, t[1542] * W8SCALE, t[1799] * W8SCALE);
                *(v2u*)((unsigned char*)u.WT + (size_t)(256 * u.nt + n) * u.K + 64 * u.kt + 8 * kc) = o; }
            else { v4u o; o.x = pk2(t[0], t[257]); o.y = pk2(t[514], t[771]); o.z = pk2(t[1028], t[1285]); o.w = pk2(t[1542], t[1799]);
                *(v4u*)(u.WT + (size_t)(256 * u.nt + n) * u.K + 64 * u.kt + 8 * kc) = o; } } }
    __syncthreads();
}
__device__ __forceinline__ void p0_prologue(const Args& a, LAS unsigned char* lds, int wg, int G) {
    const int tid = threadIdx.x, lane = tid & 63, wave = tid >> 6;
    unsigned char* ws = a.ws;
    LAS float* tile = (LAS float*)lds;
    const float* w_in = (const float*)a.in[3]; const float* w_out = (const float*)a.in[13]; const float* w_up = (const float*)a.in[15]; const float* w_dn = (const float*)a.in[18];
    const float* wck = (const float*)a.in[5]; const float* wcv = (const float*)a.in[7]; const float* g2 = (const float*)a.in[14];
    constexpr int U_IN = 32 * 18, U_OUT = 32 * 8, U_UP = 32 * 44, U_DN = 88 * 8, U_C = 64;
    constexpr int NT = U_IN + U_OUT + U_UP + U_DN + 2 * U_C;
    { f32x4 vc[8], vn[8]; float scc[8], scn[8]; TUnit uc{}, un{};
      for (int it = wg - G; it < NT; it += G) { const int itn = it + G; const bool hn = itn < NT;
        if (hn) { int r = itn; const float* W; int K, ldw, N, kt, nt; const float* ksc = nullptr; bf16* WT; bool f8 = false;
        if (r < U_IN) { kt = r / 18; nt = r % 18; K = DM; ldw = DIN;
            if (nt < 6) { W = w_in; N = NP1A; WT = (bf16*)(ws + WS_WIN); }
            else if (nt < 10) { W = w_in + NP1A; N = 1024; WT = (bf16*)(ws + WS_WIN8); nt -= 6; f8 = true; }
            else { W = w_in + 2584; N = 2048; WT = (bf16*)(ws + WS_WIN8 + (size_t)1024 * DM); nt -= 10; f8 = true; } }
        else if ((r -= U_IN) < U_UP) { W = w_up; K = DM; ldw = DFF2; N = DFF2; ksc = g2; WT = (bf16*)(ws + WS_WUP); kt = r / 44; nt = r % 44; f8 = true; }
        else if ((r -= U_UP) < U_DN) { W = w_dn; K = DFF; ldw = DM; N = DM; WT = (bf16*)(ws + WS_WDN); kt = r / 8; nt = r % 8; f8 = true; }
        else if ((r -= U_DN) < U_OUT) { W = w_out; K = DM; ldw = DM; N = DM; WT = (bf16*)(ws + WS_WOUT); kt = r / 8; nt = r % 8; f8 = true; }
        else if ((r -= U_OUT) < U_C) { W = wck; K = 4096; ldw = 128; N = 128; WT = (bf16*)(ws + WS_WCK); kt = r; nt = 0; }
        else { r -= U_C; W = wcv; K = 4096; ldw = 128; N = 128; WT = (bf16*)(ws + WS_WCV); kt = r; nt = 0; }
            un = TUnit{W, K, ldw, N, kt, nt, ksc, WT, f8}; tu_load(un, vn, scn); }
        if (it >= wg) tu_store(uc, vc, scc, tile);
        if (hn) { uc = un;
#pragma unroll
            for (int i = 0; i < 8; ++i) { vc[i] = vn[i]; scc[i] = scn[i]; } } } }
    const int gt = wg * NTHR + tid, NGT = G * NTHR;
    { bf16* wgt = (bf16*)(ws + WS_WG); for (int i = gt; i < 32 * DM; i += NGT) { const int r = i >> 11, k = i & (DM - 1); wgt[i] = (bf16)f2bf(r < 24 ? w_in[(size_t)k * DIN + WCOL_GATE + r] : 0.f); } }
    { const float* wsp = (const float*)a.in[9]; bf16* wm = (bf16*)(ws + WS_WM);
      for (int i = gt; i < 8 * 128 * 128; i += NGT) { const int s = i & 127, t = (i >> 7) & 127; wm[i] = (bf16)f2bf(s <= t ? wsp[i] : 0.f); } }
    { const int* pos = (const int*)a.in[1]; float* ct = (float*)(ws + WS_COS); float* st = (float*)(ws + WS_SIN);
      const float inv = powf(10000.0f, -2.0f * (float)(gt & 63) / 128.0f);
      for (int i = gt; i < MTOK * 64; i += NGT) { const int m = i >> 6; const float ang = (float)pos[m] * inv;
          const double ad = (double)ang; const double n = rint(ad * 0.15915494309189535); const float r = (float)(ad - n * 6.283185307179586);
          ct[i] = cosf(r); st[i] = sinf(r); } }
    for (int u = wg; u < 32; u += G) { const int kv = u >> 4, sl = u & 15; const float* pe = (const float*)a.in[kv ? 6 : 4]; const float* w = kv ? wcv : wck;
        const int e = tid & 127, sub = tid >> 7; const int k0 = sl * 256 + sub * 64; float s0 = 0.f, s1 = 0.f, s2 = 0.f, s3 = 0.f;
#pragma unroll 4
        for (int k = k0; k < k0 + 64; k += 4) { s0 += pe[k] * w[(size_t)k * 128 + e]; s1 += pe[k + 1] * w[(size_t)(k + 1) * 128 + e]; s2 += pe[k + 2] * w[(size_t)(k + 2) * 128 + e]; s3 += pe[k + 3] * w[(size_t)(k + 3) * 128 + e]; }
        __syncthreads(); tile[tid] = (s0 + s1) + (s2 + s3); __syncthreads();
        if (tid < 128) ((float*)(ws + WS_CTL) + CW_CCONST + (kv * 16 + sl) * 128)[tid] = (tile[tid] + tile[tid + 128]) + (tile[tid + 256] + tile[tid + 384]);
        __syncthreads(); }
    { const float* x = (const float*)a.in[0]; const float* g1 = (const float*)a.in[2]; bf16* xn = (bf16*)(ws + WS_XN); const int NW = G * NWAVES;
      for (int m = wg * NWAVES + wave; m < MTOK; m += 2 * NW) { f32x4 v[2][8]; const bool two = m + NW < MTOK;
#pragma unroll
          for (int q = 0; q < 2; ++q) { const f32x4* xr = (const f32x4*)(x + (size_t)(q && two ? m + NW : m) * DM) + 2 * lane;
#pragma unroll
              for (int j = 0; j < 4; ++j) { v[q][2 * j] = xr[128 * j]; v[q][2 * j + 1] = xr[128 * j + 1]; } }
#pragma unroll
          for (int q = 0; q < 2; ++q) { if (q && !two) break; const int mm = m + q * NW; float s = 0.f;
#pragma unroll
              for (int j = 0; j < 8; ++j) s += (v[q][j][0] * v[q][j][0] + v[q][j][1] * v[q][j][1]) + (v[q][j][2] * v[q][j][2] + v[q][j][3] * v[q][j][3]);
              const float rs = 1.0f / sqrtf(wave_sum(s) * (1.0f / DM) + EPS); v4u* o = (v4u*)(xn + (size_t)mm * DM) + lane; v2u* o8 = (v2u*)(ws + WS_XN8 + (size_t)mm * DM) + lane;
#pragma unroll
              for (int j = 0; j < 4; ++j) { const f32x4 ga = *((const f32x4*)g1 + 2 * lane + 128 * j), gb = *((const f32x4*)g1 + 2 * lane + 128 * j + 1); const f32x4 va = v[q][2 * j], vb = v[q][2 * j + 1];
                  const float y0 = va[0] * rs * ga[0], y1 = va[1] * rs * ga[1], y2 = va[2] * rs * ga[2], y3 = va[3] * rs * ga[3], y4 = vb[0] * rs * gb[0], y5 = vb[1] * rs * gb[1], y6 = vb[2] * rs * gb[2], y7 = vb[3] * rs * gb[3];
                  v4u w; w.x = pk2(y0, y1); w.y = pk2(y2, y3); w.z = pk2(y4, y5); w.w = pk2(y6, y7); o[64 * j] = w;
                  v2u w8; w8.x = pg8::pk4_fp8(y0, y1, y2, y3); w8.y = pg8::pk4_fp8(y4, y5, y6, y7); o8[64 * j] = w8; } } } }
}

__device__ __forceinline__ void p1_gates(const Args& a, int wg, int G) {
    const int lane = threadIdx.x & 63, wave = __builtin_amdgcn_readfirstlane(threadIdx.x >> 6), c = lane & 15, g = lane >> 4;
    unsigned char* ws = a.ws; const bf16* xn = (const bf16*)(ws + WS_XN); const bf16* wgt = (const bf16*)(ws + WS_WG); bf16* gates = (bf16*)(ws + WS_GATES);
    for (int t = wg * NWAVES + wave; t < MTOK / 16; t += G * NWAVES) {
        const bf16* ap = xn + (size_t)(16 * t + c) * DM + 8 * g; const bf16* bp = wgt + (size_t)c * DM + 8 * g;
        f32x4 acc0 = (f32x4){0.f, 0.f, 0.f, 0.f}, acc1 = acc0;
#pragma unroll 4
        for (int ks = 0; ks < 64; ++ks) { const bf16x8 af = *(const bf16x8*)(ap + 32 * ks), b0 = *(const bf16x8*)(bp + 32 * ks), b1 = *(const bf16x8*)(bp + (size_t)16 * DM + 32 * ks);
            acc0 = mfma16(af, b0, acc0); acc1 = mfma16(af, b1, acc1); }
#pragma unroll
        for (int i = 0; i < 4; ++i) { bf16* o = gates + (size_t)(16 * t + 4 * g + i) * 32; o[c] = (bf16)f2bf(acc0[i]); o[16 + c] = (bf16)f2bf(acc1[i]); }
    }
}

__device__ __forceinline__ void rope8(v4u x1, v4u x2, const float* cs, const float* sn, v4u& o1, v4u& o2) {
    const f32x4 c0 = *(const f32x4*)cs, c1 = *(const f32x4*)(cs + 4), s0 = *(const f32x4*)sn, s1 = *(const f32x4*)(sn + 4);
    const float c[8] = {c0[0], c0[1], c0[2], c0[3], c1[0], c1[1], c1[2], c1[3]}, s[8] = {s0[0], s0[1], s0[2], s0[3], s1[0], s1[1], s1[2], s1[3]};
    float a[8], b[8];
#pragma unroll
    for (int j = 0; j < 4; ++j) { a[2 * j] = bflo(x1[j]); a[2 * j + 1] = bfhi(x1[j]); b[2 * j] = bflo(x2[j]); b[2 * j + 1] = bfhi(x2[j]); }
#pragma unroll
    for (int j = 0; j < 4; ++j) { o1[j] = pk2(a[2 * j] * c[2 * j] - b[2 * j] * s[2 * j], a[2 * j + 1] * c[2 * j + 1] - b[2 * j + 1] * s[2 * j + 1]);
        o2[j] = pk2(b[2 * j] * c[2 * j] + a[2 * j] * s[2 * j], b[2 * j + 1] * c[2 * j + 1] + a[2 * j + 1] * s[2 * j + 1]); }
}
__device__ __forceinline__ void rope8r(v4u x1, v4u x2, f32x4 c0, f32x4 c1, f32x4 s0, f32x4 s1, v4u& o1, v4u& o2) {
    const float c[8] = {c0[0], c0[1], c0[2], c0[3], c1[0], c1[1], c1[2], c1[3]}, s[8] = {s0[0], s0[1], s0[2], s0[3], s1[0], s1[1], s1[2], s1[3]};
    float a[8], b[8];
#pragma unroll
    for (int j = 0; j < 4; ++j) { a[2 * j] = bflo(x1[j]); a[2 * j + 1] = bfhi(x1[j]); b[2 * j] = bflo(x2[j]); b[2 * j + 1] = bfhi(x2[j]); }
#pragma unroll
    for (int j = 0; j < 4; ++j) { o1[j] = pk2(a[2 * j] * c[2 * j] - b[2 * j] * s[2 * j], a[2 * j + 1] * c[2 * j + 1] - b[2 * j + 1] * s[2 * j + 1]);
        o2[j] = pk2(b[2 * j] * c[2 * j] + a[2 * j] * s[2 * j], b[2 * j + 1] * c[2 * j + 1] + a[2 * j + 1] * s[2 * j + 1]); }
}
__device__ __forceinline__ void rope8rf(v4u x1, v4u x2, f32x4 c0, f32x4 c1, f32x4 s0, f32x4 s1, v4u& o1, v4u& o2, v2u& e1, v2u& e2, float fs) {
    const float c[8] = {c0[0], c0[1], c0[2], c0[3], c1[0], c1[1], c1[2], c1[3]}, s[8] = {s0[0], s0[1], s0[2], s0[3], s1[0], s1[1], s1[2], s1[3]};
    float a[8], b[8], ra[8], rb[8];
#pragma unroll
    for (int j = 0; j < 4; ++j) { a[2 * j] = bflo(x1[j]); a[2 * j + 1] = bfhi(x1[j]); b[2 * j] = bflo(x2[j]); b[2 * j + 1] = bfhi(x2[j]); }
#pragma unroll
    for (int j = 0; j < 8; ++j) { ra[j] = a[j] * c[j] - b[j] * s[j]; rb[j] = b[j] * c[j] + a[j] * s[j]; }
#pragma unroll
    for (int j = 0; j < 4; ++j) { o1[j] = pk2(ra[2 * j], ra[2 * j + 1]); o2[j] = pk2(rb[2 * j], rb[2 * j + 1]); }
#pragma unroll
    for (int j = 0; j < 8; ++j) { ra[j] *= fs; rb[j] *= fs; }
    e1.x = pg8::pk4_fp8(ra[0], ra[1], ra[2], ra[3]); e1.y = pg8::pk4_fp8(ra[4], ra[5], ra[6], ra[7]); e2.x = pg8::pk4_fp8(rb[0], rb[1], rb[2], rb[3]); e2.y = pg8::pk4_fp8(rb[4], rb[5], rb[6], rb[7]);
}
__device__ __forceinline__ int kpos8_of(int k) { return (((k >> 2) & 3) << 4) | ((k >> 4) << 2) | (k & 3); }
__device__ __forceinline__ void p2_prep(const Args& a, LAS unsigned char* lds, int wg, int G) {
    const int tid = threadIdx.x, lane = tid & 63, wave = __builtin_amdgcn_readfirstlane(tid >> 6), c = lane & 15, g = lane >> 4;
    unsigned char* ws = a.ws; const bf16* proj = (const bf16*)(ws + WS_PROJ);
    const float* COS = (const float*)(ws + WS_COS); const float* SIN = (const float*)(ws + WS_SIN);
    constexpr int NCU = 256, NPU = 512;
    for (int u = wg; u < NCU + NPU; u += G) {
        if (u < NCU) {
            const int kv = u >> 7, bg = (u >> 5) & 3, np = u & 31, b = bg >> 1, gk = bg & 1;
            const bf16* src = proj + (size_t)b * SEQ * NP1 + (kv ? COL_VCMP : COL_KCMP) + gk * 128 + 8 * g;
            const bf16* wt = (const bf16*)(ws + (kv ? WS_WCV : WS_WCK)) + (size_t)c * 4096 + 8 * g;
            f32x4 acc[2][8];
#pragma unroll
            for (int i = 0; i < 2; ++i)
#pragma unroll
                for (int e = 0; e < 8; ++e) acc[i][e] = (f32x4){0.f, 0.f, 0.f, 0.f};
#pragma unroll 4
            for (int kk = 0; kk < 16; ++kk) { const int ks = 16 * wave + kk, l = ks >> 2, d0 = 32 * (ks & 3); bf16x8 af[2];
#pragma unroll
                for (int i = 0; i < 2; ++i) { int tok = 16 * (32 * np + 16 * i + c) + l; tok = tok < SEQ ? tok : SEQ - 1; af[i] = *(const bf16x8*)(src + (size_t)tok * NP1 + d0); }
#pragma unroll
                for (int e = 0; e < 8; ++e) { const bf16x8 bfr = *(const bf16x8*)(wt + (size_t)(16 * e) * 4096 + 32 * ks);
                    acc[0][e] = mfma16(af[0], bfr, acc[0][e]); acc[1][e] = mfma16(af[1], bfr, acc[1][e]); } }
            LAS float* red = (LAS float*)lds;
#pragma unroll
            for (int i = 0; i < 2; ++i)
#pragma unroll
                for (int e = 0; e < 8; ++e)
#pragma unroll
                    for (int ii = 0; ii < 4; ++ii) red[(((wave * 2 + i) * 8 + e) * 4 + ii) * 64 + lane] = acc[i][e][ii];
            __syncthreads();
            { const int ls = tid & 63, ii = (tid >> 6) & 3, i = tid >> 8, gs = ls >> 4, cs_ = ls & 15; float val[8];
#pragma unroll
              for (int e = 0; e < 8; ++e) { float v = 0.f;
#pragma unroll
                  for (int w = 0; w < 8; ++w) v += red[(((w * 2 + i) * 8 + e) * 4 + ii) * 64 + ls];
                  val[e] = v; }
              const float* ccp = (const float*)(ws + WS_CTL) + CW_CCONST + kv * 16 * 128; float cc[128 / 16 * 0 + 8];
#pragma unroll
              for (int e = 0; e < 8; ++e) { float t = 0.f;
#pragma unroll
                  for (int sl = 0; sl < 16; ++sl) t += ccp[sl * 128 + 16 * e + cs_];
                  cc[e] = t; }
              bf16* kc = (bf16*)(ws + WS_KC) + (size_t)bg * 1024 * 128; bf16* vct = (bf16*)(ws + WS_VCT) + (size_t)bg * 16 * 8192;
              const int n = 32 * np + 16 * i + 4 * gs + ii; const bool ok = n < 1023;
              if (kv == 0) { const int mt = b * SEQ + (ok ? 16 * n + 31 : 0);
#pragma unroll
                  for (int e = 0; e < 4; ++e) { const int f = 16 * e + cs_; const float x1 = val[e] + cc[e], x2 = val[e + 4] + cc[e + 4], cs = COS[(size_t)mt * 64 + f], sn = SIN[(size_t)mt * 64 + f];
                      kc[(size_t)n * 128 + f] = (bf16)f2bf(ok ? x1 * cs - x2 * sn : 0.f); kc[(size_t)n * 128 + f + 64] = (bf16)f2bf(ok ? x2 * cs + x1 * sn : 0.f); } }
              else {
#pragma unroll
                  for (int e = 0; e < 8; ++e) { const int f = 16 * e + cs_; vct[(size_t)(n >> 6) * 8192 + f * 64 + kpos_of(n & 63)] = (bf16)f2bf(ok ? val[e] + cc[e] : 0.f); } } }
            __syncthreads();
        } else {
            const int pu = u - NCU, b = pu >> 8, kb = pu & 255; const size_t m0 = (size_t)b * SEQ + 64 * kb;
#pragma unroll
            for (int bt = 0; bt < 2; ++bt) { v4u x1[4], x2[4]; f32x4 cs[4][2], sn[4][2];
#pragma unroll
                for (int k = 0; k < 4; ++k) { const int it = tid + NTHR * (4 * bt + k), tk = it >> 6, h = (it >> 3) & 7, ch = it & 7;
                    const bf16* p = proj + (m0 + tk) * NP1 + h * 128 + 8 * ch; x1[k] = *(const v4u*)p; x2[k] = *(const v4u*)(p + 64);
                    const float* cp = COS + (m0 + tk) * 64 + 8 * ch; const float* sp = SIN + (m0 + tk) * 64 + 8 * ch;
                    cs[k][0] = *(const f32x4*)cp; cs[k][1] = *(const f32x4*)(cp + 4); sn[k][0] = *(const f32x4*)sp; sn[k][1] = *(const f32x4*)(sp + 4); }
#pragma unroll
                for (int k = 0; k < 4; ++k) { const int it = tid + NTHR * (4 * bt + k), tk = it >> 6, h = (it >> 3) & 7, ch = it & 7; v4u o1, o2;
                    v2u e1, e2; rope8rf(x1[k], x2[k], cs[k][0], cs[k][1], sn[k][0], sn[k][1], o1, o2, e1, e2, 8.0f * C2); bf16* q = (bf16*)(ws + WS_QR) + (m0 + tk) * 1024 + h * 128 + 8 * ch; *(v4u*)q = o1; *(v4u*)(q + 64) = o2;
                    unsigned char* q8 = ws + WS_Q8 + (m0 + tk) * 1024 + h * 128 + 8 * ch; *(v2u*)q8 = e1; *(v2u*)(q8 + 64) = e2; } }
            { v4u x1[4], x2[4]; f32x4 cs[4][2], sn[4][2];
#pragma unroll
                for (int k = 0; k < 4; ++k) { const int it = tid + NTHR * k, tk = it >> 5, wh = (it >> 4) & 1, gk = (it >> 3) & 1, ch = it & 7;
                    const bf16* p = proj + (m0 + tk) * NP1 + (wh ? COL_KWIN : COL_KSEL) + gk * 128 + 8 * ch; x1[k] = *(const v4u*)p; x2[k] = *(const v4u*)(p + 64);
                    const float* cp = COS + (m0 + tk) * 64 + 8 * ch; const float* sp = SIN + (m0 + tk) * 64 + 8 * ch;
                    cs[k][0] = *(const f32x4*)cp; cs[k][1] = *(const f32x4*)(cp + 4); sn[k][0] = *(const f32x4*)sp; sn[k][1] = *(const f32x4*)(sp + 4); }
#pragma unroll
                for (int k = 0; k < 4; ++k) { const int it = tid + NTHR * k, tk = it >> 5, wh = (it >> 4) & 1, gk = (it >> 3) & 1, ch = it & 7; v4u o1, o2;
                    v2u e1, e2; rope8rf(x1[k], x2[k], cs[k][0], cs[k][1], sn[k][0], sn[k][1], o1, o2, e1, e2, 1.0f);
                    unsigned char* d = ws + (wh ? WS_KWIN : WS_KSEL) + ((size_t)(b * 2 + gk) * SEQ + 64 * kb + tk) * 128 + 8 * ch; *(v2u*)d = e1; *(v2u*)(d + 64) = e2; } }
            LAS unsigned char* T8 = lds;
            { v4u v[8];
#pragma unroll
                for (int k = 0; k < 8; ++k) { const int it = tid + NTHR * k, q = it >> 10, tk = (it >> 4) & 63, ch = it & 15, wh = q >> 1, gk = q & 1;
                    v[k] = *(const v4u*)(proj + (m0 + tk) * NP1 + (wh ? COL_VWIN : COL_VSEL) + gk * 128 + 8 * ch); }
#pragma unroll
                for (int k = 0; k < 8; ++k) { const int it = tid + NTHR * k, q = it >> 10, tk = (it >> 4) & 63, ch = it & 15;
                    LAS unsigned char* t = T8 + q * (128 * 80) + (8 * ch) * 80 + kpos8_of(tk);
                    const unsigned w0 = pg8::pk4_fp8(bflo(v[k][0]), bfhi(v[k][0]), bflo(v[k][1]), bfhi(v[k][1])), w1 = pg8::pk4_fp8(bflo(v[k][2]), bfhi(v[k][2]), bflo(v[k][3]), bfhi(v[k][3]));
#pragma unroll
                    for (int j = 0; j < 4; ++j) { t[j * 80] = (unsigned char)(w0 >> (8 * j)); t[(4 + j) * 80] = (unsigned char)(w1 >> (8 * j)); } } }
            __syncthreads();
#pragma unroll
            for (int k = 0; k < 4; ++k) { const int it = tid + NTHR * k, q = it >> 9, d = (it >> 2) & 127, ch = it & 3, wh = q >> 1, gk = q & 1;
                *(v4u*)(ws + (wh ? WS_VWINT : WS_VSELT) + ((size_t)(b * 2 + gk) * 256 + kb) * 8192 + d * 64 + 16 * ch) = *(const LAS v4u*)(T8 + q * (128 * 80) + d * 80 + 16 * ch); }
            __syncthreads();
        }
    }
}

constexpr int KL_STRIDE = 272, VL_STRIDE = 144, KL_BYTES = 64 * KL_STRIDE, VL_BYTES = 128 * VL_STRIDE;
__device__ __forceinline__ void stage_load(const bf16* src, v4u (&r)[2]) {
#pragma unroll
    for (int i = 0; i < 2; ++i) r[i] = *(const v4u*)((const char*)src + (size_t)(threadIdx.x + 512 * i) * 16);
}
__device__ __forceinline__ void stage_write_k(LAS unsigned char* Kl, const v4u (&r)[2]) {
#pragma unroll
    for (int i = 0; i < 2; ++i) { const int id = threadIdx.x + 512 * i; *(LAS v4u*)(Kl + (id >> 4) * KL_STRIDE + (id & 15) * 16) = r[i]; }
}
__device__ __forceinline__ void stage_write_v(LAS unsigned char* Vl, const v4u (&r)[2]) {
#pragma unroll
    for (int i = 0; i < 2; ++i) { const int id = threadIdx.x + 512 * i; *(LAS v4u*)(Vl + (id >> 3) * VL_STRIDE + (id & 7) * 16) = r[i]; }
}
__device__ __forceinline__ void qk_tile(const LAS unsigned char* Kl, const bf16x8 (&qf)[4], f32x4 (&s)[4], int c, int g) {
#pragma unroll
    for (int kt = 0; kt < 4; ++kt) { s[kt] = (f32x4){0.f, 0.f, 0.f, 0.f};
#pragma unroll
        for (int ks = 0; ks < 4; ++ks) { const bf16x8 kf = *(const LAS bf16x8*)(Kl + (16 * kt + c) * KL_STRIDE + (32 * ks + 8 * g) * 2); s[kt] = mfma16(kf, qf[ks], s[kt]); } }
}
__device__ __forceinline__ void pv_tile(const LAS unsigned char* Vl, const f32x4 (&p)[4], f32x4 (&o)[8], int c, int g) {
#pragma unroll
    for (int s2 = 0; s2 < 2; ++s2) { const bf16x8 pf = pack8(p[2 * s2], p[2 * s2 + 1]);
#pragma unroll
        for (int dt = 0; dt < 8; ++dt) { const bf16x8 vf = *(const LAS bf16x8*)(Vl + (16 * dt + c) * VL_STRIDE + (32 * s2 + 8 * g) * 2); o[dt] = mfma16(vf, pf, o[dt]); } }
}
__device__ __forceinline__ void online_sm(f32x4 (&s)[4], float& m, float& l, float& alpha) {
    float tm = fmaxf(fmaxf(s[0][0], s[0][1]), fmaxf(s[0][2], s[0][3]));
#pragma unroll
    for (int kt = 1; kt < 4; ++kt) tm = fmaxf(tm, fmaxf(fmaxf(s[kt][0], s[kt][1]), fmaxf(s[kt][2], s[kt][3])));
    tm = fmaxf(tm, __shfl_xor(tm, 16)); tm = fmaxf(tm, __shfl_xor(tm, 32));
    const float mn = fmaxf(m, tm); alpha = __builtin_amdgcn_exp2f((m - mn) * C2); m = mn; float ls = 0.f;
#pragma unroll
    for (int kt = 0; kt < 4; ++kt)
#pragma unroll
        for (int i = 0; i < 4; ++i) { const float p = __builtin_amdgcn_exp2f((s[kt][i] - mn) * C2); s[kt][i] = p; ls += p; }
    l = l * alpha + ls;
}
__device__ __forceinline__ void load_qf(const bf16* qr, size_t mrow, int head, int g, bf16x8 (&qf)[4]) {
#pragma unroll
    for (int ks = 0; ks < 4; ++ks) qf[ks] = *(const bf16x8*)(qr + mrow * 1024 + head * 128 + 32 * ks + 8 * g);
}
__device__ __forceinline__ void pin_qf(bf16x8 (&qf)[2][4]) {
#pragma unroll
    for (int cs = 0; cs < 2; ++cs)
#pragma unroll
        for (int ks = 0; ks < 4; ++ks) asm volatile("" : "+v"(qf[cs][ks]));
}
__device__ __forceinline__ void store_o(bf16* O, size_t mrow, int head, int g, const f32x4 (&o)[8], float inv) {
#pragma unroll
    for (int dt = 0; dt < 8; ++dt) { v2u w; w.x = pk2(o[dt][0] * inv, o[dt][1] * inv); w.y = pk2(o[dt][2] * inv, o[dt][3] * inv); *(v2u*)(O + mrow * 1024 + head * 128 + 16 * dt + 4 * g) = w; }
}
__device__ __forceinline__ void unit_bq(int u, int& bg, int& qt) { bg = u >> 8; const int x = u & 255; qt = (bg & 1) ? 255 - x : x; }


constexpr int SLOT_BYTES = 32768, TMK_OFF = 132096;
#define WAITV(n) asm volatile("s_waitcnt vmcnt(" #n ")" ::: "memory")
#define RAWBAR() do { asm volatile("" ::: "memory"); __builtin_amdgcn_s_barrier(); asm volatile("" ::: "memory"); } while (0)
__device__ __forceinline__ void dma_k(LAS unsigned char* slot, const bf16* ksrc, int wave, int lane) {
#pragma unroll
    for (int r = 0; r < 2; ++r) { const int row = 4 * wave + (lane >> 4) + 32 * r, pos = lane & 15;
        __builtin_amdgcn_global_load_lds((const unsigned*)(ksrc + row * 128 + ((pos ^ (row & 15)) * 8)), (LAS unsigned*)(slot + wave * 1024 + r * 8192), 16, 0, 0); }
}
__device__ __forceinline__ void dma_v(LAS unsigned char* slot, const bf16* vsrc, int wave, int lane) {
#pragma unroll
    for (int r = 0; r < 2; ++r) { const int d = 8 * wave + (lane >> 3) + 64 * r, pos = lane & 7;
        __builtin_amdgcn_global_load_lds((const unsigned*)(vsrc + d * 64 + ((pos ^ ((d >> 1) & 7)) * 8)), (LAS unsigned*)(slot + 16384 + wave * 1024 + r * 8192), 16, 0, 0); }
}
__device__ __forceinline__ void qk_tile_sw(const LAS unsigned char* slot, const bf16x8 (&qf)[4], f32x4 (&s)[4], const int (&kx)[4]) {
#pragma unroll
    for (int kt = 0; kt < 4; ++kt) { s[kt] = (f32x4){0.f, 0.f, 0.f, 0.f};
#pragma unroll
        for (int ks = 0; ks < 4; ++ks) { const bf16x8 kf = *(const LAS bf16x8*)(slot + kt * 4096 + kx[ks]); s[kt] = mfma16(kf, qf[ks], s[kt]); } }
}
__device__ __forceinline__ void pv_tile_sw(const LAS unsigned char* slot, const f32x4 (&p)[4], f32x4 (&o)[8], const int (&vx)[2]) {
#pragma unroll
    for (int s2 = 0; s2 < 2; ++s2) { const bf16x8 pf = pack8(p[2 * s2], p[2 * s2 + 1]);
#pragma unroll
        for (int dt = 0; dt < 8; ++dt) { const bf16x8 vf = *(const LAS bf16x8*)(slot + 16384 + dt * 2048 + vx[s2]); o[dt] = mfma16(vf, pf, o[dt]); } }
}
__device__ __forceinline__ float lmax16(float x) { const unsigned u = __builtin_bit_cast(unsigned, x); auto r = __builtin_amdgcn_permlane16_swap(u, u, false, false); unsigned r0 = r[0], r1 = r[1]; asm volatile("" : "+v"(r1)); return fmaxf(__builtin_bit_cast(float, r0), __builtin_bit_cast(float, r1)); }
__device__ __forceinline__ float lmax32(float x) { const unsigned u = __builtin_bit_cast(unsigned, x); auto r = __builtin_amdgcn_permlane32_swap(u, u, false, false); unsigned r0 = r[0], r1 = r[1]; asm volatile("" : "+v"(r1)); return fmaxf(__builtin_bit_cast(float, r0), __builtin_bit_cast(float, r1)); }
__device__ __forceinline__ float ladd16(float x) { const unsigned u = __builtin_bit_cast(unsigned, x); auto r = __builtin_amdgcn_permlane16_swap(u, u, false, false); unsigned r0 = r[0], r1 = r[1]; asm volatile("" : "+v"(r1)); return __builtin_bit_cast(float, r0) + __builtin_bit_cast(float, r1); }
__device__ __forceinline__ float ladd32(float x) { const unsigned u = __builtin_bit_cast(unsigned, x); auto r = __builtin_amdgcn_permlane32_swap(u, u, false, false); unsigned r0 = r[0], r1 = r[1]; asm volatile("" : "+v"(r1)); return __builtin_bit_cast(float, r0) + __builtin_bit_cast(float, r1); }
__device__ __forceinline__ void online_sm2(f32x4 (&s)[4], float& m, float& l, float& alpha) {
    float tm = fmaxf(fmaxf(s[0][0], s[0][1]), fmaxf(s[0][2], s[0][3]));
#pragma unroll
    for (int kt = 1; kt < 4; ++kt) tm = fmaxf(tm, fmaxf(fmaxf(s[kt][0], s[kt][1]), fmaxf(s[kt][2], s[kt][3])));
    tm = lmax16(tm); tm = lmax32(tm);
    const float mn = fmaxf(m, tm); alpha = __builtin_amdgcn_exp2f((m - mn) * C2); m = mn; float ls = 0.f;
#pragma unroll
    for (int kt = 0; kt < 4; ++kt)
#pragma unroll
        for (int i = 0; i < 4; ++i) { const float p = __builtin_amdgcn_exp2f((s[kt][i] - mn) * C2); s[kt][i] = p; ls += p; }
    l = l * alpha + ls;
}

__device__ __forceinline__ void qk2(const LAS unsigned char* slot, const bf16x8 (&qf)[2][4], f32x4 (&s)[2][4], const int (&kx)[4]) {
    bf16x8 kf[4][4];
#pragma unroll
    for (int kt = 0; kt < 4; ++kt)
#pragma unroll
        for (int ks = 0; ks < 4; ++ks) kf[kt][ks] = *(const LAS bf16x8*)(slot + kt * 4096 + kx[ks]);
    __builtin_amdgcn_sched_barrier(0);
#pragma unroll
    for (int kt = 0; kt < 4; ++kt) { s[0][kt] = (f32x4){0.f, 0.f, 0.f, 0.f}; s[1][kt] = (f32x4){0.f, 0.f, 0.f, 0.f};
#pragma unroll
        for (int ks = 0; ks < 4; ++ks) { s[0][kt] = mfma16(kf[kt][ks], qf[0][ks], s[0][kt]); s[1][kt] = mfma16(kf[kt][ks], qf[1][ks], s[1][kt]); } }
}
__device__ __forceinline__ void pv2(const LAS unsigned char* slot, const f32x4 (&p)[2][4], f32x4 (&o)[2][8], const int (&vx)[2]) {
#pragma unroll
    for (int s2 = 0; s2 < 2; ++s2) { const bf16x8 pf0 = pack8(p[0][2 * s2], p[0][2 * s2 + 1]), pf1 = pack8(p[1][2 * s2], p[1][2 * s2 + 1]);
#pragma unroll
        for (int dt = 0; dt < 8; ++dt) { const bf16x8 vf = *(const LAS bf16x8*)(slot + 16384 + dt * 2048 + vx[s2]); o[0][dt] = mfma16(vf, pf0, o[0][dt]); o[1][dt] = mfma16(vf, pf1, o[1][dt]); } }
}
__device__ __forceinline__ void pv2l(const LAS unsigned char* slot, const f32x4 (&p)[2][4], f32x4 (&o)[2][8], f32x4 (&lacc)[2], const int (&vx)[2]) {
    const bf16x8 ones8 = __builtin_bit_cast(bf16x8, (v4u){0x3f803f80u, 0x3f803f80u, 0x3f803f80u, 0x3f803f80u});
#pragma unroll
    for (int s2 = 0; s2 < 2; ++s2) { const bf16x8 pf0 = pack8(p[0][2 * s2], p[0][2 * s2 + 1]), pf1 = pack8(p[1][2 * s2], p[1][2 * s2 + 1]);
        lacc[0] = mfma16(ones8, pf0, lacc[0]); lacc[1] = mfma16(ones8, pf1, lacc[1]);
#pragma unroll
        for (int dt = 0; dt < 8; ++dt) { const bf16x8 vf = *(const LAS bf16x8*)(slot + 16384 + dt * 2048 + vx[s2]); o[0][dt] = mfma16(vf, pf0, o[0][dt]); o[1][dt] = mfma16(vf, pf1, o[1][dt]); } }
}
__device__ __forceinline__ float quad_sum(float x) {
    const float y = x + __builtin_bit_cast(float, __builtin_amdgcn_mov_dpp(__builtin_bit_cast(int, x), 0xB1, 0xf, 0xf, true));
    return y + __builtin_bit_cast(float, __builtin_amdgcn_mov_dpp(__builtin_bit_cast(int, y), 0x4E, 0xf, 0xf, true));
}
template <bool HAS_O> __device__ __forceinline__ void sm_lean(f32x4 (&s)[4], float& m, float& l, f32x4 (&o)[8], bool rowok) {
    float tm = fmaxf(fmaxf(s[0][0], s[0][1]), fmaxf(s[0][2], s[0][3]));
#pragma unroll
    for (int kt = 1; kt < 4; ++kt) tm = fmaxf(tm, fmaxf(fmaxf(s[kt][0], s[kt][1]), fmaxf(s[kt][2], s[kt][3])));
    tm = lmax16(tm); tm = lmax32(tm);
    tm = rowok ? tm : -__builtin_inff();
    const float mn = fmaxf(m, tm), alpha = __builtin_amdgcn_exp2f((m - mn) * C2); m = mn;
    const float mb = rowok ? mn * C2 : __builtin_inff(); float ls = 0.f;
#pragma unroll
    for (int kt = 0; kt < 4; ++kt)
#pragma unroll
        for (int i = 0; i < 4; ++i) { const float p = __builtin_amdgcn_exp2f(__builtin_fmaf(s[kt][i], C2, -mb)); s[kt][i] = p; ls += p; }
    l = l * alpha + ls;
    if (HAS_O) { if (!__all(alpha == 1.0f)) {
#pragma unroll
        for (int dt = 0; dt < 8; ++dt) o[dt] = o[dt] * alpha; } }
}
__device__ __forceinline__ float row16_sum(float x) {
    x = quad_sum(x);
    x += __builtin_bit_cast(float, __builtin_amdgcn_mov_dpp(__builtin_bit_cast(int, x), 0x141, 0xf, 0xf, true));
    x += __builtin_bit_cast(float, __builtin_amdgcn_mov_dpp(__builtin_bit_cast(int, x), 0x140, 0xf, 0xf, true));
    return x;
}
__device__ __forceinline__ float wave_sum_v(float x) { return ladd32(ladd16(row16_sum(x))); }
__device__ __forceinline__ float amax3(float a, float b, float c) { float r; asm("v_max3_f32 %0, %1, %2, %3" : "=v"(r) : "v"(a), "v"(b), "v"(c)); return r; }
__device__ __forceinline__ float amax2(float a, float b) { float r; asm("v_max_f32 %0, %1, %2" : "=v"(r) : "v"(a), "v"(b)); return r; }
__device__ __forceinline__ float xmax16(float x) { const unsigned u = __builtin_bit_cast(unsigned, x); auto r = __builtin_amdgcn_permlane16_swap(u, u, false, false); unsigned r0 = r[0], r1 = r[1]; asm volatile("" : "+v"(r1)); return amax2(__builtin_bit_cast(float, r0), __builtin_bit_cast(float, r1)); }
__device__ __forceinline__ float xmax32(float x) { const unsigned u = __builtin_bit_cast(unsigned, x); auto r = __builtin_amdgcn_permlane32_swap(u, u, false, false); unsigned r0 = r[0], r1 = r[1]; asm volatile("" : "+v"(r1)); return amax2(__builtin_bit_cast(float, r0), __builtin_bit_cast(float, r1)); }
constexpr float SM_THR = 10.0f;
__device__ __forceinline__ void sm_fast(f32x4 (&s)[4], float& m, f32x4& lacc, f32x4 (&o)[8], bool rowok) {
    float tm = amax3(amax3(s[0][0], s[0][1], s[0][2]), amax3(s[0][3], s[1][0], s[1][1]), amax3(s[1][2], s[1][3], s[2][0]));
    tm = amax3(tm, amax3(s[2][1], s[2][2], s[2][3]), amax3(s[3][0], s[3][1], s[3][2])); tm = amax2(tm, s[3][3]);
    tm = xmax16(tm); tm = xmax32(tm);
    tm = rowok ? tm : -__builtin_inff();
    if (__any((tm - m) * C2 > SM_THR)) { const float mn = amax2(m, tm), alpha = __builtin_amdgcn_exp2f((m - mn) * C2); m = mn; lacc = lacc * alpha;
#pragma unroll
        for (int dt = 0; dt < 8; ++dt) o[dt] = o[dt] * alpha; }
    const float mb = rowok ? m * C2 : __builtin_inff();
#pragma unroll
    for (int kt = 0; kt < 4; ++kt)
#pragma unroll
        for (int i = 0; i < 4; ++i) s[kt][i] = __builtin_amdgcn_exp2f(__builtin_fmaf(s[kt][i], C2, -mb));
}
#define SWZ_OFFSETS() int kx[4], vx[2]; \
    _Pragma("unroll") for (int ks_ = 0; ks_ < 4; ++ks_) kx[ks_] = c * 256 + ((((g ^ c) & 15) << 4) ^ (ks_ << 6)); \
    _Pragma("unroll") for (int s2_ = 0; s2_ < 2; ++s2_) vx[s2_] = c * 128 + ((((g ^ (c >> 1)) & 7) << 4) ^ (s2_ << 6))

__device__ __forceinline__ void unit_sel(int wg, int r, int G, int& bg, int& qt) {
    if (G == 256) { const int x = wg & 7, i = wg >> 3, k = (r & 1) ? (96 - 32 * r + i) : (127 - 32 * r - i); bg = x >> 1; qt = (x & 1) + 2 * k; }
    else unit_bq(wg + r * G, bg, qt);
}

using pg8::v8i32; using pg8::f32x2;
constexpr int TOPK_LSB = 10; constexpr unsigned TOPK_LOWMASK = (1u << TOPK_LSB) - 1u;
constexpr int IMP_OFF = 65536;
static_assert(IMP_OFF + 64 * 260 * 4 <= TMK_OFF && TMK_OFF + 2048 <= MISC_OFF, "cmp LDS map");
template <int CM  > __device__ __forceinline__ void p3_cmp(const Args& a, LAS unsigned char* lds, int wg, int G) {
    const int tid = threadIdx.x, lane = tid & 63, wave = __builtin_amdgcn_readfirstlane(tid >> 6), c = lane & 15, g = lane >> 4;
    unsigned char* ws = a.ws; const bf16* qr = (const bf16*)(ws + WS_QR); bf16* OC = (bf16*)(ws + WS_OC);
    LAS float* imp = (LAS float*)(lds + IMP_OFF); LAS unsigned* tmk = (LAS unsigned*)(lds + TMK_OFF);
    SWZ_OFFSETS();
    for (int u = wg; u < 1024; u += G) {
        int bg, qt; unit_bq(u, bg, qt); const int b = bg >> 1, gk = bg & 1, t0 = 64 * qt;
        const bf16* kc = (const bf16*)(ws + WS_KC) + (size_t)bg * 1024 * 128; const bf16* vct = (const bf16*)(ws + WS_VCT) + (size_t)bg * 16 * 8192;
        const int ntile = (4 * qt + 66) >> 6;
        __syncthreads();
        tmk[tid] = 0u;
        bf16x8 qf[2][4]; int nmax[2]; float m[2]; f32x2 lp[2];
#pragma unroll
        for (int cs = 0; cs < 2; ++cs) { const int ql = 8 * wave + 4 * cs + (c >> 2), t = t0 + ql; load_qf(qr, (size_t)b * SEQ + t, 4 * gk + (c & 3), g, qf[cs]);
            nmax[cs] = t >= 31 ? (t - 31) >> 4 : -1; m[cs] = -1e30f; lp[cs] = (f32x2){0.f, 0.f}; }
        pin_qf(qf);
        __syncthreads();
        if (CM != 2) dma_k(lds, kc, wave, lane);
        for (int i = 0; i < (CM == 2 ? 0 : ntile); ++i) {
            WAITV(0); RAWBAR();
            if (i + 1 < ntile) dma_k(lds + ((i + 1) & 1) * SLOT_BYTES, kc + (size_t)(i + 1) * 64 * 128, wave, lane);
            const LAS unsigned char* slot = lds + (i & 1) * SLOT_BYTES;
            bf16x8 kf[4][4];
#pragma unroll
            for (int kt = 0; kt < 4; ++kt)
#pragma unroll
                for (int ks = 0; ks < 4; ++ks) kf[kt][ks] = *(const LAS bf16x8*)(slot + kt * 4096 + kx[ks]);
            __builtin_amdgcn_sched_barrier(0);
            f32x4 s0[4], s1[4];
#pragma unroll
            for (int kt = 0; kt < 4; ++kt) { s0[kt] = (f32x4){0.f, 0.f, 0.f, 0.f};
#pragma unroll
                for (int ks = 0; ks < 4; ++ks) s0[kt] = mfma16(kf[kt][ks], qf[0][ks], s0[kt]); }
            __builtin_amdgcn_sched_barrier(0);
            const bool bnd1 = 64 * i + 63 > 4 * qt - 2;
#define CMP_QK1(kt_) do { s1[kt_] = (f32x4){0.f, 0.f, 0.f, 0.f}; _Pragma("unroll") for (int ks_ = 0; ks_ < 4; ++ks_) s1[kt_] = mfma16(kf[kt_][ks_], qf[1][ks_], s1[kt_]); } while (0)
#define CMP_MASK(S, CS) do { if (bnd1) { _Pragma("unroll") for (int kt_ = 0; kt_ < 4; ++kt_) _Pragma("unroll") for (int ii_ = 0; ii_ < 4; ++ii_) { const int n_ = 64 * i + 16 * kt_ + 4 * g + ii_; S[kt_][ii_] = n_ <= nmax[CS] ? S[kt_][ii_] : -__builtin_inff(); } } } while (0)
#define CMP_MAXCHK(S, CS) do { float tm_ = fmaxf(fmaxf(fmaxf(S[0][0], S[0][1]), fmaxf(S[0][2], S[0][3])), fmaxf(fmaxf(S[1][0], S[1][1]), fmaxf(S[1][2], S[1][3]))); \
        tm_ = fmaxf(tm_, fmaxf(fmaxf(fmaxf(S[2][0], S[2][1]), fmaxf(S[2][2], S[2][3])), fmaxf(fmaxf(S[3][0], S[3][1]), fmaxf(S[3][2], S[3][3])))); \
        if (__any((tm_ - m[CS]) * C2 > 8.0f)) { tm_ = lmax32(lmax16(tm_)); const float mn_ = fmaxf(m[CS], tm_), al_ = __builtin_amdgcn_exp2f((m[CS] - mn_) * C2); m[CS] = mn_; lp[CS] = lp[CS] * al_; } } while (0)
#define CMP_EXPSUM(S, CS, kt_) do { const float mbv_ = m[CS] * C2; _Pragma("unroll") for (int ii_ = 0; ii_ < 4; ++ii_) S[kt_][ii_] = __builtin_amdgcn_exp2f(__builtin_fmaf(S[kt_][ii_], C2, -mbv_)); \
        lp[CS] += (f32x2){S[kt_][0], S[kt_][1]}; lp[CS] += (f32x2){S[kt_][2], S[kt_][3]}; } while (0)
            CMP_QK1(0); CMP_MASK(s0, 0); CMP_MAXCHK(s0, 0); __builtin_amdgcn_sched_barrier(0);
            CMP_QK1(1); CMP_EXPSUM(s0, 0, 0); CMP_EXPSUM(s0, 0, 1); __builtin_amdgcn_sched_barrier(0);
            CMP_QK1(2); CMP_EXPSUM(s0, 0, 2); __builtin_amdgcn_sched_barrier(0);
            CMP_QK1(3); CMP_EXPSUM(s0, 0, 3); __builtin_amdgcn_sched_barrier(0);
            CMP_MASK(s1, 1); CMP_MAXCHK(s1, 1);
#pragma unroll
            for (int kt = 0; kt < 4; ++kt) CMP_EXPSUM(s1, 1, kt);
        }
        float mb[2];
#pragma unroll
        for (int cs = 0; cs < 2; ++cs) { float lt = lp[cs].x + lp[cs].y; lt = ladd16(lt); lt = ladd32(lt); mb[cs] = lt > 0.f ? m[cs] * C2 + __builtin_amdgcn_logf(lt) : __builtin_inff(); }
        __syncthreads();
        f32x4 o[2][8];
#pragma unroll
        for (int cs = 0; cs < 2; ++cs)
#pragma unroll
            for (int dt = 0; dt < 8; ++dt) o[cs][dt] = (f32x4){0.f, 0.f, 0.f, 0.f};
        float wrap[2] = {0.f, 0.f};
        if (CM < 2) { dma_k(lds, kc, wave, lane); dma_v(lds, vct, wave, lane); }
        for (int i = 0; i < (CM >= 2 ? 0 : ntile); ++i) {
            WAITV(0); RAWBAR();
            if (i + 1 < ntile) { LAS unsigned char* sl = lds + ((i + 1) & 1) * SLOT_BYTES; dma_k(sl, kc + (size_t)(i + 1) * 64 * 128, wave, lane); dma_v(sl, vct + (size_t)(i + 1) * 8192, wave, lane); }
            const LAS unsigned char* slot = lds + (i & 1) * SLOT_BYTES;
            const bool bnd = 64 * i + 63 > 4 * qt - 2;
            f32x4 s0[4], s1[4];
            { bf16x8 kf[4][4];
#pragma unroll
              for (int kt = 0; kt < 4; ++kt)
#pragma unroll
                  for (int ks = 0; ks < 4; ++ks) kf[kt][ks] = *(const LAS bf16x8*)(slot + kt * 4096 + kx[ks]);
              __builtin_amdgcn_sched_barrier(0);
#pragma unroll
              for (int kt = 0; kt < 4; ++kt) { s0[kt] = (f32x4){0.f, 0.f, 0.f, 0.f};
#pragma unroll
                  for (int ks = 0; ks < 4; ++ks) s0[kt] = mfma16(kf[kt][ks], qf[0][ks], s0[kt]); }
              __builtin_amdgcn_sched_barrier(0);
#define CMP_PIMP(S, CS, kt_) do { const int ql_ = 8 * wave + 4 * CS + (c >> 2); \
        _Pragma("unroll") for (int ii_ = 0; ii_ < 4; ++ii_) { const int n_ = 64 * i + 16 * kt_ + 4 * g + ii_; const float p_ = __builtin_amdgcn_exp2f(__builtin_fmaf(S[kt_][ii_], C2, -mb[CS])); S[kt_][ii_] = (!bnd || n_ <= nmax[CS]) ? p_ : 0.f; } \
        const float s4_ = quad_sum((S[kt_][0] + S[kt_][1]) + (S[kt_][2] + S[kt_][3])), p3_ = quad_sum(S[kt_][3]); \
        const float up_ = __shfl(p3_, (lane + 48) & 63); const float cin_ = g > 0 ? up_ : wrap[CS]; wrap[CS] = up_; \
        if ((c & 3) == 0) imp[ql_ * 260 + 16 * i + 4 * kt_ + g] = s4_ + cin_; } while (0)
#define CMP_QK1B(kt_) do { s1[kt_] = (f32x4){0.f, 0.f, 0.f, 0.f}; _Pragma("unroll") for (int ks_ = 0; ks_ < 4; ++ks_) s1[kt_] = mfma16(kf[kt_][ks_], qf[1][ks_], s1[kt_]); } while (0)
              CMP_QK1B(0); CMP_PIMP(s0, 0, 0); __builtin_amdgcn_sched_barrier(0);
              CMP_QK1B(1); CMP_PIMP(s0, 0, 1); __builtin_amdgcn_sched_barrier(0);
              CMP_QK1B(2); CMP_PIMP(s0, 0, 2); __builtin_amdgcn_sched_barrier(0);
              CMP_QK1B(3); CMP_PIMP(s0, 0, 3); __builtin_amdgcn_sched_barrier(0); }
            { const bf16x8 pa = pack8(s0[0], s0[1]), pb = pack8(s0[2], s0[3]); bf16x8 vf[8];
#pragma unroll
              for (int dt = 0; dt < 8; ++dt) vf[dt] = *(const LAS bf16x8*)(slot + 16384 + dt * 2048 + vx[0]);
              __builtin_amdgcn_sched_barrier(0);
#pragma unroll
              for (int dt = 0; dt < 4; ++dt) o[0][dt] = mfma16(vf[dt], pa, o[0][dt]);
              CMP_PIMP(s1, 1, 0); __builtin_amdgcn_sched_barrier(0);
#pragma unroll
              for (int dt = 4; dt < 8; ++dt) o[0][dt] = mfma16(vf[dt], pa, o[0][dt]);
              CMP_PIMP(s1, 1, 1); __builtin_amdgcn_sched_barrier(0);
#pragma unroll
              for (int dt = 0; dt < 8; ++dt) vf[dt] = *(const LAS bf16x8*)(slot + 16384 + dt * 2048 + vx[1]);
              __builtin_amdgcn_sched_barrier(0);
#pragma unroll
              for (int dt = 0; dt < 4; ++dt) o[0][dt] = mfma16(vf[dt], pb, o[0][dt]);
              CMP_PIMP(s1, 1, 2); __builtin_amdgcn_sched_barrier(0);
#pragma unroll
              for (int dt = 4; dt < 8; ++dt) o[0][dt] = mfma16(vf[dt], pb, o[0][dt]);
              CMP_PIMP(s1, 1, 3); __builtin_amdgcn_sched_barrier(0);
              const bf16x8 qa = pack8(s1[0], s1[1]), qb = pack8(s1[2], s1[3]);
#pragma unroll
              for (int dt = 0; dt < 8; ++dt) o[1][dt] = mfma16(vf[dt], qb, o[1][dt]);
              __builtin_amdgcn_sched_barrier(0);
#pragma unroll
              for (int dt = 0; dt < 8; ++dt) vf[dt] = *(const LAS bf16x8*)(slot + 16384 + dt * 2048 + vx[0]);
#pragma unroll
              for (int dt = 0; dt < 8; ++dt) o[1][dt] = mfma16(vf[dt], qa, o[1][dt]); }
        }
#pragma unroll
        for (int cs = 0; cs < 2; ++cs) { const int ql = 8 * wave + 4 * cs + (c >> 2); store_o(OC, (size_t)b * SEQ + t0 + ql, 4 * gk + (c & 3), g, o[cs], 1.0f); }
        __syncthreads();
        const int cur = qt;
        for (int q0 = 0; q0 < ((CM == 1 || CM == 3) ? 0 : 8); q0 += 4) { unsigned key[4][4], prefix[4] = {0u, 0u, 0u, 0u};
#pragma unroll
            for (int u4 = 0; u4 < 4; ++u4) { const int ql = 8 * wave + q0 + u4;
#pragma unroll
                for (int k = 0; k < 4; ++k) { const int j = 64 * k + lane; const bool forced = (j == 0) | (j == cur) | (j == cur - 1);
                    key[u4][k] = forced ? 0xffffffffu : (j <= cur ? __builtin_bit_cast(unsigned, imp[ql * 260 + j]) + 1u : 0u); } }
            const int nk = (cur >> 6) + 1;
#define TOPK_SEARCH(NK) for (int bit = 30; bit >= TOPK_LSB; --bit) { \
                _Pragma("unroll") for (int u4 = 0; u4 < 4; ++u4) { const unsigned trial = prefix[u4] | (1u << bit); int cnt = 0; \
                    _Pragma("unroll") for (int k = 0; k < NK; ++k) cnt += __popcll(__ballot(key[u4][k] >= trial)); \
                    if (cnt >= 16) prefix[u4] = trial; } }
            if (nk == 1) { TOPK_SEARCH(1) } else if (nk == 2) { TOPK_SEARCH(2) } else if (nk == 3) { TOPK_SEARCH(3) } else { TOPK_SEARCH(4) }
#undef TOPK_SEARCH
#pragma unroll
            for (int u4 = 0; u4 < 4; ++u4) { const int ql = 8 * wave + q0 + u4; int cgt = 0; const unsigned hi = prefix[u4] | TOPK_LOWMASK;
#pragma unroll
                for (int k = 0; k < 4; ++k) cgt += __popcll(__ballot(key[u4][k] > hi));
                int need = 16 - cgt, before = 0;
#pragma unroll
                for (int k = 0; k < 4; ++k) { const bool ineq = key[u4][k] >= prefix[u4] && key[u4][k] <= hi; const unsigned long long eq = __ballot(ineq); const int rank = before + __popcll(eq & ((1ull << lane) - 1ull)); before += __popcll(eq);
                    const bool sel = (key[u4][k] > hi) || (ineq && rank < need); const int j = 64 * k + lane;
                    if (sel && j <= cur) __hip_atomic_fetch_or(tmk + 2 * j + (ql >> 5), 1u << (ql & 31), __ATOMIC_RELAXED, __HIP_MEMORY_SCOPE_WORKGROUP); } }
        }
        __syncthreads();
        if (tid < 256) { v2u w; w.x = tmk[2 * tid]; w.y = tmk[2 * tid + 1]; *((v2u*)(ws + WS_TMASK) + ((size_t)(bg * 256 + qt) * 256 + tid)) = w; }
    }
}

constexpr int SLOT8 = 16384, SELB = 4;
static_assert(2 * SELB * SLOT8 <= TMK_OFF, "sel ring");
constexpr float SM_THR8 = 8.0f;
__device__ __forceinline__ void dma_k8(LAS unsigned char* slot, const unsigned char* ksrc, int wave, int lane) {
    const unsigned row = 8u * wave + (lane >> 3), pos = lane & 7, off = row * 128u + ((pos ^ ((row >> 1) & 7u)) * 16u);
    __builtin_amdgcn_global_load_lds((const unsigned*)(ksrc + off), (LAS unsigned*)(slot + wave * 1024), 16, 0, 0);
}
__device__ __forceinline__ void dma_v8(LAS unsigned char* slot, const unsigned char* vsrc, int wave, int lane) {
    const unsigned d = 16u * wave + (lane >> 2), pos = lane & 3, off = d * 64u + ((pos ^ ((d >> 2) & 3u)) * 16u);
    __builtin_amdgcn_global_load_lds((const unsigned*)(vsrc + off), (LAS unsigned*)(slot + 8192 + wave * 1024), 16, 0, 0);
}
#define MFMA8_B(acc, A, B) acc = __builtin_amdgcn_mfma_scale_f32_16x16x128_f8f6f4(A, B, acc, 0, 0, 0, 0x7f7f7f7f, 0, 0x7f7f7f7f)
#define SEL_GAP() __builtin_amdgcn_sched_barrier(0)
#define MFMA8_ACC(acc, A, B) asm volatile("v_mfma_scale_f32_16x16x128_f8f6f4 %0, %1, %2, %0, %3, %3 op_sel_hi:[0,0,0]" : "+v"(acc) : "v"(A), "v"(B), "v"(0x7f7f7f7f))
__device__ __forceinline__ float max16(const f32x4 (&s)[4]) {
    float t0, t1, t2;
    asm("v_max3_f32 %0, %3, %4, %5\n v_max3_f32 %1, %6, %7, %8\n v_max3_f32 %2, %9, %10, %11\n v_max3_f32 %0, %0, %1, %2\n v_max3_f32 %1, %12, %13, %14\n v_max3_f32 %2, %15, %16, %17\n v_max3_f32 %0, %0, %1, %2\n v_max_f32 %0, %0, %18"
        : "=&v"(t0), "=&v"(t1), "=&v"(t2)
        : "v"(s[0][0]), "v"(s[0][1]), "v"(s[0][2]), "v"(s[0][3]), "v"(s[1][0]), "v"(s[1][1]), "v"(s[1][2]), "v"(s[1][3]), "v"(s[2][0]), "v"(s[2][1]), "v"(s[2][2]), "v"(s[2][3]), "v"(s[3][0]), "v"(s[3][1]), "v"(s[3][2]), "v"(s[3][3]));
    return t0;
}
template <int MODE  > __device__ __forceinline__ void p4_sel(const Args& a, LAS unsigned char* lds, int wg, int G) {
    const int tid = threadIdx.x, lane = tid & 63, wave = __builtin_amdgcn_readfirstlane(tid >> 6), c = lane & 15, g = lane >> 4;
    unsigned char* ws = a.ws; const unsigned char* q8 = ws + WS_Q8; bf16* OS = (bf16*)(ws + WS_OS);
    LAS unsigned* tmk = (LAS unsigned*)(lds + TMK_OFF);
    const int ky = (c >> 1) & 7, kxa = c * 128 + (((2 * g) ^ ky) << 4), kxb = c * 128 + (((2 * g + 1) ^ ky) << 4), vxo = c * 64 + ((g ^ ((c >> 2) & 3)) << 4);
    const float NINF = -__builtin_inff();
    for (int r = 0; r * G + wg < 1024; ++r) {
        int bg, qt; unit_sel(wg, r, G, bg, qt); const int b = bg >> 1, gk = bg & 1, t0 = 64 * qt, cur = qt;
        const unsigned char* ks = ws + WS_KSEL + (size_t)bg * SEQ * 128; const unsigned char* vst = ws + WS_VSELT + (size_t)bg * 256 * 8192;
        __syncthreads();
        tmk[tid] = *((const unsigned*)(ws + WS_TMASK) + ((size_t)(bg * 256 + qt) * 512 + tid));
        v8i32 qf[2]; float nmb[2], thr[2]; f32x2 lsum[2]; f32x4 o[2][8]; int tq[2];
        v8i32 pLo = {0, 0, 0, 0, 0, 0, 0, 0}, pHi = {0, 0, 0, 0, 0, 0, 0, 0}; asm volatile("" : "+v"(pLo), "+v"(pHi));
#pragma unroll
        for (int cs = 0; cs < 2; ++cs) { const int ql = 8 * wave + 4 * cs + (c >> 2); tq[cs] = t0 + ql; qf[cs] = *(const v8i32*)(q8 + ((size_t)b * SEQ + tq[cs]) * 1024 + (4 * gk + (c & 3)) * 128 + 32 * g); nmb[cs] = 0.f; thr[cs] = NINF; lsum[cs] = (f32x2){0.f, 0.f};
#pragma unroll
            for (int dt = 0; dt < 8; ++dt) o[cs][dt] = (f32x4){0.f, 0.f, 0.f, 0.f}; }
        asm volatile("" : "+v"(qf[0])); asm volatile("" : "+v"(qf[1]));
        __syncthreads();
#pragma unroll
        for (int jp = 0; jp < SELB; ++jp) if (MODE != 2 && jp <= cur) { dma_k8(lds + jp * SLOT8, ks + (size_t)jp * 64 * 128, wave, lane); dma_v8(lds + jp * SLOT8, vst + (size_t)jp * 8192, wave, lane); }
        for (int js = 0; js <= cur; js += SELB) {
            WAITV(0); RAWBAR();
#pragma unroll
            for (int jp = SELB; jp < 2 * SELB; ++jp) if (MODE != 2 && js + jp <= cur) { LAS unsigned char* sl = lds + ((js + jp) & (2 * SELB - 1)) * SLOT8; dma_k8(sl, ks + (size_t)(js + jp) * 64 * 128, wave, lane); dma_v8(sl, vst + (size_t)(js + jp) * 8192, wave, lane); }
            unsigned mws[SELB];
#pragma unroll
            for (int jj = 0; jj < SELB; ++jj) mws[jj] = tmk[2 * (js + jj) + (wave >> 2)];
            unsigned m8s[SELB];
#pragma unroll
            for (int jj = 0; jj < SELB; ++jj) { const unsigned mw = __builtin_amdgcn_readfirstlane(mws[jj]); m8s[jj] = (MODE == 1 || js + jj > cur) ? 0u : ((mw >> (8 * (wave & 3))) & 0xffu); }
#pragma unroll
          for (int jj = 0; jj < SELB; ++jj) { const int j = js + jj;
            if (m8s[jj] != 0u) {
            const LAS unsigned char* slot = lds + (j & (2 * SELB - 1)) * SLOT8; const unsigned m8 = m8s[jj];
            v8i32 kf[4];
#pragma unroll
            for (int kt = 0; kt < 4; ++kt) kf[kt] = pg8::cat8(*(const LAS bf16x8*)(slot + kt * 2048 + kxa), *(const LAS bf16x8*)(slot + kt * 2048 + kxb));
#pragma unroll
            for (int cs = 0; cs < 2; ++cs) { const unsigned nib = (m8 >> (4 * cs)) & 0xfu;
                if (nib != 0u) {
                    const bool selq = (nib >> (c >> 2)) & 1u; f32x4 s[4];
                    { const float cv = selq ? nmb[cs] : NINF; const f32x4 cacc = {cv, cv, cv, cv};
#pragma unroll
                      for (int kt = 0; kt < 4; ++kt) s[kt] = __builtin_amdgcn_mfma_scale_f32_16x16x128_f8f6f4(kf[kt], qf[cs], cacc, 0, 0, 0, 0x7f7f7f7f, 0, 0x7c7c7c7c); }
                    v8i32 vf[4];
#pragma unroll
                    for (int j2 = 0; j2 < 4; ++j2) vf[j2] = pg8::cat8(*(const LAS bf16x8*)(slot + 8192 + j2 * 2048 + vxo), *(const LAS bf16x8*)(slot + 8192 + j2 * 2048 + 1024 + vxo));
                    __builtin_amdgcn_sched_barrier(0);
                    if (j == cur) {
#pragma unroll
                        for (int kt = 0; kt < 4; ++kt)
#pragma unroll
                            for (int ii = 0; ii < 4; ++ii) { const int kp = 64 * j + 16 * kt + 4 * g + ii; s[kt][ii] = kp <= tq[cs] ? s[kt][ii] : NINF; } }
                    const float tm = max16(s);
                    if (__any(tm > thr[cs])) {
                        const float tr = xmax32(xmax16(tm)); const bool un = thr[cs] == NINF, live = tr > NINF;
                        const float d = un ? (live ? tr : 0.f) : fmaxf(tr, 0.f), alpha = __builtin_amdgcn_exp2f(-d);
                        thr[cs] = (un && !live) ? NINF : SM_THR8; nmb[cs] -= d; lsum[cs] = lsum[cs] * alpha;
#pragma unroll
                        for (int dt = 0; dt < 8; ++dt) o[cs][dt] = o[cs][dt] * alpha;
#pragma unroll
                        for (int kt = 0; kt < 4; ++kt)
#pragma unroll
                            for (int i = 0; i < 4; ++i) s[kt][i] -= d; }
#pragma unroll
                    for (int kt = 0; kt < 4; ++kt) {
#pragma unroll
                        for (int i = 0; i < 4; ++i) s[kt][i] = __builtin_amdgcn_exp2f(s[kt][i]);
                        lsum[cs] += (f32x2){s[kt][0], s[kt][1]}; lsum[cs] += (f32x2){s[kt][2], s[kt][3]};
                        int w = pLo[kt]; w = __builtin_amdgcn_cvt_pk_fp8_f32(s[kt][0], s[kt][1], w, false); w = __builtin_amdgcn_cvt_pk_fp8_f32(s[kt][2], s[kt][3], w, true); pLo[kt] = w; pHi[4 + kt] = w; }
#pragma unroll
                    for (int j2 = 0; j2 < 4; ++j2) { MFMA8_ACC(o[cs][2 * j2], vf[j2], pLo); MFMA8_ACC(o[cs][2 * j2 + 1], vf[j2], pHi); } } }
          } }
        }
        asm volatile("s_nop 15\n s_nop 15" ::: "memory");
#pragma unroll
        for (int cs = 0; cs < 2; ++cs) { const float lt = ladd32(ladd16(lsum[cs].x + lsum[cs].y)); const float inv = lt > 0.f ? 1.0f / lt : 0.f;
            if (MODE == 0) store_o(OS, (size_t)b * SEQ + tq[cs], 4 * gk + (c & 3), g, o[cs], inv); else { asm volatile("" :: "v"(inv), "v"(o[cs][0]), "v"(o[cs][7])); } }
    }
}

__device__ __forceinline__ void waitv_dyn(int n) {
    switch (n) { case 0: WAITV(0); break; case 2: WAITV(2); break; case 4: WAITV(4); break; case 6: WAITV(6); break; case 8: WAITV(8); break; case 10: WAITV(10); break; case 12: WAITV(12); break; default: WAITV(14); break; }
}
#define WIN_EXP2(S, kt_, h_) do { S[kt_][2 * (h_)] = __builtin_amdgcn_exp2f(S[kt_][2 * (h_)]); S[kt_][2 * (h_) + 1] = __builtin_amdgcn_exp2f(S[kt_][2 * (h_) + 1]); } while (0)
#define WIN_CVT(S, PN, LS, kt_, h_) do { PN[kt_] = __builtin_amdgcn_cvt_pk_fp8_f32(S[kt_][2 * (h_)], S[kt_][2 * (h_) + 1], PN[kt_], (h_) != 0); LS += (f32x2){S[kt_][2 * (h_)], S[kt_][2 * (h_) + 1]}; } while (0)
#define WIN_RARE(S, TM, CS) do { const float tr_ = xmax32(xmax16(TM)); const bool un_ = thr[CS] == NINF, live_ = tr_ > NINF; \
    const float d_ = un_ ? (live_ ? tr_ : 0.f) : fmaxf(tr_, 0.f), alpha_ = __builtin_amdgcn_exp2f(-d_); thr[CS] = (un_ && !live_) ? NINF : SM_THR8; nmb[CS] -= d_; lsum[CS] = lsum[CS] * alpha_; \
    _Pragma("unroll") for (int dt_ = 0; dt_ < 8; ++dt_) o[CS][dt_] = o[CS][dt_] * alpha_; \
    _Pragma("unroll") for (int kt_ = 0; kt_ < 4; ++kt_) _Pragma("unroll") for (int i_ = 0; i_ < 4; ++i_) S[kt_][i_] -= d_; } while (0)
__device__ __forceinline__ void p5_win(const Args& a, LAS unsigned char* lds, int wg, int G) {
    const int tid = threadIdx.x, lane = tid & 63, wave = __builtin_amdgcn_readfirstlane(tid >> 6), c = lane & 15, g = lane >> 4;
    unsigned char* ws = a.ws; const unsigned char* q8 = ws + WS_Q8; bf16* OW = (bf16*)(ws + WS_OW);
    const int ky = (c >> 1) & 7, kxa = c * 128 + (((2 * g) ^ ky) << 4), kxb = c * 128 + (((2 * g + 1) ^ ky) << 4), vxo = c * 64 + ((g ^ ((c >> 2) & 3)) << 4);
    const float NINF = -__builtin_inff();
    for (int u = wg; u < 1024; u += G) {
        const int bg = u >> 8, x = u & 255, qt = (G == 256) ? ((x & 7) * 32 + (x >> 3)) : x, b = bg >> 1, gk = bg & 1, t0 = 64 * qt;
        const unsigned char* kw = ws + WS_KWIN + (size_t)bg * SEQ * 128; const unsigned char* vwt = ws + WS_VWINT + (size_t)bg * 256 * 8192;
        v8i32 qf[2]; float nmb[2], thr[2]; f32x2 lsum[2]; f32x4 o[2][8]; int tq[2];
        v8i32 pLo0 = {0, 0, 0, 0, 0, 0, 0, 0}, pHi0 = {0, 0, 0, 0, 0, 0, 0, 0}, pLo1 = {0, 0, 0, 0, 0, 0, 0, 0}, pHi1 = {0, 0, 0, 0, 0, 0, 0, 0};
        asm volatile("" : "+v"(pLo0), "+v"(pHi0)); asm volatile("" : "+v"(pLo1), "+v"(pHi1));
#pragma unroll
        for (int cs = 0; cs < 2; ++cs) { const int ql = 8 * wave + 4 * cs + (c >> 2); tq[cs] = t0 + ql; qf[cs] = *(const v8i32*)(q8 + ((size_t)b * SEQ + tq[cs]) * 1024 + (4 * gk + (c & 3)) * 128 + 32 * g); nmb[cs] = 0.f; thr[cs] = NINF; lsum[cs] = (f32x2){0.f, 0.f};
#pragma unroll
            for (int dt = 0; dt < 8; ++dt) o[cs][dt] = (f32x4){0.f, 0.f, 0.f, 0.f}; }
        const int j0 = qt >= 8 ? qt - 8 : 0, nb = qt - j0 + 1, nfirst = nb < 8 ? nb : 8;
        asm volatile("" : "+v"(qf[0])); asm volatile("" : "+v"(qf[1]));
        __syncthreads();
        for (int i = 0; i < nfirst; ++i) { LAS unsigned char* sl = lds + ((j0 + i) & 7) * SLOT8; dma_k8(sl, kw + (size_t)(j0 + i) * 64 * 128, wave, lane); dma_v8(sl, vwt + (size_t)(j0 + i) * 8192, wave, lane); }
        int nissued = nfirst;
        for (int i0 = 0; i0 < nb; i0 += 3) {
            const int iend = i0 + 3 < nb ? i0 + 3 : nb, left = nissued - iend;
            waitv_dyn(left > 0 ? 2 * left : 0); RAWBAR();
            if (i0 == 3 && nb == 9) { LAS unsigned char* sl = lds + ((j0 + 8) & 7) * SLOT8; dma_k8(sl, kw + (size_t)(j0 + 8) * 64 * 128, wave, lane); dma_v8(sl, vwt + (size_t)(j0 + 8) * 8192, wave, lane); nissued = 9; }
            for (int i = i0; i < iend; ++i) { const int j = j0 + i;
                const LAS unsigned char* slot = lds + (j & 7) * SLOT8;
                f32x4 s0[4], s1[4];
                { v8i32 kf[4];
#pragma unroll
                  for (int kt = 0; kt < 4; ++kt) kf[kt] = pg8::cat8(*(const LAS bf16x8*)(slot + kt * 2048 + kxa), *(const LAS bf16x8*)(slot + kt * 2048 + kxb));
                  const f32x4 c0 = {nmb[0], nmb[0], nmb[0], nmb[0]}, c1 = {nmb[1], nmb[1], nmb[1], nmb[1]};
                  __builtin_amdgcn_sched_barrier(0);
#pragma unroll
                  for (int kt = 0; kt < 4; ++kt) s0[kt] = __builtin_amdgcn_mfma_scale_f32_16x16x128_f8f6f4(kf[kt], qf[0], c0, 0, 0, 0, 0x7f7f7f7f, 0, 0x7c7c7c7c);
#pragma unroll
                  for (int kt = 0; kt < 4; ++kt) s1[kt] = __builtin_amdgcn_mfma_scale_f32_16x16x128_f8f6f4(kf[kt], qf[1], c1, 0, 0, 0, 0x7f7f7f7f, 0, 0x7c7c7c7c); }
                v8i32 vf[4];
#pragma unroll
                for (int j2 = 0; j2 < 4; ++j2) vf[j2] = pg8::cat8(*(const LAS bf16x8*)(slot + 8192 + j2 * 2048 + vxo), *(const LAS bf16x8*)(slot + 8192 + j2 * 2048 + 1024 + vxo));
                __builtin_amdgcn_sched_barrier(0);
                if (j == qt || j + 8 == qt) {
                    int l0 = tq[0] - 64 * j - 4 * g, l1 = tq[1] - 64 * j - 4 * g; asm volatile("" : "+v"(l0), "+v"(l1));
#pragma unroll
                    for (int kt = 0; kt < 4; ++kt)
#pragma unroll
                        for (int ii = 0; ii < 4; ++ii) { s0[kt][ii] = ((unsigned)(l0 - (16 * kt + ii)) < 512u) ? s0[kt][ii] : NINF; s1[kt][ii] = ((unsigned)(l1 - (16 * kt + ii)) < 512u) ? s1[kt][ii] : NINF; } }
                int pn0[4] = {0, 0, 0, 0}, pn1[4] = {0, 0, 0, 0}; f32x2 ls0 = {0.f, 0.f}, ls1 = {0.f, 0.f};
                { const float tm = __builtin_fmaxf(__builtin_fmaxf(__builtin_fmaxf(__builtin_fmaxf(s0[0][0], s0[0][1]), __builtin_fmaxf(s0[0][2], s0[0][3])), __builtin_fmaxf(__builtin_fmaxf(s0[1][0], s0[1][1]), __builtin_fmaxf(s0[1][2], s0[1][3]))),
                                                     __builtin_fmaxf(__builtin_fmaxf(__builtin_fmaxf(s0[2][0], s0[2][1]), __builtin_fmaxf(s0[2][2], s0[2][3])), __builtin_fmaxf(__builtin_fmaxf(s0[3][0], s0[3][1]), __builtin_fmaxf(s0[3][2], s0[3][3]))));
                  if (__any(tm > thr[0])) WIN_RARE(s0, tm, 0); }
#pragma unroll
                for (int kt = 0; kt < 4; ++kt) { WIN_EXP2(s0, kt, 0); WIN_EXP2(s0, kt, 1); WIN_CVT(s0, pn0, ls0, kt, 0); WIN_CVT(s0, pn0, ls0, kt, 1); }
#pragma unroll
                for (int kt = 0; kt < 4; ++kt) { pLo0[kt] = pn0[kt]; pHi0[4 + kt] = pn0[kt]; }
                lsum[0] += ls0;
                { const float tm = __builtin_fmaxf(__builtin_fmaxf(__builtin_fmaxf(__builtin_fmaxf(s1[0][0], s1[0][1]), __builtin_fmaxf(s1[0][2], s1[0][3])), __builtin_fmaxf(__builtin_fmaxf(s1[1][0], s1[1][1]), __builtin_fmaxf(s1[1][2], s1[1][3]))),
                                                     __builtin_fmaxf(__builtin_fmaxf(__builtin_fmaxf(s1[2][0], s1[2][1]), __builtin_fmaxf(s1[2][2], s1[2][3])), __builtin_fmaxf(__builtin_fmaxf(s1[3][0], s1[3][1]), __builtin_fmaxf(s1[3][2], s1[3][3]))));
                  if (__any(tm > thr[1])) WIN_RARE(s1, tm, 1); }
                __builtin_amdgcn_sched_barrier(0);
                MFMA8_B(o[0][0], vf[0], pLo0); WIN_EXP2(s1, 0, 0); SEL_GAP();
                MFMA8_B(o[0][1], vf[0], pHi0); WIN_EXP2(s1, 0, 1); WIN_CVT(s1, pn1, ls1, 0, 0); SEL_GAP();
                MFMA8_B(o[0][2], vf[1], pLo0); WIN_EXP2(s1, 1, 0); WIN_CVT(s1, pn1, ls1, 0, 1); SEL_GAP();
                MFMA8_B(o[0][3], vf[1], pHi0); WIN_EXP2(s1, 1, 1); WIN_CVT(s1, pn1, ls1, 1, 0); SEL_GAP();
                MFMA8_B(o[0][4], vf[2], pLo0); WIN_EXP2(s1, 2, 0); WIN_CVT(s1, pn1, ls1, 1, 1); SEL_GAP();
                MFMA8_B(o[0][5], vf[2], pHi0); WIN_EXP2(s1, 2, 1); WIN_CVT(s1, pn1, ls1, 2, 0); SEL_GAP();
                MFMA8_B(o[0][6], vf[3], pLo0); WIN_EXP2(s1, 3, 0); WIN_CVT(s1, pn1, ls1, 2, 1); SEL_GAP();
                MFMA8_B(o[0][7], vf[3], pHi0); WIN_EXP2(s1, 3, 1); WIN_CVT(s1, pn1, ls1, 3, 0); SEL_GAP();
                WIN_CVT(s1, pn1, ls1, 3, 1);
#pragma unroll
                for (int kt = 0; kt < 4; ++kt) { pLo1[kt] = pn1[kt]; pHi1[4 + kt] = pn1[kt]; }
                lsum[1] += ls1;
#pragma unroll
                for (int j2 = 0; j2 < 4; ++j2) { MFMA8_B(o[1][2 * j2], vf[j2], pLo1); MFMA8_B(o[1][2 * j2 + 1], vf[j2], pHi1); }
            }
        }
#pragma unroll
        for (int cs = 0; cs < 2; ++cs) { const float lt = ladd32(ladd16(lsum[cs].x + lsum[cs].y)); const float inv = lt > 0.f ? 1.0f / lt : 0.f;
            store_o(OW, (size_t)b * SEQ + tq[cs], 4 * gk + (c & 3), g, o[cs], inv); }
    }
}

__device__ __forceinline__ void gelu4(v2u w, float (&o)[4]) {
    const pg8::f32x2 a = pg8::gelu_pk((pg8::f32x2){bflo(w.x), bfhi(w.x)}), b = pg8::gelu_pk((pg8::f32x2){bflo(w.y), bfhi(w.y)}); o[0] = a.x; o[1] = a.y; o[2] = b.x; o[3] = b.y;
}
__device__ __forceinline__ void p6_mix(const Args& a, LAS unsigned char* lds, int wg, int G) {
    const int tid = threadIdx.x, lane = tid & 63, wave = __builtin_amdgcn_readfirstlane(tid >> 6), c = lane & 15, g = lane >> 4;
    unsigned char* ws = a.ws; const bf16* proj = (const bf16*)(ws + WS_PROJ); bf16* STG = (bf16*)(ws + WS_XN)  ; unsigned char* MIX = (unsigned char*)(ws + WS_QR)  ;
    { const float* gn = (const float*)a.in[8]; const float* bs = (const float*)a.in[10]; const float* og = (const float*)a.in[12]; const bf16* wm = (const bf16*)(ws + WS_WM);
      for (int u = wg; u < 256; u += G) { const size_t m0 = (size_t)(u >> 7) * SEQ + 128 * (u & 127); const int t = 16 * wave + c; float ssum = 0.f;
        const int sr = tid >> 4, c0 = 8 * (tid & 15);
        v4u vv[4];
#pragma unroll
        for (int ps = 0; ps < 4; ++ps) vv[ps] = *(const v4u*)(proj + (m0 + 32 * ps + sr) * NP1 + COL_V + c0);
        for (int hg = 0; hg < 8; ++hg) { LAS bf16* buf = (LAS bf16*)lds + (hg & 1) * (128 * 136);
            const f32x4 gna = *(const f32x4*)(gn + hg * 128 + c0), gnb = *(const f32x4*)(gn + hg * 128 + c0 + 4);
            v4u uq[4]; bf16x8 bfr[4];
#pragma unroll
            for (int q = 0; q < 4; ++q) uq[q] = *(const v4u*)(proj + (m0 + t) * NP1 + COL_U + hg * 128 + 32 * g + 8 * q);
#pragma unroll
            for (int ks = 0; ks < 4; ++ks) bfr[ks] = *(const bf16x8*)(wm + ((size_t)hg * 128 + t) * 128 + 32 * ks + 8 * g);
            const float bst = bs[hg * 128 + t];
#pragma unroll
            for (int ps = 0; ps < 4; ++ps) { const int s = 32 * ps + sr; float x[8]; float xa[4], xb[4];
                gelu4((v2u){vv[ps].x, vv[ps].y}, xa); gelu4((v2u){vv[ps].z, vv[ps].w}, xb);
#pragma unroll
                for (int j = 0; j < 4; ++j) { x[j] = xa[j]; x[4 + j] = xb[j]; }
                float ss = 0.f;
#pragma unroll
                for (int j = 0; j < 8; ++j) ss += x[j] * x[j];
                ss = row16_sum(ss);
                const float rs = __builtin_amdgcn_rsqf(ss * (1.0f / 128.0f) + EPS);
#pragma unroll
                for (int j = 0; j < 8; ++j) buf[(c0 + j) * 136 + (s ^ c0)] = (bf16)f2bf(x[j] * rs * (j < 4 ? gna[j] : gnb[j - 4])); }
            if (hg < 7) {
#pragma unroll
                for (int ps = 0; ps < 4; ++ps) vv[ps] = *(const v4u*)(proj + (m0 + 32 * ps + sr) * NP1 + COL_V + (hg + 1) * 128 + c0); }
            __syncthreads();
            f32x4 acc[8];
#pragma unroll
            for (int ct = 0; ct < 8; ++ct) acc[ct] = (f32x4){0.f, 0.f, 0.f, 0.f};
#pragma unroll
            for (int ks = 0; ks < 4; ++ks) { if (ks <= (wave >> 1)) {
#pragma unroll
                for (int ct = 0; ct < 8; ++ct) { const int row = 32 * (c >> 2) + 4 * ct + (c & 3); const bf16x8 af = *(const LAS bf16x8*)(buf + row * 136 + ((32 * ks + 8 * g) ^ (8 * ((row >> 3) & 15)))); acc[ct] = mfma16(af, bfr[ks], acc[ct]); } } }
#pragma unroll
            for (int q = 0; q < 4; ++q) { v4u w4;
#pragma unroll
                for (int hf = 0; hf < 2; ++hf) { const int ct = 2 * q + hf; float gu[4]; gelu4(hf ? (v2u){uq[q].z, uq[q].w} : (v2u){uq[q].x, uq[q].y}, gu);
                    const float o0 = gu[0] * (acc[ct][0] + bst), o1 = gu[1] * (acc[ct][1] + bst), o2 = gu[2] * (acc[ct][2] + bst), o3 = gu[3] * (acc[ct][3] + bst);
                    ssum += (o0 * o0 + o1 * o1) + (o2 * o2 + o3 * o3); if (hf) { w4.z = pk2(o0, o1); w4.w = pk2(o2, o3); } else { w4.x = pk2(o0, o1); w4.y = pk2(o2, o3); } }
                *(v4u*)(STG + (m0 + t) * 1024 + hg * 128 + 32 * g + 8 * q) = w4; } }
        ssum = ladd32(ladd16(ssum));
        LAS float* rsl = (LAS float*)lds + 2 * 128 * 136 / 2;
        if (g == 0) rsl[t] = __builtin_amdgcn_rsqf(ssum * (1.0f / 1024.0f) + EPS);
        asm volatile("s_waitcnt vmcnt(0)" ::: "memory");
        __syncthreads();
        { const int tr = tid >> 2, q4 = tid & 3; const float rs = rsl[tr];
#pragma unroll 4
          for (int st = 0; st < 16; ++st) { const int ch = 64 * st + 16 * q4; const bf16* sp = STG + (m0 + tr) * 1024 + ch; const v4u xa = *(const v4u*)sp, xb = *(const v4u*)(sp + 8);
              const f32x4 g0 = *(const f32x4*)(og + ch), g1 = *(const f32x4*)(og + ch + 4), g2 = *(const f32x4*)(og + ch + 8), g3 = *(const f32x4*)(og + ch + 12); v4u w;
              w.x = pg8::pk4_fp8(bflo(xa.x) * rs * g0[0], bfhi(xa.x) * rs * g0[1], bflo(xa.y) * rs * g0[2], bfhi(xa.y) * rs * g0[3]); w.y = pg8::pk4_fp8(bflo(xa.z) * rs * g1[0], bfhi(xa.z) * rs * g1[1], bflo(xa.w) * rs * g1[2], bfhi(xa.w) * rs * g1[3]);
              w.z = pg8::pk4_fp8(bflo(xb.x) * rs * g2[0], bfhi(xb.x) * rs * g2[1], bflo(xb.y) * rs * g2[2], bfhi(xb.y) * rs * g2[3]); w.w = pg8::pk4_fp8(bflo(xb.z) * rs * g3[0], bfhi(xb.z) * rs * g3[1], bflo(xb.w) * rs * g3[2], bfhi(xb.w) * rs * g3[3]);
              *(v4u*)(MIX + (m0 + tr) * DM + 1024 + ch) = w; } }
        __syncthreads(); } }
    { const bf16* OC = (const bf16*)(ws + WS_OC); const bf16* OS = (const bf16*)(ws + WS_OS); const bf16* OW = (const bf16*)(ws + WS_OW); const float* ng = (const float*)a.in[11];
      const int h = lane >> 3, d0 = (lane & 7) * 16;
      const f32x4 gA = *(const f32x4*)(ng + h * 128 + d0), gB = *(const f32x4*)(ng + h * 128 + d0 + 4), gC = *(const f32x4*)(ng + h * 128 + d0 + 8), gD = *(const f32x4*)(ng + h * 128 + d0 + 12);
      const int NW2 = G * NWAVES;
      for (int m = wg * NWAVES + wave; m < MTOK; m += 2 * NW2) { v4u x[2][2], y[2][2], z[2][2]; unsigned gw[2][3];
#pragma unroll
        for (int q = 0; q < 2; ++q) { const int mm = m + q * NW2; const size_t off = (size_t)mm * 1024 + h * 128 + d0; const bf16* gp = (const bf16*)(ws + WS_GATES) + (size_t)mm * 32 + h * 3;
            gw[q][0] = gp[0]; gw[q][1] = gp[1]; gw[q][2] = gp[2];
#pragma unroll
            for (int hf = 0; hf < 2; ++hf) { x[q][hf] = *(const v4u*)(OC + off + 8 * hf); y[q][hf] = *(const v4u*)(OS + off + 8 * hf); z[q][hf] = *(const v4u*)(OW + off + 8 * hf); } }
#pragma unroll
        for (int q = 0; q < 2; ++q) { const int mm = m + q * NW2; const float g0 = sigmoidf(bf2f(gw[q][0])), g1 = sigmoidf(bf2f(gw[q][1])), g2 = sigmoidf(bf2f(gw[q][2])); float o[16]; float ss = 0.f;
#pragma unroll
            for (int hf = 0; hf < 2; ++hf)
#pragma unroll
                for (int j = 0; j < 4; ++j) { const float lo = g0 * bflo(x[q][hf][j]) + g1 * bflo(y[q][hf][j]) + g2 * bflo(z[q][hf][j]), hi = g0 * bfhi(x[q][hf][j]) + g1 * bfhi(y[q][hf][j]) + g2 * bfhi(z[q][hf][j]); o[8 * hf + 2 * j] = lo; o[8 * hf + 2 * j + 1] = hi; ss += lo * lo + hi * hi; }
            const float rs = __builtin_amdgcn_rsqf(wave_sum_v(ss) * (1.0f / 1024.0f) + EPS);
            v4u w8; w8.x = pg8::pk4_fp8(o[0] * rs * gA[0], o[1] * rs * gA[1], o[2] * rs * gA[2], o[3] * rs * gA[3]); w8.y = pg8::pk4_fp8(o[4] * rs * gB[0], o[5] * rs * gB[1], o[6] * rs * gB[2], o[7] * rs * gB[3]);
            w8.z = pg8::pk4_fp8(o[8] * rs * gC[0], o[9] * rs * gC[1], o[10] * rs * gC[2], o[11] * rs * gC[3]); w8.w = pg8::pk4_fp8(o[12] * rs * gD[0], o[13] * rs * gD[1], o[14] * rs * gD[2], o[15] * rs * gD[3]);
            *(v4u*)(MIX + (size_t)mm * DM + h * 128 + d0) = w8; } } }
}

__device__ __forceinline__ void unpack8_fp8(v2u x, float (&o)[8]) {
#pragma unroll
    for (int h = 0; h < 2; ++h) { const int w = (int)(h ? x.y : x.x); const auto lo = __builtin_amdgcn_cvt_pk_f32_fp8(w, false), hi = __builtin_amdgcn_cvt_pk_f32_fp8(w, true); o[4 * h] = lo[0]; o[4 * h + 1] = lo[1]; o[4 * h + 2] = hi[0]; o[4 * h + 3] = hi[1]; }
}
__device__ __forceinline__ void p_conv(const Args& a, int wg, int G) {
    unsigned char* ws = a.ws; const unsigned char* AH = (const unsigned char*)(ws + WS_AH); unsigned char* HM = (unsigned char*)(ws + WS_HMID);
    const float* cw = (const float*)a.in[16]; const float* cb = (const float*)a.in[17];
    constexpr int TB = 32, NCG = DFF / 8, NIT = (MTOK / TB) * NCG;
    for (int it = wg * NTHR + threadIdx.x; it < NIT; it += G * NTHR) { const int tb = it / NCG, cg = it - tb * NCG, n0 = 8 * cg, t0 = tb * TB;
        f32x2 w0[2][4], w1[2][4], w2[2][4], bb[2][4], p2[2][4], p1[2][4];
#pragma unroll
        for (int hf = 0; hf < 2; ++hf)
#pragma unroll
            for (int q = 0; q < 2; ++q) { const int n = n0 + hf * DFF + 4 * q; const f32x4 a0 = *(const f32x4*)(cw + n), a1 = *(const f32x4*)(cw + DFF2 + n), a2 = *(const f32x4*)(cw + 2 * DFF2 + n), ab = *(const f32x4*)(cb + n);
                w0[hf][2 * q] = (f32x2){a0[0], a0[1]}; w0[hf][2 * q + 1] = (f32x2){a0[2], a0[3]}; w1[hf][2 * q] = (f32x2){a1[0], a1[1]}; w1[hf][2 * q + 1] = (f32x2){a1[2], a1[3]};
                w2[hf][2 * q] = (f32x2){a2[0], a2[1]}; w2[hf][2 * q + 1] = (f32x2){a2[2], a2[3]}; bb[hf][2 * q] = (f32x2){ab[0], ab[1]}; bb[hf][2 * q + 1] = (f32x2){ab[2], ab[3]}; }
#pragma unroll
        for (int hf = 0; hf < 2; ++hf) { v2u x2 = (v2u){0u, 0u}, x1 = x2;
            if ((t0 & (SEQ - 1)) >= 2) { x2 = *(const v2u*)(AH + (size_t)(t0 - 2) * DFF2 + n0 + hf * DFF); x1 = *(const v2u*)(AH + (size_t)(t0 - 1) * DFF2 + n0 + hf * DFF); }
            p2[hf][0] = __builtin_amdgcn_cvt_pk_f32_fp8((int)x2.x, false); p2[hf][1] = __builtin_amdgcn_cvt_pk_f32_fp8((int)x2.x, true); p2[hf][2] = __builtin_amdgcn_cvt_pk_f32_fp8((int)x2.y, false); p2[hf][3] = __builtin_amdgcn_cvt_pk_f32_fp8((int)x2.y, true);
            p1[hf][0] = __builtin_amdgcn_cvt_pk_f32_fp8((int)x1.x, false); p1[hf][1] = __builtin_amdgcn_cvt_pk_f32_fp8((int)x1.x, true); p1[hf][2] = __builtin_amdgcn_cvt_pk_f32_fp8((int)x1.y, false); p1[hf][3] = __builtin_amdgcn_cvt_pk_f32_fp8((int)x1.y, true); }
        for (int tbb = t0; tbb < t0 + TB; tbb += 8) {
            v2u raw[8][2];
#pragma unroll
            for (int k = 0; k < 8; ++k)
#pragma unroll
                for (int hf = 0; hf < 2; ++hf) raw[k][hf] = *(const v2u*)(AH + (size_t)(tbb + k) * DFF2 + n0 + hf * DFF);
#pragma unroll
            for (int k = 0; k < 8; ++k) { f32x2 cu[2][4], acc[2][4];
#pragma unroll
                for (int hf = 0; hf < 2; ++hf) { cu[hf][0] = __builtin_amdgcn_cvt_pk_f32_fp8((int)raw[k][hf].x, false); cu[hf][1] = __builtin_amdgcn_cvt_pk_f32_fp8((int)raw[k][hf].x, true);
                    cu[hf][2] = __builtin_amdgcn_cvt_pk_f32_fp8((int)raw[k][hf].y, false); cu[hf][3] = __builtin_amdgcn_cvt_pk_f32_fp8((int)raw[k][hf].y, true);
#pragma unroll
                    for (int p = 0; p < 4; ++p) acc[hf][p] = __builtin_elementwise_fma(w2[hf][p], cu[hf][p], __builtin_elementwise_fma(w1[hf][p], p1[hf][p], __builtin_elementwise_fma(w0[hf][p], p2[hf][p], bb[hf][p]))); }
                f32x2 r[4];
                f32x2 d[4], gu[4];
#pragma unroll
                for (int p = 0; p < 4; ++p) { const f32x2 e = acc[0][p] * -1.4426950408889634f; d[p].x = __builtin_amdgcn_exp2f(e.x); d[p].y = __builtin_amdgcn_exp2f(e.y); gu[p] = acc[0][p] * acc[1][p]; }
#pragma unroll
                for (int p = 0; p < 4; ++p) { d[p] = d[p] + 1.0f; }
#pragma unroll
                for (int p = 0; p < 4; ++p) { f32x2 sg; sg.x = __builtin_amdgcn_rcpf(d[p].x); sg.y = __builtin_amdgcn_rcpf(d[p].y); r[p] = gu[p] * sg; }
                v2u w; w.x = pg8::pk4_fp8(r[0].x, r[0].y, r[1].x, r[1].y); w.y = pg8::pk4_fp8(r[2].x, r[2].y, r[3].x, r[3].y); *(v2u*)(HM + (size_t)(tbb + k) * DFF + n0) = w;
#pragma unroll
                for (int hf = 0; hf < 2; ++hf)
#pragma unroll
                    for (int p = 0; p < 4; ++p) { p2[hf][p] = p1[hf][p]; p1[hf][p] = cu[hf][p]; } } } }
}

__device__ __forceinline__ void p_final(const Args& a, int wg, int G) {
    const int lane = threadIdx.x & 63, wave = threadIdx.x >> 6; const float* fg = (const float*)a.in[19]; const bf16* h2 = (const bf16*)(a.ws + WS_H2BF);
    const int NW = G * NWAVES;
    for (int m = wg * NWAVES + wave; m < MTOK; m += 2 * NW) {
        v4u r[2][4]; const bool two = m + NW < MTOK;
#pragma unroll
        for (int q = 0; q < 2; ++q) { const v4u* xr = (const v4u*)(h2 + (size_t)(q && two ? m + NW : m) * DM) + lane;
#pragma unroll
            for (int j = 0; j < 4; ++j) r[q][j] = xr[64 * j]; }
#pragma unroll
        for (int q = 0; q < 2; ++q) { if (q && !two) break; const int mm = m + q * NW; float v[32]; float s = 0.f;
#pragma unroll
            for (int j = 0; j < 4; ++j)
#pragma unroll
                for (int k = 0; k < 4; ++k) { v[8 * j + 2 * k] = bflo(r[q][j][k]); v[8 * j + 2 * k + 1] = bfhi(r[q][j][k]); s += v[8 * j + 2 * k] * v[8 * j + 2 * k] + v[8 * j + 2 * k + 1] * v[8 * j + 2 * k + 1]; }
            const float rs = 1.0f / sqrtf(wave_sum(s) * (1.0f / DM) + EPS);
#pragma unroll
            for (int j = 0; j < 4; ++j) { const int c0 = 8 * (lane + 64 * j); const f32x4 ga = *(const f32x4*)(fg + c0), gb = *(const f32x4*)(fg + c0 + 4); f32x4* o = (f32x4*)(a.out + (size_t)mm * DM + c0);
                o[0] = (f32x4){v[8 * j] * rs * ga[0], v[8 * j + 1] * rs * ga[1], v[8 * j + 2] * rs * ga[2], v[8 * j + 3] * rs * ga[3]};
                o[1] = (f32x4){v[8 * j + 4] * rs * gb[0], v[8 * j + 5] * rs * gb[1], v[8 * j + 6] * rs * gb[2], v[8 * j + 7] * rs * gb[3]}; } } }
}

constexpr int NPHASE = 14;
#ifndef PROBE_DUP
#define PROBE_DUP 0
#endif
#ifndef PROBE_SEL
#define PROBE_P3 0
#define PROBE_SEL 0
#endif
#ifndef PROBE_G3
#define PROBE_G3 0
#endif
__global__ void __launch_bounds__(NTHR, 2) nsa_layer_fwd(Args a) {
    extern __shared__ __attribute__((aligned(16))) unsigned char lds_raw[];
    LAS unsigned char* lds = (LAS unsigned char*)lds_raw;
    volatile LAS unsigned* MISC = (volatile LAS unsigned*)(lds + MISC_OFF);
    const int tid = threadIdx.x, G = gridDim.x, wg = blockIdx.x;
    if (tid < 32) MISC[tid] = 0u;
    __syncthreads();
    unsigned char* ws = a.ws; unsigned* ctl = (unsigned*)(ws + WS_CTL);
    const int lo = a.ph_lo, hi = a.ph_hi;
    XcdBarrier bar; bar.bar = ctl + CW_BAR + a.li * XCD_BAR_WORDS; bar.x = 0; bar.st = MISC + 8;
    if (hi - lo > 1) bar = xcd_barrier_post(ctl + CW_BAR + a.li * XCD_BAR_WORDS, MISC + 8);
#define IN(k) (lo <= (k) && (k) < hi)
#define SEAM(k) do { if ((k) != 4 && (k) != 10 && (k) != 11 && IN(k) && IN((k) + 1)) xcd_barrier(bar); } while (0)
    bf16* XN = (bf16*)(ws + WS_XN); bf16* PROJ = (bf16*)(ws + WS_PROJ); bf16* H1B = (bf16*)(ws + WS_H1B); bf16* AH = (bf16*)(ws + WS_AH); bf16* HMID = (bf16*)(ws + WS_HMID);
    float* rowss = (float*)ctl + CW_ROWSS;

#define PH(k, ...) do { if (IN(k)) { __VA_ARGS__ if ((PROBE_DUP >> (k)) & 1) { __VA_ARGS__ } } SEAM(k); } while (0)
    PH(0, { p0_prologue(a, lds, wg, G); });
    PH(1, { { pg8::Gemm gm{XN, (const bf16*)(ws + WS_WIN), MTOK, NP1A, DM}; pg8::StaticOrder S; S.init(MTOK, NP1A, G, wg);
              pg8::EpiBf16<0, true> E{PROJ, NP1, nullptr, 0, 0, 1.f}; pg8::gemm_phase<pg8::EpiBf16<0, true>, pg8::StaticOrder, true, true>(lds, gm, S, E); }
            { pg8::Gemm gm{(const bf16*)(ws + WS_XN8), (const bf16*)(ws + WS_WIN8), MTOK, NP1 - NP1A, DM / 2}; pg8::StaticOrder S; S.init(MTOK, NP1 - NP1A, G, wg);
              pg8::EpiBf16<0, true> E{PROJ + NP1A, NP1, nullptr, NP1 - NP1A, 0, 1.0f / W8SCALE}; pg8::gemm_phase<pg8::EpiBf16<0, true>, pg8::StaticOrder, true, true, true>(lds, gm, S, E); }
            p1_gates(a, wg, G); });
    PH(2, { p2_prep(a, lds, wg, G); });
    if (IN(3) && PROBE_P3) { if (PROBE_P3 == 1) p3_cmp<1>(a, lds, wg, G); else if (PROBE_P3 == 2) p3_cmp<2>(a, lds, wg, G); else if (PROBE_P3 == 3) p3_cmp<3>(a, lds, wg, G); else p5_win(a, lds, wg, G); xcd_barrier(bar); }
    PH(3, { p3_cmp<0>(a, lds, wg, G); p5_win(a, lds, wg, G); });
    PH(4, { p4_sel<0>(a, lds, wg, G); });
    if (IN(4) && PROBE_SEL) { xcd_barrier(bar); if (PROBE_SEL == 1) p4_sel<1>(a, lds, wg, G); else p4_sel<2>(a, lds, wg, G); xcd_barrier(bar); }
    if (IN(4) && IN(6)) xcd_barrier(bar);
    PH(6, { p6_mix(a, lds, wg, G); });
    PH(7, { pg8::Gemm gm{(const bf16*)(ws + WS_QR), (const bf16*)(ws + WS_WOUT), MTOK, DM, DM / 2}; pg8::StaticOrder S; S.init(MTOK, DM, G, wg);
        pg8::EpiStream<true, true, true> E{(const float*)a.in[0], nullptr, (bf16*)(ws + WS_H1BF), (unsigned char*)H1B, rowss, DM, 1.0f / W8SCALE};
        pg8::gemm_phase<pg8::EpiStream<true, true, true>, pg8::StaticOrder, true, true, true>(lds, gm, S, E); });
    PH(8, { pg8::Gemm gm{H1B, (const bf16*)(ws + WS_WUP), MTOK, DFF2, DM / 2}; pg8::StaticOrder S; S.init(MTOK, DFF2, G, wg);
        pg8::EpiScaleT<true> E{AH, DFF2, rowss, 1.0f / DM, EPS, 1.0f / W8SCALE}; pg8::gemm_phase<pg8::EpiScaleT<true>, pg8::StaticOrder, true, true, true>(lds, gm, S, E); });
    if (IN(8) && PROBE_G3) { xcd_barrier(bar); pg8::Gemm gm{H1B, (const bf16*)(ws + WS_WUP), MTOK, DFF2, DM / 2}; pg8::StaticOrder S; S.init(MTOK, DFF2, G, wg); pg8::EpiNull E{nullptr}; pg8::gemm_phase<pg8::EpiNull, pg8::StaticOrder, true, true, true>(lds, gm, S, E); xcd_barrier(bar); }
    PH(9, { p_conv(a, wg, G); });
    PH(12, { pg8::Gemm gm{HMID, (const bf16*)(ws + WS_WDN), MTOK, DM, DFF / 2}; pg8::StaticOrder S; S.init(MTOK, DM, G, wg);
        pg8::EpiStream<false, false, false> E{nullptr, (const bf16*)(ws + WS_H1BF), (bf16*)(ws + WS_H2BF), nullptr, nullptr, DM, 1.0f / W8SCALE};
        pg8::gemm_phase<pg8::EpiStream<false, false, false>, pg8::StaticOrder, true, true, true>(lds, gm, S, E); });
    PH(13, { p_final(a, wg, G); });
#undef PH
#undef IN
#undef SEAM
}

#ifndef MK_N_LAUNCHES
#define MK_N_LAUNCHES 1
#endif
extern "C" void kernel_launch(void* const* d_in, const int* in_sizes, int n_in, void* d_out, int out_size, void* d_ws, size_t ws_size, hipStream_t stream) {
    static int grid = 0;
    if (grid == 0) {
        if (n_in != 20 || out_size != MTOK * DM || ws_size < WS_END2) { fprintf(stderr, "kernel_launch: unexpected shapes (n_in %d, out %d, ws %zu)\n", n_in, out_size, ws_size); grid = -1; return; }
        int dev = 0, cus = 0, per_cu = 0;
        if (hipGetDevice(&dev) != hipSuccess || hipDeviceGetAttribute(&cus, hipDeviceAttributeMultiprocessorCount, dev) != hipSuccess) { grid = -1; return; }
        if (hipFuncSetAttribute((const void*)nsa_layer_fwd, hipFuncAttributeMaxDynamicSharedMemorySize, LDS_BYTES) != hipSuccess) { fprintf(stderr, "kernel_launch: hipFuncSetAttribute failed\n"); grid = -1; return; }
        if (hipOccupancyMaxActiveBlocksPerMultiprocessor(&per_cu, (const void*)nsa_layer_fwd, NTHR, LDS_BYTES) != hipSuccess || per_cu < 1) { fprintf(stderr, "kernel_launch: occupancy query says %d blocks per CU\n", per_cu); }
        (void)hipGetLastError();
        grid = cus;
    }
    if (grid < 0) return;
    if (hipMemsetAsync((char*)d_ws + WS_CTL, 0, CTL_ZERO_BYTES, stream) != hipSuccess) return;
    Args a{};
    for (int i = 0; i < 20; ++i) a.in[i] = d_in[i];
    a.out = (float*)d_out; a.ws = (unsigned char*)d_ws;
    constexpr int NL = MK_N_LAUNCHES;
    for (int li = 0; li < NL; ++li) {
        a.ph_lo = (NL == NPHASE) ? li : (li * NPHASE) / NL; a.ph_hi = (NL == NPHASE) ? li + 1 : ((li + 1) * NPHASE) / NL; a.li = li; a.pad = 0;
        hipLaunchKernelGGL(nsa_layer_fwd, dim3(grid), dim3(NTHR), LDS_BYTES, stream, a);
    }
}
```

```cpp
#include <hip/hip_runtime.h>
#include <cstdio>
#include <cstdint>

namespace pg8 {
#define PG8_LAS __attribute__((address_space(3)))
typedef unsigned short bf16_t;
typedef short bf16x8 __attribute__((ext_vector_type(8)));
typedef float f32x4 __attribute__((ext_vector_type(4)));
typedef unsigned u32x4 __attribute__((ext_vector_type(4)));
constexpr int BM = 256, BK = 64, HALF = 128, HTB = HALF * BK * 2  , STAGE_BYTES = 8 * HTB, NXCD = 8, WGM = 8;

__host__ __device__ __forceinline__ int lds_byte(int r, int c) { const int st = (r >> 4) * 2 + (c >> 5), rr = r & 15, cc = c & 31, ob = rr * 64 + cc * 2; return st * 1024 + (ob ^ (((ob >> 9) & 1) << 5)); }
__host__ __device__ __forceinline__ void stage_rc(int b, int& R, int& C) { const int st = b / 1024, sb = b % 1024, swz = sb ^ (((sb >> 9) & 1) << 5); R = (st >> 1) * 16 + swz / 64; C = (st & 1) * 32 + (swz % 64) / 2; }
__host__ __device__ __forceinline__ int perm32(int rho) { const int n = rho >> 4, i = rho & 15; return 8 * (i >> 2) + 4 * n + (i & 3); }

struct Unit { int pm, pn; };
struct Gemm { const bf16_t* A; const bf16_t* Bt; int M, N, K; };

struct StaticOrder {
    int nM, nN, nwg, G, c;
    __host__ __device__ void init(int M, int N, int G_, int c_) { nM = M / BM; nN = N / BM; nwg = nM * nN; G = G_; c = c_; }
    __host__ __device__ bool next(int i, Unit& u) const {
        const long L = (long)i * G + c; if (L >= nwg) return false;
        int wgid = (int)L; { const int q = nwg / NXCD, r = nwg % NXCD, xcd = wgid % NXCD, off = wgid / NXCD; wgid = (xcd < r ? xcd * (q + 1) : r * (q + 1) + (xcd - r) * q) + off; }
        const int nig = WGM * nN, gid = wgid / nig, fm = gid * WGM, gsz = (nM - fm) < WGM ? (nM - fm) : WGM;
        u.pm = fm + ((wgid % nig) % gsz); u.pn = (wgid % nig) / gsz; return true;
    }
    __device__ __forceinline__ void a_ready(const Unit&) const {}
    __device__ __forceinline__ void done(const Unit&) const {}
};

__device__ __forceinline__ unsigned cvt_pk_bf16(float lo, float hi) { unsigned r; asm volatile("v_cvt_pk_bf16_f32 %0, %1, %2" : "=v"(r) : "v"(lo), "v"(hi)); return r; }
typedef float f32x2 __attribute__((ext_vector_type(2)));
__device__ __forceinline__ f32x2 gelu_pk(f32x2 v) {
    const f32x2 av = __builtin_elementwise_abs(v), d = av * 0.2316418882f + 1.0f;
    f32x2 t; t.x = __builtin_amdgcn_rcpf(d.x); t.y = __builtin_amdgcn_rcpf(d.y);
    f32x2 q = t * 0.5307027145f + (-0.7265760135f); q = q * t + 0.7107068705f; q = q * t + (-0.142248368f); q = q * t + 0.127414796f; q = q * t;
    const f32x2 s = (v * v) * (-0.72134752044f);
    f32x2 e; e.x = __builtin_amdgcn_exp2f(s.x); e.y = __builtin_amdgcn_exp2f(s.y);
    const f32x2 m = v * (q * e), r = v - m;
    f32x2 o; o.x = v.x < 0.f ? m.x : r.x; o.y = v.y < 0.f ? m.y : r.y; return o;
}

template <int ACT  , bool BJ = false  > struct EpiBf16 {
    static constexpr bool PERM = true, AFTER_DRAIN = false; static constexpr bool BJ16 = BJ; static_assert(ACT == 0 || ACT == 1, "EpiBf16: ACT is 0 (none) or 1 (gelu_pk)");
    bf16_t* O; int ldc; const float* bias; int split_cols; size_t split_stride; float scale0;
    __device__ __forceinline__ void operator()(const f32x4 (&acc)[2][2][4][2], const Unit& u, int wr, int wc, int fr, int fq) const {
        const int row0 = u.pm * BM + wr * 64 + fr; int colt = u.pn * BM; bf16_t* base = O;
        float sc = 1.f; if (split_cols) { const int t = colt / split_cols; base += (size_t)t * split_stride; colt -= t * split_cols; if (t == 0) sc = scale0; }
        const int lc0 = BJ ? wc * 64 + 16 * fq : wc * 32 + 8 * fq, col0 = colt + lc0, bcol0 = u.pn * BM + lc0; constexpr int BJS = BJ ? 8 : HALF;
        f32x4 bv[2][2];
#pragma unroll
        for (int bj = 0; bj < 2; ++bj)
#pragma unroll
            for (int n = 0; n < 2; ++n) bv[bj][n] = bias ? *(const f32x4*)(bias + bcol0 + bj * BJS + 4 * n) : (f32x4){0.f, 0.f, 0.f, 0.f};
#pragma unroll
        for (int ai = 0; ai < 2; ++ai)
#pragma unroll
            for (int m = 0; m < 4; ++m) { bf16_t* rowp = base + (size_t)(row0 + ai * HALF + m * 16) * ldc + col0;
#pragma unroll
                for (int bj = 0; bj < 2; ++bj) { f32x4 v0 = acc[ai][bj][m][0] + bv[bj][0], v1 = acc[ai][bj][m][1] + bv[bj][1];
                    if (ACT == 1) { f32x2 a = gelu_pk((f32x2){v0[0], v0[1]}), b = gelu_pk((f32x2){v0[2], v0[3]}), c = gelu_pk((f32x2){v1[0], v1[1]}), d = gelu_pk((f32x2){v1[2], v1[3]});
                        v0 = (f32x4){a.x, a.y, b.x, b.y}; v1 = (f32x4){c.x, c.y, d.x, d.y}; }
                    v0 = v0 * sc; v1 = v1 * sc; u32x4 w; w.x = cvt_pk_bf16(v0[0], v0[1]); w.y = cvt_pk_bf16(v0[2], v0[3]); w.z = cvt_pk_bf16(v1[0], v1[1]); w.w = cvt_pk_bf16(v1[2], v1[3]);
                    *(u32x4*)(rowp + bj * BJS) = w; } }
    }
};

typedef int v8i32 __attribute__((ext_vector_type(8)));
typedef int v4i32 __attribute__((ext_vector_type(4)));
__device__ __forceinline__ v8i32 cat8(bf16x8 lo, bf16x8 hi) { const v4i32 a = __builtin_bit_cast(v4i32, lo), b = __builtin_bit_cast(v4i32, hi); return __builtin_shufflevector(a, b, 0, 1, 2, 3, 4, 5, 6, 7); }
__device__ __forceinline__ unsigned pk4_fp8(float a, float b, float c, float d) { int p = 0; p = __builtin_amdgcn_cvt_pk_fp8_f32(a, b, p, false); p = __builtin_amdgcn_cvt_pk_fp8_f32(c, d, p, true); return (unsigned)p; }
template <class Epi, class Sched, bool ALIGN_EPI = false, bool SP2 = false, bool FP8 = false>
__device__ __forceinline__ void gemm_phase(PG8_LAS unsigned char* lds, const Gemm g, const Sched& S, const Epi& E) {
    const int tid = threadIdx.x, wid = __builtin_amdgcn_readfirstlane(tid >> 6), lane = tid & 63, wr = wid >> 2, wc = wid & 3, fr = lane & 15, fq = lane >> 4;
    const int K = g.K, nt = K / BK;
    unsigned voffA[2], voffB[2];
#pragma unroll
    for (int i = 0; i < 2; ++i) { int R, C; stage_rc(tid * 16 + i * 8192, R, C); const int Rp = Epi::PERM ? ((R & ~31) + perm32(R & 31)) : R, Rb = Epi::BJ16 ? (16 * (Rp >> 3) + (Rp & 7)) : Rp;
        voffA[i] = (unsigned)(R * K + C) * 2u; voffB[i] = (unsigned)(Rb * K + C) * 2u; }
    const size_t kstep = (size_t)(BK * 2);
    const size_t hstep = (size_t)HALF * K * 2;
    const size_t hstepB = Epi::BJ16 ? (size_t)8 * K * 2 : hstep;
    const size_t tstep = 2 * hstep;
    const unsigned ldsw = (unsigned)wid * 1024u;
    const int aoff = lds_byte(wr * 64 + fr, fq * 8), boff = lds_byte(wc * 32 + fr, fq * 8);
    constexpr int akd = 1024, bkd = 1024;
#define PG8_SA(b, h) (((b) * 2 + (h)) * HTB)
#define PG8_SB(b, h) ((4 + (b) * 2 + (h)) * HTB)
#define PG8_STAGE(bufoff, gbase, voff) do { _Pragma("unroll") for (int _i = 0; _i < 2; ++_i) \
        __builtin_amdgcn_global_load_lds((const unsigned*)((const char*)(gbase) + (voff)[_i]), (PG8_LAS unsigned*)(lds + (bufoff) + ldsw + _i * 8192), 16, 0, 0); } while (0)
#define PG8_LDA(dst, b, h) do { if constexpr (FP8) { _Pragma("unroll") for (int m = 0; m < 4; ++m) dst##8[m] = cat8(*(const PG8_LAS bf16x8*)(lds + PG8_SA(b, h) + aoff + m * 2048), *(const PG8_LAS bf16x8*)(lds + PG8_SA(b, h) + aoff + m * 2048 + akd)); } \
    else { _Pragma("unroll") for (int m = 0; m < 4; ++m) _Pragma("unroll") for (int k = 0; k < 2; ++k) dst[m][k] = *(const PG8_LAS bf16x8*)(lds + PG8_SA(b, h) + aoff + m * 2048 + k * 1024); } } while (0)
#define PG8_LDB(dst, b, h) do { if constexpr (FP8) { _Pragma("unroll") for (int n = 0; n < 2; ++n) dst##8[n] = cat8(*(const PG8_LAS bf16x8*)(lds + PG8_SB(b, h) + boff + n * 2048), *(const PG8_LAS bf16x8*)(lds + PG8_SB(b, h) + boff + n * 2048 + bkd)); } \
    else { _Pragma("unroll") for (int n = 0; n < 2; ++n) _Pragma("unroll") for (int k = 0; k < 2; ++k) dst[n][k] = *(const PG8_LAS bf16x8*)(lds + PG8_SB(b, h) + boff + n * 2048 + k * 1024); } } while (0)
#define PG8_MMA(ai, bj, At, Bt) do { __builtin_amdgcn_s_setprio(1); _Pragma("unroll") for (int m = 0; m < 4; ++m) _Pragma("unroll") for (int n = 0; n < 2; ++n) { \
        if constexpr (FP8) { asm volatile("v_mfma_scale_f32_16x16x128_f8f6f4 %0, %1, %2, %0, %3, %3 op_sel_hi:[0,0,0]" : "+v"(acc[ai][bj][m][n]) : "v"(Bt##8[n]), "v"(At##8[m]), "v"(0x7f7f7f7f)); }   \
        else { _Pragma("unroll") for (int k = 0; k < 2; ++k) acc[ai][bj][m][n] = __builtin_amdgcn_mfma_f32_16x16x32_bf16(Bt[n][k], At[m][k], acc[ai][bj][m][n], 0, 0, 0); } } __builtin_amdgcn_s_setprio(0); } while (0)
#define PG8_WAIT_V(n) asm volatile("s_waitcnt vmcnt(" #n ")" ::: "memory")
#define PG8_WAIT_L(n) asm volatile("s_waitcnt lgkmcnt(" #n ")" ::: "memory")
#define PG8_BAR __builtin_amdgcn_s_barrier()
#define PG8_SCHED __builtin_amdgcn_sched_barrier(0)
    Unit cur, nxt; int ui = 0;
    if (!S.next(0, cur)) return;
    f32x4 acc[2][2][4][2];
#pragma unroll
    for (int a = 0; a < 2; ++a)
#pragma unroll
        for (int b = 0; b < 2; ++b)
#pragma unroll
            for (int m = 0; m < 4; ++m)
#pragma unroll
                for (int n = 0; n < 2; ++n) acc[a][b][m][n] = (f32x4){0.f, 0.f, 0.f, 0.f};
    bf16x8 At[4][2], B0[2][2], B1[2][2]; v8i32 At8[4], B08[2], B18[2];
    const char* cA = (const char*)g.A + (size_t)cur.pm * tstep; const char* cB = (const char*)g.Bt + (size_t)cur.pn * tstep;
    S.a_ready(cur);
    if constexpr (SP2) {
        PG8_STAGE(PG8_SB(0, 0), cB, voffB); PG8_STAGE(PG8_SB(0, 1), cB + hstepB, voffB); PG8_STAGE(PG8_SA(0, 0), cA, voffA); PG8_STAGE(PG8_SA(0, 1), cA + hstep, voffA);
        if (wr == 1) PG8_BAR;
        PG8_WAIT_V(2); PG8_BAR;
        PG8_STAGE(PG8_SB(1, 0), cB + kstep, voffB); PG8_STAGE(PG8_SA(1, 0), cA + kstep, voffA); PG8_STAGE(PG8_SB(1, 1), cB + hstepB + kstep, voffB);
        PG8_WAIT_V(6); PG8_BAR;
    } else {
        PG8_STAGE(PG8_SB(0, 0), cB, voffB); PG8_STAGE(PG8_SA(0, 0), cA, voffA); PG8_STAGE(PG8_SB(0, 1), cB + hstepB, voffB); PG8_STAGE(PG8_SA(0, 1), cA + hstep, voffA);
        if (wr == 1) PG8_BAR;
        PG8_WAIT_V(4); PG8_BAR;
        PG8_STAGE(PG8_SB(1, 0), cB + kstep, voffB); PG8_STAGE(PG8_SA(1, 0), cA + kstep, voffA); PG8_STAGE(PG8_SB(1, 1), cB + hstepB + kstep, voffB);
        PG8_WAIT_V(6); PG8_BAR;
    }
    for (;;) {
        const bool has_next = S.next(ui + 1, nxt);
        const char* nA = has_next ? (const char*)g.A + (size_t)nxt.pm * tstep : cA; const char* nB = has_next ? (const char*)g.Bt + (size_t)nxt.pn * tstep : cB;
        for (int t = 0; t < nt; t += 2) {
            const bool last = (t == nt - 2);
            const char* a1 = cA + (size_t)(t + 1) * kstep;
            const char* a2 = last ? nA : cA + (size_t)(t + 2) * kstep; const char* b2 = last ? nB : cB + (size_t)(t + 2) * kstep;
            const char* a3 = a2 + kstep; const char* b3 = b2 + kstep;
            if (last && has_next) S.a_ready(nxt);
            if constexpr (SP2) {
            PG8_LDB(B0, 0, 0); PG8_LDB(B1, 0, 1); PG8_SCHED; PG8_LDA(At, 0, 0); PG8_STAGE(PG8_SA(1, 1), a1 + hstep, voffA);
            PG8_WAIT_V(8); PG8_WAIT_L(0); PG8_BAR; PG8_MMA(0, 0, At, B0); PG8_MMA(0, 1, At, B1); PG8_BAR; PG8_SCHED;
            PG8_LDA(At, 0, 1); PG8_STAGE(PG8_SB(0, 0), b2, voffB); PG8_STAGE(PG8_SB(0, 1), b2 + hstepB, voffB); PG8_STAGE(PG8_SA(0, 0), a2, voffA);
            PG8_WAIT_V(8); PG8_WAIT_L(0); PG8_BAR; PG8_MMA(1, 0, At, B0); PG8_MMA(1, 1, At, B1); PG8_BAR; PG8_SCHED;
            PG8_LDB(B0, 1, 0); PG8_LDB(B1, 1, 1); PG8_SCHED; PG8_LDA(At, 1, 0); PG8_STAGE(PG8_SA(0, 1), a2 + hstep, voffA);
            PG8_WAIT_V(8); PG8_WAIT_L(0); PG8_BAR; PG8_MMA(0, 0, At, B0); PG8_MMA(0, 1, At, B1); PG8_BAR; PG8_SCHED;
            PG8_LDA(At, 1, 1); PG8_STAGE(PG8_SB(1, 0), b3, voffB); PG8_STAGE(PG8_SB(1, 1), b3 + hstepB, voffB); PG8_STAGE(PG8_SA(1, 0), a3, voffA);
            PG8_WAIT_V(8); PG8_WAIT_L(0); PG8_BAR; PG8_MMA(1, 0, At, B0); PG8_MMA(1, 1, At, B1); PG8_BAR; PG8_SCHED;
            } else {
            PG8_LDB(B0, 0, 0); PG8_SCHED; PG8_LDA(At, 0, 0); PG8_STAGE(PG8_SA(1, 1), a1 + hstep, voffA);
            PG8_WAIT_L(8); PG8_BAR; PG8_WAIT_L(0); PG8_MMA(0, 0, At, B0); PG8_BAR; PG8_SCHED;
            PG8_LDB(B1, 0, 1); PG8_STAGE(PG8_SB(0, 0), b2, voffB);
            PG8_BAR; PG8_WAIT_L(0); PG8_MMA(0, 1, At, B1); PG8_BAR;
            PG8_LDA(At, 0, 1); PG8_STAGE(PG8_SA(0, 0), a2, voffA);
            PG8_BAR; PG8_WAIT_L(0); PG8_MMA(1, 0, At, B0); PG8_BAR; PG8_SCHED;
            PG8_STAGE(PG8_SB(0, 1), b2 + hstepB, voffB);
            PG8_WAIT_V(6); PG8_BAR; PG8_MMA(1, 1, At, B1); PG8_BAR;
            PG8_LDB(B0, 1, 0); PG8_SCHED; PG8_LDA(At, 1, 0); PG8_STAGE(PG8_SA(0, 1), a2 + hstep, voffA);
            PG8_WAIT_L(8); PG8_BAR; PG8_WAIT_L(0); PG8_MMA(0, 0, At, B0); PG8_BAR; PG8_SCHED;
            PG8_LDB(B1, 1, 1); PG8_STAGE(PG8_SB(1, 0), b3, voffB);
            PG8_BAR; PG8_WAIT_L(0); PG8_MMA(0, 1, At, B1); PG8_BAR;
            PG8_LDA(At, 1, 1); PG8_STAGE(PG8_SA(1, 0), a3, voffA);
            PG8_BAR; PG8_WAIT_L(0); PG8_MMA(1, 0, At, B0); PG8_BAR; PG8_SCHED;
            PG8_STAGE(PG8_SB(1, 1), b3 + hstepB, voffB);
            PG8_WAIT_V(6); PG8_BAR; PG8_MMA(1, 1, At, B1); PG8_BAR;
            }
        }
        if constexpr (ALIGN_EPI) { if (wr == 0) PG8_BAR; }
        if constexpr (FP8) asm volatile("s_nop 15\n\ts_nop 15" ::: "memory");
        if constexpr (!Epi::AFTER_DRAIN) { E(acc, cur, wr, wc, fr, fq); S.done(cur); }
        if (!has_next) break;
#pragma unroll
        for (int a = 0; a < 2; ++a)
#pragma unroll
            for (int b = 0; b < 2; ++b)
#pragma unroll
                for (int m = 0; m < 4; ++m)
#pragma unroll
                    for (int n = 0; n < 2; ++n) acc[a][b][m][n] = (f32x4){0.f, 0.f, 0.f, 0.f};
        cur = nxt; cA = nA; cB = nB; ++ui;
        if constexpr (ALIGN_EPI) { if (wr == 1) PG8_BAR; }
    }
    PG8_WAIT_V(0);
    if constexpr (!ALIGN_EPI) { if (wr == 0) PG8_BAR; }
    PG8_BAR;
    if constexpr (Epi::AFTER_DRAIN) { E.fused(acc, cur, wr, wc, fr, fq, lds, wid, lane); S.done(cur); }
#undef PG8_SA
#undef PG8_SB
#undef PG8_STAGE
#undef PG8_LDA
#undef PG8_LDB
#undef PG8_MMA
#undef PG8_WAIT_V
#undef PG8_WAIT_L
#undef PG8_BAR
#undef PG8_SCHED
}
}

namespace pg8 {
typedef unsigned u32x2 __attribute__((ext_vector_type(2)));
template <int BF  , bool SS> struct EpiResid {
    static constexpr bool PERM = false, AFTER_DRAIN = false; static constexpr bool BJ16 = false;
    const float* res; float* out; bf16_t* ob; float* rowss; int ld; float ascale;
    __device__ __forceinline__ void operator()(const f32x4 (&acc)[2][2][4][2], const Unit& u, int wr, int wc, int fr, int fq) const {
        const int row0 = u.pm * BM + wr * 64 + fr, col0 = u.pn * BM + wc * 32 + 4 * fq;
#pragma unroll
        for (int ai = 0; ai < 2; ++ai)
#pragma unroll
            for (int m = 0; m < 4; ++m) { const int row = row0 + ai * HALF + m * 16; const size_t ro = (size_t)row * ld + col0; float ss = 0.f;
#pragma unroll
                for (int bj = 0; bj < 2; ++bj)
#pragma unroll
                    for (int n = 0; n < 2; ++n) { const size_t o = ro + bj * HALF + n * 16; const f32x4 r4 = *(const f32x4*)(res + o); const f32x4 v = acc[ai][bj][m][n] * ascale + r4;
                        *(f32x4*)(out + o) = v;
                        if (BF == 1) { u32x2 w; w.x = cvt_pk_bf16(v[0], v[1]); w.y = cvt_pk_bf16(v[2], v[3]); *(u32x2*)(ob + o) = w; }
                        if (BF == 2) { *(unsigned*)((unsigned char*)ob + o) = pk4_fp8(v[0], v[1], v[2], v[3]); }
                        if (SS) ss += (v[0] * v[0] + v[1] * v[1]) + (v[2] * v[2] + v[3] * v[3]); }
                if (SS) { ss += __shfl_xor(ss, 16); ss += __shfl_xor(ss, 32); if (fq == 0) atomicAdd(rowss + row, ss); } }
    }
};
struct EpiNull { static constexpr bool PERM = true, AFTER_DRAIN = false; static constexpr bool BJ16 = false; float* O;
    __device__ __forceinline__ void operator()(const f32x4 (&acc)[2][2][4][2], const Unit& u, int wr, int wc, int fr, int fq) const {
#pragma unroll
      for (int a = 0; a < 2; ++a)
#pragma unroll
        for (int b = 0; b < 2; ++b)
#pragma unroll
          for (int m = 0; m < 4; ++m)
#pragma unroll
            for (int n = 0; n < 2; ++n) asm volatile("" :: "v"(acc[a][b][m][n])); } };
template <bool RES_F32, bool F8, bool SS> struct EpiStream {
    static constexpr bool PERM = true, AFTER_DRAIN = false; static constexpr bool BJ16 = true;
    const float* resf; const bf16_t* resb; bf16_t* ob; unsigned char* o8; float* rowss; int ld; float ascale;
    __device__ __forceinline__ void operator()(const f32x4 (&acc)[2][2][4][2], const Unit& u, int wr, int wc, int fr, int fq) const {
        const int row0 = u.pm * BM + wr * 64 + fr, col0 = u.pn * BM + wc * 64 + 16 * fq;
#pragma unroll
        for (int ai = 0; ai < 2; ++ai)
#pragma unroll
            for (int m = 0; m < 4; ++m) { const int row = row0 + ai * HALF + m * 16; const size_t ro = (size_t)row * ld + col0; float ss = 0.f; f32x4 r4[4];
                if (RES_F32) {
#pragma unroll
                    for (int q = 0; q < 4; ++q) r4[q] = *(const f32x4*)(resf + ro + 4 * q); }
                else { const u32x4 ra = *(const u32x4*)(resb + ro), rb = *(const u32x4*)(resb + ro + 8); const unsigned rw[8] = {ra.x, ra.y, ra.z, ra.w, rb.x, rb.y, rb.z, rb.w};
#pragma unroll
                    for (int q = 0; q < 4; ++q) r4[q] = (f32x4){__builtin_bit_cast(float, rw[2 * q] << 16), __builtin_bit_cast(float, rw[2 * q] & 0xffff0000u), __builtin_bit_cast(float, rw[2 * q + 1] << 16), __builtin_bit_cast(float, rw[2 * q + 1] & 0xffff0000u)}; }
                f32x4 v[4];
#pragma unroll
                for (int q = 0; q < 4; ++q) { v[q] = acc[ai][q >> 1][m][q & 1] * ascale + r4[q]; if (SS) ss += (v[q][0] * v[q][0] + v[q][1] * v[q][1]) + (v[q][2] * v[q][2] + v[q][3] * v[q][3]); }
                u32x4 wa, wb; wa.x = cvt_pk_bf16(v[0][0], v[0][1]); wa.y = cvt_pk_bf16(v[0][2], v[0][3]); wa.z = cvt_pk_bf16(v[1][0], v[1][1]); wa.w = cvt_pk_bf16(v[1][2], v[1][3]);
                wb.x = cvt_pk_bf16(v[2][0], v[2][1]); wb.y = cvt_pk_bf16(v[2][2], v[2][3]); wb.z = cvt_pk_bf16(v[3][0], v[3][1]); wb.w = cvt_pk_bf16(v[3][2], v[3][3]);
                *(u32x4*)(ob + ro) = wa; *(u32x4*)(ob + ro + 8) = wb;
                if (F8) { u32x4 w8; w8.x = pk4_fp8(v[0][0], v[0][1], v[0][2], v[0][3]); w8.y = pk4_fp8(v[1][0], v[1][1], v[1][2], v[1][3]); w8.z = pk4_fp8(v[2][0], v[2][1], v[2][2], v[2][3]); w8.w = pk4_fp8(v[3][0], v[3][1], v[3][2], v[3][3]); *(u32x4*)(o8 + ro) = w8; }
                if (SS) { ss += __shfl_xor(ss, 16); ss += __shfl_xor(ss, 32); if (fq == 0) atomicAdd(rowss + row, ss); } }
    }
};
template <bool F8OUT> struct EpiScaleT {
    static constexpr bool PERM = true, AFTER_DRAIN = false; static constexpr bool BJ16 = F8OUT;
    bf16_t* O; int ldc; const float* rowss; float inv_n, eps, oscale;
    __device__ __forceinline__ void operator()(const f32x4 (&acc)[2][2][4][2], const Unit& u, int wr, int wc, int fr, int fq) const {
        const int row0 = u.pm * BM + wr * 64 + fr, col0 = u.pn * BM + wc * 32 + 8 * fq;
#pragma unroll
        for (int ai = 0; ai < 2; ++ai)
#pragma unroll
            for (int m = 0; m < 4; ++m) { const int row = row0 + ai * HALF + m * 16; const float rs = __builtin_amdgcn_rsqf(rowss[row] * inv_n + eps) * oscale;
                bf16_t* rowp = O + (size_t)row * ldc + col0;
                if (F8OUT) { const f32x4 v0 = acc[ai][0][m][0] * rs, v1 = acc[ai][0][m][1] * rs, v2 = acc[ai][1][m][0] * rs, v3 = acc[ai][1][m][1] * rs; u32x4 w;
                    w.x = pk4_fp8(v0[0], v0[1], v0[2], v0[3]); w.y = pk4_fp8(v1[0], v1[1], v1[2], v1[3]); w.z = pk4_fp8(v2[0], v2[1], v2[2], v2[3]); w.w = pk4_fp8(v3[0], v3[1], v3[2], v3[3]);
                    *(u32x4*)((unsigned char*)O + (size_t)row * ldc + u.pn * BM + wc * 64 + 16 * fq) = w; }
                else
#pragma unroll
                for (int bj = 0; bj < 2; ++bj) { const f32x4 v0 = acc[ai][bj][m][0] * rs, v1 = acc[ai][bj][m][1] * rs;
                    if (F8OUT) { }
                    else { u32x4 w; w.x = cvt_pk_bf16(v0[0], v0[1]); w.y = cvt_pk_bf16(v0[2], v0[3]); w.z = cvt_pk_bf16(v1[0], v1[1]); w.w = cvt_pk_bf16(v1[2], v1[3]);
                        *(u32x4*)(rowp + bj * HALF) = w; } } }
    }
};
typedef EpiScaleT<false> EpiScaleBf16;
}

constexpr int BATCH = 2, SEQ = 16384, DM = 2048, MTOK = BATCH * SEQ;
constexpr int DIN = 4632, NP1 = 4608;
constexpr int NP1A = 1536;
constexpr int HD = 128, NH = 8;
constexpr int COL_KCMP = 1024, COL_VCMP = 1280, COL_KSEL = 1536, COL_VSEL = 1792, COL_KWIN = 2048, COL_VWIN = 2304, WCOL_GATE = 2560  , COL_U = 2560, COL_V = 3584;
constexpr int DFF = 5632, DFF2 = 11264;
constexpr float EPS = 1e-6f;
constexpr float W8SCALE = 64.0f;
constexpr float C2 = 0.08838834764831845f * 1.4426950408889634f;
constexpr int NWAVES = 8, NTHR = 512;

constexpr size_t MiB = 1u << 20;
constexpr size_t WS_CTL = 0, CTL_ZERO_BYTES = 1 * MiB;
constexpr size_t WS_WIN = 1 * MiB, WS_WOUT = 20 * MiB, WS_WUP = 28 * MiB, WS_WDN = 72 * MiB, WS_WCK = 94 * MiB, WS_WCV = 95 * MiB, WS_WM = 96 * MiB;
constexpr size_t WS_COS = 97 * MiB, WS_SIN = 105 * MiB, WS_KC = 113 * MiB, WS_VCT = 114 * MiB, WS_KSEL = 115 * MiB, WS_KWIN = 131 * MiB, WS_VSELT = 147 * MiB, WS_VWINT = 163 * MiB;
constexpr size_t WS_TMASK = 179 * MiB, WS_H1B = 181 * MiB;
constexpr size_t WS_Q8 = 309 * MiB  ;
constexpr size_t WS_XN = 309 * MiB  , WS_QR = 373 * MiB  , WS_PROJ = 437 * MiB, WS_OC = 741 * MiB, WS_OS = 805 * MiB, WS_OW = 869 * MiB;
constexpr size_t WS_AH = 309 * MiB  , WS_HMID = 661 * MiB, WS_END = 1013 * MiB;
constexpr size_t WS_H1BF = 837 * MiB  , WS_H2BF = 309 * MiB  ;
constexpr size_t WS_WIN8 = 9 * MiB  , WS_XN8 = 741 * MiB  ;
constexpr size_t WS_WG = 96 * MiB + 512 * 1024  , WS_GATES = 1013 * MiB  , WS_END2 = 1015 * MiB;
static_assert(WS_PROJ + (size_t)MTOK * NP1 * 2 <= WS_OC && WS_AH + (size_t)MTOK * DFF2 <= WS_HMID && WS_HMID + (size_t)MTOK * DFF <= WS_END, "ws map");
constexpr int CW_BAR = 4096;
constexpr int CW_CCONST = 65536;
constexpr int CW_ROWSS = 131072;
static_assert(CW_BAR + 16 * 3456 <= CW_CCONST && (CW_ROWSS + MTOK) * 4 <= (int)CTL_ZERO_BYTES, "ctl map");
constexpr int LDS_BYTES = 147456;
constexpr int MISC_OFF = LDS_BYTES - 256;

#define GAS __attribute__((address_space(1)))
#define LAS __attribute__((address_space(3)))
typedef unsigned short bf16;
typedef unsigned v4u __attribute__((ext_vector_type(4)));
typedef unsigned v2u __attribute__((ext_vector_type(2)));
typedef float f32x4 __attribute__((ext_vector_type(4)));
typedef short bf16x8 __attribute__((ext_vector_type(8)));
__device__ __forceinline__ float bf2f(unsigned v) { return __builtin_bit_cast(float, v << 16); }
__device__ __forceinline__ float bflo(unsigned w) { return __builtin_bit_cast(float, w << 16); }
__device__ __forceinline__ float bfhi(unsigned w) { return __builtin_bit_cast(float, w & 0xffff0000u); }
__device__ __forceinline__ unsigned pk2(float lo, float hi) { return pg8::cvt_pk_bf16(lo, hi); }
__device__ __forceinline__ unsigned f2bf(float f) { return pg8::cvt_pk_bf16(f, 0.f) & 0xffffu; }
__device__ __forceinline__ float wave_sum(float v) {
#pragma unroll
    for (int o = 1; o < 64; o <<= 1) v += __shfl_xor(v, o);
    return v;
}
__device__ __forceinline__ float gelu_exact(float x) { return 0.5f * x * (1.0f + erff(x * 0.70710678118654752f)); }
__device__ __forceinline__ float sigmoidf(float x) { return __builtin_amdgcn_rcpf(1.0f + __builtin_amdgcn_exp2f(x * -1.4426950408889634f)); }
__device__ __forceinline__ f32x4 mfma16(bf16x8 a, bf16x8 b, f32x4 c) { return __builtin_amdgcn_mfma_f32_16x16x32_bf16(a, b, c, 0, 0, 0); }
__device__ __forceinline__ bf16x8 pack8(f32x4 a, f32x4 b) { v4u w; w.x = pk2(a[0], a[1]); w.y = pk2(a[2], a[3]); w.z = pk2(b[0], b[1]); w.w = pk2(b[2], b[3]); return __builtin_bit_cast(bf16x8, w); }
__device__ __forceinline__ int kpos_of(int k) { return (k & 32) | (((k >> 2) & 3) << 3) | (((k >> 4) & 1) << 2) | (k & 3); }


#define XB_TMO      128
#define XB_XCNT(j)  (256  + 64 * (j))
#define XB_XSUB(j)  (1280 + 64 * (j))
#define XB_XGEN(j)  (2304 + 64 * (j))
#define XB_TOP      3328
#define XB_TOPGEN   3392
#define XCD_BAR_WORDS 3456
#define XB_SPIN_CAP (1u << 18)

__device__ __forceinline__ unsigned xb_ld(unsigned* p)              { return __hip_atomic_load(p, __ATOMIC_RELAXED, __HIP_MEMORY_SCOPE_AGENT); }
__device__ __forceinline__ unsigned xb_add(unsigned* p, unsigned v) { return __hip_atomic_fetch_add(p, v, __ATOMIC_RELAXED, __HIP_MEMORY_SCOPE_AGENT); }
__device__ __forceinline__ unsigned xb_xcc_id() { return (unsigned)__builtin_amdgcn_s_getreg((3 << 11) | 20) & 0xFu; }
#define XB_SPIN(cond, bar) do { unsigned _sp = 0; while (cond) { __builtin_amdgcn_s_sleep(1); \
    if ((++_sp & 255u) == 0u) { if (xb_ld(&(bar)[XB_TMO])) break; if (_sp > XB_SPIN_CAP) { atomicAdd(&(bar)[XB_TMO], 1u); break; } } } } while (0)

struct XcdBarrier {
    unsigned* bar; unsigned x;
    volatile LAS unsigned* st;
};

__device__ __forceinline__ XcdBarrier xcd_barrier_post(unsigned* bar, volatile LAS unsigned* st) {
    XcdBarrier b; b.bar = bar; b.x = xb_xcc_id(); b.st = st;
    if (threadIdx.x == 0) (void)xb_add(&bar[XB_XCNT(b.x)], 1u);
    return b;
}
__device__ __forceinline__ void xcd_barrier_complete(unsigned* bar, unsigned x, unsigned& nloc, unsigned& nx) {
    const unsigned G = gridDim.x * gridDim.y * gridDim.z;
    unsigned sum, cnt, mine, sp = 0u;
    for (;;) {
        sum = 0u; cnt = 0u; mine = 0u;
#pragma unroll
        for (unsigned j = 0; j < 16; ++j) { const unsigned c = xb_ld(&bar[XB_XCNT(j)]); sum += c; cnt += (c > 0u) ? 1u : 0u; mine = (j == x) ? c : mine; }
        if (sum == G) break;
        __builtin_amdgcn_s_sleep(1);
        if ((++sp & 255u) == 0u) { if (xb_ld(&bar[XB_TMO])) break; if (sp > XB_SPIN_CAP) { atomicAdd(&bar[XB_TMO], 1u); break; } }
    }
    nloc = mine > 0u ? mine : 1u; nx = cnt > 0u ? cnt : 1u;
}

__device__ __forceinline__ void xcd_barrier(const XcdBarrier& b) {
    asm volatile("s_waitcnt vmcnt(0)" ::: "memory");
    __syncthreads();
    if (threadIdx.x == 0) {
        unsigned* bar = b.bar;
        __builtin_amdgcn_s_waitcnt(0);
        unsigned nloc = b.st[0], nx = b.st[1];
        if (nloc == 0u) { xcd_barrier_complete(bar, b.x, nloc, nx); b.st[0] = nloc; b.st[1] = nx; }
        const unsigned old = xb_add(&bar[XB_XSUB(b.x)], 1u);
        const unsigned gen = old / nloc;
        if (old + 1u == (gen + 1u) * nloc) {
            __builtin_amdgcn_fence(__ATOMIC_RELEASE, "agent");
            asm volatile("s_waitcnt vmcnt(0)" ::: "memory");
            const unsigned og = xb_add(&bar[XB_TOP], 1u);
            const unsigned tg = og / nx;
            if (og + 1u == (tg + 1u) * nx) xb_add(&bar[XB_TOPGEN], 1u);
            else XB_SPIN(xb_ld(&bar[XB_TOPGEN]) == tg, bar);
            __builtin_amdgcn_fence(__ATOMIC_ACQUIRE, "agent");
            xb_add(&bar[XB_XGEN(b.x)], 1u);
            asm volatile("s_waitcnt vmcnt(0)" ::: "memory");
        } else {
            XB_SPIN(xb_ld(&bar[XB_XGEN(b.x)]) == gen, bar);
            __builtin_amdgcn_fence(__ATOMIC_ACQUIRE, "agent");
            asm volatile("s_waitcnt vmcnt(0)" ::: "memory");
        }
    }
    __syncthreads();
}


struct Args { const void* in[20]; float* out; unsigned char* ws; int ph_lo, ph_hi, li, pad; };

struct TUnit { const float* W; int K, ldw, N, kt, nt; const float* ksc; bf16* WT; bool f8; };
__device__ __forceinline__ void tu_load(const TUnit& u, f32x4 (&v)[8], float (&sc)[8]) {
    const int tid = threadIdx.x;
#pragma unroll
    for (int i = 0; i < 8; ++i) { const int idx = tid + NTHR * i, k = idx >> 6, n = 256 * u.nt + 4 * (idx & 63);
        v[i] = (f32x4){0.f, 0.f, 0.f, 0.f}; if (n < u.N) v[i] = *(const f32x4*)(u.W + (size_t)(64 * u.kt + k) * u.ldw + n); sc[i] = u.ksc ? u.ksc[64 * u.kt + k] : 1.f; }
}
__device__ __forceinline__ void tu_store(const TUnit& u, const f32x4 (&v)[8], const float (&sc)[8], LAS float* tile) {
    const int tid = threadIdx.x;
#pragma unroll
    for (int i = 0; i < 8; ++i) { const int idx = tid + NTHR * i, k = idx >> 6; LAS float* t = tile + k * 257 + (idx & 63); t[0] = v[i][0] * sc[i]; t[64] = v[i][1] * sc[i]; t[128] = v[i][2] * sc[i]; t[192] = v[i][3] * sc[i]; }
    __syncthreads();
#pragma unroll
    for (int i = 0; i < 4; ++i) { const int kc = tid & 7, q = tid >> 3, n = 4 * q + i; const LAS float* t = tile + (8 * kc) * 257 + 64 * i + q;
        if (256 * u.nt + n < u.N) {
            if (u.f8) { v2u o; o.x = pg8::pk4_fp8(t[0] * W8SCALE, t[257] * W8SCALE, t[514] * W8SCALE, t[771] * W8SCALE); o.y = pg8::pk4_fp8(t[1028] * W8SCALE, t[1285] * W8SCALE, t[1542] * W8SCALE, t[1799] * W8SCALE);
                *(v2u*)((unsigned char*)u.WT + (size_t)(256 * u.nt + n) * u.K + 64 * u.kt + 8 * kc) = o; }
            else { v4u o; o.x = pk2(t[0], t[257]); o.y = pk2(t[514], t[771]); o.z = pk2(t[1028], t[1285]); o.w = pk2(t[1542], t[1799]);
                *(v4u*)(u.WT + (size_t)(256 * u.nt + n) * u.K + 64 * u.kt + 8 * kc) = o; } } }
    __syncthreads();
}
__device__ __forceinline__ void p0_prologue(const Args& a, LAS unsigned char* lds, int wg, int G) {
    const int tid = threadIdx.x, lane = tid & 63, wave = tid >> 6;
    unsigned char* ws = a.ws;
    LAS float* tile = (LAS float*)lds;
    const float* w_in = (const float*)a.in[3]; const float* w_out = (const float*)a.in[13]; const float* w_up = (const float*)a.in[15]; const float* w_dn = (const float*)a.in[18];
    const float* wck = (const float*)a.in[5]; const float* wcv = (const float*)a.in[7]; const float* g2 = (const float*)a.in[14];
    constexpr int U_IN = 32 * 18, U_OUT = 32 * 8, U_UP = 32 * 44, U_DN = 88 * 8, U_C = 64;
    constexpr int NT = U_IN + U_OUT + U_UP + U_DN + 2 * U_C;
    { f32x4 vc[8], vn[8]; float scc[8], scn[8]; TUnit uc{}, un{};
      for (int it = wg - G; it < NT; it += G) { const int itn = it + G; const bool hn = itn < NT;
        if (hn) { int r = itn; const float* W; int K, ldw, N, kt, nt; const float* ksc = nullptr; bf16* WT; bool f8 = false;
        if (r < U_IN) { kt = r / 18; nt = r % 18; K = DM; ldw = DIN;
            if (nt < 6) { W = w_in; N = NP1A; WT = (bf16*)(ws + WS_WIN); }
            else if (nt < 10) { W = w_in + NP1A; N = 1024; WT = (bf16*)(ws + WS_WIN8); nt -= 6; f8 = true; }
            else { W = w_in + 2584; N = 2048; WT = (bf16*)(ws + WS_WIN8 + (size_t)1024 * DM); nt -= 10; f8 = true; } }
        else if ((r -= U_IN) < U_UP) { W = w_up; K = DM; ldw = DFF2; N = DFF2; ksc = g2; WT = (bf16*)(ws + WS_WUP); kt = r / 44; nt = r % 44; f8 = true; }
        else if ((r -= U_UP) < U_DN) { W = w_dn; K = DFF; ldw = DM; N = DM; WT = (bf16*)(ws + WS_WDN); kt = r / 8; nt = r % 8; f8 = true; }
        else if ((r -= U_DN) < U_OUT) { W = w_out; K = DM; ldw = DM; N = DM; WT = (bf16*)(ws + WS_WOUT); kt = r / 8; nt = r % 8; f8 = true; }
        else if ((r -= U_OUT) < U_C) { W = wck; K = 4096; ldw = 128; N = 128; WT = (bf16*)(ws + WS_WCK); kt = r; nt = 0; }
        else { r -= U_C; W = wcv; K = 4096; ldw = 128; N = 128; WT = (bf16*)(ws + WS_WCV); kt = r; nt = 0; }
            un = TUnit{W, K, ldw, N, kt, nt, ksc, WT, f8}; tu_load(un, vn, scn); }
        if (it >= wg) tu_store(uc, vc, scc, tile);
        if (hn) { uc = un;
#pragma unroll
            for (int i = 0; i < 8; ++i) { vc[i] = vn[i]; scc[i] = scn[i]; } } } }
    const int gt = wg * NTHR + tid, NGT = G * NTHR;
    { bf16* wgt = (bf16*)(ws + WS_WG); for (int i = gt; i < 32 * DM; i += NGT) { const int r = i >> 11, k = i & (DM - 1); wgt[i] = (bf16)f2bf(r < 24 ? w_in[(size_t)k * DIN + WCOL_GATE + r] : 0.f); } }
    { const float* wsp = (const float*)a.in[9]; bf16* wm = (bf16*)(ws + WS_WM);
      for (int i = gt; i < 8 * 128 * 128; i += NGT) { const int s = i & 127, t = (i >> 7) & 127; wm[i] = (bf16)f2bf(s <= t ? wsp[i] : 0.f); } }
    { const int* pos = (const int*)a.in[1]; float* ct = (float*)(ws + WS_COS); float* st = (float*)(ws + WS_SIN);
      const float inv = powf(10000.0f, -2.0f * (float)(gt & 63) / 128.0f);
      for (int i = gt; i < MTOK * 64; i += NGT) { const int m = i >> 6; const float ang = (float)pos[m] * inv;
          const double ad = (double)ang; const double n = rint(ad * 0.15915494309189535); const float r = (float)(ad - n * 6.283185307179586);
          ct[i] = cosf(r); st[i] = sinf(r); } }
    for (int u = wg; u < 32; u += G) { const int kv = u >> 4, sl = u & 15; const float* pe = (const float*)a.in[kv ? 6 : 4]; const float* w = kv ? wcv : wck;
        const int e = tid & 127, sub = tid >> 7; const int k0 = sl * 256 + sub * 64; float s0 = 0.f, s1 = 0.f, s2 = 0.f, s3 = 0.f;
#pragma unroll 4
        for (int k = k0; k < k0 + 64; k += 4) { s0 += pe[k] * w[(size_t)k * 128 + e]; s1 += pe[k + 1] * w[(size_t)(k + 1) * 128 + e]; s2 += pe[k + 2] * w[(size_t)(k + 2) * 128 + e]; s3 += pe[k + 3] * w[(size_t)(k + 3) * 128 + e]; }
        __syncthreads(); tile[tid] = (s0 + s1) + (s2 + s3); __syncthreads();
        if (tid < 128) ((float*)(ws + WS_CTL) + CW_CCONST + (kv * 16 + sl) * 128)[tid] = (tile[tid] + tile[tid + 128]) + (tile[tid + 256] + tile[tid + 384]);
        __syncthreads(); }
    { const float* x = (const float*)a.in[0]; const float* g1 = (const float*)a.in[2]; bf16* xn = (bf16*)(ws + WS_XN); const int NW = G * NWAVES;
      for (int m = wg * NWAVES + wave; m < MTOK; m += 2 * NW) { f32x4 v[2][8]; const bool two = m + NW < MTOK;
#pragma unroll
          for (int q = 0; q < 2; ++q) { const f32x4* xr = (const f32x4*)(x + (size_t)(q && two ? m + NW : m) * DM) + 2 * lane;
#pragma unroll
              for (int j = 0; j < 4; ++j) { v[q][2 * j] = xr[128 * j]; v[q][2 * j + 1] = xr[128 * j + 1]; } }
#pragma unroll
          for (int q = 0; q < 2; ++q) { if (q && !two) break; const int mm = m + q * NW; float s = 0.f;
#pragma unroll
              for (int j = 0; j < 8; ++j) s += (v[q][j][0] * v[q][j][0] + v[q][j][1] * v[q][j][1]) + (v[q][j][2] * v[q][j][2] + v[q][j][3] * v[q][j][3]);
              const float rs = 1.0f / sqrtf(wave_sum(s) * (1.0f / DM) + EPS); v4u* o = (v4u*)(xn + (size_t)mm * DM) + lane; v2u* o8 = (v2u*)(ws + WS_XN8 + (size_t)mm * DM) + lane;
#pragma unroll
              for (int j = 0; j < 4; ++j) { const f32x4 ga = *((const f32x4*)g1 + 2 * lane + 128 * j), gb = *((const f32x4*)g1 + 2 * lane + 128 * j + 1); const f32x4 va = v[q][2 * j], vb = v[q][2 * j + 1];
                  const float y0 = va[0] * rs * ga[0], y1 = va[1] * rs * ga[1], y2 = va[2] * rs * ga[2], y3 = va[3] * rs * ga[3], y4 = vb[0] * rs * gb[0], y5 = vb[1] * rs * gb[1], y6 = vb[2] * rs * gb[2], y7 = vb[3] * rs * gb[3];
                  v4u w; w.x = pk2(y0, y1); w.y = pk2(y2, y3); w.z = pk2(y4, y5); w.w = pk2(y6, y7); o[64 * j] = w;
                  v2u w8; w8.x = pg8::pk4_fp8(y0, y1, y2, y3); w8.y = pg8::pk4_fp8(y4, y5, y6, y7); o8[64 * j] = w8; } } } }
}

__device__ __forceinline__ void p1_gates(const Args& a, int wg, int G) {
    const int lane = threadIdx.x & 63, wave = __builtin_amdgcn_readfirstlane(threadIdx.x >> 6), c = lane & 15, g = lane >> 4;
    unsigned char* ws = a.ws; const bf16* xn = (const bf16*)(ws + WS_XN); const bf16* wgt = (const bf16*)(ws + WS_WG); bf16* gates = (bf16*)(ws + WS_GATES);
    for (int t = wg * NWAVES + wave; t < MTOK / 16; t += G * NWAVES) {
        const bf16* ap = xn + (size_t)(16 * t + c) * DM + 8 * g; const bf16* bp = wgt + (size_t)c * DM + 8 * g;
        f32x4 acc0 = (f32x4){0.f, 0.f, 0.f, 0.f}, acc1 = acc0;
#pragma unroll 4
        for (int ks = 0; ks < 64; ++ks) { const bf16x8 af = *(const bf16x8*)(ap + 32 * ks), b0 = *(const bf16x8*)(bp + 32 * ks), b1 = *(const bf16x8*)(bp + (size_t)16 * DM + 32 * ks);
            acc0 = mfma16(af, b0, acc0); acc1 = mfma16(af, b1, acc1); }
#pragma unroll
        for (int i = 0; i < 4; ++i) { bf16* o = gates + (size_t)(16 * t + 4 * g + i) * 32; o[c] = (bf16)f2bf(acc0[i]); o[16 + c] = (bf16)f2bf(acc1[i]); }
    }
}

__device__ __forceinline__ void rope8(v4u x1, v4u x2, const float* cs, const float* sn, v4u& o1, v4u& o2) {
    const f32x4 c0 = *(const f32x4*)cs, c1 = *(const f32x4*)(cs + 4), s0 = *(const f32x4*)sn, s1 = *(const f32x4*)(sn + 4);
    const float c[8] = {c0[0], c0[1], c0[2], c0[3], c1[0], c1[1], c1[2], c1[3]}, s[8] = {s0[0], s0[1], s0[2], s0[3], s1[0], s1[1], s1[2], s1[3]};
    float a[8], b[8];
#pragma unroll
    for (int j = 0; j < 4; ++j) { a[2 * j] = bflo(x1[j]); a[2 * j + 1] = bfhi(x1[j]); b[2 * j] = bflo(x2[j]); b[2 * j + 1] = bfhi(x2[j]); }
#pragma unroll
    for (int j = 0; j < 4; ++j) { o1[j] = pk2(a[2 * j] * c[2 * j] - b[2 * j] * s[2 * j], a[2 * j + 1] * c[2 * j + 1] - b[2 * j + 1] * s[2 * j + 1]);
        o2[j] = pk2(b[2 * j] * c[2 * j] + a[2 * j] * s[2 * j], b[2 * j + 1] * c[2 * j + 1] + a[2 * j + 1] * s[2 * j + 1]); }
}
__device__ __forceinline__ void rope8r(v4u x1, v4u x2, f32x4 c0, f32x4 c1, f32x4 s0, f32x4 s1, v4u& o1, v4u& o2) {
    const float c[8] = {c0[0], c0[1], c0[2], c0[3], c1[0], c1[1], c1[2], c1[3]}, s[8] = {s0[0], s0[1], s0[2], s0[3], s1[0], s1[1], s1[2], s1[3]};
    float a[8], b[8];
#pragma unroll
    for (int j = 0; j < 4; ++j) { a[2 * j] = bflo(x1[j]); a[2 * j + 1] = bfhi(x1[j]); b[2 * j] = bflo(x2[j]); b[2 * j + 1] = bfhi(x2[j]); }
#pragma unroll
    for (int j = 0; j < 4; ++j) { o1[j] = pk2(a[2 * j] * c[2 * j] - b[2 * j] * s[2 * j], a[2 * j + 1] * c[2 * j + 1] - b[2 * j + 1] * s[2 * j + 1]);
        o2[j] = pk2(b[2 * j] * c[2 * j] + a[2 * j] * s[2 * j], b[2 * j + 1] * c[2 * j + 1] + a[2 * j + 1] * s[2 * j + 1]); }
}
__device__ __forceinline__ void rope8rf(v4u x1, v4u x2, f32x4 c0, f32x4 c1, f32x4 s0, f32x4 s1, v4u& o1, v4u& o2, v2u& e1, v2u& e2, float fs) {
    const float c[8] = {c0[0], c0[1], c0[2], c0[3], c1[0], c1[1], c1[2], c1[3]}, s[8] = {s0[0], s0[1], s0[2], s0[3], s1[0], s1[1], s1[2], s1[3]};
    float a[8], b[8], ra[8], rb[8];
#pragma unroll
    for (int j = 0; j < 4; ++j) { a[2 * j] = bflo(x1[j]); a[2 * j + 1] = bfhi(x1[j]); b[2 * j] = bflo(x2[j]); b[2 * j + 1] = bfhi(x2[j]); }
#pragma unroll
    for (int j = 0; j < 8; ++j) { ra[j] = a[j] * c[j] - b[j] * s[j]; rb[j] = b[j] * c[j] + a[j] * s[j]; }
#pragma unroll
    for (int j = 0; j < 4; ++j) { o1[j] = pk2(ra[2 * j], ra[2 * j + 1]); o2[j] = pk2(rb[2 * j], rb[2 * j + 1]); }
#pragma unroll
    for (int j = 0; j < 8; ++j) { ra[j] *= fs; rb[j] *= fs; }
    e1.x = pg8::pk4_fp8(ra[0], ra[1], ra[2], ra[3]); e1.y = pg8::pk4_fp8(ra[4], ra[5], ra[6], ra[7]); e2.x = pg8::pk4_fp8(rb[0], rb[1], rb[2], rb[3]); e2.y = pg8::pk4_fp8(rb[4], rb[5], rb[6], rb[7]);
}
__device__ __forceinline__ int kpos8_of(int k) { return (((k >> 2) & 3) << 4) | ((k >> 4) << 2) | (k & 3); }
__device__ __forceinline__ void p2_prep(const Args& a, LAS unsigned char* lds, int wg, int G) {
    const int tid = threadIdx.x, lane = tid & 63, wave = __builtin_amdgcn_readfirstlane(tid >> 6), c = lane & 15, g = lane >> 4;
    unsigned char* ws = a.ws; const bf16* proj = (const bf16*)(ws + WS_PROJ);
    const float* COS = (const float*)(ws + WS_COS); const float* SIN = (const float*)(ws + WS_SIN);
    constexpr int NCU = 256, NPU = 512;
    for (int u = wg; u < NCU + NPU; u += G) {
        if (u < NCU) {
            const int kv = u >> 7, bg = (u >> 5) & 3, np = u & 31, b = bg >> 1, gk = bg & 1;
            const bf16* src = proj + (size_t)b * SEQ * NP1 + (kv ? COL_VCMP : COL_KCMP) + gk * 128 + 8 * g;
            const bf16* wt = (const bf16*)(ws + (kv ? WS_WCV : WS_WCK)) + (size_t)c * 4096 + 8 * g;
            f32x4 acc[2][8];
#pragma unroll
            for (int i = 0; i < 2; ++i)
#pragma unroll
                for (int e = 0; e < 8; ++e) acc[i][e] = (f32x4){0.f, 0.f, 0.f, 0.f};
#pragma unroll 4
            for (int kk = 0; kk < 16; ++kk) { const int ks = 16 * wave + kk, l = ks >> 2, d0 = 32 * (ks & 3); bf16x8 af[2];
#pragma unroll
                for (int i = 0; i < 2; ++i) { int tok = 16 * (32 * np + 16 * i + c) + l; tok = tok < SEQ ? tok : SEQ - 1; af[i] = *(const bf16x8*)(src + (size_t)tok * NP1 + d0); }
#pragma unroll
                for (int e = 0; e < 8; ++e) { const bf16x8 bfr = *(const bf16x8*)(wt + (size_t)(16 * e) * 4096 + 32 * ks);
                    acc[0][e] = mfma16(af[0], bfr, acc[0][e]); acc[1][e] = mfma16(af[1], bfr, acc[1][e]); } }
            LAS float* red = (LAS float*)lds;
#pragma unroll
            for (int i = 0; i < 2; ++i)
#pragma unroll
                for (int e = 0; e < 8; ++e)
#pragma unroll
                    for (int ii = 0; ii < 4; ++ii) red[(((wave * 2 + i) * 8 + e) * 4 + ii) * 64 + lane] = acc[i][e][ii];
            __syncthreads();
            { const int ls = tid & 63, ii = (tid >> 6) & 3, i = tid >> 8, gs = ls >> 4, cs_ = ls & 15; float val[8];
#pragma unroll
              for (int e = 0; e < 8; ++e) { float v = 0.f;
#pragma unroll
                  for (int w = 0; w < 8; ++w) v += red[(((w * 2 + i) * 8 + e) * 4 + ii) * 64 + ls];
                  val[e] = v; }
              const float* ccp = (const float*)(ws + WS_CTL) + CW_CCONST + kv * 16 * 128; float cc[128 / 16 * 0 + 8];
#pragma unroll
              for (int e = 0; e < 8; ++e) { float t = 0.f;
#pragma unroll
                  for (int sl = 0; sl < 16; ++sl) t += ccp[sl * 128 + 16 * e + cs_];
                  cc[e] = t; }
              bf16* kc = (bf16*)(ws + WS_KC) + (size_t)bg * 1024 * 128; bf16* vct = (bf16*)(ws + WS_VCT) + (size_t)bg * 16 * 8192;
              const int n = 32 * np + 16 * i + 4 * gs + ii; const bool ok = n < 1023;
              if (kv == 0) { const int mt = b * SEQ + (ok ? 16 * n + 31 : 0);
#pragma unroll
                  for (int e = 0; e < 4; ++e) { const int f = 16 * e + cs_; const float x1 = val[e] + cc[e], x2 = val[e + 4] + cc[e + 4], cs = COS[(size_t)mt * 64 + f], sn = SIN[(size_t)mt * 64 + f];
                      kc[(size_t)n * 128 + f] = (bf16)f2bf(ok ? x1 * cs - x2 * sn : 0.f); kc[(size_t)n * 128 + f + 64] = (bf16)f2bf(ok ? x2 * cs + x1 * sn : 0.f); } }
              else {
#pragma unroll
                  for (int e = 0; e < 8; ++e) { const int f = 16 * e + cs_; vct[(size_t)(n >> 6) * 8192 + f * 64 + kpos_of(n & 63)] = (bf16)f2bf(ok ? val[e] + cc[e] : 0.f); } } }
            __syncthreads();
        } else {
            const int pu = u - NCU, b = pu >> 8, kb = pu & 255; const size_t m0 = (size_t)b * SEQ + 64 * kb;
#pragma unroll
            for (int bt = 0; bt < 2; ++bt) { v4u x1[4], x2[4]; f32x4 cs[4][2], sn[4][2];
#pragma unroll
                for (int k = 0; k < 4; ++k) { const int it = tid + NTHR * (4 * bt + k), tk = it >> 6, h = (it >> 3) & 7, ch = it & 7;
                    const bf16* p = proj + (m0 + tk) * NP1 + h * 128 + 8 * ch; x1[k] = *(const v4u*)p; x2[k] = *(const v4u*)(p + 64);
                    const float* cp = COS + (m0 + tk) * 64 + 8 * ch; const float* sp = SIN + (m0 + tk) * 64 + 8 * ch;
                    cs[k][0] = *(const f32x4*)cp; cs[k][1] = *(const f32x4*)(cp + 4); sn[k][0] = *(const f32x4*)sp; sn[k][1] = *(const f32x4*)(sp + 4); }
#pragma unroll
                for (int k = 0; k < 4; ++k) { const int it = tid + NTHR * (4 * bt + k), tk = it >> 6, h = (it >> 3) & 7, ch = it & 7; v4u o1, o2;
                    v2u e1, e2; rope8rf(x1[k], x2[k], cs[k][0], cs[k][1], sn[k][0], sn[k][1], o1, o2, e1, e2, 8.0f * C2); bf16* q = (bf16*)(ws + WS_QR) + (m0 + tk) * 1024 + h * 128 + 8 * ch; *(v4u*)q = o1; *(v4u*)(q + 64) = o2;
                    unsigned char* q8 = ws + WS_Q8 + (m0 + tk) * 1024 + h * 128 + 8 * ch; *(v2u*)q8 = e1; *(v2u*)(q8 + 64) = e2; } }
            { v4u x1[4], x2[4]; f32x4 cs[4][2], sn[4][2];
#pragma unroll
                for (int k = 0; k < 4; ++k) { const int it = tid + NTHR * k, tk = it >> 5, wh = (it >> 4) & 1, gk = (it >> 3) & 1, ch = it & 7;
                    const bf16* p = proj + (m0 + tk) * NP1 + (wh ? COL_KWIN : COL_KSEL) + gk * 128 + 8 * ch; x1[k] = *(const v4u*)p; x2[k] = *(const v4u*)(p + 64);
                    const float* cp = COS + (m0 + tk) * 64 + 8 * ch; const float* sp = SIN + (m0 + tk) * 64 + 8 * ch;
                    cs[k][0] = *(const f32x4*)cp; cs[k][1] = *(const f32x4*)(cp + 4); sn[k][0] = *(const f32x4*)sp; sn[k][1] = *(const f32x4*)(sp + 4); }
#pragma unroll
                for (int k = 0; k < 4; ++k) { const int it = tid + NTHR * k, tk = it >> 5, wh = (it >> 4) & 1, gk = (it >> 3) & 1, ch = it & 7; v4u o1, o2;
                    v2u e1, e2; rope8rf(x1[k], x2[k], cs[k][0], cs[k][1], sn[k][0], sn[k][1], o1, o2, e1, e2, 1.0f);
                    unsigned char* d = ws + (wh ? WS_KWIN : WS_KSEL) + ((size_t)(b * 2 + gk) * SEQ + 64 * kb + tk) * 128 + 8 * ch; *(v2u*)d = e1; *(v2u*)(d + 64) = e2; } }
            LAS unsigned char* T8 = lds;
            { v4u v[8];
#pragma unroll
                for (int k = 0; k < 8; ++k) { const int it = tid + NTHR * k, q = it >> 10, tk = (it >> 4) & 63, ch = it & 15, wh = q >> 1, gk = q & 1;
                    v[k] = *(const v4u*)(proj + (m0 + tk) * NP1 + (wh ? COL_VWIN : COL_VSEL) + gk * 128 + 8 * ch); }
#pragma unroll
                for (int k = 0; k < 8; ++k) { const int it = tid + NTHR * k, q = it >> 10, tk = (it >> 4) & 63, ch = it & 15;
                    LAS unsigned char* t = T8 + q * (128 * 80) + (8 * ch) * 80 + (kpos8_of(tk) ^ ((ch >> 1) << 3));
                    const unsigned w0 = pg8::pk4_fp8(bflo(v[k][0]), bfhi(v[k][0]), bflo(v[k][1]), bfhi(v[k][1])), w1 = pg8::pk4_fp8(bflo(v[k][2]), bfhi(v[k][2]), bflo(v[k][3]), bfhi(v[k][3]));
#pragma unroll
                    for (int j = 0; j < 4; ++j) { t[j * 80] = (unsigned char)(w0 >> (8 * j)); t[(4 + j) * 80] = (unsigned char)(w1 >> (8 * j)); } } }
            __syncthreads();
#pragma unroll
            for (int k = 0; k < 4; ++k) { const int it = tid + NTHR * k, q = it >> 9, d = (it >> 2) & 127, ch = it & 3, wh = q >> 1, gk = q & 1;
                const int sw = (d >> 4) & 7; v4u r = *(const LAS v4u*)(T8 + q * (128 * 80) + d * 80 + 16 * (ch ^ (sw >> 1))); if (sw & 1) r = (v4u){r.z, r.w, r.x, r.y};
                *(v4u*)(ws + (wh ? WS_VWINT : WS_VSELT) + ((size_t)(b * 2 + gk) * 256 + kb) * 8192 + d * 64 + 16 * ch) = r; }
            __syncthreads();
        }
    }
}

constexpr int KL_STRIDE = 272, VL_STRIDE = 144, KL_BYTES = 64 * KL_STRIDE, VL_BYTES = 128 * VL_STRIDE;
__device__ __forceinline__ void stage_load(const bf16* src, v4u (&r)[2]) {
#pragma unroll
    for (int i = 0; i < 2; ++i) r[i] = *(const v4u*)((const char*)src + (size_t)(threadIdx.x + 512 * i) * 16);
}
__device__ __forceinline__ void stage_write_k(LAS unsigned char* Kl, const v4u (&r)[2]) {
#pragma unroll
    for (int i = 0; i < 2; ++i) { const int id = threadIdx.x + 512 * i; *(LAS v4u*)(Kl + (id >> 4) * KL_STRIDE + (id & 15) * 16) = r[i]; }
}
__device__ __forceinline__ void stage_write_v(LAS unsigned char* Vl, const v4u (&r)[2]) {
#pragma unroll
    for (int i = 0; i < 2; ++i) { const int id = threadIdx.x + 512 * i; *(LAS v4u*)(Vl + (id >> 3) * VL_STRIDE + (id & 7) * 16) = r[i]; }
}
__device__ __forceinline__ void qk_tile(const LAS unsigned char* Kl, const bf16x8 (&qf)[4], f32x4 (&s)[4], int c, int g) {
#pragma unroll
    for (int kt = 0; kt < 4; ++kt) { s[kt] = (f32x4){0.f, 0.f, 0.f, 0.f};
#pragma unroll
        for (int ks = 0; ks < 4; ++ks) { const bf16x8 kf = *(const LAS bf16x8*)(Kl + (16 * kt + c) * KL_STRIDE + (32 * ks + 8 * g) * 2); s[kt] = mfma16(kf, qf[ks], s[kt]); } }
}
__device__ __forceinline__ void pv_tile(const LAS unsigned char* Vl, const f32x4 (&p)[4], f32x4 (&o)[8], int c, int g) {
#pragma unroll
    for (int s2 = 0; s2 < 2; ++s2) { const bf16x8 pf = pack8(p[2 * s2], p[2 * s2 + 1]);
#pragma unroll
        for (int dt = 0; dt < 8; ++dt) { const bf16x8 vf = *(const LAS bf16x8*)(Vl + (16 * dt + c) * VL_STRIDE + (32 * s2 + 8 * g) * 2); o[dt] = mfma16(vf, pf, o[dt]); } }
}
__device__ __forceinline__ void online_sm(f32x4 (&s)[4], float& m, float& l, float& alpha) {
    float tm = fmaxf(fmaxf(s[0][0], s[0][1]), fmaxf(s[0][2], s[0][3]));
#pragma unroll
    for (int kt = 1; kt < 4; ++kt) tm = fmaxf(tm, fmaxf(fmaxf(s[kt][0], s[kt][1]), fmaxf(s[kt][2], s[kt][3])));
    tm = fmaxf(tm, __shfl_xor(tm, 16)); tm = fmaxf(tm, __shfl_xor(tm, 32));
    const float mn = fmaxf(m, tm); alpha = __builtin_amdgcn_exp2f((m - mn) * C2); m = mn; float ls = 0.f;
#pragma unroll
    for (int kt = 0; kt < 4; ++kt)
#pragma unroll
        for (int i = 0; i < 4; ++i) { const float p = __builtin_amdgcn_exp2f((s[kt][i] - mn) * C2); s[kt][i] = p; ls += p; }
    l = l * alpha + ls;
}
__device__ __forceinline__ void load_qf(const bf16* qr, size_t mrow, int head, int g, bf16x8 (&qf)[4]) {
#pragma unroll
    for (int ks = 0; ks < 4; ++ks) qf[ks] = *(const bf16x8*)(qr + mrow * 1024 + head * 128 + 32 * ks + 8 * g);
}
__device__ __forceinline__ void pin_qf(bf16x8 (&qf)[2][4]) {
#pragma unroll
    for (int cs = 0; cs < 2; ++cs)
#pragma unroll
        for (int ks = 0; ks < 4; ++ks) asm volatile("" : "+v"(qf[cs][ks]));
}
__device__ __forceinline__ void store_o(bf16* O, size_t mrow, int head, int g, const f32x4 (&o)[8], float inv) {
#pragma unroll
    for (int dt = 0; dt < 8; ++dt) { v2u w; w.x = pk2(o[dt][0] * inv, o[dt][1] * inv); w.y = pk2(o[dt][2] * inv, o[dt][3] * inv); *(v2u*)(O + mrow * 1024 + head * 128 + 16 * dt + 4 * g) = w; }
}
__device__ __forceinline__ void unit_bq(int u, int& bg, int& qt) { bg = u >> 8; const int x = u & 255; qt = (bg & 1) ? 255 - x : x; }


constexpr int SLOT_BYTES = 32768, TMK_OFF = 132096;
#define WAITV(n) asm volatile("s_waitcnt vmcnt(" #n ")" ::: "memory")
#define RAWBAR() do { asm volatile("" ::: "memory"); __builtin_amdgcn_s_barrier(); asm volatile("" ::: "memory"); } while (0)
__device__ __forceinline__ void dma_k(LAS unsigned char* slot, const bf16* ksrc, int wave, int lane) {
#pragma unroll
    for (int r = 0; r < 2; ++r) { const int row = 4 * wave + (lane >> 4) + 32 * r, pos = lane & 15;
        __builtin_amdgcn_global_load_lds((const unsigned*)(ksrc + row * 128 + ((pos ^ (row & 15)) * 8)), (LAS unsigned*)(slot + wave * 1024 + r * 8192), 16, 0, 0); }
}
__device__ __forceinline__ void dma_v(LAS unsigned char* slot, const bf16* vsrc, int wave, int lane) {
#pragma unroll
    for (int r = 0; r < 2; ++r) { const int d = 8 * wave + (lane >> 3) + 64 * r, pos = lane & 7;
        __builtin_amdgcn_global_load_lds((const unsigned*)(vsrc + d * 64 + ((pos ^ ((d >> 1) & 7)) * 8)), (LAS unsigned*)(slot + 16384 + wave * 1024 + r * 8192), 16, 0, 0); }
}
__device__ __forceinline__ void qk_tile_sw(const LAS unsigned char* slot, const bf16x8 (&qf)[4], f32x4 (&s)[4], const int (&kx)[4]) {
#pragma unroll
    for (int kt = 0; kt < 4; ++kt) { s[kt] = (f32x4){0.f, 0.f, 0.f, 0.f};
#pragma unroll
        for (int ks = 0; ks < 4; ++ks) { const bf16x8 kf = *(const LAS bf16x8*)(slot + kt * 4096 + kx[ks]); s[kt] = mfma16(kf, qf[ks], s[kt]); } }
}
__device__ __forceinline__ void pv_tile_sw(const LAS unsigned char* slot, const f32x4 (&p)[4], f32x4 (&o)[8], const int (&vx)[2]) {
#pragma unroll
    for (int s2 = 0; s2 < 2; ++s2) { const bf16x8 pf = pack8(p[2 * s2], p[2 * s2 + 1]);
#pragma unroll
        for (int dt = 0; dt < 8; ++dt) { const bf16x8 vf = *(const LAS bf16x8*)(slot + 16384 + dt * 2048 + vx[s2]); o[dt] = mfma16(vf, pf, o[dt]); } }
}
__device__ __forceinline__ float lmax16(float x) { const unsigned u = __builtin_bit_cast(unsigned, x); auto r = __builtin_amdgcn_permlane16_swap(u, u, false, false); unsigned r0 = r[0], r1 = r[1]; asm volatile("" : "+v"(r1)); return fmaxf(__builtin_bit_cast(float, r0), __builtin_bit_cast(float, r1)); }
__device__ __forceinline__ float lmax32(float x) { const unsigned u = __builtin_bit_cast(unsigned, x); auto r = __builtin_amdgcn_permlane32_swap(u, u, false, false); unsigned r0 = r[0], r1 = r[1]; asm volatile("" : "+v"(r1)); return fmaxf(__builtin_bit_cast(float, r0), __builtin_bit_cast(float, r1)); }
__device__ __forceinline__ float ladd16(float x) { const unsigned u = __builtin_bit_cast(unsigned, x); auto r = __builtin_amdgcn_permlane16_swap(u, u, false, false); unsigned r0 = r[0], r1 = r[1]; asm volatile("" : "+v"(r1)); return __builtin_bit_cast(float, r0) + __builtin_bit_cast(float, r1); }
__device__ __forceinline__ float ladd32(float x) { const unsigned u = __builtin_bit_cast(unsigned, x); auto r = __builtin_amdgcn_permlane32_swap(u, u, false, false); unsigned r0 = r[0], r1 = r[1]; asm volatile("" : "+v"(r1)); return __builtin_bit_cast(float, r0) + __builtin_bit_cast(float, r1); }
__device__ __forceinline__ void online_sm2(f32x4 (&s)[4], float& m, float& l, float& alpha) {
    float tm = fmaxf(fmaxf(s[0][0], s[0][1]), fmaxf(s[0][2], s[0][3]));
#pragma unroll
    for (int kt = 1; kt < 4; ++kt) tm = fmaxf(tm, fmaxf(fmaxf(s[kt][0], s[kt][1]), fmaxf(s[kt][2], s[kt][3])));
    tm = lmax16(tm); tm = lmax32(tm);
    const float mn = fmaxf(m, tm); alpha = __builtin_amdgcn_exp2f((m - mn) * C2); m = mn; float ls = 0.f;
#pragma unroll
    for (int kt = 0; kt < 4; ++kt)
#pragma unroll
        for (int i = 0; i < 4; ++i) { const float p = __builtin_amdgcn_exp2f((s[kt][i] - mn) * C2); s[kt][i] = p; ls += p; }
    l = l * alpha + ls;
}

__device__ __forceinline__ void qk2(const LAS unsigned char* slot, const bf16x8 (&qf)[2][4], f32x4 (&s)[2][4], const int (&kx)[4]) {
    bf16x8 kf[4][4];
#pragma unroll
    for (int kt = 0; kt < 4; ++kt)
#pragma unroll
        for (int ks = 0; ks < 4; ++ks) kf[kt][ks] = *(const LAS bf16x8*)(slot + kt * 4096 + kx[ks]);
    __builtin_amdgcn_sched_barrier(0);
#pragma unroll
    for (int kt = 0; kt < 4; ++kt) { s[0][kt] = (f32x4){0.f, 0.f, 0.f, 0.f}; s[1][kt] = (f32x4){0.f, 0.f, 0.f, 0.f};
#pragma unroll
        for (int ks = 0; ks < 4; ++ks) { s[0][kt] = mfma16(kf[kt][ks], qf[0][ks], s[0][kt]); s[1][kt] = mfma16(kf[kt][ks], qf[1][ks], s[1][kt]); } }
}
__device__ __forceinline__ void pv2(const LAS unsigned char* slot, const f32x4 (&p)[2][4], f32x4 (&o)[2][8], const int (&vx)[2]) {
#pragma unroll
    for (int s2 = 0; s2 < 2; ++s2) { const bf16x8 pf0 = pack8(p[0][2 * s2], p[0][2 * s2 + 1]), pf1 = pack8(p[1][2 * s2], p[1][2 * s2 + 1]);
#pragma unroll
        for (int dt = 0; dt < 8; ++dt) { const bf16x8 vf = *(const LAS bf16x8*)(slot + 16384 + dt * 2048 + vx[s2]); o[0][dt] = mfma16(vf, pf0, o[0][dt]); o[1][dt] = mfma16(vf, pf1, o[1][dt]); } }
}
__device__ __forceinline__ void pv2l(const LAS unsigned char* slot, const f32x4 (&p)[2][4], f32x4 (&o)[2][8], f32x4 (&lacc)[2], const int (&vx)[2]) {
    const bf16x8 ones8 = __builtin_bit_cast(bf16x8, (v4u){0x3f803f80u, 0x3f803f80u, 0x3f803f80u, 0x3f803f80u});
#pragma unroll
    for (int s2 = 0; s2 < 2; ++s2) { const bf16x8 pf0 = pack8(p[0][2 * s2], p[0][2 * s2 + 1]), pf1 = pack8(p[1][2 * s2], p[1][2 * s2 + 1]);
        lacc[0] = mfma16(ones8, pf0, lacc[0]); lacc[1] = mfma16(ones8, pf1, lacc[1]);
#pragma unroll
        for (int dt = 0; dt < 8; ++dt) { const bf16x8 vf = *(const LAS bf16x8*)(slot + 16384 + dt * 2048 + vx[s2]); o[0][dt] = mfma16(vf, pf0, o[0][dt]); o[1][dt] = mfma16(vf, pf1, o[1][dt]); } }
}
__device__ __forceinline__ float quad_sum(float x) {
    const float y = x + __builtin_bit_cast(float, __builtin_amdgcn_mov_dpp(__builtin_bit_cast(int, x), 0xB1, 0xf, 0xf, true));
    return y + __builtin_bit_cast(float, __builtin_amdgcn_mov_dpp(__builtin_bit_cast(int, y), 0x4E, 0xf, 0xf, true));
}
template <bool HAS_O> __device__ __forceinline__ void sm_lean(f32x4 (&s)[4], float& m, float& l, f32x4 (&o)[8], bool rowok) {
    float tm = fmaxf(fmaxf(s[0][0], s[0][1]), fmaxf(s[0][2], s[0][3]));
#pragma unroll
    for (int kt = 1; kt < 4; ++kt) tm = fmaxf(tm, fmaxf(fmaxf(s[kt][0], s[kt][1]), fmaxf(s[kt][2], s[kt][3])));
    tm = lmax16(tm); tm = lmax32(tm);
    tm = rowok ? tm : -__builtin_inff();
    const float mn = fmaxf(m, tm), alpha = __builtin_amdgcn_exp2f((m - mn) * C2); m = mn;
    const float mb = rowok ? mn * C2 : __builtin_inff(); float ls = 0.f;
#pragma unroll
    for (int kt = 0; kt < 4; ++kt)
#pragma unroll
        for (int i = 0; i < 4; ++i) { const float p = __builtin_amdgcn_exp2f(__builtin_fmaf(s[kt][i], C2, -mb)); s[kt][i] = p; ls += p; }
    l = l * alpha + ls;
    if (HAS_O) { if (!__all(alpha == 1.0f)) {
#pragma unroll
        for (int dt = 0; dt < 8; ++dt) o[dt] = o[dt] * alpha; } }
}
__device__ __forceinline__ float row16_sum(float x) {
    x = quad_sum(x);
    x += __builtin_bit_cast(float, __builtin_amdgcn_mov_dpp(__builtin_bit_cast(int, x), 0x141, 0xf, 0xf, true));
    x += __builtin_bit_cast(float, __builtin_amdgcn_mov_dpp(__builtin_bit_cast(int, x), 0x140, 0xf, 0xf, true));
    return x;
}
__device__ __forceinline__ float wave_sum_v(float x) { return ladd32(ladd16(row16_sum(x))); }
__device__ __forceinline__ float amax3(float a, float b, float c) { float r; asm("v_max3_f32 %0, %1, %2, %3" : "=v"(r) : "v"(a), "v"(b), "v"(c)); return r; }
__device__ __forceinline__ float amax2(float a, float b) { float r; asm("v_max_f32 %0, %1, %2" : "=v"(r) : "v"(a), "v"(b)); return r; }
__device__ __forceinline__ float xmax16(float x) { const unsigned u = __builtin_bit_cast(unsigned, x); auto r = __builtin_amdgcn_permlane16_swap(u, u, false, false); unsigned r0 = r[0], r1 = r[1]; asm volatile("" : "+v"(r1)); return amax2(__builtin_bit_cast(float, r0), __builtin_bit_cast(float, r1)); }
__device__ __forceinline__ float xmax32(float x) { const unsigned u = __builtin_bit_cast(unsigned, x); auto r = __builtin_amdgcn_permlane32_swap(u, u, false, false); unsigned r0 = r[0], r1 = r[1]; asm volatile("" : "+v"(r1)); return amax2(__builtin_bit_cast(float, r0), __builtin_bit_cast(float, r1)); }
constexpr float SM_THR = 10.0f;
__device__ __forceinline__ void sm_fast(f32x4 (&s)[4], float& m, f32x4& lacc, f32x4 (&o)[8], bool rowok) {
    float tm = amax3(amax3(s[0][0], s[0][1], s[0][2]), amax3(s[0][3], s[1][0], s[1][1]), amax3(s[1][2], s[1][3], s[2][0]));
    tm = amax3(tm, amax3(s[2][1], s[2][2], s[2][3]), amax3(s[3][0], s[3][1], s[3][2])); tm = amax2(tm, s[3][3]);
    tm = xmax16(tm); tm = xmax32(tm);
    tm = rowok ? tm : -__builtin_inff();
    if (__any((tm - m) * C2 > SM_THR)) { const float mn = amax2(m, tm), alpha = __builtin_amdgcn_exp2f((m - mn) * C2); m = mn; lacc = lacc * alpha;
#pragma unroll
        for (int dt = 0; dt < 8; ++dt) o[dt] = o[dt] * alpha; }
    const float mb = rowok ? m * C2 : __builtin_inff();
#pragma unroll
    for (int kt = 0; kt < 4; ++kt)
#pragma unroll
        for (int i = 0; i < 4; ++i) s[kt][i] = __builtin_amdgcn_exp2f(__builtin_fmaf(s[kt][i], C2, -mb));
}
#define SWZ_OFFSETS() int kx[4], vx[2]; \
    _Pragma("unroll") for (int ks_ = 0; ks_ < 4; ++ks_) kx[ks_] = c * 256 + ((((g ^ c) & 15) << 4) ^ (ks_ << 6)); \
    _Pragma("unroll") for (int s2_ = 0; s2_ < 2; ++s2_) vx[s2_] = c * 128 + ((((g ^ (c >> 1)) & 7) << 4) ^ (s2_ << 6))

__device__ __forceinline__ void unit_sel(int wg, int r, int G, int& bg, int& qt) {
    if (G == 256) { const int x = wg & 7, i = wg >> 3, k = (r & 1) ? (96 - 32 * r + i) : (127 - 32 * r - i); bg = x >> 1; qt = (x & 1) + 2 * k; }
    else unit_bq(wg + r * G, bg, qt);
}

using pg8::v8i32; using pg8::f32x2;
constexpr int TOPK_LSB = 10; constexpr unsigned TOPK_LOWMASK = (1u << TOPK_LSB) - 1u;
constexpr int IMP_OFF = 65536;
static_assert(IMP_OFF + 64 * 260 * 4 <= TMK_OFF && TMK_OFF + 2048 <= MISC_OFF, "cmp LDS map");
template <int CM  > __device__ __forceinline__ void p3_cmp(const Args& a, LAS unsigned char* lds, int wg, int G) {
    const int tid = threadIdx.x, lane = tid & 63, wave = __builtin_amdgcn_readfirstlane(tid >> 6), c = lane & 15, g = lane >> 4;
    unsigned char* ws = a.ws; const bf16* qr = (const bf16*)(ws + WS_QR); bf16* OC = (bf16*)(ws + WS_OC);
    LAS float* imp = (LAS float*)(lds + IMP_OFF); LAS unsigned* tmk = (LAS unsigned*)(lds + TMK_OFF);
    SWZ_OFFSETS();
    for (int u = wg; u < 1024; u += G) {
        int bg, qt; unit_bq(u, bg, qt); const int b = bg >> 1, gk = bg & 1, t0 = 64 * qt;
        const bf16* kc = (const bf16*)(ws + WS_KC) + (size_t)bg * 1024 * 128; const bf16* vct = (const bf16*)(ws + WS_VCT) + (size_t)bg * 16 * 8192;
        const int ntile = (4 * qt + 66) >> 6;
        __syncthreads();
        tmk[tid] = 0u;
        bf16x8 qf[2][4]; int nmax[2]; float m[2]; f32x2 lp[2];
#pragma unroll
        for (int cs = 0; cs < 2; ++cs) { const int ql = 8 * wave + 4 * cs + (c >> 2), t = t0 + ql; load_qf(qr, (size_t)b * SEQ + t, 4 * gk + (c & 3), g, qf[cs]);
            nmax[cs] = t >= 31 ? (t - 31) >> 4 : -1; m[cs] = -1e30f; lp[cs] = (f32x2){0.f, 0.f}; }
        pin_qf(qf);
        __syncthreads();
        if (CM != 2) dma_k(lds, kc, wave, lane);
        for (int i = 0; i < (CM == 2 ? 0 : ntile); ++i) {
            WAITV(0); RAWBAR();
            if (i + 1 < ntile) dma_k(lds + ((i + 1) & 1) * SLOT_BYTES, kc + (size_t)(i + 1) * 64 * 128, wave, lane);
            const LAS unsigned char* slot = lds + (i & 1) * SLOT_BYTES;
            bf16x8 kf[4][4];
#pragma unroll
            for (int kt = 0; kt < 4; ++kt)
#pragma unroll
                for (int ks = 0; ks < 4; ++ks) kf[kt][ks] = *(const LAS bf16x8*)(slot + kt * 4096 + kx[ks]);
            __builtin_amdgcn_sched_barrier(0);
            f32x4 s0[4], s1[4];
#pragma unroll
            for (int kt = 0; kt < 4; ++kt) { s0[kt] = (f32x4){0.f, 0.f, 0.f, 0.f};
#pragma unroll
                for (int ks = 0; ks < 4; ++ks) s0[kt] = mfma16(kf[kt][ks], qf[0][ks], s0[kt]); }
            __builtin_amdgcn_sched_barrier(0);
            const bool bnd1 = 64 * i + 63 > 4 * qt - 2;
#define CMP_QK1(kt_) do { s1[kt_] = (f32x4){0.f, 0.f, 0.f, 0.f}; _Pragma("unroll") for (int ks_ = 0; ks_ < 4; ++ks_) s1[kt_] = mfma16(kf[kt_][ks_], qf[1][ks_], s1[kt_]); } while (0)
#define CMP_MASK(S, CS) do { if (bnd1) { _Pragma("unroll") for (int kt_ = 0; kt_ < 4; ++kt_) _Pragma("unroll") for (int ii_ = 0; ii_ < 4; ++ii_) { const int n_ = 64 * i + 16 * kt_ + 4 * g + ii_; S[kt_][ii_] = n_ <= nmax[CS] ? S[kt_][ii_] : -__builtin_inff(); } } } while (0)
#define CMP_MAXCHK(S, CS) do { float tm_ = fmaxf(fmaxf(fmaxf(S[0][0], S[0][1]), fmaxf(S[0][2], S[0][3])), fmaxf(fmaxf(S[1][0], S[1][1]), fmaxf(S[1][2], S[1][3]))); \
        tm_ = fmaxf(tm_, fmaxf(fmaxf(fmaxf(S[2][0], S[2][1]), fmaxf(S[2][2], S[2][3])), fmaxf(fmaxf(S[3][0], S[3][1]), fmaxf(S[3][2], S[3][3])))); \
        if (__any((tm_ - m[CS]) * C2 > 8.0f)) { tm_ = lmax32(lmax16(tm_)); const float mn_ = fmaxf(m[CS], tm_), al_ = __builtin_amdgcn_exp2f((m[CS] - mn_) * C2); m[CS] = mn_; lp[CS] = lp[CS] * al_; } } while (0)
#define CMP_EXPSUM(S, CS, kt_) do { const float mbv_ = m[CS] * C2; _Pragma("unroll") for (int ii_ = 0; ii_ < 4; ++ii_) S[kt_][ii_] = __builtin_amdgcn_exp2f(__builtin_fmaf(S[kt_][ii_], C2, -mbv_)); \
        lp[CS] += (f32x2){S[kt_][0], S[kt_][1]}; lp[CS] += (f32x2){S[kt_][2], S[kt_][3]}; } while (0)
            CMP_QK1(0); CMP_MASK(s0, 0); CMP_MAXCHK(s0, 0); __builtin_amdgcn_sched_barrier(0);
            CMP_QK1(1); CMP_EXPSUM(s0, 0, 0); CMP_EXPSUM(s0, 0, 1); __builtin_amdgcn_sched_barrier(0);
            CMP_QK1(2); CMP_EXPSUM(s0, 0, 2); __builtin_amdgcn_sched_barrier(0);
            CMP_QK1(3); CMP_EXPSUM(s0, 0, 3); __builtin_amdgcn_sched_barrier(0);
            CMP_MASK(s1, 1); CMP_MAXCHK(s1, 1);
#pragma unroll
            for (int kt = 0; kt < 4; ++kt) CMP_EXPSUM(s1, 1, kt);
        }
        float mb[2];
#pragma unroll
        for (int cs = 0; cs < 2; ++cs) { float lt = lp[cs].x + lp[cs].y; lt = ladd16(lt); lt = ladd32(lt); mb[cs] = lt > 0.f ? m[cs] * C2 + __builtin_amdgcn_logf(lt) : __builtin_inff(); }
        __syncthreads();
        f32x4 o[2][8];
#pragma unroll
        for (int cs = 0; cs < 2; ++cs)
#pragma unroll
            for (int dt = 0; dt < 8; ++dt) o[cs][dt] = (f32x4){0.f, 0.f, 0.f, 0.f};
        float wrap[2] = {0.f, 0.f};
        if (CM < 2) { dma_k(lds, kc, wave, lane); dma_v(lds, vct, wave, lane); }
        for (int i = 0; i < (CM >= 2 ? 0 : ntile); ++i) {
            WAITV(0); RAWBAR();
            if (i + 1 < ntile) { LAS unsigned char* sl = lds + ((i + 1) & 1) * SLOT_BYTES; dma_k(sl, kc + (size_t)(i + 1) * 64 * 128, wave, lane); dma_v(sl, vct + (size_t)(i + 1) * 8192, wave, lane); }
            const LAS unsigned char* slot = lds + (i & 1) * SLOT_BYTES;
            const bool bnd = 64 * i + 63 > 4 * qt - 2;
            f32x4 s0[4], s1[4];
            { bf16x8 kf[4][4];
#pragma unroll
              for (int kt = 0; kt < 4; ++kt)
#pragma unroll
                  for (int ks = 0; ks < 4; ++ks) kf[kt][ks] = *(const LAS bf16x8*)(slot + kt * 4096 + kx[ks]);
              __builtin_amdgcn_sched_barrier(0);
#pragma unroll
              for (int kt = 0; kt < 4; ++kt) { s0[kt] = (f32x4){0.f, 0.f, 0.f, 0.f};
#pragma unroll
                  for (int ks = 0; ks < 4; ++ks) s0[kt] = mfma16(kf[kt][ks], qf[0][ks], s0[kt]); }
              __builtin_amdgcn_sched_barrier(0);
#define CMP_PIMP(S, CS, kt_) do { const int ql_ = 8 * wave + 4 * CS + (c >> 2); \
        _Pragma("unroll") for (int ii_ = 0; ii_ < 4; ++ii_) { const int n_ = 64 * i + 16 * kt_ + 4 * g + ii_; const float p_ = __builtin_amdgcn_exp2f(__builtin_fmaf(S[kt_][ii_], C2, -mb[CS])); S[kt_][ii_] = (!bnd || n_ <= nmax[CS]) ? p_ : 0.f; } \
        const float s4_ = quad_sum((S[kt_][0] + S[kt_][1]) + (S[kt_][2] + S[kt_][3])), p3_ = quad_sum(S[kt_][3]); \
        const float up_ = __shfl(p3_, (lane + 48) & 63); const float cin_ = g > 0 ? up_ : wrap[CS]; wrap[CS] = up_; \
        if ((c & 3) == 0) imp[ql_ * 260 + 16 * i + 4 * kt_ + g] = s4_ + cin_; } while (0)
#define CMP_QK1B(kt_) do { s1[kt_] = (f32x4){0.f, 0.f, 0.f, 0.f}; _Pragma("unroll") for (int ks_ = 0; ks_ < 4; ++ks_) s1[kt_] = mfma16(kf[kt_][ks_], qf[1][ks_], s1[kt_]); } while (0)
              CMP_QK1B(0); CMP_PIMP(s0, 0, 0); __builtin_amdgcn_sched_barrier(0);
              CMP_QK1B(1); CMP_PIMP(s0, 0, 1); __builtin_amdgcn_sched_barrier(0);
              CMP_QK1B(2); CMP_PIMP(s0, 0, 2); __builtin_amdgcn_sched_barrier(0);
              CMP_QK1B(3); CMP_PIMP(s0, 0, 3); __builtin_amdgcn_sched_barrier(0); }
            { const bf16x8 pa = pack8(s0[0], s0[1]), pb = pack8(s0[2], s0[3]); bf16x8 vf[8];
#pragma unroll
              for (int dt = 0; dt < 8; ++dt) vf[dt] = *(const LAS bf16x8*)(slot + 16384 + dt * 2048 + vx[0]);
              __builtin_amdgcn_sched_barrier(0);
#pragma unroll
              for (int dt = 0; dt < 4; ++dt) o[0][dt] = mfma16(vf[dt], pa, o[0][dt]);
              CMP_PIMP(s1, 1, 0); __builtin_amdgcn_sched_barrier(0);
#pragma unroll
              for (int dt = 4; dt < 8; ++dt) o[0][dt] = mfma16(vf[dt], pa, o[0][dt]);
              CMP_PIMP(s1, 1, 1); __builtin_amdgcn_sched_barrier(0);
#pragma unroll
              for (int dt = 0; dt < 8; ++dt) vf[dt] = *(const LAS bf16x8*)(slot + 16384 + dt * 2048 + vx[1]);
              __builtin_amdgcn_sched_barrier(0);
#pragma unroll
              for (int dt = 0; dt < 4; ++dt) o[0][dt] = mfma16(vf[dt], pb, o[0][dt]);
              CMP_PIMP(s1, 1, 2); __builtin_amdgcn_sched_barrier(0);
#pragma unroll
              for (int dt = 4; dt < 8; ++dt) o[0][dt] = mfma16(vf[dt], pb, o[0][dt]);
              CMP_PIMP(s1, 1, 3); __builtin_amdgcn_sched_barrier(0);
              const bf16x8 qa = pack8(s1[0], s1[1]), qb = pack8(s1[2], s1[3]);
#pragma unroll
              for (int dt = 0; dt < 8; ++dt) o[1][dt] = mfma16(vf[dt], qb, o[1][dt]);
              __builtin_amdgcn_sched_barrier(0);
#pragma unroll
              for (int dt = 0; dt < 8; ++dt) vf[dt] = *(const LAS bf16x8*)(slot + 16384 + dt * 2048 + vx[0]);
#pragma unroll
              for (int dt = 0; dt < 8; ++dt) o[1][dt] = mfma16(vf[dt], qa, o[1][dt]); }
        }
#pragma unroll
        for (int cs = 0; cs < 2; ++cs) { const int ql = 8 * wave + 4 * cs + (c >> 2); store_o(OC, (size_t)b * SEQ + t0 + ql, 4 * gk + (c & 3), g, o[cs], 1.0f); }
        __syncthreads();
        const int cur = qt;
        for (int q0 = 0; q0 < ((CM == 1 || CM == 3) ? 0 : 8); q0 += 4) { unsigned key[4][4], prefix[4] = {0u, 0u, 0u, 0u};
#pragma unroll
            for (int u4 = 0; u4 < 4; ++u4) { const int ql = 8 * wave + q0 + u4;
#pragma unroll
                for (int k = 0; k < 4; ++k) { const int j = 64 * k + lane; const bool forced = (j == 0) | (j == cur) | (j == cur - 1);
                    key[u4][k] = forced ? 0xffffffffu : (j <= cur ? __builtin_bit_cast(unsigned, imp[ql * 260 + j]) + 1u : 0u); } }
            const int nk = (cur >> 6) + 1;
#define TOPK_SEARCH(NK) for (int bit = 30; bit >= TOPK_LSB; --bit) { \
                _Pragma("unroll") for (int u4 = 0; u4 < 4; ++u4) { const unsigned trial = prefix[u4] | (1u << bit); int cnt = 0; \
                    _Pragma("unroll") for (int k = 0; k < NK; ++k) cnt += __popcll(__ballot(key[u4][k] >= trial)); \
                    if (cnt >= 16) prefix[u4] = trial; } }
            if (nk == 1) { TOPK_SEARCH(1) } else if (nk == 2) { TOPK_SEARCH(2) } else if (nk == 3) { TOPK_SEARCH(3) } else { TOPK_SEARCH(4) }
#undef TOPK_SEARCH
#pragma unroll
            for (int u4 = 0; u4 < 4; ++u4) { const int ql = 8 * wave + q0 + u4; int cgt = 0; const unsigned hi = prefix[u4] | TOPK_LOWMASK;
#pragma unroll
                for (int k = 0; k < 4; ++k) cgt += __popcll(__ballot(key[u4][k] > hi));
                int need = 16 - cgt, before = 0;
#pragma unroll
                for (int k = 0; k < 4; ++k) { const bool ineq = key[u4][k] >= prefix[u4] && key[u4][k] <= hi; const unsigned long long eq = __ballot(ineq); const int rank = before + __popcll(eq & ((1ull << lane) - 1ull)); before += __popcll(eq);
                    const bool sel = (key[u4][k] > hi) || (ineq && rank < need); const int j = 64 * k + lane;
                    if (sel && j <= cur) __hip_atomic_fetch_or(tmk + 2 * j + (ql >> 5), 1u << (ql & 31), __ATOMIC_RELAXED, __HIP_MEMORY_SCOPE_WORKGROUP); } }
        }
        __syncthreads();
        if (tid < 256) { v2u w; w.x = tmk[2 * tid]; w.y = tmk[2 * tid + 1]; *((v2u*)(ws + WS_TMASK) + ((size_t)(bg * 256 + qt) * 256 + tid)) = w; }
    }
}

constexpr int SLOT8 = 16384, SELB = 4;
static_assert(2 * SELB * SLOT8 <= TMK_OFF, "sel ring");
constexpr float SM_THR8 = 8.0f;
__device__ __forceinline__ void dma_k8(LAS unsigned char* slot, const unsigned char* ksrc, int wave, int lane) {
    const unsigned row = 8u * wave + (lane >> 3), pos = lane & 7, off = row * 128u + ((pos ^ ((row ^ (row >> 1)) & 7u)) * 16u);
    __builtin_amdgcn_global_load_lds((const unsigned*)(ksrc + off), (LAS unsigned*)(slot + wave * 1024), 16, 0, 0);
}
__device__ __forceinline__ void dma_v8(LAS unsigned char* slot, const unsigned char* vsrc, int wave, int lane) {
    const unsigned d = 16u * wave + (lane >> 2), pos = lane & 3, off = d * 64u + ((pos ^ (((d >> 2) & 1u) << 1)) * 16u);
    __builtin_amdgcn_global_load_lds((const unsigned*)(vsrc + off), (LAS unsigned*)(slot + 8192 + wave * 1024), 16, 0, 0);
}
#define MFMA8_B(acc, A, B) acc = __builtin_amdgcn_mfma_scale_f32_16x16x128_f8f6f4(A, B, acc, 0, 0, 0, 0x7f7f7f7f, 0, 0x7f7f7f7f)
#define SEL_GAP() __builtin_amdgcn_sched_barrier(0)
#define MFMA8_ACC(acc, A, B) asm volatile("v_mfma_scale_f32_16x16x128_f8f6f4 %0, %1, %2, %0, %3, %3 op_sel_hi:[0,0,0]" : "+v"(acc) : "v"(A), "v"(B), "v"(0x7f7f7f7f))
__device__ __forceinline__ float max16(const f32x4 (&s)[4]) {
    float t0, t1, t2;
    asm("v_max3_f32 %0, %3, %4, %5\n v_max3_f32 %1, %6, %7, %8\n v_max3_f32 %2, %9, %10, %11\n v_max3_f32 %0, %0, %1, %2\n v_max3_f32 %1, %12, %13, %14\n v_max3_f32 %2, %15, %16, %17\n v_max3_f32 %0, %0, %1, %2\n v_max_f32 %0, %0, %18"
        : "=&v"(t0), "=&v"(t1), "=&v"(t2)
        : "v"(s[0][0]), "v"(s[0][1]), "v"(s[0][2]), "v"(s[0][3]), "v"(s[1][0]), "v"(s[1][1]), "v"(s[1][2]), "v"(s[1][3]), "v"(s[2][0]), "v"(s[2][1]), "v"(s[2][2]), "v"(s[2][3]), "v"(s[3][0]), "v"(s[3][1]), "v"(s[3][2]), "v"(s[3][3]));
    return t0;
}
template <int MODE  > __device__ __forceinline__ void p4_sel(const Args& a, LAS unsigned char* lds, int wg, int G) {
    const int tid = threadIdx.x, lane = tid & 63, wave = __builtin_amdgcn_readfirstlane(tid >> 6), c = lane & 15, g = lane >> 4;
    unsigned char* ws = a.ws; const unsigned char* q8 = ws + WS_Q8; bf16* OS = (bf16*)(ws + WS_OS);
    LAS unsigned* tmk = (LAS unsigned*)(lds + TMK_OFF);
    const int ky = (c ^ (c >> 1)) & 7, kxa = c * 128 + (((2 * g) ^ ky) << 4), kxb = c * 128 + (((2 * g + 1) ^ ky) << 4), vxo = c * 64 + ((g ^ (((c >> 2) & 1) << 1)) << 4);
    const float NINF = -__builtin_inff();
    for (int r = 0; r * G + wg < 1024; ++r) {
        int bg, qt; unit_sel(wg, r, G, bg, qt); const int b = bg >> 1, gk = bg & 1, t0 = 64 * qt, cur = qt;
        const unsigned char* ks = ws + WS_KSEL + (size_t)bg * SEQ * 128; const unsigned char* vst = ws + WS_VSELT + (size_t)bg * 256 * 8192;
        __syncthreads();
        tmk[tid] = *((const unsigned*)(ws + WS_TMASK) + ((size_t)(bg * 256 + qt) * 512 + tid));
        v8i32 qf[2]; float nmb[2], thr[2]; f32x2 lsum[2]; f32x4 o[2][8]; int tq[2];
        v8i32 pLo = {0, 0, 0, 0, 0, 0, 0, 0}, pHi = {0, 0, 0, 0, 0, 0, 0, 0}; asm volatile("" : "+v"(pLo), "+v"(pHi));
#pragma unroll
        for (int cs = 0; cs < 2; ++cs) { const int ql = 8 * wave + 4 * cs + (c >> 2); tq[cs] = t0 + ql; qf[cs] = *(const v8i32*)(q8 + ((size_t)b * SEQ + tq[cs]) * 1024 + (4 * gk + (c & 3)) * 128 + 32 * g); nmb[cs] = 0.f; thr[cs] = NINF; lsum[cs] = (f32x2){0.f, 0.f};
#pragma unroll
            for (int dt = 0; dt < 8; ++dt) o[cs][dt] = (f32x4){0.f, 0.f, 0.f, 0.f}; }
        asm volatile("" : "+v"(qf[0])); asm volatile("" : "+v"(qf[1]));
        __syncthreads();
#pragma unroll
        for (int jp = 0; jp < SELB; ++jp) if (MODE != 2 && jp <= cur) { dma_k8(lds + jp * SLOT8, ks + (size_t)jp * 64 * 128, wave, lane); dma_v8(lds + jp * SLOT8, vst + (size_t)jp * 8192, wave, lane); }
        for (int js = 0; js <= cur; js += SELB) {
            WAITV(0); RAWBAR();
#pragma unroll
            for (int jp = SELB; jp < 2 * SELB; ++jp) if (MODE != 2 && js + jp <= cur) { LAS unsigned char* sl = lds + ((js + jp) & (2 * SELB - 1)) * SLOT8; dma_k8(sl, ks + (size_t)(js + jp) * 64 * 128, wave, lane); dma_v8(sl, vst + (size_t)(js + jp) * 8192, wave, lane); }
            unsigned mws[SELB];
#pragma unroll
            for (int jj = 0; jj < SELB; ++jj) mws[jj] = tmk[2 * (js + jj) + (wave >> 2)];
            unsigned m8s[SELB];
#pragma unroll
            for (int jj = 0; jj < SELB; ++jj) { const unsigned mw = __builtin_amdgcn_readfirstlane(mws[jj]); m8s[jj] = (MODE == 1 || js + jj > cur) ? 0u : ((mw >> (8 * (wave & 3))) & 0xffu); }
#pragma unroll
          for (int jj = 0; jj < SELB; ++jj) { const int j = js + jj;
            if (m8s[jj] != 0u) {
            const LAS unsigned char* slot = lds + (j & (2 * SELB - 1)) * SLOT8; const unsigned m8 = m8s[jj];
            v8i32 kf[4];
#pragma unroll
            for (int kt = 0; kt < 4; ++kt) kf[kt] = pg8::cat8(*(const LAS bf16x8*)(slot + kt * 2048 + kxa), *(const LAS bf16x8*)(slot + kt * 2048 + kxb));
#pragma unroll
            for (int cs = 0; cs < 2; ++cs) { const unsigned nib = (m8 >> (4 * cs)) & 0xfu;
                if (nib != 0u) {
                    const bool selq = (nib >> (c >> 2)) & 1u; f32x4 s[4];
                    { const float cv = selq ? nmb[cs] : NINF; const f32x4 cacc = {cv, cv, cv, cv};
#pragma unroll
                      for (int kt = 0; kt < 4; ++kt) s[kt] = __builtin_amdgcn_mfma_scale_f32_16x16x128_f8f6f4(kf[kt], qf[cs], cacc, 0, 0, 0, 0x7f7f7f7f, 0, 0x7c7c7c7c); }
                    v8i32 vf[4];
#pragma unroll
                    for (int j2 = 0; j2 < 4; ++j2) vf[j2] = pg8::cat8(*(const LAS bf16x8*)(slot + 8192 + j2 * 2048 + vxo), *(const LAS bf16x8*)(slot + 8192 + j2 * 2048 + 1024 + vxo));
                    __builtin_amdgcn_sched_barrier(0);
                    if (j == cur) {
#pragma unroll
                        for (int kt = 0; kt < 4; ++kt)
#pragma unroll
                            for (int ii = 0; ii < 4; ++ii) { const int kp = 64 * j + 16 * kt + 4 * g + ii; s[kt][ii] = kp <= tq[cs] ? s[kt][ii] : NINF; } }
                    const float tm = max16(s);
                    if (__any(tm > thr[cs])) {
                        const float tr = xmax32(xmax16(tm)); const bool un = thr[cs] == NINF, live = tr > NINF;
                        const float d = un ? (live ? tr : 0.f) : fmaxf(tr, 0.f), alpha = __builtin_amdgcn_exp2f(-d);
                        thr[cs] = (un && !live) ? NINF : SM_THR8; nmb[cs] -= d; lsum[cs] = lsum[cs] * alpha;
#pragma unroll
                        for (int dt = 0; dt < 8; ++dt) o[cs][dt] = o[cs][dt] * alpha;
#pragma unroll
                        for (int kt = 0; kt < 4; ++kt)
#pragma unroll
                            for (int i = 0; i < 4; ++i) s[kt][i] -= d; }
#pragma unroll
                    for (int kt = 0; kt < 4; ++kt) {
#pragma unroll
                        for (int i = 0; i < 4; ++i) s[kt][i] = __builtin_amdgcn_exp2f(s[kt][i]);
                        lsum[cs] += (f32x2){s[kt][0], s[kt][1]}; lsum[cs] += (f32x2){s[kt][2], s[kt][3]};
                        int w = pLo[kt]; w = __builtin_amdgcn_cvt_pk_fp8_f32(s[kt][0], s[kt][1], w, false); w = __builtin_amdgcn_cvt_pk_fp8_f32(s[kt][2], s[kt][3], w, true); pLo[kt] = w; pHi[4 + kt] = w; }
#pragma unroll
                    for (int j2 = 0; j2 < 4; ++j2) { MFMA8_ACC(o[cs][2 * j2], vf[j2], pLo); MFMA8_ACC(o[cs][2 * j2 + 1], vf[j2], pHi); } } }
          } }
        }
        asm volatile("s_nop 15\n s_nop 15" ::: "memory");
#pragma unroll
        for (int cs = 0; cs < 2; ++cs) { const float lt = ladd32(ladd16(lsum[cs].x + lsum[cs].y)); const float inv = lt > 0.f ? 1.0f / lt : 0.f;
            if (MODE == 0) store_o(OS, (size_t)b * SEQ + tq[cs], 4 * gk + (c & 3), g, o[cs], inv); else { asm volatile("" :: "v"(inv), "v"(o[cs][0]), "v"(o[cs][7])); } }
    }
}

__device__ __forceinline__ void waitv_dyn(int n) {
    switch (n) { case 0: WAITV(0); break; case 2: WAITV(2); break; case 4: WAITV(4); break; case 6: WAITV(6); break; case 8: WAITV(8); break; case 10: WAITV(10); break; case 12: WAITV(12); break; default: WAITV(14); break; }
}
#define WIN_EXP2(S, kt_, h_) do { S[kt_][2 * (h_)] = __builtin_amdgcn_exp2f(S[kt_][2 * (h_)]); S[kt_][2 * (h_) + 1] = __builtin_amdgcn_exp2f(S[kt_][2 * (h_) + 1]); } while (0)
#define WIN_CVT(S, PN, LS, kt_, h_) do { PN[kt_] = __builtin_amdgcn_cvt_pk_fp8_f32(S[kt_][2 * (h_)], S[kt_][2 * (h_) + 1], PN[kt_], (h_) != 0); LS += (f32x2){S[kt_][2 * (h_)], S[kt_][2 * (h_) + 1]}; } while (0)
#define WIN_RARE(S, TM, CS) do { const float tr_ = xmax32(xmax16(TM)); const bool un_ = thr[CS] == NINF, live_ = tr_ > NINF; \
    const float d_ = un_ ? (live_ ? tr_ : 0.f) : fmaxf(tr_, 0.f), alpha_ = __builtin_amdgcn_exp2f(-d_); thr[CS] = (un_ && !live_) ? NINF : SM_THR8; nmb[CS] -= d_; lsum[CS] = lsum[CS] * alpha_; \
    _Pragma("unroll") for (int dt_ = 0; dt_ < 8; ++dt_) o[CS][dt_] = o[CS][dt_] * alpha_; \
    _Pragma("unroll") for (int kt_ = 0; kt_ < 4; ++kt_) _Pragma("unroll") for (int i_ = 0; i_ < 4; ++i_) S[kt_][i_] -= d_; } while (0)
__device__ __forceinline__ void p5_win(const Args& a, LAS unsigned char* lds, int wg, int G) {
    const int tid = threadIdx.x, lane = tid & 63, wave = __builtin_amdgcn_readfirstlane(tid >> 6), c = lane & 15, g = lane >> 4;
    unsigned char* ws = a.ws; const unsigned char* q8 = ws + WS_Q8; bf16* OW = (bf16*)(ws + WS_OW);
    const int ky = (c ^ (c >> 1)) & 7, kxa = c * 128 + (((2 * g) ^ ky) << 4), kxb = c * 128 + (((2 * g + 1) ^ ky) << 4), vxo = c * 64 + ((g ^ (((c >> 2) & 1) << 1)) << 4);
    const float NINF = -__builtin_inff();
    for (int u = wg; u < 1024; u += G) {
        const int bg = u >> 8, x = u & 255, qt = (G == 256) ? ((x & 7) * 32 + (x >> 3)) : x, b = bg >> 1, gk = bg & 1, t0 = 64 * qt;
        const unsigned char* kw = ws + WS_KWIN + (size_t)bg * SEQ * 128; const unsigned char* vwt = ws + WS_VWINT + (size_t)bg * 256 * 8192;
        v8i32 qf[2]; float nmb[2], thr[2]; f32x2 lsum[2]; f32x4 o[2][8]; int tq[2];
        v8i32 pLo0 = {0, 0, 0, 0, 0, 0, 0, 0}, pHi0 = {0, 0, 0, 0, 0, 0, 0, 0}, pLo1 = {0, 0, 0, 0, 0, 0, 0, 0}, pHi1 = {0, 0, 0, 0, 0, 0, 0, 0};
        asm volatile("" : "+v"(pLo0), "+v"(pHi0)); asm volatile("" : "+v"(pLo1), "+v"(pHi1));
#pragma unroll
        for (int cs = 0; cs < 2; ++cs) { const int ql = 8 * wave + 4 * cs + (c >> 2); tq[cs] = t0 + ql; qf[cs] = *(const v8i32*)(q8 + ((size_t)b * SEQ + tq[cs]) * 1024 + (4 * gk + (c & 3)) * 128 + 32 * g); nmb[cs] = 0.f; thr[cs] = NINF; lsum[cs] = (f32x2){0.f, 0.f};
#pragma unroll
            for (int dt = 0; dt < 8; ++dt) o[cs][dt] = (f32x4){0.f, 0.f, 0.f, 0.f}; }
        const int j0 = qt >= 8 ? qt - 8 : 0, nb = qt - j0 + 1, nfirst = nb < 8 ? nb : 8;
        asm volatile("" : "+v"(qf[0])); asm volatile("" : "+v"(qf[1]));
        __syncthreads();
        for (int i = 0; i < nfirst; ++i) { LAS unsigned char* sl = lds + ((j0 + i) & 7) * SLOT8; dma_k8(sl, kw + (size_t)(j0 + i) * 64 * 128, wave, lane); dma_v8(sl, vwt + (size_t)(j0 + i) * 8192, wave, lane); }
        int nissued = nfirst;
        for (int i0 = 0; i0 < nb; i0 += 3) {
            const int iend = i0 + 3 < nb ? i0 + 3 : nb, left = nissued - iend;
            waitv_dyn(left > 0 ? 2 * left : 0); RAWBAR();
            if (i0 == 3 && nb == 9) { LAS unsigned char* sl = lds + ((j0 + 8) & 7) * SLOT8; dma_k8(sl, kw + (size_t)(j0 + 8) * 64 * 128, wave, lane); dma_v8(sl, vwt + (size_t)(j0 + 8) * 8192, wave, lane); nissued = 9; }
            for (int i = i0; i < iend; ++i) { const int j = j0 + i;
                const LAS unsigned char* slot = lds + (j & 7) * SLOT8;
                f32x4 s0[4], s1[4];
                { v8i32 kf[4];
#pragma unroll
                  for (int kt = 0; kt < 4; ++kt) kf[kt] = pg8::cat8(*(const LAS bf16x8*)(slot + kt * 2048 + kxa), *(const LAS bf16x8*)(slot + kt * 2048 + kxb));
                  const f32x4 c0 = {nmb[0], nmb[0], nmb[0], nmb[0]}, c1 = {nmb[1], nmb[1], nmb[1], nmb[1]};
                  __builtin_amdgcn_sched_barrier(0);
#pragma unroll
                  for (int kt = 0; kt < 4; ++kt) s0[kt] = __builtin_amdgcn_mfma_scale_f32_16x16x128_f8f6f4(kf[kt], qf[0], c0, 0, 0, 0, 0x7f7f7f7f, 0, 0x7c7c7c7c);
#pragma unroll
                  for (int kt = 0; kt < 4; ++kt) s1[kt] = __builtin_amdgcn_mfma_scale_f32_16x16x128_f8f6f4(kf[kt], qf[1], c1, 0, 0, 0, 0x7f7f7f7f, 0, 0x7c7c7c7c); }
                v8i32 vf[4];
#pragma unroll
                for (int j2 = 0; j2 < 4; ++j2) vf[j2] = pg8::cat8(*(const LAS bf16x8*)(slot + 8192 + j2 * 2048 + vxo), *(const LAS bf16x8*)(slot + 8192 + j2 * 2048 + 1024 + vxo));
                __builtin_amdgcn_sched_barrier(0);
                if (j == qt || j + 8 == qt) {
                    int l0 = tq[0] - 64 * j - 4 * g, l1 = tq[1] - 64 * j - 4 * g; asm volatile("" : "+v"(l0), "+v"(l1));
#pragma unroll
                    for (int kt = 0; kt < 4; ++kt)
#pragma unroll
                        for (int ii = 0; ii < 4; ++ii) { s0[kt][ii] = ((unsigned)(l0 - (16 * kt + ii)) < 512u) ? s0[kt][ii] : NINF; s1[kt][ii] = ((unsigned)(l1 - (16 * kt + ii)) < 512u) ? s1[kt][ii] : NINF; } }
                int pn0[4] = {0, 0, 0, 0}, pn1[4] = {0, 0, 0, 0}; f32x2 ls0 = {0.f, 0.f}, ls1 = {0.f, 0.f};
                { const float tm = __builtin_fmaxf(__builtin_fmaxf(__builtin_fmaxf(__builtin_fmaxf(s0[0][0], s0[0][1]), __builtin_fmaxf(s0[0][2], s0[0][3])), __builtin_fmaxf(__builtin_fmaxf(s0[1][0], s0[1][1]), __builtin_fmaxf(s0[1][2], s0[1][3]))),
                                                     __builtin_fmaxf(__builtin_fmaxf(__builtin_fmaxf(s0[2][0], s0[2][1]), __builtin_fmaxf(s0[2][2], s0[2][3])), __builtin_fmaxf(__builtin_fmaxf(s0[3][0], s0[3][1]), __builtin_fmaxf(s0[3][2], s0[3][3]))));
                  if (__any(tm > thr[0])) WIN_RARE(s0, tm, 0); }
#pragma unroll
                for (int kt = 0; kt < 4; ++kt) { WIN_EXP2(s0, kt, 0); WIN_EXP2(s0, kt, 1); WIN_CVT(s0, pn0, ls0, kt, 0); WIN_CVT(s0, pn0, ls0, kt, 1); }
#pragma unroll
                for (int kt = 0; kt < 4; ++kt) { pLo0[kt] = pn0[kt]; pHi0[4 + kt] = pn0[kt]; }
                lsum[0] += ls0;
                { const float tm = __builtin_fmaxf(__builtin_fmaxf(__builtin_fmaxf(__builtin_fmaxf(s1[0][0], s1[0][1]), __builtin_fmaxf(s1[0][2], s1[0][3])), __builtin_fmaxf(__builtin_fmaxf(s1[1][0], s1[1][1]), __builtin_fmaxf(s1[1][2], s1[1][3]))),
                                                     __builtin_fmaxf(__builtin_fmaxf(__builtin_fmaxf(s1[2][0], s1[2][1]), __builtin_fmaxf(s1[2][2], s1[2][3])), __builtin_fmaxf(__builtin_fmaxf(s1[3][0], s1[3][1]), __builtin_fmaxf(s1[3][2], s1[3][3]))));
                  if (__any(tm > thr[1])) WIN_RARE(s1, tm, 1); }
                __builtin_amdgcn_sched_barrier(0);
                MFMA8_B(o[0][0], vf[0], pLo0); WIN_EXP2(s1, 0, 0); SEL_GAP();
                MFMA8_B(o[0][1], vf[0], pHi0); WIN_EXP2(s1, 0, 1); WIN_CVT(s1, pn1, ls1, 0, 0); SEL_GAP();
                MFMA8_B(o[0][2], vf[1], pLo0); WIN_EXP2(s1, 1, 0); WIN_CVT(s1, pn1, ls1, 0, 1); SEL_GAP();
                MFMA8_B(o[0][3], vf[1], pHi0); WIN_EXP2(s1, 1, 1); WIN_CVT(s1, pn1, ls1, 1, 0); SEL_GAP();
                MFMA8_B(o[0][4], vf[2], pLo0); WIN_EXP2(s1, 2, 0); WIN_CVT(s1, pn1, ls1, 1, 1); SEL_GAP();
                MFMA8_B(o[0][5], vf[2], pHi0); WIN_EXP2(s1, 2, 1); WIN_CVT(s1, pn1, ls1, 2, 0); SEL_GAP();
                MFMA8_B(o[0][6], vf[3], pLo0); WIN_EXP2(s1, 3, 0); WIN_CVT(s1, pn1, ls1, 2, 1); SEL_GAP();
                MFMA8_B(o[0][7], vf[3], pHi0); WIN_EXP2(s1, 3, 1); WIN_CVT(s1, pn1, ls1, 3, 0); SEL_GAP();
                WIN_CVT(s1, pn1, ls1, 3, 1);
#pragma unroll
                for (int kt = 0; kt < 4; ++kt) { pLo1[kt] = pn1[kt]; pHi1[4 + kt] = pn1[kt]; }
                lsum[1] += ls1;
#pragma unroll
                for (int j2 = 0; j2 < 4; ++j2) { MFMA8_B(o[1][2 * j2], vf[j2], pLo1); MFMA8_B(o[1][2 * j2 + 1], vf[j2], pHi1); }
            }
        }
#pragma unroll
        for (int cs = 0; cs < 2; ++cs) { const float lt = ladd32(ladd16(lsum[cs].x + lsum[cs].y)); const float inv = lt > 0.f ? 1.0f / lt : 0.f;
            store_o(OW, (size_t)b * SEQ + tq[cs], 4 * gk + (c & 3), g, o[cs], inv); }
    }
}

__device__ __forceinline__ void gelu4(v2u w, float (&o)[4]) {
    const pg8::f32x2 a = pg8::gelu_pk((pg8::f32x2){bflo(w.x), bfhi(w.x)}), b = pg8::gelu_pk((pg8::f32x2){bflo(w.y), bfhi(w.y)}); o[0] = a.x; o[1] = a.y; o[2] = b.x; o[3] = b.y;
}
__device__ __forceinline__ void p6_mix(const Args& a, LAS unsigned char* lds, int wg, int G) {
    const int tid = threadIdx.x, lane = tid & 63, wave = __builtin_amdgcn_readfirstlane(tid >> 6), c = lane & 15, g = lane >> 4;
    unsigned char* ws = a.ws; const bf16* proj = (const bf16*)(ws + WS_PROJ); bf16* STG = (bf16*)(ws + WS_XN)  ; unsigned char* MIX = (unsigned char*)(ws + WS_QR)  ;
    { const float* gn = (const float*)a.in[8]; const float* bs = (const float*)a.in[10]; const float* og = (const float*)a.in[12]; const bf16* wm = (const bf16*)(ws + WS_WM);
      for (int u = wg; u < 256; u += G) { const size_t m0 = (size_t)(u >> 7) * SEQ + 128 * (u & 127); const int t = 16 * wave + c; float ssum = 0.f;
        const int sr = tid >> 4, c0 = 8 * (tid & 15);
        v4u vv[4];
#pragma unroll
        for (int ps = 0; ps < 4; ++ps) vv[ps] = *(const v4u*)(proj + (m0 + 32 * ps + sr) * NP1 + COL_V + c0);
        for (int hg = 0; hg < 8; ++hg) { LAS bf16* buf = (LAS bf16*)lds + (hg & 1) * (128 * 136);
            const f32x4 gna = *(const f32x4*)(gn + hg * 128 + c0), gnb = *(const f32x4*)(gn + hg * 128 + c0 + 4);
            v4u uq[4]; bf16x8 bfr[4];
#pragma unroll
            for (int q = 0; q < 4; ++q) uq[q] = *(const v4u*)(proj + (m0 + t) * NP1 + COL_U + hg * 128 + 32 * g + 8 * q);
#pragma unroll
            for (int ks = 0; ks < 4; ++ks) bfr[ks] = *(const bf16x8*)(wm + ((size_t)hg * 128 + t) * 128 + 32 * ks + 8 * g);
            const float bst = bs[hg * 128 + t];
#pragma unroll
            for (int ps = 0; ps < 4; ++ps) { const int s = 32 * ps + sr; float x[8]; float xa[4], xb[4];
                gelu4((v2u){vv[ps].x, vv[ps].y}, xa); gelu4((v2u){vv[ps].z, vv[ps].w}, xb);
#pragma unroll
                for (int j = 0; j < 4; ++j) { x[j] = xa[j]; x[4 + j] = xb[j]; }
                float ss = 0.f;
#pragma unroll
                for (int j = 0; j < 8; ++j) ss += x[j] * x[j];
                ss = row16_sum(ss);
                const float rs = __builtin_amdgcn_rsqf(ss * (1.0f / 128.0f) + EPS);
#pragma unroll
                for (int j = 0; j < 8; ++j) buf[(c0 + j) * 136 + (s ^ c0)] = (bf16)f2bf(x[j] * rs * (j < 4 ? gna[j] : gnb[j - 4])); }
            if (hg < 7) {
#pragma unroll
                for (int ps = 0; ps < 4; ++ps) vv[ps] = *(const v4u*)(proj + (m0 + 32 * ps + sr) * NP1 + COL_V + (hg + 1) * 128 + c0); }
            __syncthreads();
            f32x4 acc[8];
#pragma unroll
            for (int ct = 0; ct < 8; ++ct) acc[ct] = (f32x4){0.f, 0.f, 0.f, 0.f};
#pragma unroll
            for (int ks = 0; ks < 4; ++ks) { if (ks <= (wave >> 1)) {
#pragma unroll
                for (int ct = 0; ct < 8; ++ct) { const int row = 32 * (c >> 2) + 4 * ct + (c & 3); const bf16x8 af = *(const LAS bf16x8*)(buf + row * 136 + ((32 * ks + 8 * g) ^ (8 * ((row >> 3) & 15)))); acc[ct] = mfma16(af, bfr[ks], acc[ct]); } } }
#pragma unroll
            for (int q = 0; q < 4; ++q) { v4u w4;
#pragma unroll
                for (int hf = 0; hf < 2; ++hf) { const int ct = 2 * q + hf; float gu[4]; gelu4(hf ? (v2u){uq[q].z, uq[q].w} : (v2u){uq[q].x, uq[q].y}, gu);
                    const float o0 = gu[0] * (acc[ct][0] + bst), o1 = gu[1] * (acc[ct][1] + bst), o2 = gu[2] * (acc[ct][2] + bst), o3 = gu[3] * (acc[ct][3] + bst);
                    ssum += (o0 * o0 + o1 * o1) + (o2 * o2 + o3 * o3); if (hf) { w4.z = pk2(o0, o1); w4.w = pk2(o2, o3); } else { w4.x = pk2(o0, o1); w4.y = pk2(o2, o3); } }
                *(v4u*)(STG + (m0 + t) * 1024 + hg * 128 + 32 * g + 8 * q) = w4; } }
        ssum = ladd32(ladd16(ssum));
        LAS float* rsl = (LAS float*)lds + 2 * 128 * 136 / 2;
        if (g == 0) rsl[t] = __builtin_amdgcn_rsqf(ssum * (1.0f / 1024.0f) + EPS);
        asm volatile("s_waitcnt vmcnt(0)" ::: "memory");
        __syncthreads();
        { const int tr = tid >> 2, q4 = tid & 3; const float rs = rsl[tr];
#pragma unroll 4
          for (int st = 0; st < 16; ++st) { const int ch = 64 * st + 16 * q4; const bf16* sp = STG + (m0 + tr) * 1024 + ch; const v4u xa = *(const v4u*)sp, xb = *(const v4u*)(sp + 8);
              const f32x4 g0 = *(const f32x4*)(og + ch), g1 = *(const f32x4*)(og + ch + 4), g2 = *(const f32x4*)(og + ch + 8), g3 = *(const f32x4*)(og + ch + 12); v4u w;
              w.x = pg8::pk4_fp8(bflo(xa.x) * rs * g0[0], bfhi(xa.x) * rs * g0[1], bflo(xa.y) * rs * g0[2], bfhi(xa.y) * rs * g0[3]); w.y = pg8::pk4_fp8(bflo(xa.z) * rs * g1[0], bfhi(xa.z) * rs * g1[1], bflo(xa.w) * rs * g1[2], bfhi(xa.w) * rs * g1[3]);
              w.z = pg8::pk4_fp8(bflo(xb.x) * rs * g2[0], bfhi(xb.x) * rs * g2[1], bflo(xb.y) * rs * g2[2], bfhi(xb.y) * rs * g2[3]); w.w = pg8::pk4_fp8(bflo(xb.z) * rs * g3[0], bfhi(xb.z) * rs * g3[1], bflo(xb.w) * rs * g3[2], bfhi(xb.w) * rs * g3[3]);
              *(v4u*)(MIX + (m0 + tr) * DM + 1024 + ch) = w; } }
        __syncthreads(); } }
    { const bf16* OC = (const bf16*)(ws + WS_OC); const bf16* OS = (const bf16*)(ws + WS_OS); const bf16* OW = (const bf16*)(ws + WS_OW); const float* ng = (const float*)a.in[11];
      const int h = lane >> 3, d0 = (lane & 7) * 16;
      const f32x4 gA = *(const f32x4*)(ng + h * 128 + d0), gB = *(const f32x4*)(ng + h * 128 + d0 + 4), gC = *(const f32x4*)(ng + h * 128 + d0 + 8), gD = *(const f32x4*)(ng + h * 128 + d0 + 12);
      const int NW2 = G * NWAVES;
      for (int m = wg * NWAVES + wave; m < MTOK; m += 2 * NW2) { v4u x[2][2], y[2][2], z[2][2]; unsigned gw[2][3];
#pragma unroll
        for (int q = 0; q < 2; ++q) { const int mm = m + q * NW2; const size_t off = (size_t)mm * 1024 + h * 128 + d0; const bf16* gp = (const bf16*)(ws + WS_GATES) + (size_t)mm * 32 + h * 3;
            gw[q][0] = gp[0]; gw[q][1] = gp[1]; gw[q][2] = gp[2];
#pragma unroll
            for (int hf = 0; hf < 2; ++hf) { x[q][hf] = *(const v4u*)(OC + off + 8 * hf); y[q][hf] = *(const v4u*)(OS + off + 8 * hf); z[q][hf] = *(const v4u*)(OW + off + 8 * hf); } }
#pragma unroll
        for (int q = 0; q < 2; ++q) { const int mm = m + q * NW2; const float g0 = sigmoidf(bf2f(gw[q][0])), g1 = sigmoidf(bf2f(gw[q][1])), g2 = sigmoidf(bf2f(gw[q][2])); float o[16]; float ss = 0.f;
#pragma unroll
            for (int hf = 0; hf < 2; ++hf)
#pragma unroll
                for (int j = 0; j < 4; ++j) { const float lo = g0 * bflo(x[q][hf][j]) + g1 * bflo(y[q][hf][j]) + g2 * bflo(z[q][hf][j]), hi = g0 * bfhi(x[q][hf][j]) + g1 * bfhi(y[q][hf][j]) + g2 * bfhi(z[q][hf][j]); o[8 * hf + 2 * j] = lo; o[8 * hf + 2 * j + 1] = hi; ss += lo * lo + hi * hi; }
            const float rs = __builtin_amdgcn_rsqf(wave_sum_v(ss) * (1.0f / 1024.0f) + EPS);
            v4u w8; w8.x = pg8::pk4_fp8(o[0] * rs * gA[0], o[1] * rs * gA[1], o[2] * rs * gA[2], o[3] * rs * gA[3]); w8.y = pg8::pk4_fp8(o[4] * rs * gB[0], o[5] * rs * gB[1], o[6] * rs * gB[2], o[7] * rs * gB[3]);
            w8.z = pg8::pk4_fp8(o[8] * rs * gC[0], o[9] * rs * gC[1], o[10] * rs * gC[2], o[11] * rs * gC[3]); w8.w = pg8::pk4_fp8(o[12] * rs * gD[0], o[13] * rs * gD[1], o[14] * rs * gD[2], o[15] * rs * gD[3]);
            *(v4u*)(MIX + (size_t)mm * DM + h * 128 + d0) = w8; } } }
}

__device__ __forceinline__ void unpack8_fp8(v2u x, float (&o)[8]) {
#pragma unroll
    for (int h = 0; h < 2; ++h) { const int w = (int)(h ? x.y : x.x); const auto lo = __builtin_amdgcn_cvt_pk_f32_fp8(w, false), hi = __builtin_amdgcn_cvt_pk_f32_fp8(w, true); o[4 * h] = lo[0]; o[4 * h + 1] = lo[1]; o[4 * h + 2] = hi[0]; o[4 * h + 3] = hi[1]; }
}
__device__ __forceinline__ void p_conv(const Args& a, int wg, int G) {
    unsigned char* ws = a.ws; const unsigned char* AH = (const unsigned char*)(ws + WS_AH); unsigned char* HM = (unsigned char*)(ws + WS_HMID);
    const float* cw = (const float*)a.in[16]; const float* cb = (const float*)a.in[17];
    constexpr int TB = 32, NCG = DFF / 8, NIT = (MTOK / TB) * NCG;
    for (int it = wg * NTHR + threadIdx.x; it < NIT; it += G * NTHR) { const int tb = it / NCG, cg = it - tb * NCG, n0 = 8 * cg, t0 = tb * TB;
        f32x2 w0[2][4], w1[2][4], w2[2][4], bb[2][4], p2[2][4], p1[2][4];
#pragma unroll
        for (int hf = 0; hf < 2; ++hf)
#pragma unroll
            for (int q = 0; q < 2; ++q) { const int n = n0 + hf * DFF + 4 * q; const f32x4 a0 = *(const f32x4*)(cw + n), a1 = *(const f32x4*)(cw + DFF2 + n), a2 = *(const f32x4*)(cw + 2 * DFF2 + n), ab = *(const f32x4*)(cb + n);
                w0[hf][2 * q] = (f32x2){a0[0], a0[1]}; w0[hf][2 * q + 1] = (f32x2){a0[2], a0[3]}; w1[hf][2 * q] = (f32x2){a1[0], a1[1]}; w1[hf][2 * q + 1] = (f32x2){a1[2], a1[3]};
                w2[hf][2 * q] = (f32x2){a2[0], a2[1]}; w2[hf][2 * q + 1] = (f32x2){a2[2], a2[3]}; bb[hf][2 * q] = (f32x2){ab[0], ab[1]}; bb[hf][2 * q + 1] = (f32x2){ab[2], ab[3]}; }
#pragma unroll
        for (int hf = 0; hf < 2; ++hf) { v2u x2 = (v2u){0u, 0u}, x1 = x2;
            if ((t0 & (SEQ - 1)) >= 2) { x2 = *(const v2u*)(AH + (size_t)(t0 - 2) * DFF2 + n0 + hf * DFF); x1 = *(const v2u*)(AH + (size_t)(t0 - 1) * DFF2 + n0 + hf * DFF); }
            p2[hf][0] = __builtin_amdgcn_cvt_pk_f32_fp8((int)x2.x, false); p2[hf][1] = __builtin_amdgcn_cvt_pk_f32_fp8((int)x2.x, true); p2[hf][2] = __builtin_amdgcn_cvt_pk_f32_fp8((int)x2.y, false); p2[hf][3] = __builtin_amdgcn_cvt_pk_f32_fp8((int)x2.y, true);
            p1[hf][0] = __builtin_amdgcn_cvt_pk_f32_fp8((int)x1.x, false); p1[hf][1] = __builtin_amdgcn_cvt_pk_f32_fp8((int)x1.x, true); p1[hf][2] = __builtin_amdgcn_cvt_pk_f32_fp8((int)x1.y, false); p1[hf][3] = __builtin_amdgcn_cvt_pk_f32_fp8((int)x1.y, true); }
        for (int tbb = t0; tbb < t0 + TB; tbb += 8) {
            v2u raw[8][2];
#pragma unroll
            for (int k = 0; k < 8; ++k)
#pragma unroll
                for (int hf = 0; hf < 2; ++hf) raw[k][hf] = *(const v2u*)(AH + (size_t)(tbb + k) * DFF2 + n0 + hf * DFF);
#pragma unroll
            for (int k = 0; k < 8; ++k) { f32x2 cu[2][4], acc[2][4];
#pragma unroll
                for (int hf = 0; hf < 2; ++hf) { cu[hf][0] = __builtin_amdgcn_cvt_pk_f32_fp8((int)raw[k][hf].x, false); cu[hf][1] = __builtin_amdgcn_cvt_pk_f32_fp8((int)raw[k][hf].x, true);
                    cu[hf][2] = __builtin_amdgcn_cvt_pk_f32_fp8((int)raw[k][hf].y, false); cu[hf][3] = __builtin_amdgcn_cvt_pk_f32_fp8((int)raw[k][hf].y, true);
#pragma unroll
                    for (int p = 0; p < 4; ++p) acc[hf][p] = __builtin_elementwise_fma(w2[hf][p], cu[hf][p], __builtin_elementwise_fma(w1[hf][p], p1[hf][p], __builtin_elementwise_fma(w0[hf][p], p2[hf][p], bb[hf][p]))); }
                f32x2 r[4];
                f32x2 d[4], gu[4];
#pragma unroll
                for (int p = 0; p < 4; ++p) { const f32x2 e = acc[0][p] * -1.4426950408889634f; d[p].x = __builtin_amdgcn_exp2f(e.x); d[p].y = __builtin_amdgcn_exp2f(e.y); gu[p] = acc[0][p] * acc[1][p]; }
#pragma unroll
                for (int p = 0; p < 4; ++p) { d[p] = d[p] + 1.0f; }
#pragma unroll
                for (int p = 0; p < 4; ++p) { f32x2 sg; sg.x = __builtin_amdgcn_rcpf(d[p].x); sg.y = __builtin_amdgcn_rcpf(d[p].y); r[p] = gu[p] * sg; }
                v2u w; w.x = pg8::pk4_fp8(r[0].x, r[0].y, r[1].x, r[1].y); w.y = pg8::pk4_fp8(r[2].x, r[2].y, r[3].x, r[3].y); *(v2u*)(HM + (size_t)(tbb + k) * DFF + n0) = w;
#pragma unroll
                for (int hf = 0; hf < 2; ++hf)
#pragma unroll
                    for (int p = 0; p < 4; ++p) { p2[hf][p] = p1[hf][p]; p1[hf][p] = cu[hf][p]; } } } }
}

__device__ __forceinline__ void p_final(const Args& a, int wg, int G) {
    const int lane = threadIdx.x & 63, wave = threadIdx.x >> 6; const float* fg = (const float*)a.in[19]; const bf16* h2 = (const bf16*)(a.ws + WS_H2BF);
    const int NW = G * NWAVES;
    for (int m = wg * NWAVES + wave; m < MTOK; m += 2 * NW) {
        v4u r[2][4]; const bool two = m + NW < MTOK;
#pragma unroll
        for (int q = 0; q < 2; ++q) { const v4u* xr = (const v4u*)(h2 + (size_t)(q && two ? m + NW : m) * DM) + lane;
#pragma unroll
            for (int j = 0; j < 4; ++j) r[q][j] = xr[64 * j]; }
#pragma unroll
        for (int q = 0; q < 2; ++q) { if (q && !two) break; const int mm = m + q * NW; float v[32]; float s = 0.f;
#pragma unroll
            for (int j = 0; j < 4; ++j)
#pragma unroll
                for (int k = 0; k < 4; ++k) { v[8 * j + 2 * k] = bflo(r[q][j][k]); v[8 * j + 2 * k + 1] = bfhi(r[q][j][k]); s += v[8 * j + 2 * k] * v[8 * j + 2 * k] + v[8 * j + 2 * k + 1] * v[8 * j + 2 * k + 1]; }
            const float rs = 1.0f / sqrtf(wave_sum(s) * (1.0f / DM) + EPS);
#pragma unroll
            for (int j = 0; j < 4; ++j) { const int c0 = 8 * (lane + 64 * j); const f32x4 ga = *(const f32x4*)(fg + c0), gb = *(const f32x4*)(fg + c0 + 4); f32x4* o = (f32x4*)(a.out + (size_t)mm * DM + c0);
                o[0] = (f32x4){v[8 * j] * rs * ga[0], v[8 * j + 1] * rs * ga[1], v[8 * j + 2] * rs * ga[2], v[8 * j + 3] * rs * ga[3]};
                o[1] = (f32x4){v[8 * j + 4] * rs * gb[0], v[8 * j + 5] * rs * gb[1], v[8 * j + 6] * rs * gb[2], v[8 * j + 7] * rs * gb[3]}; } } }
}

constexpr int NPHASE = 14;
#ifndef PROBE_DUP
#define PROBE_DUP 0
#endif
#ifndef PROBE_SEL
#define PROBE_P3 0
#define PROBE_SEL 0
#endif
#ifndef PROBE_G3
#define PROBE_G3 0
#endif
__global__ void __launch_bounds__(NTHR, 2) nsa_layer_fwd(Args a) {
    extern __shared__ __attribute__((aligned(16))) unsigned char lds_raw[];
    LAS unsigned char* lds = (LAS unsigned char*)lds_raw;
    volatile LAS unsigned* MISC = (volatile LAS unsigned*)(lds + MISC_OFF);
    const int tid = threadIdx.x, G = gridDim.x, wg = blockIdx.x;
    if (tid < 32) MISC[tid] = 0u;
    __syncthreads();
    unsigned char* ws = a.ws; unsigned* ctl = (unsigned*)(ws + WS_CTL);
    const int lo = a.ph_lo, hi = a.ph_hi;
    XcdBarrier bar; bar.bar = ctl + CW_BAR + a.li * XCD_BAR_WORDS; bar.x = 0; bar.st = MISC + 8;
    if (hi - lo > 1) bar = xcd_barrier_post(ctl + CW_BAR + a.li * XCD_BAR_WORDS, MISC + 8);
#define IN(k) (lo <= (k) && (k) < hi)
#define SEAM(k) do { if ((k) != 4 && (k) != 10 && (k) != 11 && IN(k) && IN((k) + 1)) xcd_barrier(bar); } while (0)
    bf16* XN = (bf16*)(ws + WS_XN); bf16* PROJ = (bf16*)(ws + WS_PROJ); bf16* H1B = (bf16*)(ws + WS_H1B); bf16* AH = (bf16*)(ws + WS_AH); bf16* HMID = (bf16*)(ws + WS_HMID);
    float* rowss = (float*)ctl + CW_ROWSS;

#define PH(k, ...) do { if (IN(k)) { __VA_ARGS__ if ((PROBE_DUP >> (k)) & 1) { __VA_ARGS__ } } SEAM(k); } while (0)
    PH(0, { p0_prologue(a, lds, wg, G); });
    PH(1, { { pg8::Gemm gm{XN, (const bf16*)(ws + WS_WIN), MTOK, NP1A, DM}; pg8::StaticOrder S; S.init(MTOK, NP1A, G, wg);
              pg8::EpiBf16<0, true> E{PROJ, NP1, nullptr, 0, 0, 1.f}; pg8::gemm_phase<pg8::EpiBf16<0, true>, pg8::StaticOrder, true, true>(lds, gm, S, E); }
            { pg8::Gemm gm{(const bf16*)(ws + WS_XN8), (const bf16*)(ws + WS_WIN8), MTOK, NP1 - NP1A, DM / 2}; pg8::StaticOrder S; S.init(MTOK, NP1 - NP1A, G, wg);
              pg8::EpiBf16<0, true> E{PROJ + NP1A, NP1, nullptr, NP1 - NP1A, 0, 1.0f / W8SCALE}; pg8::gemm_phase<pg8::EpiBf16<0, true>, pg8::StaticOrder, true, true, true>(lds, gm, S, E); }
            p1_gates(a, wg, G); });
    PH(2, { p2_prep(a, lds, wg, G); });
    if (IN(3) && PROBE_P3) { if (PROBE_P3 == 1) p3_cmp<1>(a, lds, wg, G); else if (PROBE_P3 == 2) p3_cmp<2>(a, lds, wg, G); else if (PROBE_P3 == 3) p3_cmp<3>(a, lds, wg, G); else p5_win(a, lds, wg, G); xcd_barrier(bar); }
    PH(3, { p3_cmp<0>(a, lds, wg, G); p5_win(a, lds, wg, G); });
    PH(4, { p4_sel<0>(a, lds, wg, G); });
    if (IN(4) && PROBE_SEL) { xcd_barrier(bar); if (PROBE_SEL == 1) p4_sel<1>(a, lds, wg, G); else p4_sel<2>(a, lds, wg, G); xcd_barrier(bar); }
    if (IN(4) && IN(6)) xcd_barrier(bar);
    PH(6, { p6_mix(a, lds, wg, G); });
    PH(7, { pg8::Gemm gm{(const bf16*)(ws + WS_QR), (const bf16*)(ws + WS_WOUT), MTOK, DM, DM / 2}; pg8::StaticOrder S; S.init(MTOK, DM, G, wg);
        pg8::EpiStream<true, true, true> E{(const float*)a.in[0], nullptr, (bf16*)(ws + WS_H1BF), (unsigned char*)H1B, rowss, DM, 1.0f / W8SCALE};
        pg8::gemm_phase<pg8::EpiStream<true, true, true>, pg8::StaticOrder, true, true, true>(lds, gm, S, E); });
    PH(8, { pg8::Gemm gm{H1B, (const bf16*)(ws + WS_WUP), MTOK, DFF2, DM / 2}; pg8::StaticOrder S; S.init(MTOK, DFF2, G, wg);
        pg8::EpiScaleT<true> E{AH, DFF2, rowss, 1.0f / DM, EPS, 1.0f / W8SCALE}; pg8::gemm_phase<pg8::EpiScaleT<true>, pg8::StaticOrder, true, true, true>(lds, gm, S, E); });
    if (IN(8) && PROBE_G3) { xcd_barrier(bar); pg8::Gemm gm{H1B, (const bf16*)(ws + WS_WUP), MTOK, DFF2, DM / 2}; pg8::StaticOrder S; S.init(MTOK, DFF2, G, wg); pg8::EpiNull E{nullptr}; pg8::gemm_phase<pg8::EpiNull, pg8::StaticOrder, true, true, true>(lds, gm, S, E); xcd_barrier(bar); }
    PH(9, { p_conv(a, wg, G); });
    PH(12, { pg8::Gemm gm{HMID, (const bf16*)(ws + WS_WDN), MTOK, DM, DFF / 2}; pg8::StaticOrder S; S.init(MTOK, DM, G, wg);
        pg8::EpiStream<false, false, false> E{nullptr, (const bf16*)(ws + WS_H1BF), (bf16*)(ws + WS_H2BF), nullptr, nullptr, DM, 1.0f / W8SCALE};
        pg8::gemm_phase<pg8::EpiStream<false, false, false>, pg8::StaticOrder, true, true, true>(lds, gm, S, E); });
    PH(13, { p_final(a, wg, G); });
#undef PH
#undef IN
#undef SEAM
}

#ifndef MK_N_LAUNCHES
#define MK_N_LAUNCHES 1
#endif
extern "C" void kernel_launch(void* const* d_in, const int* in_sizes, int n_in, void* d_out, int out_size, void* d_ws, size_t ws_size, hipStream_t stream) {
    static int grid = 0;
    if (grid == 0) {
        if (n_in != 20 || out_size != MTOK * DM || ws_size < WS_END2) { fprintf(stderr, "kernel_launch: unexpected shapes (n_in %d, out %d, ws %zu)\n", n_in, out_size, ws_size); grid = -1; return; }
        int dev = 0, cus = 0, per_cu = 0;
        if (hipGetDevice(&dev) != hipSuccess || hipDeviceGetAttribute(&cus, hipDeviceAttributeMultiprocessorCount, dev) != hipSuccess) { grid = -1; return; }
        if (hipFuncSetAttribute((const void*)nsa_layer_fwd, hipFuncAttributeMaxDynamicSharedMemorySize, LDS_BYTES) != hipSuccess) { fprintf(stderr, "kernel_launch: hipFuncSetAttribute failed\n"); grid = -1; return; }
        if (hipOccupancyMaxActiveBlocksPerMultiprocessor(&per_cu, (const void*)nsa_layer_fwd, NTHR, LDS_BYTES) != hipSuccess || per_cu < 1) { fprintf(stderr, "kernel_launch: occupancy query says %d blocks per CU\n", per_cu); }
        (void)hipGetLastError();
        grid = cus;
    }
    if (grid < 0) return;
    if (hipMemsetAsync((char*)d_ws + WS_CTL, 0, CTL_ZERO_BYTES, stream) != hipSuccess) return;
    Args a{};
    for (int i = 0; i < 20; ++i) a.in[i] = d_in[i];
    a.out = (float*)d_out; a.ws = (unsigned char*)d_ws;
    constexpr int NL = MK_N_LAUNCHES;
    for (int li = 0; li < NL; ++li) {
        a.ph_lo = (NL == NPHASE) ? li : (li * NPHASE) / NL; a.ph_hi = (NL == NPHASE) ? li + 1 : ((li + 1) * NPHASE) / NL; a.li = li; a.pad = 0;
        hipLaunchKernelGGL(nsa_layer_fwd, dim3(grid), dim3(NTHR), LDS_BYTES, stream, a);
    }
}
```

```cpp
#include <hip/hip_runtime.h>
#include <cstdio>
#include <cstdint>

namespace pg8 {
#define PG8_LAS __attribute__((address_space(3)))
typedef unsigned short bf16_t;
typedef short bf16x8 __attribute__((ext_vector_type(8)));
typedef float f32x4 __attribute__((ext_vector_type(4)));
typedef unsigned u32x4 __attribute__((ext_vector_type(4)));
constexpr int BM = 256, BK = 64, HALF = 128, HTB = HALF * BK * 2  , STAGE_BYTES = 8 * HTB, NXCD = 8, WGM = 8;

__host__ __device__ __forceinline__ int lds_byte(int r, int c) { const int st = (r >> 4) * 2 + (c >> 5), rr = r & 15, cc = c & 31, ob = rr * 64 + cc * 2; return st * 1024 + (ob ^ (((ob >> 9) & 1) << 5)); }
__host__ __device__ __forceinline__ void stage_rc(int b, int& R, int& C) { const int st = b / 1024, sb = b % 1024, swz = sb ^ (((sb >> 9) & 1) << 5); R = (st >> 1) * 16 + swz / 64; C = (st & 1) * 32 + (swz % 64) / 2; }
__host__ __device__ __forceinline__ int perm32(int rho) { const int n = rho >> 4, i = rho & 15; return 8 * (i >> 2) + 4 * n + (i & 3); }

struct Unit { int pm, pn; };
struct Gemm { const bf16_t* A; const bf16_t* Bt; int M, N, K; };

struct StaticOrder {
    int nM, nN, nwg, G, c;
    __host__ __device__ void init(int M, int N, int G_, int c_) { nM = M / BM; nN = N / BM; nwg = nM * nN; G = G_; c = c_; }
    __host__ __device__ bool next(int i, Unit& u) const {
        const long L = (long)i * G + c; if (L >= nwg) return false;
        int wgid = (int)L; { const int q = nwg / NXCD, r = nwg % NXCD, xcd = wgid % NXCD, off = wgid / NXCD; wgid = (xcd < r ? xcd * (q + 1) : r * (q + 1) + (xcd - r) * q) + off; }
        const int nig = WGM * nN, gid = wgid / nig, fm = gid * WGM, gsz = (nM - fm) < WGM ? (nM - fm) : WGM;
        u.pm = fm + ((wgid % nig) % gsz); u.pn = (wgid % nig) / gsz; return true;
    }
    __device__ __forceinline__ void a_ready(const Unit&) const {}
    __device__ __forceinline__ void done(const Unit&) const {}
};

__device__ __forceinline__ unsigned cvt_pk_bf16(float lo, float hi) { unsigned r; asm volatile("v_cvt_pk_bf16_f32 %0, %1, %2" : "=v"(r) : "v"(lo), "v"(hi)); return r; }
typedef float f32x2 __attribute__((ext_vector_type(2)));
__device__ __forceinline__ f32x2 gelu_pk(f32x2 v) {
    const f32x2 av = __builtin_elementwise_abs(v), d = av * 0.2316418882f + 1.0f;
    f32x2 t; t.x = __builtin_amdgcn_rcpf(d.x); t.y = __builtin_amdgcn_rcpf(d.y);
    f32x2 q = t * 0.5307027145f + (-0.7265760135f); q = q * t + 0.7107068705f; q = q * t + (-0.142248368f); q = q * t + 0.127414796f; q = q * t;
    const f32x2 s = (v * v) * (-0.72134752044f);
    f32x2 e; e.x = __builtin_amdgcn_exp2f(s.x); e.y = __builtin_amdgcn_exp2f(s.y);
    const f32x2 m = v * (q * e), r = v - m;
    f32x2 o; o.x = v.x < 0.f ? m.x : r.x; o.y = v.y < 0.f ? m.y : r.y; return o;
}

template <int ACT  , bool BJ = false  > struct EpiBf16 {
    static constexpr bool PERM = true, AFTER_DRAIN = false; static constexpr bool BJ16 = BJ; static_assert(ACT == 0 || ACT == 1, "EpiBf16: ACT is 0 (none) or 1 (gelu_pk)");
    bf16_t* O; int ldc; const float* bias; int split_cols; size_t split_stride; float scale0;
    __device__ __forceinline__ void operator()(const f32x4 (&acc)[2][2][4][2], const Unit& u, int wr, int wc, int fr, int fq) const {
        const int row0 = u.pm * BM + wr * 64 + fr; int colt = u.pn * BM; bf16_t* base = O;
        float sc = 1.f; if (split_cols) { const int t = colt / split_cols; base += (size_t)t * split_stride; colt -= t * split_cols; if (t == 0) sc = scale0; }
        const int lc0 = BJ ? wc * 64 + 16 * fq : wc * 32 + 8 * fq, col0 = colt + lc0, bcol0 = u.pn * BM + lc0; constexpr int BJS = BJ ? 8 : HALF;
        f32x4 bv[2][2];
#pragma unroll
        for (int bj = 0; bj < 2; ++bj)
#pragma unroll
            for (int n = 0; n < 2; ++n) bv[bj][n] = bias ? *(const f32x4*)(bias + bcol0 + bj * BJS + 4 * n) : (f32x4){0.f, 0.f, 0.f, 0.f};
#pragma unroll
        for (int ai = 0; ai < 2; ++ai)
#pragma unroll
            for (int m = 0; m < 4; ++m) { bf16_t* rowp = base + (size_t)(row0 + ai * HALF + m * 16) * ldc + col0;
#pragma unroll
                for (int bj = 0; bj < 2; ++bj) { f32x4 v0 = acc[ai][bj][m][0] + bv[bj][0], v1 = acc[ai][bj][m][1] + bv[bj][1];
                    if (ACT == 1) { f32x2 a = gelu_pk((f32x2){v0[0], v0[1]}), b = gelu_pk((f32x2){v0[2], v0[3]}), c = gelu_pk((f32x2){v1[0], v1[1]}), d = gelu_pk((f32x2){v1[2], v1[3]});
                        v0 = (f32x4){a.x, a.y, b.x, b.y}; v1 = (f32x4){c.x, c.y, d.x, d.y}; }
                    v0 = v0 * sc; v1 = v1 * sc; u32x4 w; w.x = cvt_pk_bf16(v0[0], v0[1]); w.y = cvt_pk_bf16(v0[2], v0[3]); w.z = cvt_pk_bf16(v1[0], v1[1]); w.w = cvt_pk_bf16(v1[2], v1[3]);
                    *(u32x4*)(rowp + bj * BJS) = w; } }
    }
};

typedef int v8i32 __attribute__((ext_vector_type(8)));
typedef int v4i32 __attribute__((ext_vector_type(4)));
__device__ __forceinline__ v8i32 cat8(bf16x8 lo, bf16x8 hi) { const v4i32 a = __builtin_bit_cast(v4i32, lo), b = __builtin_bit_cast(v4i32, hi); return __builtin_shufflevector(a, b, 0, 1, 2, 3, 4, 5, 6, 7); }
__device__ __forceinline__ unsigned pk4_fp8(float a, float b, float c, float d) { int p = 0; p = __builtin_amdgcn_cvt_pk_fp8_f32(a, b, p, false); p = __builtin_amdgcn_cvt_pk_fp8_f32(c, d, p, true); return (unsigned)p; }
template <class Epi, class Sched, bool ALIGN_EPI = false, bool SP2 = false, bool FP8 = false>
__device__ __forceinline__ void gemm_phase(PG8_LAS unsigned char* lds, const Gemm g, const Sched& S, const Epi& E) {
    const int tid = threadIdx.x, wid = __builtin_amdgcn_readfirstlane(tid >> 6), lane = tid & 63, wr = wid >> 2, wc = wid & 3, fr = lane & 15, fq = lane >> 4;
    const int K = g.K, nt = K / BK;
    unsigned voffA[2], voffB[2];
#pragma unroll
    for (int i = 0; i < 2; ++i) { int R, C; stage_rc(tid * 16 + i * 8192, R, C); const int Rp = Epi::PERM ? ((R & ~31) + perm32(R & 31)) : R, Rb = Epi::BJ16 ? (16 * (Rp >> 3) + (Rp & 7)) : Rp;
        voffA[i] = (unsigned)(R * K + C) * 2u; voffB[i] = (unsigned)(Rb * K + C) * 2u; }
    const size_t kstep = (size_t)(BK * 2);
    const size_t hstep = (size_t)HALF * K * 2;
    const size_t hstepB = Epi::BJ16 ? (size_t)8 * K * 2 : hstep;
    const size_t tstep = 2 * hstep;
    const unsigned ldsw = (unsigned)wid * 1024u;
    const int aoff = lds_byte(wr * 64 + fr, fq * 8), boff = lds_byte(wc * 32 + fr, fq * 8);
    constexpr int akd = 1024, bkd = 1024;
#define PG8_SA(b, h) (((b) * 2 + (h)) * HTB)
#define PG8_SB(b, h) ((4 + (b) * 2 + (h)) * HTB)
#define PG8_STAGE(bufoff, gbase, voff) do { _Pragma("unroll") for (int _i = 0; _i < 2; ++_i) \
        __builtin_amdgcn_global_load_lds((const unsigned*)((const char*)(gbase) + (voff)[_i]), (PG8_LAS unsigned*)(lds + (bufoff) + ldsw + _i * 8192), 16, 0, 0); } while (0)
#define PG8_LDA(dst, b, h) do { if constexpr (FP8) { _Pragma("unroll") for (int m = 0; m < 4; ++m) dst##8[m] = cat8(*(const PG8_LAS bf16x8*)(lds + PG8_SA(b, h) + aoff + m * 2048), *(const PG8_LAS bf16x8*)(lds + PG8_SA(b, h) + aoff + m * 2048 + akd)); } \
    else { _Pragma("unroll") for (int m = 0; m < 4; ++m) _Pragma("unroll") for (int k = 0; k < 2; ++k) dst[m][k] = *(const PG8_LAS bf16x8*)(lds + PG8_SA(b, h) + aoff + m * 2048 + k * 1024); } } while (0)
#define PG8_LDB(dst, b, h) do { if constexpr (FP8) { _Pragma("unroll") for (int n = 0; n < 2; ++n) dst##8[n] = cat8(*(const PG8_LAS bf16x8*)(lds + PG8_SB(b, h) + boff + n * 2048), *(const PG8_LAS bf16x8*)(lds + PG8_SB(b, h) + boff + n * 2048 + bkd)); } \
    else { _Pragma("unroll") for (int n = 0; n < 2; ++n) _Pragma("unroll") for (int k = 0; k < 2; ++k) dst[n][k] = *(const PG8_LAS bf16x8*)(lds + PG8_SB(b, h) + boff + n * 2048 + k * 1024); } } while (0)
#define PG8_MMA(ai, bj, At, Bt) do { __builtin_amdgcn_s_setprio(1); _Pragma("unroll") for (int m = 0; m < 4; ++m) _Pragma("unroll") for (int n = 0; n < 2; ++n) { \
        if constexpr (FP8) { asm volatile("v_mfma_scale_f32_16x16x128_f8f6f4 %0, %1, %2, %0, %3, %3 op_sel_hi:[0,0,0]" : "+v"(acc[ai][bj][m][n]) : "v"(Bt##8[n]), "v"(At##8[m]), "v"(0x7f7f7f7f)); }   \
        else { _Pragma("unroll") for (int k = 0; k < 2; ++k) acc[ai][bj][m][n] = __builtin_amdgcn_mfma_f32_16x16x32_bf16(Bt[n][k], At[m][k], acc[ai][bj][m][n], 0, 0, 0); } } __builtin_amdgcn_s_setprio(0); } while (0)
#define PG8_WAIT_V(n) asm volatile("s_waitcnt vmcnt(" #n ")" ::: "memory")
#define PG8_WAIT_L(n) asm volatile("s_waitcnt lgkmcnt(" #n ")" ::: "memory")
#define PG8_BAR __builtin_amdgcn_s_barrier()
#define PG8_SCHED __builtin_amdgcn_sched_barrier(0)
    Unit cur, nxt; int ui = 0;
    if (!S.next(0, cur)) return;
    f32x4 acc[2][2][4][2];
#pragma unroll
    for (int a = 0; a < 2; ++a)
#pragma unroll
        for (int b = 0; b < 2; ++b)
#pragma unroll
            for (int m = 0; m < 4; ++m)
#pragma unroll
                for (int n = 0; n < 2; ++n) acc[a][b][m][n] = (f32x4){0.f, 0.f, 0.f, 0.f};
    bf16x8 At[4][2], B0[2][2], B1[2][2]; v8i32 At8[4], B08[2], B18[2];
    const char* cA = (const char*)g.A + (size_t)cur.pm * tstep; const char* cB = (const char*)g.Bt + (size_t)cur.pn * tstep;
    S.a_ready(cur);
    if constexpr (SP2) {
        PG8_STAGE(PG8_SB(0, 0), cB, voffB); PG8_STAGE(PG8_SB(0, 1), cB + hstepB, voffB); PG8_STAGE(PG8_SA(0, 0), cA, voffA); PG8_STAGE(PG8_SA(0, 1), cA + hstep, voffA);
        if (wr == 1) PG8_BAR;
        PG8_WAIT_V(2); PG8_BAR;
        PG8_STAGE(PG8_SB(1, 0), cB + kstep, voffB); PG8_STAGE(PG8_SA(1, 0), cA + kstep, voffA); PG8_STAGE(PG8_SB(1, 1), cB + hstepB + kstep, voffB);
        PG8_WAIT_V(6); PG8_BAR;
    } else {
        PG8_STAGE(PG8_SB(0, 0), cB, voffB); PG8_STAGE(PG8_SA(0, 0), cA, voffA); PG8_STAGE(PG8_SB(0, 1), cB + hstepB, voffB); PG8_STAGE(PG8_SA(0, 1), cA + hstep, voffA);
        if (wr == 1) PG8_BAR;
        PG8_WAIT_V(4); PG8_BAR;
        PG8_STAGE(PG8_SB(1, 0), cB + kstep, voffB); PG8_STAGE(PG8_SA(1, 0), cA + kstep, voffA); PG8_STAGE(PG8_SB(1, 1), cB + hstepB + kstep, voffB);
        PG8_WAIT_V(6); PG8_BAR;
    }
    for (;;) {
        const bool has_next = S.next(ui + 1, nxt);
        const char* nA = has_next ? (const char*)g.A + (size_t)nxt.pm * tstep : cA; const char* nB = has_next ? (const char*)g.Bt + (size_t)nxt.pn * tstep : cB;
        for (int t = 0; t < nt; t += 2) {
            const bool last = (t == nt - 2);
            const char* a1 = cA + (size_t)(t + 1) * kstep;
            const char* a2 = last ? nA : cA + (size_t)(t + 2) * kstep; const char* b2 = last ? nB : cB + (size_t)(t + 2) * kstep;
            const char* a3 = a2 + kstep; const char* b3 = b2 + kstep;
            if (last && has_next) S.a_ready(nxt);
            if constexpr (SP2) {
            PG8_LDB(B0, 0, 0); PG8_LDB(B1, 0, 1); PG8_SCHED; PG8_LDA(At, 0, 0); PG8_STAGE(PG8_SA(1, 1), a1 + hstep, voffA);
            PG8_WAIT_V(8); PG8_WAIT_L(0); PG8_BAR; PG8_MMA(0, 0, At, B0); PG8_MMA(0, 1, At, B1); PG8_BAR; PG8_SCHED;
            PG8_LDA(At, 0, 1); PG8_STAGE(PG8_SB(0, 0), b2, voffB); PG8_STAGE(PG8_SB(0, 1), b2 + hstepB, voffB); PG8_STAGE(PG8_SA(0, 0), a2, voffA);
            PG8_WAIT_V(8); PG8_WAIT_L(0); PG8_BAR; PG8_MMA(1, 0, At, B0); PG8_MMA(1, 1, At, B1); PG8_BAR; PG8_SCHED;
            PG8_LDB(B0, 1, 0); PG8_LDB(B1, 1, 1); PG8_SCHED; PG8_LDA(At, 1, 0); PG8_STAGE(PG8_SA(0, 1), a2 + hstep, voffA);
            PG8_WAIT_V(8); PG8_WAIT_L(0); PG8_BAR; PG8_MMA(0, 0, At, B0); PG8_MMA(0, 1, At, B1); PG8_BAR; PG8_SCHED;
            PG8_LDA(At, 1, 1); PG8_STAGE(PG8_SB(1, 0), b3, voffB); PG8_STAGE(PG8_SB(1, 1), b3 + hstepB, voffB); PG8_STAGE(PG8_SA(1, 0), a3, voffA);
            PG8_WAIT_V(8); PG8_WAIT_L(0); PG8_BAR; PG8_MMA(1, 0, At, B0); PG8_MMA(1, 1, At, B1); PG8_BAR; PG8_SCHED;
            } else {
            PG8_LDB(B0, 0, 0); PG8_SCHED; PG8_LDA(At, 0, 0); PG8_STAGE(PG8_SA(1, 1), a1 + hstep, voffA);
            PG8_WAIT_L(8); PG8_BAR; PG8_WAIT_L(0); PG8_MMA(0, 0, At, B0); PG8_BAR; PG8_SCHED;
            PG8_LDB(B1, 0, 1); PG8_STAGE(PG8_SB(0, 0), b2, voffB);
            PG8_BAR; PG8_WAIT_L(0); PG8_MMA(0, 1, At, B1); PG8_BAR;
            PG8_LDA(At, 0, 1); PG8_STAGE(PG8_SA(0, 0), a2, voffA);
            PG8_BAR; PG8_WAIT_L(0); PG8_MMA(1, 0, At, B0); PG8_BAR; PG8_SCHED;
            PG8_STAGE(PG8_SB(0, 1), b2 + hstepB, voffB);
            PG8_WAIT_V(6); PG8_BAR; PG8_MMA(1, 1, At, B1); PG8_BAR;
            PG8_LDB(B0, 1, 0); PG8_SCHED; PG8_LDA(At, 1, 0); PG8_STAGE(PG8_SA(0, 1), a2 + hstep, voffA);
            PG8_WAIT_L(8); PG8_BAR; PG8_WAIT_L(0); PG8_MMA(0, 0, At, B0); PG8_BAR; PG8_SCHED;
            PG8_LDB(B1, 1, 1); PG8_STAGE(PG8_SB(1, 0), b3, voffB);
            PG8_BAR; PG8_WAIT_L(0); PG8_MMA(0, 1, At, B1); PG8_BAR;
            PG8_LDA(At, 1, 1); PG8_STAGE(PG8_SA(1, 0), a3, voffA);
            PG8_BAR; PG8_WAIT_L(0); PG8_MMA(1, 0, At, B0); PG8_BAR; PG8_SCHED;
            PG8_STAGE(PG8_SB(1, 1), b3 + hstepB, voffB);
            PG8_WAIT_V(6); PG8_BAR; PG8_MMA(1, 1, At, B1); PG8_BAR;
            }
        }
        if constexpr (ALIGN_EPI) { if (wr == 0) PG8_BAR; }
        if constexpr (FP8) asm volatile("s_nop 15\n\ts_nop 15" ::: "memory");
        if constexpr (!Epi::AFTER_DRAIN) { E(acc, cur, wr, wc, fr, fq); S.done(cur); }
        if (!has_next) break;
#pragma unroll
        for (int a = 0; a < 2; ++a)
#pragma unroll
            for (int b = 0; b < 2; ++b)
#pragma unroll
                for (int m = 0; m < 4; ++m)
#pragma unroll
                    for (int n = 0; n < 2; ++n) acc[a][b][m][n] = (f32x4){0.f, 0.f, 0.f, 0.f};
        cur = nxt; cA = nA; cB = nB; ++ui;
        if constexpr (ALIGN_EPI) { if (wr == 1) PG8_BAR; }
    }
    PG8_WAIT_V(0);
    if constexpr (!ALIGN_EPI) { if (wr == 0) PG8_BAR; }
    PG8_BAR;
    if constexpr (Epi::AFTER_DRAIN) { E.fused(acc, cur, wr, wc, fr, fq, lds, wid, lane); S.done(cur); }
#undef PG8_SA
#undef PG8_SB
#undef PG8_STAGE
#undef PG8_LDA
#undef PG8_LDB
#undef PG8_MMA
#undef PG8_WAIT_V
#undef PG8_WAIT_L
#undef PG8_BAR
#undef PG8_SCHED
}
}

namespace pg8 {
typedef unsigned u32x2 __attribute__((ext_vector_type(2)));
template <int BF  , bool SS> struct EpiResid {
    static constexpr bool PERM = false, AFTER_DRAIN = false; static constexpr bool BJ16 = false;
    const float* res; float* out; bf16_t* ob; float* rowss; int ld; float ascale;
    __device__ __forceinline__ void operator()(const f32x4 (&acc)[2][2][4][2], const Unit& u, int wr, int wc, int fr, int fq) const {
        const int row0 = u.pm * BM + wr * 64 + fr, col0 = u.pn * BM + wc * 32 + 4 * fq;
#pragma unroll
        for (int ai = 0; ai < 2; ++ai)
#pragma unroll
            for (int m = 0; m < 4; ++m) { const int row = row0 + ai * HALF + m * 16; const size_t ro = (size_t)row * ld + col0; float ss = 0.f;
#pragma unroll
                for (int bj = 0; bj < 2; ++bj)
#pragma unroll
                    for (int n = 0; n < 2; ++n) { const size_t o = ro + bj * HALF + n * 16; const f32x4 r4 = *(const f32x4*)(res + o); const f32x4 v = acc[ai][bj][m][n] * ascale + r4;
                        *(f32x4*)(out + o) = v;
                        if (BF == 1) { u32x2 w; w.x = cvt_pk_bf16(v[0], v[1]); w.y = cvt_pk_bf16(v[2], v[3]); *(u32x2*)(ob + o) = w; }
                        if (BF == 2) { *(unsigned*)((unsigned char*)ob + o) = pk4_fp8(v[0], v[1], v[2], v[3]); }
                        if (SS) ss += (v[0] * v[0] + v[1] * v[1]) + (v[2] * v[2] + v[3] * v[3]); }
                if (SS) { ss += __shfl_xor(ss, 16); ss += __shfl_xor(ss, 32); if (fq == 0) atomicAdd(rowss + row, ss); } }
    }
};
struct EpiNull { static constexpr bool PERM = true, AFTER_DRAIN = false; static constexpr bool BJ16 = false; float* O;
    __device__ __forceinline__ void operator()(const f32x4 (&acc)[2][2][4][2], const Unit& u, int wr, int wc, int fr, int fq) const {
#pragma unroll
      for (int a = 0; a < 2; ++a)
#pragma unroll
        for (int b = 0; b < 2; ++b)
#pragma unroll
          for (int m = 0; m < 4; ++m)
#pragma unroll
            for (int n = 0; n < 2; ++n) asm volatile("" :: "v"(acc[a][b][m][n])); } };
template <bool RES_F32, bool F8, bool SS> struct EpiStream {
    static constexpr bool PERM = true, AFTER_DRAIN = false; static constexpr bool BJ16 = true;
    const float* resf; const bf16_t* resb; bf16_t* ob; unsigned char* o8; float* rowss; int ld; float ascale;
    __device__ __forceinline__ void operator()(const f32x4 (&acc)[2][2][4][2], const Unit& u, int wr, int wc, int fr, int fq) const {
        const int row0 = u.pm * BM + wr * 64 + fr, col0 = u.pn * BM + wc * 64 + 16 * fq;
#pragma unroll
        for (int ai = 0; ai < 2; ++ai)
#pragma unroll
            for (int m = 0; m < 4; ++m) { const int row = row0 + ai * HALF + m * 16; const size_t ro = (size_t)row * ld + col0; float ss = 0.f; f32x4 r4[4];
                if (RES_F32) {
#pragma unroll
                    for (int q = 0; q < 4; ++q) r4[q] = *(const f32x4*)(resf + ro + 4 * q); }
                else { const u32x4 ra = *(const u32x4*)(resb + ro), rb = *(const u32x4*)(resb + ro + 8); const unsigned rw[8] = {ra.x, ra.y, ra.z, ra.w, rb.x, rb.y, rb.z, rb.w};
#pragma unroll
                    for (int q = 0; q < 4; ++q) r4[q] = (f32x4){__builtin_bit_cast(float, rw[2 * q] << 16), __builtin_bit_cast(float, rw[2 * q] & 0xffff0000u), __builtin_bit_cast(float, rw[2 * q + 1] << 16), __builtin_bit_cast(float, rw[2 * q + 1] & 0xffff0000u)}; }
                f32x4 v[4];
#pragma unroll
                for (int q = 0; q < 4; ++q) { v[q] = acc[ai][q >> 1][m][q & 1] * ascale + r4[q]; if (SS) ss += (v[q][0] * v[q][0] + v[q][1] * v[q][1]) + (v[q][2] * v[q][2] + v[q][3] * v[q][3]); }
                u32x4 wa, wb; wa.x = cvt_pk_bf16(v[0][0], v[0][1]); wa.y = cvt_pk_bf16(v[0][2], v[0][3]); wa.z = cvt_pk_bf16(v[1][0], v[1][1]); wa.w = cvt_pk_bf16(v[1][2], v[1][3]);
                wb.x = cvt_pk_bf16(v[2][0], v[2][1]); wb.y = cvt_pk_bf16(v[2][2], v[2][3]); wb.z = cvt_pk_bf16(v[3][0], v[3][1]); wb.w = cvt_pk_bf16(v[3][2], v[3][3]);
                *(u32x4*)(ob + ro) = wa; *(u32x4*)(ob + ro + 8) = wb;
                if (F8) { u32x4 w8; w8.x = pk4_fp8(v[0][0], v[0][1], v[0][2], v[0][3]); w8.y = pk4_fp8(v[1][0], v[1][1], v[1][2], v[1][3]); w8.z = pk4_fp8(v[2][0], v[2][1], v[2][2], v[2][3]); w8.w = pk4_fp8(v[3][0], v[3][1], v[3][2], v[3][3]); *(u32x4*)(o8 + ro) = w8; }
                if (SS) { ss += __shfl_xor(ss, 16); ss += __shfl_xor(ss, 32); if (fq == 0) atomicAdd(rowss + row, ss); } }
    }
};
template <bool F8OUT> struct EpiScaleT {
    static constexpr bool PERM = true, AFTER_DRAIN = false; static constexpr bool BJ16 = F8OUT;
    bf16_t* O; int ldc; const float* rowss; float inv_n, eps, oscale;
    __device__ __forceinline__ void operator()(const f32x4 (&acc)[2][2][4][2], const Unit& u, int wr, int wc, int fr, int fq) const {
        const int row0 = u.pm * BM + wr * 64 + fr, col0 = u.pn * BM + wc * 32 + 8 * fq;
#pragma unroll
        for (int ai = 0; ai < 2; ++ai)
#pragma unroll
            for (int m = 0; m < 4; ++m) { const int row = row0 + ai * HALF + m * 16; const float rs = __builtin_amdgcn_rsqf(rowss[row] * inv_n + eps) * oscale;
                bf16_t* rowp = O + (size_t)row * ldc + col0;
                if (F8OUT) { const f32x4 v0 = acc[ai][0][m][0] * rs, v1 = acc[ai][0][m][1] * rs, v2 = acc[ai][1][m][0] * rs, v3 = acc[ai][1][m][1] * rs; u32x4 w;
                    w.x = pk4_fp8(v0[0], v0[1], v0[2], v0[3]); w.y = pk4_fp8(v1[0], v1[1], v1[2], v1[3]); w.z = pk4_fp8(v2[0], v2[1], v2[2], v2[3]); w.w = pk4_fp8(v3[0], v3[1], v3[2], v3[3]);
                    *(u32x4*)((unsigned char*)O + (size_t)row * ldc + u.pn * BM + wc * 64 + 16 * fq) = w; }
                else
#pragma unroll
                for (int bj = 0; bj < 2; ++bj) { const f32x4 v0 = acc[ai][bj][m][0] * rs, v1 = acc[ai][bj][m][1] * rs;
                    if (F8OUT) { }
                    else { u32x4 w; w.x = cvt_pk_bf16(v0[0], v0[1]); w.y = cvt_pk_bf16(v0[2], v0[3]); w.z = cvt_pk_bf16(v1[0], v1[1]); w.w = cvt_pk_bf16(v1[2], v1[3]);
                        *(u32x4*)(rowp + bj * HALF) = w; } } }
    }
};
typedef EpiScaleT<false> EpiScaleBf16;
}

constexpr int BATCH = 2, SEQ = 16384, DM = 2048, MTOK = BATCH * SEQ;
constexpr int DIN = 4632, NP1 = 4608;
constexpr int NP1A = 1536;
constexpr int HD = 128, NH = 8;
constexpr int COL_KCMP = 1024, COL_VCMP = 1280, COL_KSEL = 1536, COL_VSEL = 1792, COL_KWIN = 2048, COL_VWIN = 2304, WCOL_GATE = 2560  , COL_U = 2560, COL_V = 3584;
constexpr int DFF = 5632, DFF2 = 11264;
constexpr float EPS = 1e-6f;
constexpr float W8SCALE = 64.0f;
constexpr float C2 = 0.08838834764831845f * 1.4426950408889634f;
constexpr int NWAVES = 8, NTHR = 512;

constexpr size_t MiB = 1u << 20;
constexpr size_t WS_CTL = 0, CTL_ZERO_BYTES = 1 * MiB;
constexpr size_t WS_WIN = 1 * MiB, WS_WOUT = 20 * MiB, WS_WUP = 28 * MiB, WS_WDN = 72 * MiB, WS_WCK = 94 * MiB, WS_WCV = 95 * MiB, WS_WM = 96 * MiB;
constexpr size_t WS_COS = 97 * MiB, WS_SIN = 105 * MiB, WS_KC = 113 * MiB, WS_VCT = 114 * MiB, WS_KSEL = 115 * MiB, WS_KWIN = 131 * MiB, WS_VSELT = 147 * MiB, WS_VWINT = 163 * MiB;
constexpr size_t WS_TMASK = 179 * MiB, WS_H1B = 181 * MiB;
constexpr size_t WS_Q8 = 309 * MiB  ;
constexpr size_t WS_XN = 309 * MiB  , WS_QR = 373 * MiB  , WS_PROJ = 437 * MiB, WS_OC = 741 * MiB, WS_OS = 805 * MiB, WS_OW = 869 * MiB;
constexpr size_t WS_AH = 309 * MiB  , WS_HMID = 661 * MiB, WS_END = 1013 * MiB;
constexpr size_t WS_H1BF = 837 * MiB  , WS_H2BF = 309 * MiB  ;
constexpr size_t WS_WIN8 = 9 * MiB  , WS_XN8 = 741 * MiB  ;
constexpr size_t WS_WG = 96 * MiB + 512 * 1024  , WS_GATES = 1013 * MiB  , WS_END2 = 1015 * MiB;
static_assert(WS_PROJ + (size_t)MTOK * NP1 * 2 <= WS_OC && WS_AH + (size_t)MTOK * DFF2 <= WS_HMID && WS_HMID + (size_t)MTOK * DFF <= WS_END, "ws map");
constexpr int CW_BAR = 4096;
constexpr int CW_CCONST = 65536;
constexpr int CW_ROWSS = 131072;
static_assert(CW_BAR + 16 * 3456 <= CW_CCONST && (CW_ROWSS + MTOK) * 4 <= (int)CTL_ZERO_BYTES, "ctl map");
constexpr int LDS_BYTES = 147456;
constexpr int MISC_OFF = LDS_BYTES - 256;

#define GAS __attribute__((address_space(1)))
#define LAS __attribute__((address_space(3)))
typedef unsigned short bf16;
typedef unsigned v4u __attribute__((ext_vector_type(4)));
typedef unsigned v2u __attribute__((ext_vector_type(2)));
typedef float f32x4 __attribute__((ext_vector_type(4)));
typedef short bf16x8 __attribute__((ext_vector_type(8)));
__device__ __forceinline__ float bf2f(unsigned v) { return __builtin_bit_cast(float, v << 16); }
__device__ __forceinline__ float bflo(unsigned w) { return __builtin_bit_cast(float, w << 16); }
__device__ __forceinline__ float bfhi(unsigned w) { return __builtin_bit_cast(float, w & 0xffff0000u); }
__device__ __forceinline__ unsigned pk2(float lo, float hi) { return pg8::cvt_pk_bf16(lo, hi); }
__device__ __forceinline__ unsigned f2bf(float f) { return pg8::cvt_pk_bf16(f, 0.f) & 0xffffu; }
__device__ __forceinline__ float wave_sum(float v) {
#pragma unroll
    for (int o = 1; o < 64; o <<= 1) v += __shfl_xor(v, o);
    return v;
}
__device__ __forceinline__ float gelu_exact(float x) { return 0.5f * x * (1.0f + erff(x * 0.70710678118654752f)); }
__device__ __forceinline__ float sigmoidf(float x) { return __builtin_amdgcn_rcpf(1.0f + __builtin_amdgcn_exp2f(x * -1.4426950408889634f)); }
__device__ __forceinline__ f32x4 mfma16(bf16x8 a, bf16x8 b, f32x4 c) { return __builtin_amdgcn_mfma_f32_16x16x32_bf16(a, b, c, 0, 0, 0); }
__device__ __forceinline__ bf16x8 pack8(f32x4 a, f32x4 b) { v4u w; w.x = pk2(a[0], a[1]); w.y = pk2(a[2], a[3]); w.z = pk2(b[0], b[1]); w.w = pk2(b[2], b[3]); return __builtin_bit_cast(bf16x8, w); }
__device__ __forceinline__ int kpos_of(int k) { return (k & 32) | (((k >> 2) & 3) << 3) | (((k >> 4) & 1) << 2) | (k & 3); }


#define XB_TMO      128
#define XB_XCNT(j)  (256  + 64 * (j))
#define XB_XSUB(j)  (1280 + 64 * (j))
#define XB_XGEN(j)  (2304 + 64 * (j))
#define XB_TOP      3328
#define XB_TOPGEN   3392
#define XCD_BAR_WORDS 3456
#define XB_SPIN_CAP (1u << 18)

__device__ __forceinline__ unsigned xb_ld(unsigned* p)              { return __hip_atomic_load(p, __ATOMIC_RELAXED, __HIP_MEMORY_SCOPE_AGENT); }
__device__ __forceinline__ unsigned xb_add(unsigned* p, unsigned v) { return __hip_atomic_fetch_add(p, v, __ATOMIC_RELAXED, __HIP_MEMORY_SCOPE_AGENT); }
__device__ __forceinline__ unsigned xb_xcc_id() { return (unsigned)__builtin_amdgcn_s_getreg((3 << 11) | 20) & 0xFu; }
#define XB_SPIN(cond, bar) do { unsigned _sp = 0; while (cond) { __builtin_amdgcn_s_sleep(1); \
    if ((++_sp & 255u) == 0u) { if (xb_ld(&(bar)[XB_TMO])) break; if (_sp > XB_SPIN_CAP) { atomicAdd(&(bar)[XB_TMO], 1u); break; } } } } while (0)

struct XcdBarrier {
    unsigned* bar; unsigned x;
    volatile LAS unsigned* st;
};

__device__ __forceinline__ XcdBarrier xcd_barrier_post(unsigned* bar, volatile LAS unsigned* st) {
    XcdBarrier b; b.bar = bar; b.x = xb_xcc_id(); b.st = st;
    if (threadIdx.x == 0) (void)xb_add(&bar[XB_XCNT(b.x)], 1u);
    return b;
}
__device__ __forceinline__ void xcd_barrier_complete(unsigned* bar, unsigned x, unsigned& nloc, unsigned& nx) {
    const unsigned G = gridDim.x * gridDim.y * gridDim.z;
    unsigned sum, cnt, mine, sp = 0u;
    for (;;) {
        sum = 0u; cnt = 0u; mine = 0u;
#pragma unroll
        for (unsigned j = 0; j < 16; ++j) { const unsigned c = xb_ld(&bar[XB_XCNT(j)]); sum += c; cnt += (c > 0u) ? 1u : 0u; mine = (j == x) ? c : mine; }
        if (sum == G) break;
        __builtin_amdgcn_s_sleep(1);
        if ((++sp & 255u) == 0u) { if (xb_ld(&bar[XB_TMO])) break; if (sp > XB_SPIN_CAP) { atomicAdd(&bar[XB_TMO], 1u); break; } }
    }
    nloc = mine > 0u ? mine : 1u; nx = cnt > 0u ? cnt : 1u;
}

__device__ __forceinline__ void xcd_barrier(const XcdBarrier& b) {
    asm volatile("s_waitcnt vmcnt(0)" ::: "memory");
    __syncthreads();
    if (threadIdx.x == 0) {
        unsigned* bar = b.bar;
        __builtin_amdgcn_s_waitcnt(0);
        unsigned nloc = b.st[0], nx = b.st[1];
        if (nloc == 0u) { xcd_barrier_complete(bar, b.x, nloc, nx); b.st[0] = nloc; b.st[1] = nx; }
        const unsigned old = xb_add(&bar[XB_XSUB(b.x)], 1u);
        const unsigned gen = old / nloc;
        if (old + 1u == (gen + 1u) * nloc) {
            __builtin_amdgcn_fence(__ATOMIC_RELEASE, "agent");
            asm volatile("s_waitcnt vmcnt(0)" ::: "memory");
            const unsigned og = xb_add(&bar[XB_TOP], 1u);
            const unsigned tg = og / nx;
            if (og + 1u == (tg + 1u) * nx) xb_add(&bar[XB_TOPGEN], 1u);
            else XB_SPIN(xb_ld(&bar[XB_TOPGEN]) == tg, bar);
            __builtin_amdgcn_fence(__ATOMIC_ACQUIRE, "agent");
            xb_add(&bar[XB_XGEN(b.x)], 1u);
            asm volatile("s_waitcnt vmcnt(0)" ::: "memory");
        } else {
            XB_SPIN(xb_ld(&bar[XB_XGEN(b.x)]) == gen, bar);
            __builtin_amdgcn_fence(__ATOMIC_ACQUIRE, "agent");
            asm volatile("s_waitcnt vmcnt(0)" ::: "memory");
        }
    }
    __syncthreads();
}


struct Args { const void* in[20]; float* out; unsigned char* ws; int ph_lo, ph_hi, li, pad; };

struct TUnit { const float* W; int K, ldw, N, kt, nt; const float* ksc; bf16* WT; bool f8; };
__device__ __forceinline__ void tu_load(const TUnit& u, f32x4 (&v)[8], float (&sc)[8]) {
    const int tid = threadIdx.x;
#pragma unroll
    for (int i = 0; i < 8; ++i) { const int idx = tid + NTHR * i, k = idx >> 6, n = 256 * u.nt + 4 * (idx & 63);
        v[i] = (f32x4){0.f, 0.f, 0.f, 0.f}; if (n < u.N) v[i] = *(const f32x4*)(u.W + (size_t)(64 * u.kt + k) * u.ldw + n); sc[i] = u.ksc ? u.ksc[64 * u.kt + k] : 1.f; }
}
__device__ __forceinline__ void tu_store(const TUnit& u, const f32x4 (&v)[8], const float (&sc)[8], LAS float* tile) {
    const int tid = threadIdx.x;
#pragma unroll
    for (int i = 0; i < 8; ++i) { const int idx = tid + NTHR * i, k = idx >> 6; LAS float* t = tile + k * 257 + (idx & 63); t[0] = v[i][0] * sc[i]; t[64] = v[i][1] * sc[i]; t[128] = v[i][2] * sc[i]; t[192] = v[i][3] * sc[i]; }
    __syncthreads();
#pragma unroll
    for (int i = 0; i < 4; ++i) { const int kc = tid & 7, q = tid >> 3, n = 4 * q + i; const LAS float* t = tile + (8 * kc) * 257 + 64 * i + q;
        if (256 * u.nt + n < u.N) {
            if (u.f8) { v2u o; o.x = pg8::pk4_fp8(t[0] * W8SCALE, t[257] * W8SCALE, t[514] * W8SCALE, t[771] * W8SCALE); o.y = pg8::pk4_fp8(t[1028] * W8SCALE, t[1285] * W8SCALE, t[1542] * W8SCALE, t[1799] * W8SCALE);
                *(v2u*)((unsigned char*)u.WT + (size_t)(256 * u.nt + n) * u.K + 64 * u.kt + 8 * kc) = o; }
            else { v4u o; o.x = pk2(t[0], t[257]); o.y = pk2(t[514], t[771]); o.z = pk2(t[1028], t[1285]); o.w = pk2(t[1542], t[1799]);
                *(v4u*)(u.WT + (size_t)(256 * u.nt + n) * u.K + 64 * u.kt + 8 * kc) = o; } } }
    __syncthreads();
}
__device__ __forceinline__ void p0_prologue(const Args& a, LAS unsigned char* lds, int wg, int G) {
    const int tid = threadIdx.x, lane = tid & 63, wave = tid >> 6;
    unsigned char* ws = a.ws;
    LAS float* tile = (LAS float*)lds;
    const float* w_in = (const float*)a.in[3]; const float* w_out = (const float*)a.in[13]; const float* w_up = (const float*)a.in[15]; const float* w_dn = (const float*)a.in[18];
    const float* wck = (const float*)a.in[5]; const float* wcv = (const float*)a.in[7]; const float* g2 = (const float*)a.in[14];
    constexpr int U_IN = 32 * 18, U_OUT = 32 * 8, U_UP = 32 * 44, U_DN = 88 * 8, U_C = 64;
    constexpr int NT = U_IN + U_OUT + U_UP + U_DN + 2 * U_C;
    { f32x4 vc[8], vn[8]; float scc[8], scn[8]; TUnit uc{}, un{};
      for (int it = wg - G; it < NT; it += G) { const int itn = it + G; const bool hn = itn < NT;
        if (hn) { int r = itn; const float* W; int K, ldw, N, kt, nt; const float* ksc = nullptr; bf16* WT; bool f8 = false;
        if (r < U_IN) { kt = r / 18; nt = r % 18; K = DM; ldw = DIN;
            if (nt < 6) { W = w_in; N = NP1A; WT = (bf16*)(ws + WS_WIN); }
            else if (nt < 10) { W = w_in + NP1A; N = 1024; WT = (bf16*)(ws + WS_WIN8); nt -= 6; f8 = true; }
            else { W = w_in + 2584; N = 2048; WT = (bf16*)(ws + WS_WIN8 + (size_t)1024 * DM); nt -= 10; f8 = true; } }
        else if ((r -= U_IN) < U_UP) { W = w_up; K = DM; ldw = DFF2; N = DFF2; ksc = g2; WT = (bf16*)(ws + WS_WUP); kt = r / 44; nt = r % 44; f8 = true; }
        else if ((r -= U_UP) < U_DN) { W = w_dn; K = DFF; ldw = DM; N = DM; WT = (bf16*)(ws + WS_WDN); kt = r / 8; nt = r % 8; f8 = true; }
        else if ((r -= U_DN) < U_OUT) { W = w_out; K = DM; ldw = DM; N = DM; WT = (bf16*)(ws + WS_WOUT); kt = r / 8; nt = r % 8; f8 = true; }
        else if ((r -= U_OUT) < U_C) { W = wck; K = 4096; ldw = 128; N = 128; WT = (bf16*)(ws + WS_WCK); kt = r; nt = 0; }
        else { r -= U_C; W = wcv; K = 4096; ldw = 128; N = 128; WT = (bf16*)(ws + WS_WCV); kt = r; nt = 0; }
            un = TUnit{W, K, ldw, N, kt, nt, ksc, WT, f8}; tu_load(un, vn, scn); }
        if (it >= wg) tu_store(uc, vc, scc, tile);
        if (hn) { uc = un;
#pragma unroll
            for (int i = 0; i < 8; ++i) { vc[i] = vn[i]; scc[i] = scn[i]; } } } }
    const int gt = wg * NTHR + tid, NGT = G * NTHR;
    { bf16* wgt = (bf16*)(ws + WS_WG); for (int i = gt; i < 32 * DM; i += NGT) { const int r = i >> 11, k = i & (DM - 1); wgt[i] = (bf16)f2bf(r < 24 ? w_in[(size_t)k * DIN + WCOL_GATE + r] : 0.f); } }
    { const float* wsp = (const float*)a.in[9]; bf16* wm = (bf16*)(ws + WS_WM);
      for (int i = gt; i < 8 * 128 * 128; i += NGT) { const int s = i & 127, t = (i >> 7) & 127; wm[i] = (bf16)f2bf(s <= t ? wsp[i] : 0.f); } }
    { const int* pos = (const int*)a.in[1]; float* ct = (float*)(ws + WS_COS); float* st = (float*)(ws + WS_SIN);
      const float inv = powf(10000.0f, -2.0f * (float)(gt & 63) / 128.0f);
      for (int i = gt; i < MTOK * 64; i += NGT) { const int m = i >> 6; const float ang = (float)pos[m] * inv;
          const double ad = (double)ang; const double n = rint(ad * 0.15915494309189535); const float r = (float)(ad - n * 6.283185307179586);
          ct[i] = cosf(r); st[i] = sinf(r); } }
    for (int u = wg; u < 32; u += G) { const int kv = u >> 4, sl = u & 15; const float* pe = (const float*)a.in[kv ? 6 : 4]; const float* w = kv ? wcv : wck;
        const int e = tid & 127, sub = tid >> 7; const int k0 = sl * 256 + sub * 64; float s0 = 0.f, s1 = 0.f, s2 = 0.f, s3 = 0.f;
#pragma unroll 4
        for (int k = k0; k < k0 + 64; k += 4) { s0 += pe[k] * w[(size_t)k * 128 + e]; s1 += pe[k + 1] * w[(size_t)(k + 1) * 128 + e]; s2 += pe[k + 2] * w[(size_t)(k + 2) * 128 + e]; s3 += pe[k + 3] * w[(size_t)(k + 3) * 128 + e]; }
        __syncthreads(); tile[tid] = (s0 + s1) + (s2 + s3); __syncthreads();
        if (tid < 128) ((float*)(ws + WS_CTL) + CW_CCONST + (kv * 16 + sl) * 128)[tid] = (tile[tid] + tile[tid + 128]) + (tile[tid + 256] + tile[tid + 384]);
        __syncthreads(); }
    { const float* x = (const float*)a.in[0]; const float* g1 = (const float*)a.in[2]; bf16* xn = (bf16*)(ws + WS_XN); const int NW = G * NWAVES;
      for (int m = wg * NWAVES + wave; m < MTOK; m += 2 * NW) { f32x4 v[2][8]; const bool two = m + NW < MTOK;
#pragma unroll
          for (int q = 0; q < 2; ++q) { const f32x4* xr = (const f32x4*)(x + (size_t)(q && two ? m + NW : m) * DM) + 2 * lane;
#pragma unroll
              for (int j = 0; j < 4; ++j) { v[q][2 * j] = xr[128 * j]; v[q][2 * j + 1] = xr[128 * j + 1]; } }
#pragma unroll
          for (int q = 0; q < 2; ++q) { if (q && !two) break; const int mm = m + q * NW; float s = 0.f;
#pragma unroll
              for (int j = 0; j < 8; ++j) s += (v[q][j][0] * v[q][j][0] + v[q][j][1] * v[q][j][1]) + (v[q][j][2] * v[q][j][2] + v[q][j][3] * v[q][j][3]);
              const float rs = 1.0f / sqrtf(wave_sum(s) * (1.0f / DM) + EPS); v4u* o = (v4u*)(xn + (size_t)mm * DM) + lane; v2u* o8 = (v2u*)(ws + WS_XN8 + (size_t)mm * DM) + lane;
#pragma unroll
              for (int j = 0; j < 4; ++j) { const f32x4 ga = *((const f32x4*)g1 + 2 * lane + 128 * j), gb = *((const f32x4*)g1 + 2 * lane + 128 * j + 1); const f32x4 va = v[q][2 * j], vb = v[q][2 * j + 1];
                  const float y0 = va[0] * rs * ga[0], y1 = va[1] * rs * ga[1], y2 = va[2] * rs * ga[2], y3 = va[3] * rs * ga[3], y4 = vb[0] * rs * gb[0], y5 = vb[1] * rs * gb[1], y6 = vb[2] * rs * gb[2], y7 = vb[3] * rs * gb[3];
                  v4u w; w.x = pk2(y0, y1); w.y = pk2(y2, y3); w.z = pk2(y4, y5); w.w = pk2(y6, y7); o[64 * j] = w;
                  v2u w8; w8.x = pg8::pk4_fp8(y0, y1, y2, y3); w8.y = pg8::pk4_fp8(y4, y5, y6, y7); o8[64 * j] = w8; } } } }
}

__device__ __forceinline__ void p1_gates(const Args& a, int wg, int G) {
    const int lane = threadIdx.x & 63, wave = __builtin_amdgcn_readfirstlane(threadIdx.x >> 6), c = lane & 15, g = lane >> 4;
    unsigned char* ws = a.ws; const bf16* xn = (const bf16*)(ws + WS_XN); const bf16* wgt = (const bf16*)(ws + WS_WG); bf16* gates = (bf16*)(ws + WS_GATES);
    for (int t = wg * NWAVES + wave; t < MTOK / 16; t += G * NWAVES) {
        const bf16* ap = xn + (size_t)(16 * t + c) * DM + 8 * g; const bf16* bp = wgt + (size_t)c * DM + 8 * g;
        f32x4 acc0 = (f32x4){0.f, 0.f, 0.f, 0.f}, acc1 = acc0;
#pragma unroll 4
        for (int ks = 0; ks < 64; ++ks) { const bf16x8 af = *(const bf16x8*)(ap + 32 * ks), b0 = *(const bf16x8*)(bp + 32 * ks), b1 = *(const bf16x8*)(bp + (size_t)16 * DM + 32 * ks);
            acc0 = mfma16(af, b0, acc0); acc1 = mfma16(af, b1, acc1); }
#pragma unroll
        for (int i = 0; i < 4; ++i) { bf16* o = gates + (size_t)(16 * t + 4 * g + i) * 32; o[c] = (bf16)f2bf(acc0[i]); o[16 + c] = (bf16)f2bf(acc1[i]); }
    }
}

__device__ __forceinline__ void rope8(v4u x1, v4u x2, const float* cs, const float* sn, v4u& o1, v4u& o2) {
    const f32x4 c0 = *(const f32x4*)cs, c1 = *(const f32x4*)(cs + 4), s0 = *(const f32x4*)sn, s1 = *(const f32x4*)(sn + 4);
    const float c[8] = {c0[0], c0[1], c0[2], c0[3], c1[0], c1[1], c1[2], c1[3]}, s[8] = {s0[0], s0[1], s0[2], s0[3], s1[0], s1[1], s1[2], s1[3]};
    float a[8], b[8];
#pragma unroll
    for (int j = 0; j < 4; ++j) { a[2 * j] = bflo(x1[j]); a[2 * j + 1] = bfhi(x1[j]); b[2 * j] = bflo(x2[j]); b[2 * j + 1] = bfhi(x2[j]); }
#pragma unroll
    for (int j = 0; j < 4; ++j) { o1[j] = pk2(a[2 * j] * c[2 * j] - b[2 * j] * s[2 * j], a[2 * j + 1] * c[2 * j + 1] - b[2 * j + 1] * s[2 * j + 1]);
        o2[j] = pk2(b[2 * j] * c[2 * j] + a[2 * j] * s[2 * j], b[2 * j + 1] * c[2 * j + 1] + a[2 * j + 1] * s[2 * j + 1]); }
}
__device__ __forceinline__ void rope8r(v4u x1, v4u x2, f32x4 c0, f32x4 c1, f32x4 s0, f32x4 s1, v4u& o1, v4u& o2) {
    const float c[8] = {c0[0], c0[1], c0[2], c0[3], c1[0], c1[1], c1[2], c1[3]}, s[8] = {s0[0], s0[1], s0[2], s0[3], s1[0], s1[1], s1[2], s1[3]};
    float a[8], b[8];
#pragma unroll
    for (int j = 0; j < 4; ++j) { a[2 * j] = bflo(x1[j]); a[2 * j + 1] = bfhi(x1[j]); b[2 * j] = bflo(x2[j]); b[2 * j + 1] = bfhi(x2[j]); }
#pragma unroll
    for (int j = 0; j < 4; ++j) { o1[j] = pk2(a[2 * j] * c[2 * j] - b[2 * j] * s[2 * j], a[2 * j + 1] * c[2 * j + 1] - b[2 * j + 1] * s[2 * j + 1]);
        o2[j] = pk2(b[2 * j] * c[2 * j] + a[2 * j] * s[2 * j], b[2 * j + 1] * c[2 * j + 1] + a[2 * j + 1] * s[2 * j + 1]); }
}
__device__ __forceinline__ void rope8rf(v4u x1, v4u x2, f32x4 c0, f32x4 c1, f32x4 s0, f32x4 s1, v4u& o1, v4u& o2, v2u& e1, v2u& e2, float fs) {
    const float c[8] = {c0[0], c0[1], c0[2], c0[3], c1[0], c1[1], c1[2], c1[3]}, s[8] = {s0[0], s0[1], s0[2], s0[3], s1[0], s1[1], s1[2], s1[3]};
    float a[8], b[8], ra[8], rb[8];
#pragma unroll
    for (int j = 0; j < 4; ++j) { a[2 * j] = bflo(x1[j]); a[2 * j + 1] = bfhi(x1[j]); b[2 * j] = bflo(x2[j]); b[2 * j + 1] = bfhi(x2[j]); }
#pragma unroll
    for (int j = 0; j < 8; ++j) { ra[j] = a[j] * c[j] - b[j] * s[j]; rb[j] = b[j] * c[j] + a[j] * s[j]; }
#pragma unroll
    for (int j = 0; j < 4; ++j) { o1[j] = pk2(ra[2 * j], ra[2 * j + 1]); o2[j] = pk2(rb[2 * j], rb[2 * j + 1]); }
#pragma unroll
    for (int j = 0; j < 8; ++j) { ra[j] *= fs; rb[j] *= fs; }
    e1.x = pg8::pk4_fp8(ra[0], ra[1], ra[2], ra[3]); e1.y = pg8::pk4_fp8(ra[4], ra[5], ra[6], ra[7]); e2.x = pg8::pk4_fp8(rb[0], rb[1], rb[2], rb[3]); e2.y = pg8::pk4_fp8(rb[4], rb[5], rb[6], rb[7]);
}
__device__ __forceinline__ int kpos8_of(int k) { return (((k >> 2) & 3) << 4) | ((k >> 4) << 2) | (k & 3); }
__device__ __forceinline__ void p2_prep(const Args& a, LAS unsigned char* lds, int wg, int G) {
    const int tid = threadIdx.x, lane = tid & 63, wave = __builtin_amdgcn_readfirstlane(tid >> 6), c = lane & 15, g = lane >> 4;
    unsigned char* ws = a.ws; const bf16* proj = (const bf16*)(ws + WS_PROJ);
    const float* COS = (const float*)(ws + WS_COS); const float* SIN = (const float*)(ws + WS_SIN);
    constexpr int NCU = 256, NPU = 512;
    for (int u = wg; u < NCU + NPU; u += G) {
        if (u < NCU) {
            const int kv = u >> 7, bg = (u >> 5) & 3, np = u & 31, b = bg >> 1, gk = bg & 1;
            const bf16* src = proj + (size_t)b * SEQ * NP1 + (kv ? COL_VCMP : COL_KCMP) + gk * 128 + 8 * g;
            const bf16* wt = (const bf16*)(ws + (kv ? WS_WCV : WS_WCK)) + (size_t)c * 4096 + 8 * g;
            f32x4 acc[2][8];
#pragma unroll
            for (int i = 0; i < 2; ++i)
#pragma unroll
                for (int e = 0; e < 8; ++e) acc[i][e] = (f32x4){0.f, 0.f, 0.f, 0.f};
#pragma unroll 4
            for (int kk = 0; kk < 16; ++kk) { const int ks = 16 * wave + kk, l = ks >> 2, d0 = 32 * (ks & 3); bf16x8 af[2];
#pragma unroll
                for (int i = 0; i < 2; ++i) { int tok = 16 * (32 * np + 16 * i + c) + l; tok = tok < SEQ ? tok : SEQ - 1; af[i] = *(const bf16x8*)(src + (size_t)tok * NP1 + d0); }
#pragma unroll
                for (int e = 0; e < 8; ++e) { const bf16x8 bfr = *(const bf16x8*)(wt + (size_t)(16 * e) * 4096 + 32 * ks);
                    acc[0][e] = mfma16(af[0], bfr, acc[0][e]); acc[1][e] = mfma16(af[1], bfr, acc[1][e]); } }
            LAS float* red = (LAS float*)lds;
#pragma unroll
            for (int i = 0; i < 2; ++i)
#pragma unroll
                for (int e = 0; e < 8; ++e)
#pragma unroll
                    for (int ii = 0; ii < 4; ++ii) red[(((wave * 2 + i) * 8 + e) * 4 + ii) * 64 + lane] = acc[i][e][ii];
            __syncthreads();
            { const int ls = tid & 63, ii = (tid >> 6) & 3, i = tid >> 8, gs = ls >> 4, cs_ = ls & 15; float val[8];
#pragma unroll
              for (int e = 0; e < 8; ++e) { float v = 0.f;
#pragma unroll
                  for (int w = 0; w < 8; ++w) v += red[(((w * 2 + i) * 8 + e) * 4 + ii) * 64 + ls];
                  val[e] = v; }
              const float* ccp = (const float*)(ws + WS_CTL) + CW_CCONST + kv * 16 * 128; float cc[128 / 16 * 0 + 8];
#pragma unroll
              for (int e = 0; e < 8; ++e) { float t = 0.f;
#pragma unroll
                  for (int sl = 0; sl < 16; ++sl) t += ccp[sl * 128 + 16 * e + cs_];
                  cc[e] = t; }
              bf16* kc = (bf16*)(ws + WS_KC) + (size_t)bg * 1024 * 128; bf16* vct = (bf16*)(ws + WS_VCT) + (size_t)bg * 16 * 8192;
              const int n = 32 * np + 16 * i + 4 * gs + ii; const bool ok = n < 1023;
              if (kv == 0) { const int mt = b * SEQ + (ok ? 16 * n + 31 : 0);
#pragma unroll
                  for (int e = 0; e < 4; ++e) { const int f = 16 * e + cs_; const float x1 = val[e] + cc[e], x2 = val[e + 4] + cc[e + 4], cs = COS[(size_t)mt * 64 + f], sn = SIN[(size_t)mt * 64 + f];
                      kc[(size_t)n * 128 + f] = (bf16)f2bf(ok ? x1 * cs - x2 * sn : 0.f); kc[(size_t)n * 128 + f + 64] = (bf16)f2bf(ok ? x2 * cs + x1 * sn : 0.f); } }
              else {
#pragma unroll
                  for (int e = 0; e < 8; ++e) { const int f = 16 * e + cs_; vct[(size_t)(n >> 6) * 8192 + f * 64 + kpos_of(n & 63)] = (bf16)f2bf(ok ? val[e] + cc[e] : 0.f); } } }
            __syncthreads();
        } else {
            const int pu = u - NCU, b = pu >> 8, kb = pu & 255; const size_t m0 = (size_t)b * SEQ + 64 * kb;
#pragma unroll
            for (int bt = 0; bt < 2; ++bt) { v4u x1[4], x2[4]; f32x4 cs[4][2], sn[4][2];
#pragma unroll
                for (int k = 0; k < 4; ++k) { const int it = tid + NTHR * (4 * bt + k), tk = it >> 6, h = (it >> 3) & 7, ch = it & 7;
                    const bf16* p = proj + (m0 + tk) * NP1 + h * 128 + 8 * ch; x1[k] = *(const v4u*)p; x2[k] = *(const v4u*)(p + 64);
                    const float* cp = COS + (m0 + tk) * 64 + 8 * ch; const float* sp = SIN + (m0 + tk) * 64 + 8 * ch;
                    cs[k][0] = *(const f32x4*)cp; cs[k][1] = *(const f32x4*)(cp + 4); sn[k][0] = *(const f32x4*)sp; sn[k][1] = *(const f32x4*)(sp + 4); }
#pragma unroll
                for (int k = 0; k < 4; ++k) { const int it = tid + NTHR * (4 * bt + k), tk = it >> 6, h = (it >> 3) & 7, ch = it & 7; v4u o1, o2;
                    v2u e1, e2; rope8rf(x1[k], x2[k], cs[k][0], cs[k][1], sn[k][0], sn[k][1], o1, o2, e1, e2, 8.0f * C2); bf16* q = (bf16*)(ws + WS_QR) + (m0 + tk) * 1024 + h * 128 + 8 * ch; *(v4u*)q = o1; *(v4u*)(q + 64) = o2;
                    unsigned char* q8 = ws + WS_Q8 + (m0 + tk) * 1024 + h * 128 + 8 * ch; *(v2u*)q8 = e1; *(v2u*)(q8 + 64) = e2; } }
            { v4u x1[4], x2[4]; f32x4 cs[4][2], sn[4][2];
#pragma unroll
                for (int k = 0; k < 4; ++k) { const int it = tid + NTHR * k, tk = it >> 5, wh = (it >> 4) & 1, gk = (it >> 3) & 1, ch = it & 7;
                    const bf16* p = proj + (m0 + tk) * NP1 + (wh ? COL_KWIN : COL_KSEL) + gk * 128 + 8 * ch; x1[k] = *(const v4u*)p; x2[k] = *(const v4u*)(p + 64);
                    const float* cp = COS + (m0 + tk) * 64 + 8 * ch; const float* sp = SIN + (m0 + tk) * 64 + 8 * ch;
                    cs[k][0] = *(const f32x4*)cp; cs[k][1] = *(const f32x4*)(cp + 4); sn[k][0] = *(const f32x4*)sp; sn[k][1] = *(const f32x4*)(sp + 4); }
#pragma unroll
                for (int k = 0; k < 4; ++k) { const int it = tid + NTHR * k, tk = it >> 5, wh = (it >> 4) & 1, gk = (it >> 3) & 1, ch = it & 7; v4u o1, o2;
                    v2u e1, e2; rope8rf(x1[k], x2[k], cs[k][0], cs[k][1], sn[k][0], sn[k][1], o1, o2, e1, e2, 1.0f);
                    unsigned char* d = ws + (wh ? WS_KWIN : WS_KSEL) + ((size_t)(b * 2 + gk) * SEQ + 64 * kb + tk) * 128 + 8 * ch; *(v2u*)d = e1; *(v2u*)(d + 64) = e2; } }
            LAS unsigned char* T8 = lds;
            { v4u v[8];
#pragma unroll
                for (int k = 0; k < 8; ++k) { const int it = tid + NTHR * k, q = it >> 10, tk = (it >> 4) & 63, ch = it & 15, wh = q >> 1, gk = q & 1;
                    v[k] = *(const v4u*)(proj + (m0 + tk) * NP1 + (wh ? COL_VWIN : COL_VSEL) + gk * 128 + 8 * ch); }
#pragma unroll
                for (int k = 0; k < 8; ++k) { const int it = tid + NTHR * k, q = it >> 10, tk = (it >> 4) & 63, ch = it & 15;
                    LAS unsigned char* t = T8 + q * (128 * 80) + (8 * ch) * 80 + (kpos8_of(tk) ^ ((ch >> 1) << 3));
                    const unsigned w0 = pg8::pk4_fp8(bflo(v[k][0]), bfhi(v[k][0]), bflo(v[k][1]), bfhi(v[k][1])), w1 = pg8::pk4_fp8(bflo(v[k][2]), bfhi(v[k][2]), bflo(v[k][3]), bfhi(v[k][3]));
#pragma unroll
                    for (int j = 0; j < 4; ++j) { t[j * 80] = (unsigned char)(w0 >> (8 * j)); t[(4 + j) * 80] = (unsigned char)(w1 >> (8 * j)); } } }
            __syncthreads();
#pragma unroll
            for (int k = 0; k < 4; ++k) { const int it = tid + NTHR * k, q = it >> 9, d = (it >> 2) & 127, ch = it & 3, wh = q >> 1, gk = q & 1;
                const int sw = (d >> 4) & 7; v4u r = *(const LAS v4u*)(T8 + q * (128 * 80) + d * 80 + 16 * (ch ^ (sw >> 1))); if (sw & 1) r = (v4u){r.z, r.w, r.x, r.y};
                *(v4u*)(ws + (wh ? WS_VWINT : WS_VSELT) + ((size_t)(b * 2 + gk) * 256 + kb) * 8192 + d * 64 + 16 * ch) = r; }
            __syncthreads();
        }
    }
}

constexpr int KL_STRIDE = 272, VL_STRIDE = 144, KL_BYTES = 64 * KL_STRIDE, VL_BYTES = 128 * VL_STRIDE;
__device__ __forceinline__ void stage_load(const bf16* src, v4u (&r)[2]) {
#pragma unroll
    for (int i = 0; i < 2; ++i) r[i] = *(const v4u*)((const char*)src + (size_t)(threadIdx.x + 512 * i) * 16);
}
__device__ __forceinline__ void stage_write_k(LAS unsigned char* Kl, const v4u (&r)[2]) {
#pragma unroll
    for (int i = 0; i < 2; ++i) { const int id = threadIdx.x + 512 * i; *(LAS v4u*)(Kl + (id >> 4) * KL_STRIDE + (id & 15) * 16) = r[i]; }
}
__device__ __forceinline__ void stage_write_v(LAS unsigned char* Vl, const v4u (&r)[2]) {
#pragma unroll
    for (int i = 0; i < 2; ++i) { const int id = threadIdx.x + 512 * i; *(LAS v4u*)(Vl + (id >> 3) * VL_STRIDE + (id & 7) * 16) = r[i]; }
}
__device__ __forceinline__ void qk_tile(const LAS unsigned char* Kl, const bf16x8 (&qf)[4], f32x4 (&s)[4], int c, int g) {
#pragma unroll
    for (int kt = 0; kt < 4; ++kt) { s[kt] = (f32x4){0.f, 0.f, 0.f, 0.f};
#pragma unroll
        for (int ks = 0; ks < 4; ++ks) { const bf16x8 kf = *(const LAS bf16x8*)(Kl + (16 * kt + c) * KL_STRIDE + (32 * ks + 8 * g) * 2); s[kt] = mfma16(kf, qf[ks], s[kt]); } }
}
__device__ __forceinline__ void pv_tile(const LAS unsigned char* Vl, const f32x4 (&p)[4], f32x4 (&o)[8], int c, int g) {
#pragma unroll
    for (int s2 = 0; s2 < 2; ++s2) { const bf16x8 pf = pack8(p[2 * s2], p[2 * s2 + 1]);
#pragma unroll
        for (int dt = 0; dt < 8; ++dt) { const bf16x8 vf = *(const LAS bf16x8*)(Vl + (16 * dt + c) * VL_STRIDE + (32 * s2 + 8 * g) * 2); o[dt] = mfma16(vf, pf, o[dt]); } }
}
__device__ __forceinline__ void online_sm(f32x4 (&s)[4], float& m, float& l, float& alpha) {
    float tm = fmaxf(fmaxf(s[0][0], s[0][1]), fmaxf(s[0][2], s[0][3]));
#pragma unroll
    for (int kt = 1; kt < 4; ++kt) tm = fmaxf(tm, fmaxf(fmaxf(s[kt][0], s[kt][1]), fmaxf(s[kt][2], s[kt][3])));
    tm = fmaxf(tm, __shfl_xor(tm, 16)); tm = fmaxf(tm, __shfl_xor(tm, 32));
    const float mn = fmaxf(m, tm); alpha = __builtin_amdgcn_exp2f((m - mn) * C2); m = mn; float ls = 0.f;
#pragma unroll
    for (int kt = 0; kt < 4; ++kt)
#pragma unroll
        for (int i = 0; i < 4; ++i) { const float p = __builtin_amdgcn_exp2f((s[kt][i] - mn) * C2); s[kt][i] = p; ls += p; }
    l = l * alpha + ls;
}
__device__ __forceinline__ void load_qf(const bf16* qr, size_t mrow, int head, int g, bf16x8 (&qf)[4]) {
#pragma unroll
    for (int ks = 0; ks < 4; ++ks) qf[ks] = *(const bf16x8*)(qr + mrow * 1024 + head * 128 + 32 * ks + 8 * g);
}
__device__ __forceinline__ void pin_qf(bf16x8 (&qf)[2][4]) {
#pragma unroll
    for (int cs = 0; cs < 2; ++cs)
#pragma unroll
        for (int ks = 0; ks < 4; ++ks) asm volatile("" : "+v"(qf[cs][ks]));
}
__device__ __forceinline__ void store_o(bf16* O, size_t mrow, int head, int g, const f32x4 (&o)[8], float inv) {
#pragma unroll
    for (int dt = 0; dt < 8; ++dt) { v2u w; w.x = pk2(o[dt][0] * inv, o[dt][1] * inv); w.y = pk2(o[dt][2] * inv, o[dt][3] * inv); *(v2u*)(O + mrow * 1024 + head * 128 + 16 * dt + 4 * g) = w; }
}
__device__ __forceinline__ void unit_bq(int u, int& bg, int& qt) { bg = u >> 8; const int x = u & 255; qt = (bg & 1) ? 255 - x : x; }


constexpr int SLOT_BYTES = 32768, TMK_OFF = 132096;
#define WAITV(n) asm volatile("s_waitcnt vmcnt(" #n ")" ::: "memory")
#define RAWBAR() do { asm volatile("" ::: "memory"); __builtin_amdgcn_s_barrier(); asm volatile("" ::: "memory"); } while (0)
__device__ __forceinline__ void dma_k(LAS unsigned char* slot, const bf16* ksrc, int wave, int lane) {
#pragma unroll
    for (int r = 0; r < 2; ++r) { const int row = 4 * wave + (lane >> 4) + 32 * r, pos = lane & 15;
        __builtin_amdgcn_global_load_lds((const unsigned*)(ksrc + row * 128 + ((pos ^ (row & 15)) * 8)), (LAS unsigned*)(slot + wave * 1024 + r * 8192), 16, 0, 0); }
}
__device__ __forceinline__ void dma_v(LAS unsigned char* slot, const bf16* vsrc, int wave, int lane) {
#pragma unroll
    for (int r = 0; r < 2; ++r) { const int d = 8 * wave + (lane >> 3) + 64 * r, pos = lane & 7;
        __builtin_amdgcn_global_load_lds((const unsigned*)(vsrc + d * 64 + ((pos ^ ((d >> 1) & 7)) * 8)), (LAS unsigned*)(slot + 16384 + wave * 1024 + r * 8192), 16, 0, 0); }
}
__device__ __forceinline__ void qk_tile_sw(const LAS unsigned char* slot, const bf16x8 (&qf)[4], f32x4 (&s)[4], const int (&kx)[4]) {
#pragma unroll
    for (int kt = 0; kt < 4; ++kt) { s[kt] = (f32x4){0.f, 0.f, 0.f, 0.f};
#pragma unroll
        for (int ks = 0; ks < 4; ++ks) { const bf16x8 kf = *(const LAS bf16x8*)(slot + kt * 4096 + kx[ks]); s[kt] = mfma16(kf, qf[ks], s[kt]); } }
}
__device__ __forceinline__ void pv_tile_sw(const LAS unsigned char* slot, const f32x4 (&p)[4], f32x4 (&o)[8], const int (&vx)[2]) {
#pragma unroll
    for (int s2 = 0; s2 < 2; ++s2) { const bf16x8 pf = pack8(p[2 * s2], p[2 * s2 + 1]);
#pragma unroll
        for (int dt = 0; dt < 8; ++dt) { const bf16x8 vf = *(const LAS bf16x8*)(slot + 16384 + dt * 2048 + vx[s2]); o[dt] = mfma16(vf, pf, o[dt]); } }
}
__device__ __forceinline__ float lmax16(float x) { const unsigned u = __builtin_bit_cast(unsigned, x); auto r = __builtin_amdgcn_permlane16_swap(u, u, false, false); unsigned r0 = r[0], r1 = r[1]; asm volatile("" : "+v"(r1)); return fmaxf(__builtin_bit_cast(float, r0), __builtin_bit_cast(float, r1)); }
__device__ __forceinline__ float lmax32(float x) { const unsigned u = __builtin_bit_cast(unsigned, x); auto r = __builtin_amdgcn_permlane32_swap(u, u, false, false); unsigned r0 = r[0], r1 = r[1]; asm volatile("" : "+v"(r1)); return fmaxf(__builtin_bit_cast(float, r0), __builtin_bit_cast(float, r1)); }
__device__ __forceinline__ float ladd16(float x) { const unsigned u = __builtin_bit_cast(unsigned, x); auto r = __builtin_amdgcn_permlane16_swap(u, u, false, false); unsigned r0 = r[0], r1 = r[1]; asm volatile("" : "+v"(r1)); return __builtin_bit_cast(float, r0) + __builtin_bit_cast(float, r1); }
__device__ __forceinline__ float ladd32(float x) { const unsigned u = __builtin_bit_cast(unsigned, x); auto r = __builtin_amdgcn_permlane32_swap(u, u, false, false); unsigned r0 = r[0], r1 = r[1]; asm volatile("" : "+v"(r1)); return __builtin_bit_cast(float, r0) + __builtin_bit_cast(float, r1); }
__device__ __forceinline__ void online_sm2(f32x4 (&s)[4], float& m, float& l, float& alpha) {
    float tm = fmaxf(fmaxf(s[0][0], s[0][1]), fmaxf(s[0][2], s[0][3]));
#pragma unroll
    for (int kt = 1; kt < 4; ++kt) tm = fmaxf(tm, fmaxf(fmaxf(s[kt][0], s[kt][1]), fmaxf(s[kt][2], s[kt][3])));
    tm = lmax16(tm); tm = lmax32(tm);
    const float mn = fmaxf(m, tm); alpha = __builtin_amdgcn_exp2f((m - mn) * C2); m = mn; float ls = 0.f;
#pragma unroll
    for (int kt = 0; kt < 4; ++kt)
#pragma unroll
        for (int i = 0; i < 4; ++i) { const float p = __builtin_amdgcn_exp2f((s[kt][i] - mn) * C2); s[kt][i] = p; ls += p; }
    l = l * alpha + ls;
}

__device__ __forceinline__ void qk2(const LAS unsigned char* slot, const bf16x8 (&qf)[2][4], f32x4 (&s)[2][4], const int (&kx)[4]) {
    bf16x8 kf[4][4];
#pragma unroll
    for (int kt = 0; kt < 4; ++kt)
#pragma unroll
        for (int ks = 0; ks < 4; ++ks) kf[kt][ks] = *(const LAS bf16x8*)(slot + kt * 4096 + kx[ks]);
    __builtin_amdgcn_sched_barrier(0);
#pragma unroll
    for (int kt = 0; kt < 4; ++kt) { s[0][kt] = (f32x4){0.f, 0.f, 0.f, 0.f}; s[1][kt] = (f32x4){0.f, 0.f, 0.f, 0.f};
#pragma unroll
        for (int ks = 0; ks < 4; ++ks) { s[0][kt] = mfma16(kf[kt][ks], qf[0][ks], s[0][kt]); s[1][kt] = mfma16(kf[kt][ks], qf[1][ks], s[1][kt]); } }
}
__device__ __forceinline__ void pv2(const LAS unsigned char* slot, const f32x4 (&p)[2][4], f32x4 (&o)[2][8], const int (&vx)[2]) {
#pragma unroll
    for (int s2 = 0; s2 < 2; ++s2) { const bf16x8 pf0 = pack8(p[0][2 * s2], p[0][2 * s2 + 1]), pf1 = pack8(p[1][2 * s2], p[1][2 * s2 + 1]);
#pragma unroll
        for (int dt = 0; dt < 8; ++dt) { const bf16x8 vf = *(const LAS bf16x8*)(slot + 16384 + dt * 2048 + vx[s2]); o[0][dt] = mfma16(vf, pf0, o[0][dt]); o[1][dt] = mfma16(vf, pf1, o[1][dt]); } }
}
__device__ __forceinline__ void pv2l(const LAS unsigned char* slot, const f32x4 (&p)[2][4], f32x4 (&o)[2][8], f32x4 (&lacc)[2], const int (&vx)[2]) {
    const bf16x8 ones8 = __builtin_bit_cast(bf16x8, (v4u){0x3f803f80u, 0x3f803f80u, 0x3f803f80u, 0x3f803f80u});
#pragma unroll
    for (int s2 = 0; s2 < 2; ++s2) { const bf16x8 pf0 = pack8(p[0][2 * s2], p[0][2 * s2 + 1]), pf1 = pack8(p[1][2 * s2], p[1][2 * s2 + 1]);
        lacc[0] = mfma16(ones8, pf0, lacc[0]); lacc[1] = mfma16(ones8, pf1, lacc[1]);
#pragma unroll
        for (int dt = 0; dt < 8; ++dt) { const bf16x8 vf = *(const LAS bf16x8*)(slot + 16384 + dt * 2048 + vx[s2]); o[0][dt] = mfma16(vf, pf0, o[0][dt]); o[1][dt] = mfma16(vf, pf1, o[1][dt]); } }
}
__device__ __forceinline__ float quad_sum(float x) {
    const float y = x + __builtin_bit_cast(float, __builtin_amdgcn_mov_dpp(__builtin_bit_cast(int, x), 0xB1, 0xf, 0xf, true));
    return y + __builtin_bit_cast(float, __builtin_amdgcn_mov_dpp(__builtin_bit_cast(int, y), 0x4E, 0xf, 0xf, true));
}
template <bool HAS_O> __device__ __forceinline__ void sm_lean(f32x4 (&s)[4], float& m, float& l, f32x4 (&o)[8], bool rowok) {
    float tm = fmaxf(fmaxf(s[0][0], s[0][1]), fmaxf(s[0][2], s[0][3]));
#pragma unroll
    for (int kt = 1; kt < 4; ++kt) tm = fmaxf(tm, fmaxf(fmaxf(s[kt][0], s[kt][1]), fmaxf(s[kt][2], s[kt][3])));
    tm = lmax16(tm); tm = lmax32(tm);
    tm = rowok ? tm : -__builtin_inff();
    const float mn = fmaxf(m, tm), alpha = __builtin_amdgcn_exp2f((m - mn) * C2); m = mn;
    const float mb = rowok ? mn * C2 : __builtin_inff(); float ls = 0.f;
#pragma unroll
    for (int kt = 0; kt < 4; ++kt)
#pragma unroll
        for (int i = 0; i < 4; ++i) { const float p = __builtin_amdgcn_exp2f(__builtin_fmaf(s[kt][i], C2, -mb)); s[kt][i] = p; ls += p; }
    l = l * alpha + ls;
    if (HAS_O) { if (!__all(alpha == 1.0f)) {
#pragma unroll
        for (int dt = 0; dt < 8; ++dt) o[dt] = o[dt] * alpha; } }
}
__device__ __forceinline__ float row16_sum(float x) {
    x = quad_sum(x);
    x += __builtin_bit_cast(float, __builtin_amdgcn_mov_dpp(__builtin_bit_cast(int, x), 0x141, 0xf, 0xf, true));
    x += __builtin_bit_cast(float, __builtin_amdgcn_mov_dpp(__builtin_bit_cast(int, x), 0x140, 0xf, 0xf, true));
    return x;
}
__device__ __forceinline__ float wave_sum_v(float x) { return ladd32(ladd16(row16_sum(x))); }
__device__ __forceinline__ float amax3(float a, float b, float c) { float r; asm("v_max3_f32 %0, %1, %2, %3" : "=v"(r) : "v"(a), "v"(b), "v"(c)); return r; }
__device__ __forceinline__ float amax2(float a, float b) { float r; asm("v_max_f32 %0, %1, %2" : "=v"(r) : "v"(a), "v"(b)); return r; }
__device__ __forceinline__ float xmax16(float x) { const unsigned u = __builtin_bit_cast(unsigned, x); auto r = __builtin_amdgcn_permlane16_swap(u, u, false, false); unsigned r0 = r[0], r1 = r[1]; asm volatile("" : "+v"(r1)); return amax2(__builtin_bit_cast(float, r0), __builtin_bit_cast(float, r1)); }
__device__ __forceinline__ float xmax32(float x) { const unsigned u = __builtin_bit_cast(unsigned, x); auto r = __builtin_amdgcn_permlane32_swap(u, u, false, false); unsigned r0 = r[0], r1 = r[1]; asm volatile("" : "+v"(r1)); return amax2(__builtin_bit_cast(float, r0), __builtin_bit_cast(float, r1)); }
constexpr float SM_THR = 10.0f;
__device__ __forceinline__ void sm_fast(f32x4 (&s)[4], float& m, f32x4& lacc, f32x4 (&o)[8], bool rowok) {
    float tm = amax3(amax3(s[0][0], s[0][1], s[0][2]), amax3(s[0][3], s[1][0], s[1][1]), amax3(s[1][2], s[1][3], s[2][0]));
    tm = amax3(tm, amax3(s[2][1], s[2][2], s[2][3]), amax3(s[3][0], s[3][1], s[3][2])); tm = amax2(tm, s[3][3]);
    tm = xmax16(tm); tm = xmax32(tm);
    tm = rowok ? tm : -__builtin_inff();
    if (__any((tm - m) * C2 > SM_THR)) { const float mn = amax2(m, tm), alpha = __builtin_amdgcn_exp2f((m - mn) * C2); m = mn; lacc = lacc * alpha;
#pragma unroll
        for (int dt = 0; dt < 8; ++dt) o[dt] = o[dt] * alpha; }
    const float mb = rowok ? m * C2 : __builtin_inff();
#pragma unroll
    for (int kt = 0; kt < 4; ++kt)
#pragma unroll
        for (int i = 0; i < 4; ++i) s[kt][i] = __builtin_amdgcn_exp2f(__builtin_fmaf(s[kt][i], C2, -mb));
}
#define SWZ_OFFSETS() int kx[4], vx[2]; \
    _Pragma("unroll") for (int ks_ = 0; ks_ < 4; ++ks_) kx[ks_] = c * 256 + ((((g ^ c) & 15) << 4) ^ (ks_ << 6)); \
    _Pragma("unroll") for (int s2_ = 0; s2_ < 2; ++s2_) vx[s2_] = c * 128 + ((((g ^ (c >> 1)) & 7) << 4) ^ (s2_ << 6))

__device__ __forceinline__ void unit_sel(int wg, int r, int G, int& bg, int& qt) {
    if (G == 256) { const int x = wg & 7, i = wg >> 3, k = (r & 1) ? (96 - 32 * r + i) : (127 - 32 * r - i); bg = x >> 1; qt = (x & 1) + 2 * k; }
    else unit_bq(wg + r * G, bg, qt);
}

using pg8::v8i32; using pg8::f32x2;
constexpr int TOPK_LSB = 10; constexpr unsigned TOPK_LOWMASK = (1u << TOPK_LSB) - 1u;
constexpr int IMP_OFF = 65536;
static_assert(IMP_OFF + 64 * 260 * 4 <= TMK_OFF && TMK_OFF + 2048 <= MISC_OFF, "cmp LDS map");
template <int CM  > __device__ __forceinline__ void p3_cmp(const Args& a, LAS unsigned char* lds, int wg, int G) {
    const int tid = threadIdx.x, lane = tid & 63, wave = __builtin_amdgcn_readfirstlane(tid >> 6), c = lane & 15, g = lane >> 4;
    unsigned char* ws = a.ws; const bf16* qr = (const bf16*)(ws + WS_QR); bf16* OC = (bf16*)(ws + WS_OC);
    LAS float* imp = (LAS float*)(lds + IMP_OFF); LAS unsigned* tmk = (LAS unsigned*)(lds + TMK_OFF);
    SWZ_OFFSETS();
    for (int u = wg; u < 1024; u += G) {
        int bg, qt; unit_bq(u, bg, qt); const int b = bg >> 1, gk = bg & 1, t0 = 64 * qt;
        const bf16* kc = (const bf16*)(ws + WS_KC) + (size_t)bg * 1024 * 128; const bf16* vct = (const bf16*)(ws + WS_VCT) + (size_t)bg * 16 * 8192;
        const int ntile = (4 * qt + 66) >> 6;
        __syncthreads();
        tmk[tid] = 0u;
        bf16x8 qf[2][4]; int nmax[2]; float m[2]; f32x2 lp[2];
#pragma unroll
        for (int cs = 0; cs < 2; ++cs) { const int ql = 8 * wave + 4 * cs + (c >> 2), t = t0 + ql; load_qf(qr, (size_t)b * SEQ + t, 4 * gk + (c & 3), g, qf[cs]);
            nmax[cs] = t >= 31 ? (t - 31) >> 4 : -1; m[cs] = -1e30f; lp[cs] = (f32x2){0.f, 0.f}; }
        pin_qf(qf);
        __syncthreads();
        if (CM != 2) dma_k(lds, kc, wave, lane);
        for (int i = 0; i < (CM == 2 ? 0 : ntile); ++i) {
            WAITV(0); RAWBAR();
            if (i + 1 < ntile) dma_k(lds + ((i + 1) & 1) * SLOT_BYTES, kc + (size_t)(i + 1) * 64 * 128, wave, lane);
            const LAS unsigned char* slot = lds + (i & 1) * SLOT_BYTES;
            bf16x8 kf[4][4];
#pragma unroll
            for (int kt = 0; kt < 4; ++kt)
#pragma unroll
                for (int ks = 0; ks < 4; ++ks) kf[kt][ks] = *(const LAS bf16x8*)(slot + kt * 4096 + kx[ks]);
            __builtin_amdgcn_sched_barrier(0);
            f32x4 s0[4], s1[4];
#pragma unroll
            for (int kt = 0; kt < 4; ++kt) { s0[kt] = (f32x4){0.f, 0.f, 0.f, 0.f};
#pragma unroll
                for (int ks = 0; ks < 4; ++ks) s0[kt] = mfma16(kf[kt][ks], qf[0][ks], s0[kt]); }
            __builtin_amdgcn_sched_barrier(0);
            const bool bnd1 = 64 * i + 63 > 4 * qt - 2;
#define CMP_QK1(kt_) do { s1[kt_] = (f32x4){0.f, 0.f, 0.f, 0.f}; _Pragma("unroll") for (int ks_ = 0; ks_ < 4; ++ks_) s1[kt_] = mfma16(kf[kt_][ks_], qf[1][ks_], s1[kt_]); } while (0)
#define CMP_MASK(S, CS) do { if (bnd1) { _Pragma("unroll") for (int kt_ = 0; kt_ < 4; ++kt_) _Pragma("unroll") for (int ii_ = 0; ii_ < 4; ++ii_) { const int n_ = 64 * i + 16 * kt_ + 4 * g + ii_; S[kt_][ii_] = n_ <= nmax[CS] ? S[kt_][ii_] : -__builtin_inff(); } } } while (0)
#define CMP_MAXCHK(S, CS) do { float tm_ = fmaxf(fmaxf(fmaxf(S[0][0], S[0][1]), fmaxf(S[0][2], S[0][3])), fmaxf(fmaxf(S[1][0], S[1][1]), fmaxf(S[1][2], S[1][3]))); \
        tm_ = fmaxf(tm_, fmaxf(fmaxf(fmaxf(S[2][0], S[2][1]), fmaxf(S[2][2], S[2][3])), fmaxf(fmaxf(S[3][0], S[3][1]), fmaxf(S[3][2], S[3][3])))); \
        if (__any((tm_ - m[CS]) * C2 > 8.0f)) { tm_ = lmax32(lmax16(tm_)); const float mn_ = fmaxf(m[CS], tm_), al_ = __builtin_amdgcn_exp2f((m[CS] - mn_) * C2); m[CS] = mn_; lp[CS] = lp[CS] * al_; } } while (0)
#define CMP_EXPSUM(S, CS, kt_) do { const float mbv_ = m[CS] * C2; _Pragma("unroll") for (int ii_ = 0; ii_ < 4; ++ii_) S[kt_][ii_] = __builtin_amdgcn_exp2f(__builtin_fmaf(S[kt_][ii_], C2, -mbv_)); \
        lp[CS] += (f32x2){S[kt_][0], S[kt_][1]}; lp[CS] += (f32x2){S[kt_][2], S[kt_][3]}; } while (0)
            CMP_QK1(0); CMP_MASK(s0, 0); CMP_MAXCHK(s0, 0); __builtin_amdgcn_sched_barrier(0);
            CMP_QK1(1); CMP_EXPSUM(s0, 0, 0); CMP_EXPSUM(s0, 0, 1); __builtin_amdgcn_sched_barrier(0);
            CMP_QK1(2); CMP_EXPSUM(s0, 0, 2); __builtin_amdgcn_sched_barrier(0);
            CMP_QK1(3); CMP_EXPSUM(s0, 0, 3); __builtin_amdgcn_sched_barrier(0);
            CMP_MASK(s1, 1); CMP_MAXCHK(s1, 1);
#pragma unroll
            for (int kt = 0; kt < 4; ++kt) CMP_EXPSUM(s1, 1, kt);
        }
        float mb[2];
#pragma unroll
        for (int cs = 0; cs < 2; ++cs) { float lt = lp[cs].x + lp[cs].y; lt = ladd16(lt); lt = ladd32(lt); mb[cs] = lt > 0.f ? m[cs] * C2 + __builtin_amdgcn_logf(lt) : __builtin_inff(); }
        __syncthreads();
        f32x4 o[2][8];
#pragma unroll
        for (int cs = 0; cs < 2; ++cs)
#pragma unroll
            for (int dt = 0; dt < 8; ++dt) o[cs][dt] = (f32x4){0.f, 0.f, 0.f, 0.f};
        float wrap[2] = {0.f, 0.f};
        if (CM < 2) { dma_k(lds, kc, wave, lane); dma_v(lds, vct, wave, lane); }
        for (int i = 0; i < (CM >= 2 ? 0 : ntile); ++i) {
            WAITV(0); RAWBAR();
            if (i + 1 < ntile) { LAS unsigned char* sl = lds + ((i + 1) & 1) * SLOT_BYTES; dma_k(sl, kc + (size_t)(i + 1) * 64 * 128, wave, lane); dma_v(sl, vct + (size_t)(i + 1) * 8192, wave, lane); }
            const LAS unsigned char* slot = lds + (i & 1) * SLOT_BYTES;
            const bool bnd = 64 * i + 63 > 4 * qt - 2;
            f32x4 s0[4], s1[4];
            { bf16x8 kf[4][4];
#pragma unroll
              for (int kt = 0; kt < 4; ++kt)
#pragma unroll
                  for (int ks = 0; ks < 4; ++ks) kf[kt][ks] = *(const LAS bf16x8*)(slot + kt * 4096 + kx[ks]);
              __builtin_amdgcn_sched_barrier(0);
#pragma unroll
              for (int kt = 0; kt < 4; ++kt) { s0[kt] = (f32x4){0.f, 0.f, 0.f, 0.f};
#pragma unroll
                  for (int ks = 0; ks < 4; ++ks) s0[kt] = mfma16(kf[kt][ks], qf[0][ks], s0[kt]); }
              __builtin_amdgcn_sched_barrier(0);
#define CMP_PIMP(S, CS, kt_) do { const int ql_ = 8 * wave + 4 * CS + (c >> 2); \
        _Pragma("unroll") for (int ii_ = 0; ii_ < 4; ++ii_) { const int n_ = 64 * i + 16 * kt_ + 4 * g + ii_; const float p_ = __builtin_amdgcn_exp2f(__builtin_fmaf(S[kt_][ii_], C2, -mb[CS])); S[kt_][ii_] = (!bnd || n_ <= nmax[CS]) ? p_ : 0.f; } \
        const float s4_ = quad_sum((S[kt_][0] + S[kt_][1]) + (S[kt_][2] + S[kt_][3])), p3_ = quad_sum(S[kt_][3]); \
        const float up_ = __shfl(p3_, (lane + 48) & 63); const float cin_ = g > 0 ? up_ : wrap[CS]; wrap[CS] = up_; \
        if ((c & 3) == 0) imp[ql_ * 260 + 16 * i + 4 * kt_ + g] = s4_ + cin_; } while (0)
#define CMP_QK1B(kt_) do { s1[kt_] = (f32x4){0.f, 0.f, 0.f, 0.f}; _Pragma("unroll") for (int ks_ = 0; ks_ < 4; ++ks_) s1[kt_] = mfma16(kf[kt_][ks_], qf[1][ks_], s1[kt_]); } while (0)
              CMP_QK1B(0); CMP_PIMP(s0, 0, 0); __builtin_amdgcn_sched_barrier(0);
              CMP_QK1B(1); CMP_PIMP(s0, 0, 1); __builtin_amdgcn_sched_barrier(0);
              CMP_QK1B(2); CMP_PIMP(s0, 0, 2); __builtin_amdgcn_sched_barrier(0);
              CMP_QK1B(3); CMP_PIMP(s0, 0, 3); __builtin_amdgcn_sched_barrier(0); }
            { const bf16x8 pa = pack8(s0[0], s0[1]), pb = pack8(s0[2], s0[3]); bf16x8 vf[8];
#pragma unroll
              for (int dt = 0; dt < 8; ++dt) vf[dt] = *(const LAS bf16x8*)(slot + 16384 + dt * 2048 + vx[0]);
              __builtin_amdgcn_sched_barrier(0);
#pragma unroll
              for (int dt = 0; dt < 4; ++dt) o[0][dt] = mfma16(vf[dt], pa, o[0][dt]);
              CMP_PIMP(s1, 1, 0); __builtin_amdgcn_sched_barrier(0);
#pragma unroll
              for (int dt = 4; dt < 8; ++dt) o[0][dt] = mfma16(vf[dt], pa, o[0][dt]);
              CMP_PIMP(s1, 1, 1); __builtin_amdgcn_sched_barrier(0);
#pragma unroll
              for (int dt = 0; dt < 8; ++dt) vf[dt] = *(const LAS bf16x8*)(slot + 16384 + dt * 2048 + vx[1]);
              __builtin_amdgcn_sched_barrier(0);
#pragma unroll
              for (int dt = 0; dt < 4; ++dt) o[0][dt] = mfma16(vf[dt], pb, o[0][dt]);
              CMP_PIMP(s1, 1, 2); __builtin_amdgcn_sched_barrier(0);
#pragma unroll
              for (int dt = 4; dt < 8; ++dt) o[0][dt] = mfma16(vf[dt], pb, o[0][dt]);
              CMP_PIMP(s1, 1, 3); __builtin_amdgcn_sched_barrier(0);
              const bf16x8 qa = pack8(s1[0], s1[1]), qb = pack8(s1[2], s1[3]);
#pragma unroll
              for (int dt = 0; dt < 8; ++dt) o[1][dt] = mfma16(vf[dt], qb, o[1][dt]);
              __builtin_amdgcn_sched_barrier(0);
#pragma unroll
              for (int dt = 0; dt < 8; ++dt) vf[dt] = *(const LAS bf16x8*)(slot + 16384 + dt * 2048 + vx[0]);
#pragma unroll
              for (int dt = 0; dt < 8; ++dt) o[1][dt] = mfma16(vf[dt], qa, o[1][dt]); }
        }
#pragma unroll
        for (int cs = 0; cs < 2; ++cs) { const int ql = 8 * wave + 4 * cs + (c >> 2); store_o(OC, (size_t)b * SEQ + t0 + ql, 4 * gk + (c & 3), g, o[cs], 1.0f); }
        __syncthreads();
        const int cur = qt;
        for (int q0 = 0; q0 < ((CM == 1 || CM == 3) ? 0 : 8); q0 += 4) { unsigned key[4][4], prefix[4] = {0u, 0u, 0u, 0u};
#pragma unroll
            for (int u4 = 0; u4 < 4; ++u4) { const int ql = 8 * wave + q0 + u4;
#pragma unroll
                for (int k = 0; k < 4; ++k) { const int j = 64 * k + lane; const bool forced = (j == 0) | (j == cur) | (j == cur - 1);
                    key[u4][k] = forced ? 0xffffffffu : (j <= cur ? __builtin_bit_cast(unsigned, imp[ql * 260 + j]) + 1u : 0u); } }
            const int nk = (cur >> 6) + 1;
#define TOPK_SEARCH(NK) for (int bit = 30; bit >= TOPK_LSB; --bit) { \
                _Pragma("unroll") for (int u4 = 0; u4 < 4; ++u4) { const unsigned trial = prefix[u4] | (1u << bit); int cnt = 0; \
                    _Pragma("unroll") for (int k = 0; k < NK; ++k) cnt += __popcll(__ballot(key[u4][k] >= trial)); \
                    if (cnt >= 16) prefix[u4] = trial; } }
            if (nk == 1) { TOPK_SEARCH(1) } else if (nk == 2) { TOPK_SEARCH(2) } else if (nk == 3) { TOPK_SEARCH(3) } else { TOPK_SEARCH(4) }
#undef TOPK_SEARCH
#pragma unroll
            for (int u4 = 0; u4 < 4; ++u4) { const int ql = 8 * wave + q0 + u4; int cgt = 0; const unsigned hi = prefix[u4] | TOPK_LOWMASK;
#pragma unroll
                for (int k = 0; k < 4; ++k) cgt += __popcll(__ballot(key[u4][k] > hi));
                int need = 16 - cgt, before = 0;
#pragma unroll
                for (int k = 0; k < 4; ++k) { const bool ineq = key[u4][k] >= prefix[u4] && key[u4][k] <= hi; const unsigned long long eq = __ballot(ineq); const int rank = before + __popcll(eq & ((1ull << lane) - 1ull)); before += __popcll(eq);
                    const bool sel = (key[u4][k] > hi) || (ineq && rank < need); const int j = 64 * k + lane;
                    if (sel && j <= cur) __hip_atomic_fetch_or(tmk + 2 * j + (ql >> 5), 1u << (ql & 31), __ATOMIC_RELAXED, __HIP_MEMORY_SCOPE_WORKGROUP); } }
        }
        __syncthreads();
        if (tid < 256) { v2u w; w.x = tmk[2 * tid]; w.y = tmk[2 * tid + 1]; *((v2u*)(ws + WS_TMASK) + ((size_t)(bg * 256 + qt) * 256 + tid)) = w; }
    }
}

constexpr int SLOT8 = 16384, SELB = 4;
static_assert(2 * SELB * SLOT8 <= TMK_OFF, "sel ring");
constexpr float SM_THR8 = 8.0f;
__device__ __forceinline__ void dma_k8(LAS unsigned char* slot, const unsigned char* ksrc, int wave, int lane) {
    const unsigned row = 8u * wave + (lane >> 3), pos = lane & 7, off = row * 128u + ((pos ^ ((row ^ (row >> 1)) & 7u)) * 16u);
    __builtin_amdgcn_global_load_lds((const unsigned*)(ksrc + off), (LAS unsigned*)(slot + wave * 1024), 16, 0, 0);
}
__device__ __forceinline__ void dma_v8(LAS unsigned char* slot, const unsigned char* vsrc, int wave, int lane) {
    const unsigned d = 16u * wave + (lane >> 2), pos = lane & 3, off = d * 64u + ((pos ^ (((d >> 2) & 1u) << 1)) * 16u);
    __builtin_amdgcn_global_load_lds((const unsigned*)(vsrc + off), (LAS unsigned*)(slot + 8192 + wave * 1024), 16, 0, 0);
}
#define MFMA8_B(acc, A, B) acc = __builtin_amdgcn_mfma_scale_f32_16x16x128_f8f6f4(A, B, acc, 0, 0, 0, 0x7f7f7f7f, 0, 0x7f7f7f7f)
#define SEL_GAP() __builtin_amdgcn_sched_barrier(0)
#define MFMA8_ACC(acc, A, B) asm volatile("v_mfma_scale_f32_16x16x128_f8f6f4 %0, %1, %2, %0, %3, %3 op_sel_hi:[0,0,0]" : "+v"(acc) : "v"(A), "v"(B), "v"(0x7f7f7f7f))
__device__ __forceinline__ float max16(const f32x4 (&s)[4]) {
    float t0, t1, t2;
    asm("v_max3_f32 %0, %3, %4, %5\n v_max3_f32 %1, %6, %7, %8\n v_max3_f32 %2, %9, %10, %11\n v_max3_f32 %0, %0, %1, %2\n v_max3_f32 %1, %12, %13, %14\n v_max3_f32 %2, %15, %16, %17\n v_max3_f32 %0, %0, %1, %2\n v_max_f32 %0, %0, %18"
        : "=&v"(t0), "=&v"(t1), "=&v"(t2)
        : "v"(s[0][0]), "v"(s[0][1]), "v"(s[0][2]), "v"(s[0][3]), "v"(s[1][0]), "v"(s[1][1]), "v"(s[1][2]), "v"(s[1][3]), "v"(s[2][0]), "v"(s[2][1]), "v"(s[2][2]), "v"(s[2][3]), "v"(s[3][0]), "v"(s[3][1]), "v"(s[3][2]), "v"(s[3][3]));
    return t0;
}
template <int MODE  > __device__ __forceinline__ void p4_sel(const Args& a, LAS unsigned char* lds, int wg, int G) {
    const int tid = threadIdx.x, lane = tid & 63, wave = __builtin_amdgcn_readfirstlane(tid >> 6), c = lane & 15, g = lane >> 4;
    unsigned char* ws = a.ws; const unsigned char* q8 = ws + WS_Q8; bf16* OS = (bf16*)(ws + WS_OS);
    LAS unsigned* tmk = (LAS unsigned*)(lds + TMK_OFF);
    const int ky = (c ^ (c >> 1)) & 7, kxa = c * 128 + (((2 * g) ^ ky) << 4), kxb = c * 128 + (((2 * g + 1) ^ ky) << 4), vxo = c * 64 + ((g ^ (((c >> 2) & 1) << 1)) << 4);
    const float NINF = -__builtin_inff();
    for (int r = 0; r * G + wg < 1024; ++r) {
        int bg, qt; unit_sel(wg, r, G, bg, qt); const int b = bg >> 1, gk = bg & 1, t0 = 64 * qt, cur = qt;
        const unsigned char* ks = ws + WS_KSEL + (size_t)bg * SEQ * 128; const unsigned char* vst = ws + WS_VSELT + (size_t)bg * 256 * 8192;
        __syncthreads();
        tmk[tid] = *((const unsigned*)(ws + WS_TMASK) + ((size_t)(bg * 256 + qt) * 512 + tid));
        v8i32 qf[2]; float nmb[2], thr[2]; f32x2 lsum[2]; f32x4 o[2][8]; int tq[2];
        v8i32 pLo = {0, 0, 0, 0, 0, 0, 0, 0}, pHi = {0, 0, 0, 0, 0, 0, 0, 0}; asm volatile("" : "+v"(pLo), "+v"(pHi));
#pragma unroll
        for (int cs = 0; cs < 2; ++cs) { const int ql = 8 * wave + 4 * cs + (c >> 2); tq[cs] = t0 + ql; qf[cs] = *(const v8i32*)(q8 + ((size_t)b * SEQ + tq[cs]) * 1024 + (4 * gk + (c & 3)) * 128 + 32 * g); nmb[cs] = 0.f; thr[cs] = NINF; lsum[cs] = (f32x2){0.f, 0.f};
#pragma unroll
            for (int dt = 0; dt < 8; ++dt) o[cs][dt] = (f32x4){0.f, 0.f, 0.f, 0.f}; }
        asm volatile("" : "+v"(qf[0])); asm volatile("" : "+v"(qf[1]));
        __syncthreads();
#pragma unroll
        for (int jp = 0; jp < SELB; ++jp) if (MODE != 2 && jp <= cur) { dma_k8(lds + jp * SLOT8, ks + (size_t)jp * 64 * 128, wave, lane); dma_v8(lds + jp * SLOT8, vst + (size_t)jp * 8192, wave, lane); }
        for (int js = 0; js <= cur; js += SELB) {
            WAITV(0); RAWBAR();
#pragma unroll
            for (int jp = SELB; jp < 2 * SELB; ++jp) if (MODE != 2 && js + jp <= cur) { LAS unsigned char* sl = lds + ((js + jp) & (2 * SELB - 1)) * SLOT8; dma_k8(sl, ks + (size_t)(js + jp) * 64 * 128, wave, lane); dma_v8(sl, vst + (size_t)(js + jp) * 8192, wave, lane); }
            unsigned mws[SELB];
#pragma unroll
            for (int jj = 0; jj < SELB; ++jj) mws[jj] = tmk[2 * (js + jj) + (wave >> 2)];
            unsigned m8s[SELB];
#pragma unroll
            for (int jj = 0; jj < SELB; ++jj) { const unsigned mw = __builtin_amdgcn_readfirstlane(mws[jj]); m8s[jj] = (MODE == 1 || js + jj > cur) ? 0u : ((mw >> (8 * (wave & 3))) & 0xffu); }
#pragma unroll
          for (int jj = 0; jj < SELB; ++jj) { const int j = js + jj;
            if (m8s[jj] != 0u) {
            const LAS unsigned char* slot = lds + (j & (2 * SELB - 1)) * SLOT8; const unsigned m8 = m8s[jj];
            v8i32 kf[4];
#pragma unroll
            for (int kt = 0; kt < 4; ++kt) kf[kt] = pg8::cat8(*(const LAS bf16x8*)(slot + kt * 2048 + kxa), *(const LAS bf16x8*)(slot + kt * 2048 + kxb));
#pragma unroll
            for (int cs = 0; cs < 2; ++cs) { const unsigned nib = (m8 >> (4 * cs)) & 0xfu;
                if (nib != 0u) {
                    const bool selq = (nib >> (c >> 2)) & 1u; f32x4 s[4];
                    { const float cv = selq ? nmb[cs] : NINF; const f32x4 cacc = {cv, cv, cv, cv};
#pragma unroll
                      for (int kt = 0; kt < 4; ++kt) s[kt] = __builtin_amdgcn_mfma_scale_f32_16x16x128_f8f6f4(kf[kt], qf[cs], cacc, 0, 0, 0, 0x7f7f7f7f, 0, 0x7c7c7c7c); }
                    v8i32 vf[4];
#pragma unroll
                    for (int j2 = 0; j2 < 4; ++j2) vf[j2] = pg8::cat8(*(const LAS bf16x8*)(slot + 8192 + j2 * 2048 + vxo), *(const LAS bf16x8*)(slot + 8192 + j2 * 2048 + 1024 + vxo));
                    __builtin_amdgcn_sched_barrier(0);
                    if (j == cur) {
#pragma unroll
                        for (int kt = 0; kt < 4; ++kt)
#pragma unroll
                            for (int ii = 0; ii < 4; ++ii) { const int kp = 64 * j + 16 * kt + 4 * g + ii; s[kt][ii] = kp <= tq[cs] ? s[kt][ii] : NINF; } }
                    const float tm = max16(s);
                    if (__any(tm > thr[cs])) {
                        const float tr = xmax32(xmax16(tm)); const bool un = thr[cs] == NINF, live = tr > NINF;
                        const float d = un ? (live ? tr : 0.f) : fmaxf(tr, 0.f), alpha = __builtin_amdgcn_exp2f(-d);
                        thr[cs] = (un && !live) ? NINF : SM_THR8; nmb[cs] -= d; lsum[cs] = lsum[cs] * alpha;
#pragma unroll
                        for (int dt = 0; dt < 8; ++dt) o[cs][dt] = o[cs][dt] * alpha;
#pragma unroll
                        for (int kt = 0; kt < 4; ++kt)
#pragma unroll
                            for (int i = 0; i < 4; ++i) s[kt][i] -= d; }
#pragma unroll
                    for (int kt = 0; kt < 4; ++kt) {
#pragma unroll
                        for (int i = 0; i < 4; ++i) s[kt][i] = __builtin_amdgcn_exp2f(s[kt][i]);
                        lsum[cs] += (f32x2){s[kt][0], s[kt][1]}; lsum[cs] += (f32x2){s[kt][2], s[kt][3]};
                        int w = pLo[kt]; w = __builtin_amdgcn_cvt_pk_fp8_f32(s[kt][0], s[kt][1], w, false); w = __builtin_amdgcn_cvt_pk_fp8_f32(s[kt][2], s[kt][3], w, true); pLo[kt] = w; pHi[4 + kt] = w; }
#pragma unroll
                    for (int j2 = 0; j2 < 4; ++j2) { MFMA8_ACC(o[cs][2 * j2], vf[j2], pLo); MFMA8_ACC(o[cs][2 * j2 + 1], vf[j2], pHi); } } }
          } }
        }
        asm volatile("s_nop 15\n s_nop 15" ::: "memory");
#pragma unroll
        for (int cs = 0; cs < 2; ++cs) { const float lt = ladd32(ladd16(lsum[cs].x + lsum[cs].y)); const float inv = lt > 0.f ? 1.0f / lt : 0.f;
            if (MODE == 0) store_o(OS, (size_t)b * SEQ + tq[cs], 4 * gk + (c & 3), g, o[cs], inv); else { asm volatile("" :: "v"(inv), "v"(o[cs][0]), "v"(o[cs][7])); } }
    }
}

__device__ __forceinline__ void waitv_dyn(int n) {
    switch (n) { case 0: WAITV(0); break; case 2: WAITV(2); break; case 4: WAITV(4); break; case 6: WAITV(6); break; case 8: WAITV(8); break; case 10: WAITV(10); break; case 12: WAITV(12); break; default: WAITV(14); break; }
}
#define WIN_EXP2(S, kt_, h_) do { S[kt_][2 * (h_)] = __builtin_amdgcn_exp2f(S[kt_][2 * (h_)]); S[kt_][2 * (h_) + 1] = __builtin_amdgcn_exp2f(S[kt_][2 * (h_) + 1]); } while (0)
#define WIN_CVT(S, PN, LS, kt_, h_) do { PN[kt_] = __builtin_amdgcn_cvt_pk_fp8_f32(S[kt_][2 * (h_)], S[kt_][2 * (h_) + 1], PN[kt_], (h_) != 0); LS += (f32x2){S[kt_][2 * (h_)], S[kt_][2 * (h_) + 1]}; } while (0)
#define WIN_RARE(S, TM, CS) do { const float tr_ = xmax32(xmax16(TM)); const bool un_ = thr[CS] == NINF, live_ = tr_ > NINF; \
    const float d_ = un_ ? (live_ ? tr_ : 0.f) : fmaxf(tr_, 0.f), alpha_ = __builtin_amdgcn_exp2f(-d_); thr[CS] = (un_ && !live_) ? NINF : SM_THR8; nmb[CS] -= d_; lsum[CS] = lsum[CS] * alpha_; \
    _Pragma("unroll") for (int dt_ = 0; dt_ < 8; ++dt_) o[CS][dt_] = o[CS][dt_] * alpha_; \
    _Pragma("unroll") for (int kt_ = 0; kt_ < 4; ++kt_) _Pragma("unroll") for (int i_ = 0; i_ < 4; ++i_) S[kt_][i_] -= d_; } while (0)
__device__ __forceinline__ void p5_win(const Args& a, LAS unsigned char* lds, int wg, int G) {
    const int tid = threadIdx.x, lane = tid & 63, wave = __builtin_amdgcn_readfirstlane(tid >> 6), c = lane & 15, g = lane >> 4;
    unsigned char* ws = a.ws; const unsigned char* q8 = ws + WS_Q8; bf16* OW = (bf16*)(ws + WS_OW);
    const int ky = (c ^ (c >> 1)) & 7, kxa = c * 128 + (((2 * g) ^ ky) << 4), kxb = c * 128 + (((2 * g + 1) ^ ky) << 4), vxo = c * 64 + ((g ^ (((c >> 2) & 1) << 1)) << 4);
    const float NINF = -__builtin_inff();
    for (int u = wg; u < 1024; u += G) {
        const int bg = u >> 8, x = u & 255, qt = (G == 256) ? ((x & 7) * 32 + (x >> 3)) : x, b = bg >> 1, gk = bg & 1, t0 = 64 * qt;
        const unsigned char* kw = ws + WS_KWIN + (size_t)bg * SEQ * 128; const unsigned char* vwt = ws + WS_VWINT + (size_t)bg * 256 * 8192;
        v8i32 qf[2]; float nmb[2], thr[2]; f32x2 lsum[2]; f32x4 o[2][8]; int tq[2];
        v8i32 pLo0 = {0, 0, 0, 0, 0, 0, 0, 0}, pHi0 = {0, 0, 0, 0, 0, 0, 0, 0}, pLo1 = {0, 0, 0, 0, 0, 0, 0, 0}, pHi1 = {0, 0, 0, 0, 0, 0, 0, 0};
        asm volatile("" : "+v"(pLo0), "+v"(pHi0)); asm volatile("" : "+v"(pLo1), "+v"(pHi1));
#pragma unroll
        for (int cs = 0; cs < 2; ++cs) { const int ql = 8 * wave + 4 * cs + (c >> 2); tq[cs] = t0 + ql; qf[cs] = *(const v8i32*)(q8 + ((size_t)b * SEQ + tq[cs]) * 1024 + (4 * gk + (c & 3)) * 128 + 32 * g); nmb[cs] = 0.f; thr[cs] = NINF; lsum[cs] = (f32x2){0.f, 0.f};
#pragma unroll
            for (int dt = 0; dt < 8; ++dt) o[cs][dt] = (f32x4){0.f, 0.f, 0.f, 0.f}; }
        const int j0 = qt >= 8 ? qt - 8 : 0, nb = qt - j0 + 1, nfirst = nb < 8 ? nb : 8;
        asm volatile("" : "+v"(qf[0])); asm volatile("" : "+v"(qf[1]));
        __syncthreads();
        for (int i = 0; i < nfirst; ++i) { LAS unsigned char* sl = lds + ((j0 + i) & 7) * SLOT8; dma_k8(sl, kw + (size_t)(j0 + i) * 64 * 128, wave, lane); dma_v8(sl, vwt + (size_t)(j0 + i) * 8192, wave, lane); }
        int nissued = nfirst;
        for (int i0 = 0; i0 < nb; i0 += 3) {
            const int iend = i0 + 3 < nb ? i0 + 3 : nb, left = nissued - iend;
            waitv_dyn(left > 0 ? 2 * left : 0); RAWBAR();
            if (i0 == 3 && nb == 9) { LAS unsigned char* sl = lds + ((j0 + 8) & 7) * SLOT8; dma_k8(sl, kw + (size_t)(j0 + 8) * 64 * 128, wave, lane); dma_v8(sl, vwt + (size_t)(j0 + 8) * 8192, wave, lane); nissued = 9; }
            for (int i = i0; i < iend; ++i) { const int j = j0 + i;
                const LAS unsigned char* slot = lds + (j & 7) * SLOT8;
                f32x4 s0[4], s1[4];
                { v8i32 kf[4];
#pragma unroll
                  for (int kt = 0; kt < 4; ++kt) kf[kt] = pg8::cat8(*(const LAS bf16x8*)(slot + kt * 2048 + kxa), *(const LAS bf16x8*)(slot + kt * 2048 + kxb));
                  const f32x4 c0 = {nmb[0], nmb[0], nmb[0], nmb[0]}, c1 = {nmb[1], nmb[1], nmb[1], nmb[1]};
                  __builtin_amdgcn_sched_barrier(0);
#pragma unroll
                  for (int kt = 0; kt < 4; ++kt) s0[kt] = __builtin_amdgcn_mfma_scale_f32_16x16x128_f8f6f4(kf[kt], qf[0], c0, 0, 0, 0, 0x7f7f7f7f, 0, 0x7c7c7c7c);
#pragma unroll
                  for (int kt = 0; kt < 4; ++kt) s1[kt] = __builtin_amdgcn_mfma_scale_f32_16x16x128_f8f6f4(kf[kt], qf[1], c1, 0, 0, 0, 0x7f7f7f7f, 0, 0x7c7c7c7c); }
                v8i32 vf[4];
#pragma unroll
                for (int j2 = 0; j2 < 4; ++j2) vf[j2] = pg8::cat8(*(const LAS bf16x8*)(slot + 8192 + j2 * 2048 + vxo), *(const LAS bf16x8*)(slot + 8192 + j2 * 2048 + 1024 + vxo));
                __builtin_amdgcn_sched_barrier(0);
                if (j == qt || j + 8 == qt) {
                    int l0 = tq[0] - 64 * j - 4 * g, l1 = tq[1] - 64 * j - 4 * g; asm volatile("" : "+v"(l0), "+v"(l1));
#pragma unroll
                    for (int kt = 0; kt < 4; ++kt)
#pragma unroll
                        for (int ii = 0; ii < 4; ++ii) { s0[kt][ii] = ((unsigned)(l0 - (16 * kt + ii)) < 512u) ? s0[kt][ii] : NINF; s1[kt][ii] = ((unsigned)(l1 - (16 * kt + ii)) < 512u) ? s1[kt][ii] : NINF; } }
                int pn0[4] = {0, 0, 0, 0}, pn1[4] = {0, 0, 0, 0}; f32x2 ls0 = {0.f, 0.f}, ls1 = {0.f, 0.f};
                { const float tm = __builtin_fmaxf(__builtin_fmaxf(__builtin_fmaxf(__builtin_fmaxf(s0[0][0], s0[0][1]), __builtin_fmaxf(s0[0][2], s0[0][3])), __builtin_fmaxf(__builtin_fmaxf(s0[1][0], s0[1][1]), __builtin_fmaxf(s0[1][2], s0[1][3]))),
                                                     __builtin_fmaxf(__builtin_fmaxf(__builtin_fmaxf(s0[2][0], s0[2][1]), __builtin_fmaxf(s0[2][2], s0[2][3])), __builtin_fmaxf(__builtin_fmaxf(s0[3][0], s0[3][1]), __builtin_fmaxf(s0[3][2], s0[3][3]))));
                  if (__any(tm > thr[0])) WIN_RARE(s0, tm, 0); }
#pragma unroll
                for (int kt = 0; kt < 4; ++kt) { WIN_EXP2(s0, kt, 0); WIN_EXP2(s0, kt, 1); WIN_CVT(s0, pn0, ls0, kt, 0); WIN_CVT(s0, pn0, ls0, kt, 1); }
#pragma unroll
                for (int kt = 0; kt < 4; ++kt) { pLo0[kt] = pn0[kt]; pHi0[4 + kt] = pn0[kt]; }
                lsum[0] += ls0;
                { const float tm = __builtin_fmaxf(__builtin_fmaxf(__builtin_fmaxf(__builtin_fmaxf(s1[0][0], s1[0][1]), __builtin_fmaxf(s1[0][2], s1[0][3])), __builtin_fmaxf(__builtin_fmaxf(s1[1][0], s1[1][1]), __builtin_fmaxf(s1[1][2], s1[1][3]))),
                                                     __builtin_fmaxf(__builtin_fmaxf(__builtin_fmaxf(s1[2][0], s1[2][1]), __builtin_fmaxf(s1[2][2], s1[2][3])), __builtin_fmaxf(__builtin_fmaxf(s1[3][0], s1[3][1]), __builtin_fmaxf(s1[3][2], s1[3][3]))));
                  if (__any(tm > thr[1])) WIN_RARE(s1, tm, 1); }
                __builtin_amdgcn_sched_barrier(0);
                MFMA8_B(o[0][0], vf[0], pLo0); WIN_EXP2(s1, 0, 0); SEL_GAP();
                MFMA8_B(o[0][1], vf[0], pHi0); WIN_EXP2(s1, 0, 1); WIN_CVT(s1, pn1, ls1, 0, 0); SEL_GAP();
                MFMA8_B(o[0][2], vf[1], pLo0); WIN_EXP2(s1, 1, 0); WIN_CVT(s1, pn1, ls1, 0, 1); SEL_GAP();
                MFMA8_B(o[0][3], vf[1], pHi0); WIN_EXP2(s1, 1, 1); WIN_CVT(s1, pn1, ls1, 1, 0); SEL_GAP();
                MFMA8_B(o[0][4], vf[2], pLo0); WIN_EXP2(s1, 2, 0); WIN_CVT(s1, pn1, ls1, 1, 1); SEL_GAP();
                MFMA8_B(o[0][5], vf[2], pHi0); WIN_EXP2(s1, 2, 1); WIN_CVT(s1, pn1, ls1, 2, 0); SEL_GAP();
                MFMA8_B(o[0][6], vf[3], pLo0); WIN_EXP2(s1, 3, 0); WIN_CVT(s1, pn1, ls1, 2, 1); SEL_GAP();
                MFMA8_B(o[0][7], vf[3], pHi0); WIN_EXP2(s1, 3, 1); WIN_CVT(s1, pn1, ls1, 3, 0); SEL_GAP();
                WIN_CVT(s1, pn1, ls1, 3, 1);
#pragma unroll
                for (int kt = 0; kt < 4; ++kt) { pLo1[kt] = pn1[kt]; pHi1[4 + kt] = pn1[kt]; }
                lsum[1] += ls1;
#pragma unroll
                for (int j2 = 0; j2 < 4; ++j2) { MFMA8_B(o[1][2 * j2], vf[j2], pLo1); MFMA8_B(o[1][2 * j2 + 1], vf[j2], pHi1); }
            }
        }
#pragma unroll
        for (int cs = 0; cs < 2; ++cs) { const float lt = ladd32(ladd16(lsum[cs].x + lsum[cs].y)); const float inv = lt > 0.f ? 1.0f / lt : 0.f;
            store_o(OW, (size_t)b * SEQ + tq[cs], 4 * gk + (c & 3), g, o[cs], inv); }
    }
}

__device__ __forceinline__ void gelu4(v2u w, float (&o)[4]) {
    const pg8::f32x2 a = pg8::gelu_pk((pg8::f32x2){bflo(w.x), bfhi(w.x)}), b = pg8::gelu_pk((pg8::f32x2){bflo(w.y), bfhi(w.y)}); o[0] = a.x; o[1] = a.y; o[2] = b.x; o[3] = b.y;
}
__device__ __forceinline__ void p6_mix(const Args& a, LAS unsigned char* lds, int wg, int G) {
    const int tid = threadIdx.x, lane = tid & 63, wave = __builtin_amdgcn_readfirstlane(tid >> 6), c = lane & 15, g = lane >> 4;
    unsigned char* ws = a.ws; const bf16* proj = (const bf16*)(ws + WS_PROJ); bf16* STG = (bf16*)(ws + WS_XN)  ; unsigned char* MIX = (unsigned char*)(ws + WS_QR)  ;
    { const float* gn = (const float*)a.in[8]; const float* bs = (const float*)a.in[10]; const float* og = (const float*)a.in[12]; const bf16* wm = (const bf16*)(ws + WS_WM);
      for (int u = wg; u < 256; u += G) { const size_t m0 = (size_t)(u >> 7) * SEQ + 128 * (u & 127); const int t = 16 * wave + c; float ssum = 0.f;
        const int sr = tid >> 4, c0 = 8 * (tid & 15);
        v4u vv[4];
#pragma unroll
        for (int ps = 0; ps < 4; ++ps) vv[ps] = *(const v4u*)(proj + (m0 + 32 * ps + sr) * NP1 + COL_V + c0);
        for (int hg = 0; hg < 8; ++hg) { LAS bf16* buf = (LAS bf16*)lds + (hg & 1) * (128 * 136);
            const f32x4 gna = *(const f32x4*)(gn + hg * 128 + c0), gnb = *(const f32x4*)(gn + hg * 128 + c0 + 4);
            v4u uq[4]; bf16x8 bfr[4];
#pragma unroll
            for (int q = 0; q < 4; ++q) uq[q] = *(const v4u*)(proj + (m0 + t) * NP1 + COL_U + hg * 128 + 32 * g + 8 * q);
#pragma unroll
            for (int ks = 0; ks < 4; ++ks) bfr[ks] = *(const bf16x8*)(wm + ((size_t)hg * 128 + t) * 128 + 32 * ks + 8 * g);
            const float bst = bs[hg * 128 + t];
#pragma unroll
            for (int ps = 0; ps < 4; ++ps) { const int s = 32 * ps + sr; float x[8]; float xa[4], xb[4];
                gelu4((v2u){vv[ps].x, vv[ps].y}, xa); gelu4((v2u){vv[ps].z, vv[ps].w}, xb);
#pragma unroll
                for (int j = 0; j < 4; ++j) { x[j] = xa[j]; x[4 + j] = xb[j]; }
                float ss = 0.f;
#pragma unroll
                for (int j = 0; j < 8; ++j) ss += x[j] * x[j];
                ss = row16_sum(ss);
                const float rs = __builtin_amdgcn_rsqf(ss * (1.0f / 128.0f) + EPS);
#pragma unroll
                for (int j = 0; j < 8; ++j) buf[(c0 + j) * 136 + (s ^ c0)] = (bf16)f2bf(x[j] * rs * (j < 4 ? gna[j] : gnb[j - 4])); }
            if (hg < 7) {
#pragma unroll
                for (int ps = 0; ps < 4; ++ps) vv[ps] = *(const v4u*)(proj + (m0 + 32 * ps + sr) * NP1 + COL_V + (hg + 1) * 128 + c0); }
            __syncthreads();
            f32x4 acc[8];
#pragma unroll
            for (int ct = 0; ct < 8; ++ct) acc[ct] = (f32x4){0.f, 0.f, 0.f, 0.f};
#pragma unroll
            for (int ks = 0; ks < 4; ++ks) { if (ks <= (wave >> 1)) {
#pragma unroll
                for (int ct = 0; ct < 8; ++ct) { const int row = 32 * (c >> 2) + 4 * ct + (c & 3); const bf16x8 af = *(const LAS bf16x8*)(buf + row * 136 + ((32 * ks + 8 * g) ^ (8 * ((row >> 3) & 15)))); acc[ct] = mfma16(af, bfr[ks], acc[ct]); } } }
#pragma unroll
            for (int q = 0; q < 4; ++q) { v4u w4;
#pragma unroll
                for (int hf = 0; hf < 2; ++hf) { const int ct = 2 * q + hf; float gu[4]; gelu4(hf ? (v2u){uq[q].z, uq[q].w} : (v2u){uq[q].x, uq[q].y}, gu);
                    const float o0 = gu[0] * (acc[ct][0] + bst), o1 = gu[1] * (acc[ct][1] + bst), o2 = gu[2] * (acc[ct][2] + bst), o3 = gu[3] * (acc[ct][3] + bst);
                    ssum += (o0 * o0 + o1 * o1) + (o2 * o2 + o3 * o3); if (hf) { w4.z = pk2(o0, o1); w4.w = pk2(o2, o3); } else { w4.x = pk2(o0, o1); w4.y = pk2(o2, o3); } }
                *(v4u*)(STG + (m0 + t) * 1024 + hg * 128 + 32 * g + 8 * q) = w4; } }
        ssum = ladd32(ladd16(ssum));
        LAS float* rsl = (LAS float*)lds + 2 * 128 * 136 / 2;
        if (g == 0) rsl[t] = __builtin_amdgcn_rsqf(ssum * (1.0f / 1024.0f) + EPS);
        asm volatile("s_waitcnt vmcnt(0)" ::: "memory");
        __syncthreads();
        { const int tr = tid >> 2, q4 = tid & 3; const float rs = rsl[tr];
#pragma unroll 4
          for (int st = 0; st < 16; ++st) { const int ch = 64 * st + 16 * q4; const bf16* sp = STG + (m0 + tr) * 1024 + ch; const v4u xa = *(const v4u*)sp, xb = *(const v4u*)(sp + 8);
              const f32x4 g0 = *(const f32x4*)(og + ch), g1 = *(const f32x4*)(og + ch + 4), g2 = *(const f32x4*)(og + ch + 8), g3 = *(const f32x4*)(og + ch + 12); v4u w;
              w.x = pg8::pk4_fp8(bflo(xa.x) * rs * g0[0], bfhi(xa.x) * rs * g0[1], bflo(xa.y) * rs * g0[2], bfhi(xa.y) * rs * g0[3]); w.y = pg8::pk4_fp8(bflo(xa.z) * rs * g1[0], bfhi(xa.z) * rs * g1[1], bflo(xa.w) * rs * g1[2], bfhi(xa.w) * rs * g1[3]);
              w.z = pg8::pk4_fp8(bflo(xb.x) * rs * g2[0], bfhi(xb.x) * rs * g2[1], bflo(xb.y) * rs * g2[2], bfhi(xb.y) * rs * g2[3]); w.w = pg8::pk4_fp8(bflo(xb.z) * rs * g3[0], bfhi(xb.z) * rs * g3[1], bflo(xb.w) * rs * g3[2], bfhi(xb.w) * rs * g3[3]);
              *(v4u*)(MIX + (m0 + tr) * DM + 1024 + ch) = w; } }
        __syncthreads(); } }
    { const bf16* OC = (const bf16*)(ws + WS_OC); const bf16* OS = (const bf16*)(ws + WS_OS); const bf16* OW = (const bf16*)(ws + WS_OW); const float* ng = (const float*)a.in[11];
      const int c0 = 8 * lane, hA = lane >> 4;
      f32x4 gn[2][2];
#pragma unroll
      for (int hf = 0; hf < 2; ++hf) { gn[hf][0] = *(const f32x4*)(ng + c0 + 512 * hf); gn[hf][1] = *(const f32x4*)(ng + c0 + 512 * hf + 4); }
      const int NW2 = G * NWAVES;
      for (int m = wg * NWAVES + wave; m < MTOK; m += 2 * NW2) { v4u x[2][2], y[2][2], z[2][2]; unsigned gw[2][2][3];
#pragma unroll
        for (int q = 0; q < 2; ++q) { const int mm = m + q * NW2; const size_t off = (size_t)mm * 1024 + c0;
#pragma unroll
            for (int hf = 0; hf < 2; ++hf) { const bf16* gp = (const bf16*)(ws + WS_GATES) + (size_t)mm * 32 + (hA + 4 * hf) * 3; gw[q][hf][0] = gp[0]; gw[q][hf][1] = gp[1]; gw[q][hf][2] = gp[2];
                x[q][hf] = *(const v4u*)(OC + off + 512 * hf); y[q][hf] = *(const v4u*)(OS + off + 512 * hf); z[q][hf] = *(const v4u*)(OW + off + 512 * hf); } }
#pragma unroll
        for (int q = 0; q < 2; ++q) { const int mm = m + q * NW2; float o[16]; float ss = 0.f;
#pragma unroll
            for (int hf = 0; hf < 2; ++hf) { const float g0 = sigmoidf(bf2f(gw[q][hf][0])), g1 = sigmoidf(bf2f(gw[q][hf][1])), g2 = sigmoidf(bf2f(gw[q][hf][2]));
#pragma unroll
                for (int j = 0; j < 4; ++j) { const float lo = g0 * bflo(x[q][hf][j]) + g1 * bflo(y[q][hf][j]) + g2 * bflo(z[q][hf][j]), hi = g0 * bfhi(x[q][hf][j]) + g1 * bfhi(y[q][hf][j]) + g2 * bfhi(z[q][hf][j]); o[8 * hf + 2 * j] = lo; o[8 * hf + 2 * j + 1] = hi; ss += lo * lo + hi * hi; } }
            const float rs = __builtin_amdgcn_rsqf(wave_sum_v(ss) * (1.0f / 1024.0f) + EPS);
#pragma unroll
            for (int hf = 0; hf < 2; ++hf) { v2u w8; w8.x = pg8::pk4_fp8(o[8 * hf] * rs * gn[hf][0][0], o[8 * hf + 1] * rs * gn[hf][0][1], o[8 * hf + 2] * rs * gn[hf][0][2], o[8 * hf + 3] * rs * gn[hf][0][3]);
                w8.y = pg8::pk4_fp8(o[8 * hf + 4] * rs * gn[hf][1][0], o[8 * hf + 5] * rs * gn[hf][1][1], o[8 * hf + 6] * rs * gn[hf][1][2], o[8 * hf + 7] * rs * gn[hf][1][3]);
                *(v2u*)(MIX + (size_t)mm * DM + c0 + 512 * hf) = w8; } } } }
}

__device__ __forceinline__ void unpack8_fp8(v2u x, float (&o)[8]) {
#pragma unroll
    for (int h = 0; h < 2; ++h) { const int w = (int)(h ? x.y : x.x); const auto lo = __builtin_amdgcn_cvt_pk_f32_fp8(w, false), hi = __builtin_amdgcn_cvt_pk_f32_fp8(w, true); o[4 * h] = lo[0]; o[4 * h + 1] = lo[1]; o[4 * h + 2] = hi[0]; o[4 * h + 3] = hi[1]; }
}
__device__ __forceinline__ void p_conv(const Args& a, int wg, int G) {
    unsigned char* ws = a.ws; const unsigned char* AH = (const unsigned char*)(ws + WS_AH); unsigned char* HM = (unsigned char*)(ws + WS_HMID);
    const float* cw = (const float*)a.in[16]; const float* cb = (const float*)a.in[17];
    constexpr int TB = 32, NCG = DFF / 8, NIT = (MTOK / TB) * NCG;
    for (int it = wg * NTHR + threadIdx.x; it < NIT; it += G * NTHR) { const int tb = it / NCG, cg = it - tb * NCG, n0 = 8 * cg, t0 = tb * TB;
        f32x2 w0[2][4], w1[2][4], w2[2][4], bb[2][4], p2[2][4], p1[2][4];
#pragma unroll
        for (int hf = 0; hf < 2; ++hf)
#pragma unroll
            for (int q = 0; q < 2; ++q) { const int n = n0 + hf * DFF + 4 * q; const f32x4 a0 = *(const f32x4*)(cw + n), a1 = *(const f32x4*)(cw + DFF2 + n), a2 = *(const f32x4*)(cw + 2 * DFF2 + n), ab = *(const f32x4*)(cb + n);
                w0[hf][2 * q] = (f32x2){a0[0], a0[1]}; w0[hf][2 * q + 1] = (f32x2){a0[2], a0[3]}; w1[hf][2 * q] = (f32x2){a1[0], a1[1]}; w1[hf][2 * q + 1] = (f32x2){a1[2], a1[3]};
                w2[hf][2 * q] = (f32x2){a2[0], a2[1]}; w2[hf][2 * q + 1] = (f32x2){a2[2], a2[3]}; bb[hf][2 * q] = (f32x2){ab[0], ab[1]}; bb[hf][2 * q + 1] = (f32x2){ab[2], ab[3]}; }
#pragma unroll
        for (int hf = 0; hf < 2; ++hf) { v2u x2 = (v2u){0u, 0u}, x1 = x2;
            if ((t0 & (SEQ - 1)) >= 2) { x2 = *(const v2u*)(AH + (size_t)(t0 - 2) * DFF2 + n0 + hf * DFF); x1 = *(const v2u*)(AH + (size_t)(t0 - 1) * DFF2 + n0 + hf * DFF); }
            p2[hf][0] = __builtin_amdgcn_cvt_pk_f32_fp8((int)x2.x, false); p2[hf][1] = __builtin_amdgcn_cvt_pk_f32_fp8((int)x2.x, true); p2[hf][2] = __builtin_amdgcn_cvt_pk_f32_fp8((int)x2.y, false); p2[hf][3] = __builtin_amdgcn_cvt_pk_f32_fp8((int)x2.y, true);
            p1[hf][0] = __builtin_amdgcn_cvt_pk_f32_fp8((int)x1.x, false); p1[hf][1] = __builtin_amdgcn_cvt_pk_f32_fp8((int)x1.x, true); p1[hf][2] = __builtin_amdgcn_cvt_pk_f32_fp8((int)x1.y, false); p1[hf][3] = __builtin_amdgcn_cvt_pk_f32_fp8((int)x1.y, true); }
        for (int tbb = t0; tbb < t0 + TB; tbb += 8) {
            v2u raw[8][2];
#pragma unroll
            for (int k = 0; k < 8; ++k)
#pragma unroll
                for (int hf = 0; hf < 2; ++hf) raw[k][hf] = *(const v2u*)(AH + (size_t)(tbb + k) * DFF2 + n0 + hf * DFF);
#pragma unroll
            for (int k = 0; k < 8; ++k) { f32x2 cu[2][4], acc[2][4];
#pragma unroll
                for (int hf = 0; hf < 2; ++hf) { cu[hf][0] = __builtin_amdgcn_cvt_pk_f32_fp8((int)raw[k][hf].x, false); cu[hf][1] = __builtin_amdgcn_cvt_pk_f32_fp8((int)raw[k][hf].x, true);
                    cu[hf][2] = __builtin_amdgcn_cvt_pk_f32_fp8((int)raw[k][hf].y, false); cu[hf][3] = __builtin_amdgcn_cvt_pk_f32_fp8((int)raw[k][hf].y, true);
#pragma unroll
                    for (int p = 0; p < 4; ++p) acc[hf][p] = __builtin_elementwise_fma(w2[hf][p], cu[hf][p], __builtin_elementwise_fma(w1[hf][p], p1[hf][p], __builtin_elementwise_fma(w0[hf][p], p2[hf][p], bb[hf][p]))); }
                f32x2 r[4];
                f32x2 d[4], gu[4];
#pragma unroll
                for (int p = 0; p < 4; ++p) { const f32x2 e = acc[0][p] * -1.4426950408889634f; d[p].x = __builtin_amdgcn_exp2f(e.x); d[p].y = __builtin_amdgcn_exp2f(e.y); gu[p] = acc[0][p] * acc[1][p]; }
#pragma unroll
                for (int p = 0; p < 4; ++p) { d[p] = d[p] + 1.0f; }
#pragma unroll
                for (int p = 0; p < 4; ++p) { f32x2 sg; sg.x = __builtin_amdgcn_rcpf(d[p].x); sg.y = __builtin_amdgcn_rcpf(d[p].y); r[p] = gu[p] * sg; }
                v2u w; w.x = pg8::pk4_fp8(r[0].x, r[0].y, r[1].x, r[1].y); w.y = pg8::pk4_fp8(r[2].x, r[2].y, r[3].x, r[3].y); *(v2u*)(HM + (size_t)(tbb + k) * DFF + n0) = w;
#pragma unroll
                for (int hf = 0; hf < 2; ++hf)
#pragma unroll
                    for (int p = 0; p < 4; ++p) { p2[hf][p] = p1[hf][p]; p1[hf][p] = cu[hf][p]; } } } }
}

__device__ __forceinline__ void p_final(const Args& a, int wg, int G) {
    const int lane = threadIdx.x & 63, wave = threadIdx.x >> 6; const float* fg = (const float*)a.in[19]; const bf16* h2 = (const bf16*)(a.ws + WS_H2BF);
    const int NW = G * NWAVES;
    for (int m = wg * NWAVES + wave; m < MTOK; m += 2 * NW) {
        v2u r[2][8]; const bool two = m + NW < MTOK;
#pragma unroll
        for (int q = 0; q < 2; ++q) { const v2u* xr = (const v2u*)(h2 + (size_t)(q && two ? m + NW : m) * DM) + lane;
#pragma unroll
            for (int j = 0; j < 8; ++j) r[q][j] = xr[64 * j]; }
#pragma unroll
        for (int q = 0; q < 2; ++q) { if (q && !two) break; const int mm = m + q * NW; f32x4 v[8]; float s = 0.f;
#pragma unroll
            for (int j = 0; j < 8; ++j) { v[j] = (f32x4){bflo(r[q][j].x), bfhi(r[q][j].x), bflo(r[q][j].y), bfhi(r[q][j].y)}; s += (v[j][0] * v[j][0] + v[j][1] * v[j][1]) + (v[j][2] * v[j][2] + v[j][3] * v[j][3]); }
            const float rs = 1.0f / sqrtf(wave_sum(s) * (1.0f / DM) + EPS); f32x4* o = (f32x4*)(a.out + (size_t)mm * DM) + lane;
#pragma unroll
            for (int j = 0; j < 8; ++j) { const f32x4 gg = *((const f32x4*)fg + lane + 64 * j); o[64 * j] = (f32x4){v[j][0] * rs * gg[0], v[j][1] * rs * gg[1], v[j][2] * rs * gg[2], v[j][3] * rs * gg[3]}; } } }
}

constexpr int NPHASE = 14;
#ifndef PROBE_DUP
#define PROBE_DUP 0
#endif
#ifndef PROBE_SEL
#define PROBE_P3 0
#define PROBE_SEL 0
#endif
#ifndef PROBE_G3
#define PROBE_G3 0
#endif
__global__ void __launch_bounds__(NTHR, 2) nsa_layer_fwd(Args a) {
    extern __shared__ __attribute__((aligned(16))) unsigned char lds_raw[];
    LAS unsigned char* lds = (LAS unsigned char*)lds_raw;
    volatile LAS unsigned* MISC = (volatile LAS unsigned*)(lds + MISC_OFF);
    const int tid = threadIdx.x, G = gridDim.x, wg = blockIdx.x;
    if (tid < 32) MISC[tid] = 0u;
    __syncthreads();
    unsigned char* ws = a.ws; unsigned* ctl = (unsigned*)(ws + WS_CTL);
    const int lo = a.ph_lo, hi = a.ph_hi;
    XcdBarrier bar; bar.bar = ctl + CW_BAR + a.li * XCD_BAR_WORDS; bar.x = 0; bar.st = MISC + 8;
    if (hi - lo > 1) bar = xcd_barrier_post(ctl + CW_BAR + a.li * XCD_BAR_WORDS, MISC + 8);
#define IN(k) (lo <= (k) && (k) < hi)
#define SEAM(k) do { if ((k) != 4 && (k) != 10 && (k) != 11 && IN(k) && IN((k) + 1)) xcd_barrier(bar); } while (0)
    bf16* XN = (bf16*)(ws + WS_XN); bf16* PROJ = (bf16*)(ws + WS_PROJ); bf16* H1B = (bf16*)(ws + WS_H1B); bf16* AH = (bf16*)(ws + WS_AH); bf16* HMID = (bf16*)(ws + WS_HMID);
    float* rowss = (float*)ctl + CW_ROWSS;

#define PH(k, ...) do { if (IN(k)) { __VA_ARGS__ if ((PROBE_DUP >> (k)) & 1) { __VA_ARGS__ } } SEAM(k); } while (0)
    PH(0, { p0_prologue(a, lds, wg, G); });
    PH(1, { { pg8::Gemm gm{XN, (const bf16*)(ws + WS_WIN), MTOK, NP1A, DM}; pg8::StaticOrder S; S.init(MTOK, NP1A, G, wg);
              pg8::EpiBf16<0, true> E{PROJ, NP1, nullptr, 0, 0, 1.f}; pg8::gemm_phase<pg8::EpiBf16<0, true>, pg8::StaticOrder, true, true>(lds, gm, S, E); }
            { pg8::Gemm gm{(const bf16*)(ws + WS_XN8), (const bf16*)(ws + WS_WIN8), MTOK, NP1 - NP1A, DM / 2}; pg8::StaticOrder S; S.init(MTOK, NP1 - NP1A, G, wg);
              pg8::EpiBf16<0, true> E{PROJ + NP1A, NP1, nullptr, NP1 - NP1A, 0, 1.0f / W8SCALE}; pg8::gemm_phase<pg8::EpiBf16<0, true>, pg8::StaticOrder, true, true, true>(lds, gm, S, E); }
            p1_gates(a, wg, G); });
    PH(2, { p2_prep(a, lds, wg, G); });
    if (IN(3) && PROBE_P3) { if (PROBE_P3 == 1) p3_cmp<1>(a, lds, wg, G); else if (PROBE_P3 == 2) p3_cmp<2>(a, lds, wg, G); else if (PROBE_P3 == 3) p3_cmp<3>(a, lds, wg, G); else p5_win(a, lds, wg, G); xcd_barrier(bar); }
    PH(3, { p3_cmp<0>(a, lds, wg, G); p5_win(a, lds, wg, G); });
    PH(4, { p4_sel<0>(a, lds, wg, G); });
    if (IN(4) && PROBE_SEL) { xcd_barrier(bar); if (PROBE_SEL == 1) p4_sel<1>(a, lds, wg, G); else p4_sel<2>(a, lds, wg, G); xcd_barrier(bar); }
    if (IN(4) && IN(6)) xcd_barrier(bar);
    PH(6, { p6_mix(a, lds, wg, G); });
    PH(7, { pg8::Gemm gm{(const bf16*)(ws + WS_QR), (const bf16*)(ws + WS_WOUT), MTOK, DM, DM / 2}; pg8::StaticOrder S; S.init(MTOK, DM, G, wg);
        pg8::EpiStream<true, true, true> E{(const float*)a.in[0], nullptr, (bf16*)(ws + WS_H1BF), (unsigned char*)H1B, rowss, DM, 1.0f / W8SCALE};
        pg8::gemm_phase<pg8::EpiStream<true, true, true>, pg8::StaticOrder, true, true, true>(lds, gm, S, E); });
    PH(8, { pg8::Gemm gm{H1B, (const bf16*)(ws + WS_WUP), MTOK, DFF2, DM / 2}; pg8::StaticOrder S; S.init(MTOK, DFF2, G, wg);
        pg8::EpiScaleT<true> E{AH, DFF2, rowss, 1.0f / DM, EPS, 1.0f / W8SCALE}; pg8::gemm_phase<pg8::EpiScaleT<true>, pg8::StaticOrder, true, true, true>(lds, gm, S, E); });
    if (IN(8) && PROBE_G3) { xcd_barrier(bar); pg8::Gemm gm{H1B, (const bf16*)(ws + WS_WUP), MTOK, DFF2, DM / 2}; pg8::StaticOrder S; S.init(MTOK, DFF2, G, wg); pg8::EpiNull E{nullptr}; pg8::gemm_phase<pg8::EpiNull, pg8::StaticOrder, true, true, true>(lds, gm, S, E); xcd_barrier(bar); }
    PH(9, { p_conv(a, wg, G); });
    PH(12, { pg8::Gemm gm{HMID, (const bf16*)(ws + WS_WDN), MTOK, DM, DFF / 2}; pg8::StaticOrder S; S.init(MTOK, DM, G, wg);
        pg8::EpiStream<false, false, false> E{nullptr, (const bf16*)(ws + WS_H1BF), (bf16*)(ws + WS_H2BF), nullptr, nullptr, DM, 1.0f / W8SCALE};
        pg8::gemm_phase<pg8::EpiStream<false, false, false>, pg8::StaticOrder, true, true, true>(lds, gm, S, E); });
    PH(13, { p_final(a, wg, G); });
#undef PH
#undef IN
#undef SEAM
}

#ifndef MK_N_LAUNCHES
#define MK_N_LAUNCHES 1
#endif
extern "C" void kernel_launch(void* const* d_in, const int* in_sizes, int n_in, void* d_out, int out_size, void* d_ws, size_t ws_size, hipStream_t stream) {
    static int grid = 0;
    if (grid == 0) {
        if (n_in != 20 || out_size != MTOK * DM || ws_size < WS_END2) { fprintf(stderr, "kernel_launch: unexpected shapes (n_in %d, out %d, ws %zu)\n", n_in, out_size, ws_size); grid = -1; return; }
        int dev = 0, cus = 0, per_cu = 0;
        if (hipGetDevice(&dev) != hipSuccess || hipDeviceGetAttribute(&cus, hipDeviceAttributeMultiprocessorCount, dev) != hipSuccess) { grid = -1; return; }
        if (hipFuncSetAttribute((const void*)nsa_layer_fwd, hipFuncAttributeMaxDynamicSharedMemorySize, LDS_BYTES) != hipSuccess) { fprintf(stderr, "kernel_launch: hipFuncSetAttribute failed\n"); grid = -1; return; }
        if (hipOccupancyMaxActiveBlocksPerMultiprocessor(&per_cu, (const void*)nsa_layer_fwd, NTHR, LDS_BYTES) != hipSuccess || per_cu < 1) { fprintf(stderr, "kernel_launch: occupancy query says %d blocks per CU\n", per_cu); }
        (void)hipGetLastError();
        grid = cus;
    }
    if (grid < 0) return;
    if (hipMemsetAsync((char*)d_ws + WS_CTL, 0, CTL_ZERO_BYTES, stream) != hipSuccess) return;
    Args a{};
    for (int i = 0; i < 20; ++i) a.in[i] = d_in[i];
    a.out = (float*)d_out; a.ws = (unsigned char*)d_ws;
    constexpr int NL = MK_N_LAUNCHES;
    for (int li = 0; li < NL; ++li) {
        a.ph_lo = (NL == NPHASE) ? li : (li * NPHASE) / NL; a.ph_hi = (NL == NPHASE) ? li + 1 : ((li + 1) * NPHASE) / NL; a.li = li; a.pad = 0;
        hipLaunchKernelGGL(nsa_layer_fwd, dim3(grid), dim3(NTHR), LDS_BYTES, stream, a);
    }
}
```

```cpp
#include <hip/hip_runtime.h>
#include <cstdio>
#include <cstdint>

namespace pg8 {
#define PG8_LAS __attribute__((address_space(3)))
typedef unsigned short bf16_t;
typedef short bf16x8 __attribute__((ext_vector_type(8)));
typedef float f32x4 __attribute__((ext_vector_type(4)));
typedef unsigned u32x4 __attribute__((ext_vector_type(4)));
constexpr int BM = 256, BK = 64, HALF = 128, HTB = HALF * BK * 2  , STAGE_BYTES = 8 * HTB, NXCD = 8, WGM = 8;

__host__ __device__ __forceinline__ int lds_byte(int r, int c) { const int st = (r >> 4) * 2 + (c >> 5), rr = r & 15, cc = c & 31, ob = rr * 64 + cc * 2; return st * 1024 + (ob ^ (((ob >> 9) & 1) << 5)); }
__host__ __device__ __forceinline__ void stage_rc(int b, int& R, int& C) { const int st = b / 1024, sb = b % 1024, swz = sb ^ (((sb >> 9) & 1) << 5); R = (st >> 1) * 16 + swz / 64; C = (st & 1) * 32 + (swz % 64) / 2; }
__host__ __device__ __forceinline__ int perm32(int rho) { const int n = rho >> 4, i = rho & 15; return 8 * (i >> 2) + 4 * n + (i & 3); }

struct Unit { int pm, pn; };
struct Gemm { const bf16_t* A; const bf16_t* Bt; int M, N, K; };

struct StaticOrder {
    int nM, nN, nwg, G, c;
    __host__ __device__ void init(int M, int N, int G_, int c_) { nM = M / BM; nN = N / BM; nwg = nM * nN; G = G_; c = c_; }
    __host__ __device__ bool next(int i, Unit& u) const {
        const long L = (long)i * G + c; if (L >= nwg) return false;
        int wgid = (int)L; { const int q = nwg / NXCD, r = nwg % NXCD, xcd = wgid % NXCD, off = wgid / NXCD; wgid = (xcd < r ? xcd * (q + 1) : r * (q + 1) + (xcd - r) * q) + off; }
        const int nig = WGM * nN, gid = wgid / nig, fm = gid * WGM, gsz = (nM - fm) < WGM ? (nM - fm) : WGM;
        u.pm = fm + ((wgid % nig) % gsz); u.pn = (wgid % nig) / gsz; return true;
    }
    __device__ __forceinline__ void a_ready(const Unit&) const {}
    __device__ __forceinline__ void done(const Unit&) const {}
};

__device__ __forceinline__ unsigned cvt_pk_bf16(float lo, float hi) { unsigned r; asm volatile("v_cvt_pk_bf16_f32 %0, %1, %2" : "=v"(r) : "v"(lo), "v"(hi)); return r; }
typedef float f32x2 __attribute__((ext_vector_type(2)));
__device__ __forceinline__ f32x2 gelu_pk(f32x2 v) {
    const f32x2 av = __builtin_elementwise_abs(v), d = av * 0.2316418882f + 1.0f;
    f32x2 t; t.x = __builtin_amdgcn_rcpf(d.x); t.y = __builtin_amdgcn_rcpf(d.y);
    f32x2 q = t * 0.5307027145f + (-0.7265760135f); q = q * t + 0.7107068705f; q = q * t + (-0.142248368f); q = q * t + 0.127414796f; q = q * t;
    const f32x2 s = (v * v) * (-0.72134752044f);
    f32x2 e; e.x = __builtin_amdgcn_exp2f(s.x); e.y = __builtin_amdgcn_exp2f(s.y);
    const f32x2 m = v * (q * e), r = v - m;
    f32x2 o; o.x = v.x < 0.f ? m.x : r.x; o.y = v.y < 0.f ? m.y : r.y; return o;
}

template <int ACT  , bool BJ = false  > struct EpiBf16 {
    static constexpr bool PERM = true, AFTER_DRAIN = false; static constexpr bool BJ16 = BJ; static constexpr bool PRE = false; struct PreT {}; static_assert(ACT == 0 || ACT == 1, "EpiBf16: ACT is 0 (none) or 1 (gelu_pk)");
    bf16_t* O; int ldc; const float* bias; int split_cols; size_t split_stride; float scale0;
    __device__ __forceinline__ void operator()(const f32x4 (&acc)[2][2][4][2], const Unit& u, int wr, int wc, int fr, int fq) const {
        const int row0 = u.pm * BM + wr * 64 + fr; int colt = u.pn * BM; bf16_t* base = O;
        float sc = 1.f; if (split_cols) { const int t = colt / split_cols; base += (size_t)t * split_stride; colt -= t * split_cols; if (t == 0) sc = scale0; }
        const int lc0 = BJ ? wc * 64 + 16 * fq : wc * 32 + 8 * fq, col0 = colt + lc0, bcol0 = u.pn * BM + lc0; constexpr int BJS = BJ ? 8 : HALF;
        f32x4 bv[2][2];
#pragma unroll
        for (int bj = 0; bj < 2; ++bj)
#pragma unroll
            for (int n = 0; n < 2; ++n) bv[bj][n] = bias ? *(const f32x4*)(bias + bcol0 + bj * BJS + 4 * n) : (f32x4){0.f, 0.f, 0.f, 0.f};
#pragma unroll
        for (int ai = 0; ai < 2; ++ai)
#pragma unroll
            for (int m = 0; m < 4; ++m) { bf16_t* rowp = base + (size_t)(row0 + ai * HALF + m * 16) * ldc + col0;
#pragma unroll
                for (int bj = 0; bj < 2; ++bj) { f32x4 v0 = acc[ai][bj][m][0] + bv[bj][0], v1 = acc[ai][bj][m][1] + bv[bj][1];
                    if (ACT == 1) { f32x2 a = gelu_pk((f32x2){v0[0], v0[1]}), b = gelu_pk((f32x2){v0[2], v0[3]}), c = gelu_pk((f32x2){v1[0], v1[1]}), d = gelu_pk((f32x2){v1[2], v1[3]});
                        v0 = (f32x4){a.x, a.y, b.x, b.y}; v1 = (f32x4){c.x, c.y, d.x, d.y}; }
                    v0 = v0 * sc; v1 = v1 * sc; u32x4 w; w.x = cvt_pk_bf16(v0[0], v0[1]); w.y = cvt_pk_bf16(v0[2], v0[3]); w.z = cvt_pk_bf16(v1[0], v1[1]); w.w = cvt_pk_bf16(v1[2], v1[3]);
                    *(u32x4*)(rowp + bj * BJS) = w; } }
    }
};

typedef int v8i32 __attribute__((ext_vector_type(8)));
typedef int v4i32 __attribute__((ext_vector_type(4)));
__device__ __forceinline__ v8i32 cat8(bf16x8 lo, bf16x8 hi) { const v4i32 a = __builtin_bit_cast(v4i32, lo), b = __builtin_bit_cast(v4i32, hi); return __builtin_shufflevector(a, b, 0, 1, 2, 3, 4, 5, 6, 7); }
__device__ __forceinline__ unsigned pk4_fp8(float a, float b, float c, float d) { int p = 0; p = __builtin_amdgcn_cvt_pk_fp8_f32(a, b, p, false); p = __builtin_amdgcn_cvt_pk_fp8_f32(c, d, p, true); return (unsigned)p; }
template <class Epi, class Sched, bool ALIGN_EPI = false, bool SP2 = false, bool FP8 = false>
__device__ __forceinline__ void gemm_phase(PG8_LAS unsigned char* lds, const Gemm g, const Sched& S, const Epi& E) {
    const int tid = threadIdx.x, wid = __builtin_amdgcn_readfirstlane(tid >> 6), lane = tid & 63, wr = wid >> 2, wc = wid & 3, fr = lane & 15, fq = lane >> 4;
    const int K = g.K, nt = K / BK;
    unsigned voffA[2], voffB[2];
#pragma unroll
    for (int i = 0; i < 2; ++i) { int R, C; stage_rc(tid * 16 + i * 8192, R, C); const int Rp = Epi::PERM ? ((R & ~31) + perm32(R & 31)) : R, Rb = Epi::BJ16 ? (16 * (Rp >> 3) + (Rp & 7)) : Rp;
        voffA[i] = (unsigned)(R * K + C) * 2u; voffB[i] = (unsigned)(Rb * K + C) * 2u; }
    const size_t kstep = (size_t)(BK * 2);
    const size_t hstep = (size_t)HALF * K * 2;
    const size_t hstepB = Epi::BJ16 ? (size_t)8 * K * 2 : hstep;
    const size_t tstep = 2 * hstep;
    const unsigned ldsw = (unsigned)wid * 1024u;
    const int aoff = lds_byte(wr * 64 + fr, fq * 8), boff = lds_byte(wc * 32 + fr, fq * 8);
    constexpr int akd = 1024, bkd = 1024;
#define PG8_SA(b, h) (((b) * 2 + (h)) * HTB)
#define PG8_SB(b, h) ((4 + (b) * 2 + (h)) * HTB)
#define PG8_STAGE(bufoff, gbase, voff) do { _Pragma("unroll") for (int _i = 0; _i < 2; ++_i) \
        __builtin_amdgcn_global_load_lds((const unsigned*)((const char*)(gbase) + (voff)[_i]), (PG8_LAS unsigned*)(lds + (bufoff) + ldsw + _i * 8192), 16, 0, 0); } while (0)
#define PG8_LDA(dst, b, h) do { if constexpr (FP8) { _Pragma("unroll") for (int m = 0; m < 4; ++m) dst##8[m] = cat8(*(const PG8_LAS bf16x8*)(lds + PG8_SA(b, h) + aoff + m * 2048), *(const PG8_LAS bf16x8*)(lds + PG8_SA(b, h) + aoff + m * 2048 + akd)); } \
    else { _Pragma("unroll") for (int m = 0; m < 4; ++m) _Pragma("unroll") for (int k = 0; k < 2; ++k) dst[m][k] = *(const PG8_LAS bf16x8*)(lds + PG8_SA(b, h) + aoff + m * 2048 + k * 1024); } } while (0)
#define PG8_LDB(dst, b, h) do { if constexpr (FP8) { _Pragma("unroll") for (int n = 0; n < 2; ++n) dst##8[n] = cat8(*(const PG8_LAS bf16x8*)(lds + PG8_SB(b, h) + boff + n * 2048), *(const PG8_LAS bf16x8*)(lds + PG8_SB(b, h) + boff + n * 2048 + bkd)); } \
    else { _Pragma("unroll") for (int n = 0; n < 2; ++n) _Pragma("unroll") for (int k = 0; k < 2; ++k) dst[n][k] = *(const PG8_LAS bf16x8*)(lds + PG8_SB(b, h) + boff + n * 2048 + k * 1024); } } while (0)
#define PG8_MMA(ai, bj, At, Bt) do { __builtin_amdgcn_s_setprio(1); _Pragma("unroll") for (int m = 0; m < 4; ++m) _Pragma("unroll") for (int n = 0; n < 2; ++n) { \
        if constexpr (FP8) { asm volatile("v_mfma_scale_f32_16x16x128_f8f6f4 %0, %1, %2, %0, %3, %3 op_sel_hi:[0,0,0]" : "+v"(acc[ai][bj][m][n]) : "v"(Bt##8[n]), "v"(At##8[m]), "v"(0x7f7f7f7f)); }   \
        else { _Pragma("unroll") for (int k = 0; k < 2; ++k) acc[ai][bj][m][n] = __builtin_amdgcn_mfma_f32_16x16x32_bf16(Bt[n][k], At[m][k], acc[ai][bj][m][n], 0, 0, 0); } } __builtin_amdgcn_s_setprio(0); } while (0)
#define PG8_WAIT_V(n) asm volatile("s_waitcnt vmcnt(" #n ")" ::: "memory")
#define PG8_WAIT_L(n) asm volatile("s_waitcnt lgkmcnt(" #n ")" ::: "memory")
#define PG8_BAR __builtin_amdgcn_s_barrier()
#define PG8_SCHED __builtin_amdgcn_sched_barrier(0)
    Unit cur, nxt; int ui = 0;
    if (!S.next(0, cur)) return;
    f32x4 acc[2][2][4][2];
#pragma unroll
    for (int a = 0; a < 2; ++a)
#pragma unroll
        for (int b = 0; b < 2; ++b)
#pragma unroll
            for (int m = 0; m < 4; ++m)
#pragma unroll
                for (int n = 0; n < 2; ++n) acc[a][b][m][n] = (f32x4){0.f, 0.f, 0.f, 0.f};
    bf16x8 At[4][2], B0[2][2], B1[2][2]; v8i32 At8[4], B08[2], B18[2];
    const char* cA = (const char*)g.A + (size_t)cur.pm * tstep; const char* cB = (const char*)g.Bt + (size_t)cur.pn * tstep;
    S.a_ready(cur);
    if constexpr (SP2) {
        PG8_STAGE(PG8_SB(0, 0), cB, voffB); PG8_STAGE(PG8_SB(0, 1), cB + hstepB, voffB); PG8_STAGE(PG8_SA(0, 0), cA, voffA); PG8_STAGE(PG8_SA(0, 1), cA + hstep, voffA);
        if (wr == 1) PG8_BAR;
        PG8_WAIT_V(2); PG8_BAR;
        PG8_STAGE(PG8_SB(1, 0), cB + kstep, voffB); PG8_STAGE(PG8_SA(1, 0), cA + kstep, voffA); PG8_STAGE(PG8_SB(1, 1), cB + hstepB + kstep, voffB);
        PG8_WAIT_V(6); PG8_BAR;
    } else {
        PG8_STAGE(PG8_SB(0, 0), cB, voffB); PG8_STAGE(PG8_SA(0, 0), cA, voffA); PG8_STAGE(PG8_SB(0, 1), cB + hstepB, voffB); PG8_STAGE(PG8_SA(0, 1), cA + hstep, voffA);
        if (wr == 1) PG8_BAR;
        PG8_WAIT_V(4); PG8_BAR;
        PG8_STAGE(PG8_SB(1, 0), cB + kstep, voffB); PG8_STAGE(PG8_SA(1, 0), cA + kstep, voffA); PG8_STAGE(PG8_SB(1, 1), cB + hstepB + kstep, voffB);
        PG8_WAIT_V(6); PG8_BAR;
    }
    for (;;) {
        const bool has_next = S.next(ui + 1, nxt);
        typename Epi::PreT epre; if constexpr (Epi::PRE) E.pre(cur, wr, wc, fr, fq, epre);
        const char* nA = has_next ? (const char*)g.A + (size_t)nxt.pm * tstep : cA; const char* nB = has_next ? (const char*)g.Bt + (size_t)nxt.pn * tstep : cB;
        for (int t = 0; t < nt; t += 2) {
            const bool last = (t == nt - 2);
            const char* a1 = cA + (size_t)(t + 1) * kstep;
            const char* a2 = last ? nA : cA + (size_t)(t + 2) * kstep; const char* b2 = last ? nB : cB + (size_t)(t + 2) * kstep;
            const char* a3 = a2 + kstep; const char* b3 = b2 + kstep;
            if (last && has_next) S.a_ready(nxt);
            if constexpr (SP2) {
            PG8_LDB(B0, 0, 0); PG8_LDB(B1, 0, 1); PG8_SCHED; PG8_LDA(At, 0, 0); PG8_STAGE(PG8_SA(1, 1), a1 + hstep, voffA);
            PG8_WAIT_V(8); PG8_WAIT_L(0); PG8_BAR; PG8_MMA(0, 0, At, B0); PG8_MMA(0, 1, At, B1); PG8_BAR; PG8_SCHED;
            PG8_LDA(At, 0, 1); PG8_STAGE(PG8_SB(0, 0), b2, voffB); PG8_STAGE(PG8_SB(0, 1), b2 + hstepB, voffB); PG8_STAGE(PG8_SA(0, 0), a2, voffA);
            PG8_WAIT_V(8); PG8_WAIT_L(0); PG8_BAR; PG8_MMA(1, 0, At, B0); PG8_MMA(1, 1, At, B1); PG8_BAR; PG8_SCHED;
            PG8_LDB(B0, 1, 0); PG8_LDB(B1, 1, 1); PG8_SCHED; PG8_LDA(At, 1, 0); PG8_STAGE(PG8_SA(0, 1), a2 + hstep, voffA);
            PG8_WAIT_V(8); PG8_WAIT_L(0); PG8_BAR; PG8_MMA(0, 0, At, B0); PG8_MMA(0, 1, At, B1); PG8_BAR; PG8_SCHED;
            PG8_LDA(At, 1, 1); PG8_STAGE(PG8_SB(1, 0), b3, voffB); PG8_STAGE(PG8_SB(1, 1), b3 + hstepB, voffB); PG8_STAGE(PG8_SA(1, 0), a3, voffA);
            PG8_WAIT_V(8); PG8_WAIT_L(0); PG8_BAR; PG8_MMA(1, 0, At, B0); PG8_MMA(1, 1, At, B1); PG8_BAR; PG8_SCHED;
            } else {
            PG8_LDB(B0, 0, 0); PG8_SCHED; PG8_LDA(At, 0, 0); PG8_STAGE(PG8_SA(1, 1), a1 + hstep, voffA);
            PG8_WAIT_L(8); PG8_BAR; PG8_WAIT_L(0); PG8_MMA(0, 0, At, B0); PG8_BAR; PG8_SCHED;
            PG8_LDB(B1, 0, 1); PG8_STAGE(PG8_SB(0, 0), b2, voffB);
            PG8_BAR; PG8_WAIT_L(0); PG8_MMA(0, 1, At, B1); PG8_BAR;
            PG8_LDA(At, 0, 1); PG8_STAGE(PG8_SA(0, 0), a2, voffA);
            PG8_BAR; PG8_WAIT_L(0); PG8_MMA(1, 0, At, B0); PG8_BAR; PG8_SCHED;
            PG8_STAGE(PG8_SB(0, 1), b2 + hstepB, voffB);
            PG8_WAIT_V(6); PG8_BAR; PG8_MMA(1, 1, At, B1); PG8_BAR;
            PG8_LDB(B0, 1, 0); PG8_SCHED; PG8_LDA(At, 1, 0); PG8_STAGE(PG8_SA(0, 1), a2 + hstep, voffA);
            PG8_WAIT_L(8); PG8_BAR; PG8_WAIT_L(0); PG8_MMA(0, 0, At, B0); PG8_BAR; PG8_SCHED;
            PG8_LDB(B1, 1, 1); PG8_STAGE(PG8_SB(1, 0), b3, voffB);
            PG8_BAR; PG8_WAIT_L(0); PG8_MMA(0, 1, At, B1); PG8_BAR;
            PG8_LDA(At, 1, 1); PG8_STAGE(PG8_SA(1, 0), a3, voffA);
            PG8_BAR; PG8_WAIT_L(0); PG8_MMA(1, 0, At, B0); PG8_BAR; PG8_SCHED;
            PG8_STAGE(PG8_SB(1, 1), b3 + hstepB, voffB);
            PG8_WAIT_V(6); PG8_BAR; PG8_MMA(1, 1, At, B1); PG8_BAR;
            }
        }
        if constexpr (ALIGN_EPI) { if (wr == 0) PG8_BAR; }
        if constexpr (FP8) asm volatile("s_nop 15\n\ts_nop 15" ::: "memory");
        if constexpr (!Epi::AFTER_DRAIN) { if constexpr (Epi::PRE) E(acc, cur, wr, wc, fr, fq, epre); else E(acc, cur, wr, wc, fr, fq); S.done(cur); }
        if (!has_next) break;
#pragma unroll
        for (int a = 0; a < 2; ++a)
#pragma unroll
            for (int b = 0; b < 2; ++b)
#pragma unroll
                for (int m = 0; m < 4; ++m)
#pragma unroll
                    for (int n = 0; n < 2; ++n) acc[a][b][m][n] = (f32x4){0.f, 0.f, 0.f, 0.f};
        cur = nxt; cA = nA; cB = nB; ++ui;
        if constexpr (ALIGN_EPI) { if (wr == 1) PG8_BAR; }
    }
    PG8_WAIT_V(0);
    if constexpr (!ALIGN_EPI) { if (wr == 0) PG8_BAR; }
    PG8_BAR;
    if constexpr (Epi::AFTER_DRAIN) { E.fused(acc, cur, wr, wc, fr, fq, lds, wid, lane); S.done(cur); }
#undef PG8_SA
#undef PG8_SB
#undef PG8_STAGE
#undef PG8_LDA
#undef PG8_LDB
#undef PG8_MMA
#undef PG8_WAIT_V
#undef PG8_WAIT_L
#undef PG8_BAR
#undef PG8_SCHED
}
}

namespace pg8 {
typedef unsigned u32x2 __attribute__((ext_vector_type(2)));
template <int BF  , bool SS> struct EpiResid {
    static constexpr bool PERM = false, AFTER_DRAIN = false; static constexpr bool BJ16 = false; static constexpr bool PRE = false; struct PreT {};
    const float* res; float* out; bf16_t* ob; float* rowss; int ld; float ascale;
    __device__ __forceinline__ void operator()(const f32x4 (&acc)[2][2][4][2], const Unit& u, int wr, int wc, int fr, int fq) const {
        const int row0 = u.pm * BM + wr * 64 + fr, col0 = u.pn * BM + wc * 32 + 4 * fq;
#pragma unroll
        for (int ai = 0; ai < 2; ++ai)
#pragma unroll
            for (int m = 0; m < 4; ++m) { const int row = row0 + ai * HALF + m * 16; const size_t ro = (size_t)row * ld + col0; float ss = 0.f;
#pragma unroll
                for (int bj = 0; bj < 2; ++bj)
#pragma unroll
                    for (int n = 0; n < 2; ++n) { const size_t o = ro + bj * HALF + n * 16; const f32x4 r4 = *(const f32x4*)(res + o); const f32x4 v = acc[ai][bj][m][n] * ascale + r4;
                        *(f32x4*)(out + o) = v;
                        if (BF == 1) { u32x2 w; w.x = cvt_pk_bf16(v[0], v[1]); w.y = cvt_pk_bf16(v[2], v[3]); *(u32x2*)(ob + o) = w; }
                        if (BF == 2) { *(unsigned*)((unsigned char*)ob + o) = pk4_fp8(v[0], v[1], v[2], v[3]); }
                        if (SS) ss += (v[0] * v[0] + v[1] * v[1]) + (v[2] * v[2] + v[3] * v[3]); }
                if (SS) { ss += __shfl_xor(ss, 16); ss += __shfl_xor(ss, 32); if (fq == 0) atomicAdd(rowss + row, ss); } }
    }
};
struct EpiNull { static constexpr bool PERM = true, AFTER_DRAIN = false; static constexpr bool BJ16 = false; static constexpr bool PRE = false; struct PreT {}; float* O;
    __device__ __forceinline__ void operator()(const f32x4 (&acc)[2][2][4][2], const Unit& u, int wr, int wc, int fr, int fq) const {
#pragma unroll
      for (int a = 0; a < 2; ++a)
#pragma unroll
        for (int b = 0; b < 2; ++b)
#pragma unroll
          for (int m = 0; m < 4; ++m)
#pragma unroll
            for (int n = 0; n < 2; ++n) asm volatile("" :: "v"(acc[a][b][m][n])); } };
template <bool RES_F32, bool F8, bool SS> struct EpiStream {
    static constexpr bool PERM = true, AFTER_DRAIN = false; static constexpr bool BJ16 = true; static constexpr bool PRE = true; struct PreT { u32x4 v[4]; };
    const float* resf; const bf16_t* resb; bf16_t* ob; unsigned char* o8; float* rowss; int ld; float ascale;
    __device__ __forceinline__ void pre(const Unit& u, int wr, int wc, int fr, int fq, PreT& pp) const {
        const int row0 = u.pm * BM + wr * 64 + fr, col0 = u.pn * BM + wc * 64 + 16 * fq; const size_t ro = (size_t)row0 * ld + col0;
        if constexpr (RES_F32) {
#pragma unroll
            for (int q = 0; q < 4; ++q) pp.v[q] = *(const u32x4*)(resf + ro + 4 * q); }
        else {
#pragma unroll
            for (int gi = 0; gi < 2; ++gi) { const size_t r2 = ro + (size_t)gi * 16 * ld; pp.v[2 * gi] = *(const u32x4*)(resb + r2); pp.v[2 * gi + 1] = *(const u32x4*)(resb + r2 + 8); } }
    }
    __device__ __forceinline__ void operator()(const f32x4 (&acc)[2][2][4][2], const Unit& u, int wr, int wc, int fr, int fq) const { PreT dummy; run<false>(acc, u, wr, wc, fr, fq, dummy); }
    __device__ __forceinline__ void operator()(const f32x4 (&acc)[2][2][4][2], const Unit& u, int wr, int wc, int fr, int fq, const PreT& pp) const { run<true>(acc, u, wr, wc, fr, fq, pp); }
    template <bool HP> __device__ __forceinline__ void run(const f32x4 (&acc)[2][2][4][2], const Unit& u, int wr, int wc, int fr, int fq, const PreT& pp) const {
        const int row0 = u.pm * BM + wr * 64 + fr, col0 = u.pn * BM + wc * 64 + 16 * fq;
#pragma unroll
        for (int ai = 0; ai < 2; ++ai)
#pragma unroll
            for (int m = 0; m < 4; ++m) { const int row = row0 + ai * HALF + m * 16; const size_t ro = (size_t)row * ld + col0; float ss = 0.f; f32x4 r4[4];
                if (RES_F32) {
                    if (HP && ai == 0 && m == 0) {
#pragma unroll
                        for (int q = 0; q < 4; ++q) r4[q] = __builtin_bit_cast(f32x4, pp.v[q]); }
                    else {
#pragma unroll
                        for (int q = 0; q < 4; ++q) r4[q] = *(const f32x4*)(resf + ro + 4 * q); } }
                else { u32x4 ra, rb;
                    if constexpr (HP) { if (ai == 0 && m < 2) { ra = pp.v[2 * m]; rb = pp.v[2 * m + 1]; } else { ra = *(const u32x4*)(resb + ro); rb = *(const u32x4*)(resb + ro + 8); } }
                    else { ra = *(const u32x4*)(resb + ro); rb = *(const u32x4*)(resb + ro + 8); }
                    const unsigned rw[8] = {ra.x, ra.y, ra.z, ra.w, rb.x, rb.y, rb.z, rb.w};
#pragma unroll
                    for (int q = 0; q < 4; ++q) r4[q] = (f32x4){__builtin_bit_cast(float, rw[2 * q] << 16), __builtin_bit_cast(float, rw[2 * q] & 0xffff0000u), __builtin_bit_cast(float, rw[2 * q + 1] << 16), __builtin_bit_cast(float, rw[2 * q + 1] & 0xffff0000u)}; }
                f32x4 v[4];
#pragma unroll
                for (int q = 0; q < 4; ++q) { v[q] = acc[ai][q >> 1][m][q & 1] * ascale + r4[q]; if (SS) ss += (v[q][0] * v[q][0] + v[q][1] * v[q][1]) + (v[q][2] * v[q][2] + v[q][3] * v[q][3]); }
                u32x4 wa, wb; wa.x = cvt_pk_bf16(v[0][0], v[0][1]); wa.y = cvt_pk_bf16(v[0][2], v[0][3]); wa.z = cvt_pk_bf16(v[1][0], v[1][1]); wa.w = cvt_pk_bf16(v[1][2], v[1][3]);
                wb.x = cvt_pk_bf16(v[2][0], v[2][1]); wb.y = cvt_pk_bf16(v[2][2], v[2][3]); wb.z = cvt_pk_bf16(v[3][0], v[3][1]); wb.w = cvt_pk_bf16(v[3][2], v[3][3]);
                *(u32x4*)(ob + ro) = wa; *(u32x4*)(ob + ro + 8) = wb;
                if (F8) { u32x4 w8; w8.x = pk4_fp8(v[0][0], v[0][1], v[0][2], v[0][3]); w8.y = pk4_fp8(v[1][0], v[1][1], v[1][2], v[1][3]); w8.z = pk4_fp8(v[2][0], v[2][1], v[2][2], v[2][3]); w8.w = pk4_fp8(v[3][0], v[3][1], v[3][2], v[3][3]); *(u32x4*)(o8 + ro) = w8; }
                if (SS) { ss += __shfl_xor(ss, 16); ss += __shfl_xor(ss, 32); if (fq == 0) atomicAdd(rowss + row, ss); } }
    }
};
template <bool F8OUT> struct EpiScaleT {
    static constexpr bool PERM = true, AFTER_DRAIN = false; static constexpr bool BJ16 = F8OUT; static constexpr bool PRE = F8OUT; struct PreT { float v[8]; };
    bf16_t* O; int ldc; const float* rowss; float inv_n, eps, oscale;
    __device__ __forceinline__ void pre(const Unit& u, int wr, int wc, int fr, int fq, PreT& pp) const { float (&p)[8] = pp.v;
        const int row0 = u.pm * BM + wr * 64 + fr;
#pragma unroll
        for (int ai = 0; ai < 2; ++ai)
#pragma unroll
            for (int m = 0; m < 4; ++m) p[4 * ai + m] = rowss[row0 + ai * HALF + m * 16];
    }
    __device__ __forceinline__ void operator()(const f32x4 (&acc)[2][2][4][2], const Unit& u, int wr, int wc, int fr, int fq, const PreT& pp) const { const float (&p)[8] = pp.v;
        const int row0 = u.pm * BM + wr * 64 + fr;
#pragma unroll
        for (int ai = 0; ai < 2; ++ai)
#pragma unroll
            for (int m = 0; m < 4; ++m) { const int row = row0 + ai * HALF + m * 16; const float rs = __builtin_amdgcn_rsqf(p[4 * ai + m] * inv_n + eps) * oscale;
                const f32x4 v0 = acc[ai][0][m][0] * rs, v1 = acc[ai][0][m][1] * rs, v2 = acc[ai][1][m][0] * rs, v3 = acc[ai][1][m][1] * rs; u32x4 w;
                w.x = pk4_fp8(v0[0], v0[1], v0[2], v0[3]); w.y = pk4_fp8(v1[0], v1[1], v1[2], v1[3]); w.z = pk4_fp8(v2[0], v2[1], v2[2], v2[3]); w.w = pk4_fp8(v3[0], v3[1], v3[2], v3[3]);
                *(u32x4*)((unsigned char*)O + (size_t)row * ldc + u.pn * BM + wc * 64 + 16 * fq) = w; }
    }
    __device__ __forceinline__ void operator()(const f32x4 (&acc)[2][2][4][2], const Unit& u, int wr, int wc, int fr, int fq) const {
        const int row0 = u.pm * BM + wr * 64 + fr, col0 = u.pn * BM + wc * 32 + 8 * fq;
#pragma unroll
        for (int ai = 0; ai < 2; ++ai)
#pragma unroll
            for (int m = 0; m < 4; ++m) { const int row = row0 + ai * HALF + m * 16; const float rs = __builtin_amdgcn_rsqf(rowss[row] * inv_n + eps) * oscale;
                bf16_t* rowp = O + (size_t)row * ldc + col0;
                if (F8OUT) { const f32x4 v0 = acc[ai][0][m][0] * rs, v1 = acc[ai][0][m][1] * rs, v2 = acc[ai][1][m][0] * rs, v3 = acc[ai][1][m][1] * rs; u32x4 w;
                    w.x = pk4_fp8(v0[0], v0[1], v0[2], v0[3]); w.y = pk4_fp8(v1[0], v1[1], v1[2], v1[3]); w.z = pk4_fp8(v2[0], v2[1], v2[2], v2[3]); w.w = pk4_fp8(v3[0], v3[1], v3[2], v3[3]);
                    *(u32x4*)((unsigned char*)O + (size_t)row * ldc + u.pn * BM + wc * 64 + 16 * fq) = w; }
                else
#pragma unroll
                for (int bj = 0; bj < 2; ++bj) { const f32x4 v0 = acc[ai][bj][m][0] * rs, v1 = acc[ai][bj][m][1] * rs;
                    if (F8OUT) { }
                    else { u32x4 w; w.x = cvt_pk_bf16(v0[0], v0[1]); w.y = cvt_pk_bf16(v0[2], v0[3]); w.z = cvt_pk_bf16(v1[0], v1[1]); w.w = cvt_pk_bf16(v1[2], v1[3]);
                        *(u32x4*)(rowp + bj * HALF) = w; } } }
    }
};
typedef EpiScaleT<false> EpiScaleBf16;
}

constexpr int BATCH = 2, SEQ = 16384, DM = 2048, MTOK = BATCH * SEQ;
constexpr int DIN = 4632, NP1 = 4608;
constexpr int NP1A = 1536;
constexpr int HD = 128, NH = 8;
constexpr int COL_KCMP = 1024, COL_VCMP = 1280, COL_KSEL = 1536, COL_VSEL = 1792, COL_KWIN = 2048, COL_VWIN = 2304, WCOL_GATE = 2560  , COL_U = 2560, COL_V = 3584;
constexpr int DFF = 5632, DFF2 = 11264;
constexpr float EPS = 1e-6f;
constexpr float W8SCALE = 64.0f;
constexpr float C2 = 0.08838834764831845f * 1.4426950408889634f;
constexpr int NWAVES = 8, NTHR = 512;

constexpr size_t MiB = 1u << 20;
constexpr size_t WS_CTL = 0, CTL_ZERO_BYTES = 1 * MiB;
constexpr size_t WS_WIN = 1 * MiB, WS_WOUT = 20 * MiB, WS_WUP = 28 * MiB, WS_WDN = 72 * MiB, WS_WCK = 94 * MiB, WS_WCV = 95 * MiB, WS_WM = 96 * MiB;
constexpr size_t WS_COS = 97 * MiB, WS_SIN = 105 * MiB, WS_KC = 113 * MiB, WS_VCT = 114 * MiB, WS_KSEL = 115 * MiB, WS_KWIN = 131 * MiB, WS_VSELT = 147 * MiB, WS_VWINT = 163 * MiB;
constexpr size_t WS_TMASK = 179 * MiB, WS_H1B = 181 * MiB;
constexpr size_t WS_Q8 = 309 * MiB  ;
constexpr size_t WS_XN = 309 * MiB  , WS_QR = 373 * MiB  , WS_PROJ = 437 * MiB, WS_OC = 741 * MiB, WS_OS = 805 * MiB, WS_OW = 869 * MiB;
constexpr size_t WS_AH = 309 * MiB  , WS_HMID = 661 * MiB, WS_END = 1013 * MiB;
constexpr size_t WS_H1BF = 837 * MiB  , WS_H2BF = 309 * MiB  ;
constexpr size_t WS_WIN8 = 9 * MiB  , WS_XN8 = 741 * MiB  ;
constexpr size_t WS_WG = 96 * MiB + 512 * 1024  , WS_GATES = 1013 * MiB  , WS_END2 = 1015 * MiB;
static_assert(WS_PROJ + (size_t)MTOK * NP1 * 2 <= WS_OC && WS_AH + (size_t)MTOK * DFF2 <= WS_HMID && WS_HMID + (size_t)MTOK * DFF <= WS_END, "ws map");
constexpr int CW_BAR = 4096;
constexpr int CW_CCONST = 65536;
constexpr int CW_ROWSS = 131072;
static_assert(CW_BAR + 16 * 3456 <= CW_CCONST && (CW_ROWSS + MTOK) * 4 <= (int)CTL_ZERO_BYTES, "ctl map");
constexpr int LDS_BYTES = 147456;
constexpr int MISC_OFF = LDS_BYTES - 256;

#define GAS __attribute__((address_space(1)))
#define LAS __attribute__((address_space(3)))
typedef unsigned short bf16;
typedef unsigned v4u __attribute__((ext_vector_type(4)));
typedef unsigned v2u __attribute__((ext_vector_type(2)));
typedef float f32x4 __attribute__((ext_vector_type(4)));
typedef short bf16x8 __attribute__((ext_vector_type(8)));
__device__ __forceinline__ float bf2f(unsigned v) { return __builtin_bit_cast(float, v << 16); }
__device__ __forceinline__ float bflo(unsigned w) { return __builtin_bit_cast(float, w << 16); }
__device__ __forceinline__ float bfhi(unsigned w) { return __builtin_bit_cast(float, w & 0xffff0000u); }
__device__ __forceinline__ unsigned pk2(float lo, float hi) { return pg8::cvt_pk_bf16(lo, hi); }
__device__ __forceinline__ unsigned f2bf(float f) { return pg8::cvt_pk_bf16(f, 0.f) & 0xffffu; }
__device__ __forceinline__ float wave_sum(float v) {
#pragma unroll
    for (int o = 1; o < 64; o <<= 1) v += __shfl_xor(v, o);
    return v;
}
__device__ __forceinline__ float gelu_exact(float x) { return 0.5f * x * (1.0f + erff(x * 0.70710678118654752f)); }
__device__ __forceinline__ float sigmoidf(float x) { return __builtin_amdgcn_rcpf(1.0f + __builtin_amdgcn_exp2f(x * -1.4426950408889634f)); }
__device__ __forceinline__ f32x4 mfma16(bf16x8 a, bf16x8 b, f32x4 c) { return __builtin_amdgcn_mfma_f32_16x16x32_bf16(a, b, c, 0, 0, 0); }
__device__ __forceinline__ bf16x8 pack8(f32x4 a, f32x4 b) { v4u w; w.x = pk2(a[0], a[1]); w.y = pk2(a[2], a[3]); w.z = pk2(b[0], b[1]); w.w = pk2(b[2], b[3]); return __builtin_bit_cast(bf16x8, w); }
__device__ __forceinline__ int kpos_of(int k) { return (k & 32) | (((k >> 2) & 3) << 3) | (((k >> 4) & 1) << 2) | (k & 3); }


#define XB_TMO      128
#define XB_XCNT(j)  (256  + 64 * (j))
#define XB_XSUB(j)  (1280 + 64 * (j))
#define XB_XGEN(j)  (2304 + 64 * (j))
#define XB_TOP      3328
#define XB_TOPGEN   3392
#define XCD_BAR_WORDS 3456
#define XB_SPIN_CAP (1u << 18)

__device__ __forceinline__ unsigned xb_ld(unsigned* p)              { return __hip_atomic_load(p, __ATOMIC_RELAXED, __HIP_MEMORY_SCOPE_AGENT); }
__device__ __forceinline__ unsigned xb_add(unsigned* p, unsigned v) { return __hip_atomic_fetch_add(p, v, __ATOMIC_RELAXED, __HIP_MEMORY_SCOPE_AGENT); }
__device__ __forceinline__ unsigned xb_xcc_id() { return (unsigned)__builtin_amdgcn_s_getreg((3 << 11) | 20) & 0xFu; }
#define XB_SPIN(cond, bar) do { unsigned _sp = 0; while (cond) { __builtin_amdgcn_s_sleep(1); \
    if ((++_sp & 255u) == 0u) { if (xb_ld(&(bar)[XB_TMO])) break; if (_sp > XB_SPIN_CAP) { atomicAdd(&(bar)[XB_TMO], 1u); break; } } } } while (0)

struct XcdBarrier {
    unsigned* bar; unsigned x;
    volatile LAS unsigned* st;
};

__device__ __forceinline__ XcdBarrier xcd_barrier_post(unsigned* bar, volatile LAS unsigned* st) {
    XcdBarrier b; b.bar = bar; b.x = xb_xcc_id(); b.st = st;
    if (threadIdx.x == 0) (void)xb_add(&bar[XB_XCNT(b.x)], 1u);
    return b;
}
__device__ __forceinline__ void xcd_barrier_complete(unsigned* bar, unsigned x, unsigned& nloc, unsigned& nx) {
    const unsigned G = gridDim.x * gridDim.y * gridDim.z;
    unsigned sum, cnt, mine, sp = 0u;
    for (;;) {
        sum = 0u; cnt = 0u; mine = 0u;
#pragma unroll
        for (unsigned j = 0; j < 16; ++j) { const unsigned c = xb_ld(&bar[XB_XCNT(j)]); sum += c; cnt += (c > 0u) ? 1u : 0u; mine = (j == x) ? c : mine; }
        if (sum == G) break;
        __builtin_amdgcn_s_sleep(1);
        if ((++sp & 255u) == 0u) { if (xb_ld(&bar[XB_TMO])) break; if (sp > XB_SPIN_CAP) { atomicAdd(&bar[XB_TMO], 1u); break; } }
    }
    nloc = mine > 0u ? mine : 1u; nx = cnt > 0u ? cnt : 1u;
}

__device__ __forceinline__ void xcd_barrier(const XcdBarrier& b) {
    asm volatile("s_waitcnt vmcnt(0)" ::: "memory");
    __syncthreads();
    if (threadIdx.x == 0) {
        unsigned* bar = b.bar;
        __builtin_amdgcn_s_waitcnt(0);
        unsigned nloc = b.st[0], nx = b.st[1];
        if (nloc == 0u) { xcd_barrier_complete(bar, b.x, nloc, nx); b.st[0] = nloc; b.st[1] = nx; }
        const unsigned old = xb_add(&bar[XB_XSUB(b.x)], 1u);
        const unsigned gen = old / nloc;
        if (old + 1u == (gen + 1u) * nloc) {
            __builtin_amdgcn_fence(__ATOMIC_RELEASE, "agent");
            asm volatile("s_waitcnt vmcnt(0)" ::: "memory");
            const unsigned og = xb_add(&bar[XB_TOP], 1u);
            const unsigned tg = og / nx;
            if (og + 1u == (tg + 1u) * nx) xb_add(&bar[XB_TOPGEN], 1u);
            else XB_SPIN(xb_ld(&bar[XB_TOPGEN]) == tg, bar);
            __builtin_amdgcn_fence(__ATOMIC_ACQUIRE, "agent");
            xb_add(&bar[XB_XGEN(b.x)], 1u);
            asm volatile("s_waitcnt vmcnt(0)" ::: "memory");
        } else {
            XB_SPIN(xb_ld(&bar[XB_XGEN(b.x)]) == gen, bar);
            __builtin_amdgcn_fence(__ATOMIC_ACQUIRE, "agent");
            asm volatile("s_waitcnt vmcnt(0)" ::: "memory");
        }
    }
    __syncthreads();
}


struct Args { const void* in[20]; float* out; unsigned char* ws; int ph_lo, ph_hi, li, pad; };

struct TUnit { const float* W; int K, ldw, N, kt, nt; const float* ksc; bf16* WT; bool f8; };
__device__ __forceinline__ void tu_load(const TUnit& u, f32x4 (&v)[8], float (&sc)[8]) {
    const int tid = threadIdx.x;
#pragma unroll
    for (int i = 0; i < 8; ++i) { const int idx = tid + NTHR * i, k = idx >> 6, n = 256 * u.nt + 4 * (idx & 63);
        v[i] = (f32x4){0.f, 0.f, 0.f, 0.f}; if (n < u.N) v[i] = *(const f32x4*)(u.W + (size_t)(64 * u.kt + k) * u.ldw + n); sc[i] = u.ksc ? u.ksc[64 * u.kt + k] : 1.f; }
}
__device__ __forceinline__ void tu_store(const TUnit& u, const f32x4 (&v)[8], const float (&sc)[8], LAS float* tile) {
    const int tid = threadIdx.x;
#pragma unroll
    for (int i = 0; i < 8; ++i) { const int idx = tid + NTHR * i, k = idx >> 6; LAS float* t = tile + k * 257 + (idx & 63); t[0] = v[i][0] * sc[i]; t[64] = v[i][1] * sc[i]; t[128] = v[i][2] * sc[i]; t[192] = v[i][3] * sc[i]; }
    __syncthreads();
#pragma unroll
    for (int i = 0; i < 4; ++i) { const int kc = tid & 7, q = tid >> 3, n = 4 * q + i; const LAS float* t = tile + (8 * kc) * 257 + 64 * i + q;
        if (256 * u.nt + n < u.N) {
            if (u.f8) { v2u o; o.x = pg8::pk4_fp8(t[0] * W8SCALE, t[257] * W8SCALE, t[514] * W8SCALE, t[771] * W8SCALE); o.y = pg8::pk4_fp8(t[1028] * W8SCALE, t[1285] * W8SCALE, t[1542] * W8SCALE, t[1799] * W8SCALE);
                *(v2u*)((unsigned char*)u.WT + (size_t)(256 * u.nt + n) * u.K + 64 * u.kt + 8 * kc) = o; }
            else { v4u o; o.x = pk2(t[0], t[257]); o.y = pk2(t[514], t[771]); o.z = pk2(t[1028], t[1285]); o.w = pk2(t[1542], t[1799]);
                *(v4u*)(u.WT + (size_t)(256 * u.nt + n) * u.K + 64 * u.kt + 8 * kc) = o; } } }
    __syncthreads();
}
__device__ __forceinline__ void p0_prologue(const Args& a, LAS unsigned char* lds, int wg, int G) {
    const int tid = threadIdx.x, lane = tid & 63, wave = tid >> 6;
    unsigned char* ws = a.ws;
    LAS float* tile = (LAS float*)lds;
    const float* w_in = (const float*)a.in[3]; const float* w_out = (const float*)a.in[13]; const float* w_up = (const float*)a.in[15]; const float* w_dn = (const float*)a.in[18];
    const float* wck = (const float*)a.in[5]; const float* wcv = (const float*)a.in[7]; const float* g2 = (const float*)a.in[14];
    constexpr int U_IN = 32 * 18, U_OUT = 32 * 8, U_UP = 32 * 44, U_DN = 88 * 8, U_C = 64;
    constexpr int NT = U_IN + U_OUT + U_UP + U_DN + 2 * U_C;
    { f32x4 vc[8], vn[8]; float scc[8], scn[8]; TUnit uc{}, un{};
      for (int it = wg - G; it < NT; it += G) { const int itn = it + G; const bool hn = itn < NT;
        if (hn) { int r = itn; const float* W; int K, ldw, N, kt, nt; const float* ksc = nullptr; bf16* WT; bool f8 = false;
        if (r < U_IN) { kt = r / 18; nt = r % 18; K = DM; ldw = DIN;
            if (nt < 6) { W = w_in; N = NP1A; WT = (bf16*)(ws + WS_WIN); }
            else if (nt < 10) { W = w_in + NP1A; N = 1024; WT = (bf16*)(ws + WS_WIN8); nt -= 6; f8 = true; }
            else { W = w_in + 2584; N = 2048; WT = (bf16*)(ws + WS_WIN8 + (size_t)1024 * DM); nt -= 10; f8 = true; } }
        else if ((r -= U_IN) < U_UP) { W = w_up; K = DM; ldw = DFF2; N = DFF2; ksc = g2; WT = (bf16*)(ws + WS_WUP); kt = r / 44; nt = r % 44; f8 = true; }
        else if ((r -= U_UP) < U_DN) { W = w_dn; K = DFF; ldw = DM; N = DM; WT = (bf16*)(ws + WS_WDN); kt = r / 8; nt = r % 8; f8 = true; }
        else if ((r -= U_DN) < U_OUT) { W = w_out; K = DM; ldw = DM; N = DM; WT = (bf16*)(ws + WS_WOUT); kt = r / 8; nt = r % 8; f8 = true; }
        else if ((r -= U_OUT) < U_C) { W = wck; K = 4096; ldw = 128; N = 128; WT = (bf16*)(ws + WS_WCK); kt = r; nt = 0; }
        else { r -= U_C; W = wcv; K = 4096; ldw = 128; N = 128; WT = (bf16*)(ws + WS_WCV); kt = r; nt = 0; }
            un = TUnit{W, K, ldw, N, kt, nt, ksc, WT, f8}; tu_load(un, vn, scn); }
        if (it >= wg) tu_store(uc, vc, scc, tile);
        if (hn) { uc = un;
#pragma unroll
            for (int i = 0; i < 8; ++i) { vc[i] = vn[i]; scc[i] = scn[i]; } } } }
    const int gt = wg * NTHR + tid, NGT = G * NTHR;
    { unsigned char* wgt = ws + WS_WG; for (int i = gt; i < 32 * DM; i += NGT) { const int r = i >> 11, k = i & (DM - 1); wgt[i] = (unsigned char)pg8::pk4_fp8(r < 24 ? w_in[(size_t)k * DIN + WCOL_GATE + r] * W8SCALE : 0.f, 0.f, 0.f, 0.f); } }
    { const float* wsp = (const float*)a.in[9]; bf16* wm = (bf16*)(ws + WS_WM);
      for (int i = gt; i < 8 * 128 * 128; i += NGT) { const int s = i & 127, t = (i >> 7) & 127; wm[i] = (bf16)f2bf(s <= t ? wsp[i] : 0.f); } }
    { const int* pos = (const int*)a.in[1]; float* ct = (float*)(ws + WS_COS); float* st = (float*)(ws + WS_SIN);
      const float inv = powf(10000.0f, -2.0f * (float)(gt & 63) / 128.0f);
      for (int i = gt; i < MTOK * 64; i += NGT) { const int m = i >> 6; const float ang = (float)pos[m] * inv;
          const double tr = (double)ang * 0.15915494309189535; const float rev = (float)(tr - rint(tr));
          ct[i] = __builtin_amdgcn_cosf(rev); st[i] = __builtin_amdgcn_sinf(rev); } }
    for (int u = wg; u < 32; u += G) { const int kv = u >> 4, sl = u & 15; const float* pe = (const float*)a.in[kv ? 6 : 4]; const float* w = kv ? wcv : wck;
        const int e = tid & 127, sub = tid >> 7; const int k0 = sl * 256 + sub * 64; float s0 = 0.f, s1 = 0.f, s2 = 0.f, s3 = 0.f;
#pragma unroll 4
        for (int k = k0; k < k0 + 64; k += 4) { s0 += pe[k] * w[(size_t)k * 128 + e]; s1 += pe[k + 1] * w[(size_t)(k + 1) * 128 + e]; s2 += pe[k + 2] * w[(size_t)(k + 2) * 128 + e]; s3 += pe[k + 3] * w[(size_t)(k + 3) * 128 + e]; }
        __syncthreads(); tile[tid] = (s0 + s1) + (s2 + s3); __syncthreads();
        if (tid < 128) ((float*)(ws + WS_CTL) + CW_CCONST + (kv * 16 + sl) * 128)[tid] = (tile[tid] + tile[tid + 128]) + (tile[tid + 256] + tile[tid + 384]);
        __syncthreads(); }
    { const float* x = (const float*)a.in[0]; const float* g1 = (const float*)a.in[2]; bf16* xn = (bf16*)(ws + WS_XN); const int NW = G * NWAVES;
      for (int m = wg * NWAVES + wave; m < MTOK; m += 2 * NW) { f32x4 v[2][8]; const bool two = m + NW < MTOK;
#pragma unroll
          for (int q = 0; q < 2; ++q) { const f32x4* xr = (const f32x4*)(x + (size_t)(q && two ? m + NW : m) * DM) + 2 * lane;
#pragma unroll
              for (int j = 0; j < 4; ++j) { v[q][2 * j] = xr[128 * j]; v[q][2 * j + 1] = xr[128 * j + 1]; } }
#pragma unroll
          for (int q = 0; q < 2; ++q) { if (q && !two) break; const int mm = m + q * NW; float s = 0.f;
#pragma unroll
              for (int j = 0; j < 8; ++j) s += (v[q][j][0] * v[q][j][0] + v[q][j][1] * v[q][j][1]) + (v[q][j][2] * v[q][j][2] + v[q][j][3] * v[q][j][3]);
              const float rs = 1.0f / sqrtf(wave_sum(s) * (1.0f / DM) + EPS); v4u* o = (v4u*)(xn + (size_t)mm * DM) + lane; v2u* o8 = (v2u*)(ws + WS_XN8 + (size_t)mm * DM) + lane;
#pragma unroll
              for (int j = 0; j < 4; ++j) { const f32x4 ga = *((const f32x4*)g1 + 2 * lane + 128 * j), gb = *((const f32x4*)g1 + 2 * lane + 128 * j + 1); const f32x4 va = v[q][2 * j], vb = v[q][2 * j + 1];
                  const float y0 = va[0] * rs * ga[0], y1 = va[1] * rs * ga[1], y2 = va[2] * rs * ga[2], y3 = va[3] * rs * ga[3], y4 = vb[0] * rs * gb[0], y5 = vb[1] * rs * gb[1], y6 = vb[2] * rs * gb[2], y7 = vb[3] * rs * gb[3];
                  v4u w; w.x = pk2(y0, y1); w.y = pk2(y2, y3); w.z = pk2(y4, y5); w.w = pk2(y6, y7); o[64 * j] = w;
                  v2u w8; w8.x = pg8::pk4_fp8(y0, y1, y2, y3); w8.y = pg8::pk4_fp8(y4, y5, y6, y7); o8[64 * j] = w8; } } } }
}

__device__ __forceinline__ void p1_gates(const Args& a, int wg, int G) {
    const int lane = threadIdx.x & 63, wave = __builtin_amdgcn_readfirstlane(threadIdx.x >> 6), c = lane & 15, g = lane >> 4;
    unsigned char* ws = a.ws; const unsigned char* xn8 = ws + WS_XN8; const unsigned char* wgt = ws + WS_WG; bf16* gates = (bf16*)(ws + WS_GATES);
    for (int t = wg * NWAVES + wave; t < MTOK / 16; t += G * NWAVES) {
        const unsigned char* ap = xn8 + (size_t)(16 * t + c) * DM + 32 * g; const unsigned char* bp = wgt + (size_t)c * DM + 32 * g;
        f32x4 acc0 = (f32x4){0.f, 0.f, 0.f, 0.f}, acc1 = acc0;
#pragma unroll 8
        for (int ks = 0; ks < 16; ++ks) { const pg8::v8i32 af = *(const pg8::v8i32*)(ap + 128 * ks), b0 = *(const pg8::v8i32*)(bp + 128 * ks), b1 = *(const pg8::v8i32*)(bp + (size_t)16 * DM + 128 * ks);
            acc0 = __builtin_amdgcn_mfma_scale_f32_16x16x128_f8f6f4(af, b0, acc0, 0, 0, 0, 0x7f7f7f7f, 0, 0x79797979);
            acc1 = __builtin_amdgcn_mfma_scale_f32_16x16x128_f8f6f4(af, b1, acc1, 0, 0, 0, 0x7f7f7f7f, 0, 0x79797979); }
#pragma unroll
        for (int i = 0; i < 4; ++i) { bf16* o = gates + (size_t)(16 * t + 4 * g + i) * 32; o[c] = (bf16)f2bf(acc0[i]); o[16 + c] = (bf16)f2bf(acc1[i]); }
    }
}

__device__ __forceinline__ void rope8(v4u x1, v4u x2, const float* cs, const float* sn, v4u& o1, v4u& o2) {
    const f32x4 c0 = *(const f32x4*)cs, c1 = *(const f32x4*)(cs + 4), s0 = *(const f32x4*)sn, s1 = *(const f32x4*)(sn + 4);
    const float c[8] = {c0[0], c0[1], c0[2], c0[3], c1[0], c1[1], c1[2], c1[3]}, s[8] = {s0[0], s0[1], s0[2], s0[3], s1[0], s1[1], s1[2], s1[3]};
    float a[8], b[8];
#pragma unroll
    for (int j = 0; j < 4; ++j) { a[2 * j] = bflo(x1[j]); a[2 * j + 1] = bfhi(x1[j]); b[2 * j] = bflo(x2[j]); b[2 * j + 1] = bfhi(x2[j]); }
#pragma unroll
    for (int j = 0; j < 4; ++j) { o1[j] = pk2(a[2 * j] * c[2 * j] - b[2 * j] * s[2 * j], a[2 * j + 1] * c[2 * j + 1] - b[2 * j + 1] * s[2 * j + 1]);
        o2[j] = pk2(b[2 * j] * c[2 * j] + a[2 * j] * s[2 * j], b[2 * j + 1] * c[2 * j + 1] + a[2 * j + 1] * s[2 * j + 1]); }
}
__device__ __forceinline__ void rope8r(v4u x1, v4u x2, f32x4 c0, f32x4 c1, f32x4 s0, f32x4 s1, v4u& o1, v4u& o2) {
    const float c[8] = {c0[0], c0[1], c0[2], c0[3], c1[0], c1[1], c1[2], c1[3]}, s[8] = {s0[0], s0[1], s0[2], s0[3], s1[0], s1[1], s1[2], s1[3]};
    float a[8], b[8];
#pragma unroll
    for (int j = 0; j < 4; ++j) { a[2 * j] = bflo(x1[j]); a[2 * j + 1] = bfhi(x1[j]); b[2 * j] = bflo(x2[j]); b[2 * j + 1] = bfhi(x2[j]); }
#pragma unroll
    for (int j = 0; j < 4; ++j) { o1[j] = pk2(a[2 * j] * c[2 * j] - b[2 * j] * s[2 * j], a[2 * j + 1] * c[2 * j + 1] - b[2 * j + 1] * s[2 * j + 1]);
        o2[j] = pk2(b[2 * j] * c[2 * j] + a[2 * j] * s[2 * j], b[2 * j + 1] * c[2 * j + 1] + a[2 * j + 1] * s[2 * j + 1]); }
}
__device__ __forceinline__ void rope8rf(v4u x1, v4u x2, f32x4 c0, f32x4 c1, f32x4 s0, f32x4 s1, v4u& o1, v4u& o2, v2u& e1, v2u& e2, float fs) {
    const float c[8] = {c0[0], c0[1], c0[2], c0[3], c1[0], c1[1], c1[2], c1[3]}, s[8] = {s0[0], s0[1], s0[2], s0[3], s1[0], s1[1], s1[2], s1[3]};
    float a[8], b[8], ra[8], rb[8];
#pragma unroll
    for (int j = 0; j < 4; ++j) { a[2 * j] = bflo(x1[j]); a[2 * j + 1] = bfhi(x1[j]); b[2 * j] = bflo(x2[j]); b[2 * j + 1] = bfhi(x2[j]); }
#pragma unroll
    for (int j = 0; j < 8; ++j) { ra[j] = a[j] * c[j] - b[j] * s[j]; rb[j] = b[j] * c[j] + a[j] * s[j]; }
#pragma unroll
    for (int j = 0; j < 4; ++j) { o1[j] = pk2(ra[2 * j], ra[2 * j + 1]); o2[j] = pk2(rb[2 * j], rb[2 * j + 1]); }
#pragma unroll
    for (int j = 0; j < 8; ++j) { ra[j] *= fs; rb[j] *= fs; }
    e1.x = pg8::pk4_fp8(ra[0], ra[1], ra[2], ra[3]); e1.y = pg8::pk4_fp8(ra[4], ra[5], ra[6], ra[7]); e2.x = pg8::pk4_fp8(rb[0], rb[1], rb[2], rb[3]); e2.y = pg8::pk4_fp8(rb[4], rb[5], rb[6], rb[7]);
}
__device__ __forceinline__ int kpos8_of(int k) { return (((k >> 2) & 3) << 4) | ((k >> 4) << 2) | (k & 3); }
__device__ __forceinline__ void p2_prep(const Args& a, LAS unsigned char* lds, int wg, int G) {
    const int tid = threadIdx.x, lane = tid & 63, wave = __builtin_amdgcn_readfirstlane(tid >> 6), c = lane & 15, g = lane >> 4;
    unsigned char* ws = a.ws; const bf16* proj = (const bf16*)(ws + WS_PROJ);
    const float* COS = (const float*)(ws + WS_COS); const float* SIN = (const float*)(ws + WS_SIN);
    constexpr int NCU = 256, NPU = 512;
    for (int u = wg; u < NCU + NPU; u += G) {
        if (u < NCU) {
            const int kv = u >> 7, bg = (u >> 5) & 3, np = u & 31, b = bg >> 1, gk = bg & 1;
            const bf16* src = proj + (size_t)b * SEQ * NP1 + (kv ? COL_VCMP : COL_KCMP) + gk * 128 + 8 * g;
            const bf16* wt = (const bf16*)(ws + (kv ? WS_WCV : WS_WCK)) + (size_t)c * 4096 + 8 * g;
            f32x4 acc[2][8];
#pragma unroll
            for (int i = 0; i < 2; ++i)
#pragma unroll
                for (int e = 0; e < 8; ++e) acc[i][e] = (f32x4){0.f, 0.f, 0.f, 0.f};
#pragma unroll 4
            for (int kk0 = 0; kk0 < 16; ++kk0) { const int kk = (kk0 + (wg >> 3)) & 15, ks = 16 * wave + kk, l = ks >> 2, d0 = 32 * (ks & 3); bf16x8 af[2];
#pragma unroll
                for (int i = 0; i < 2; ++i) { int tok = 16 * (32 * np + 16 * i + c) + l; tok = tok < SEQ ? tok : SEQ - 1; af[i] = *(const bf16x8*)(src + (size_t)tok * NP1 + d0); }
#pragma unroll
                for (int e = 0; e < 8; ++e) { const bf16x8 bfr = *(const bf16x8*)(wt + (size_t)(16 * e) * 4096 + 32 * ks);
                    acc[0][e] = mfma16(af[0], bfr, acc[0][e]); acc[1][e] = mfma16(af[1], bfr, acc[1][e]); } }
            LAS float* red = (LAS float*)lds;
#pragma unroll
            for (int i = 0; i < 2; ++i)
#pragma unroll
                for (int e = 0; e < 8; ++e)
#pragma unroll
                    for (int ii = 0; ii < 4; ++ii) red[(((wave * 2 + i) * 8 + e) * 4 + ii) * 64 + lane] = acc[i][e][ii];
            __syncthreads();
            { const int ls = tid & 63, ii = (tid >> 6) & 3, i = tid >> 8, gs = ls >> 4, cs_ = ls & 15; float val[8];
#pragma unroll
              for (int e = 0; e < 8; ++e) { float v = 0.f;
#pragma unroll
                  for (int w = 0; w < 8; ++w) v += red[(((w * 2 + i) * 8 + e) * 4 + ii) * 64 + ls];
                  val[e] = v; }
              const float* ccp = (const float*)(ws + WS_CTL) + CW_CCONST + kv * 16 * 128; float cc[128 / 16 * 0 + 8];
#pragma unroll
              for (int e = 0; e < 8; ++e) { float t = 0.f;
#pragma unroll
                  for (int sl = 0; sl < 16; ++sl) t += ccp[sl * 128 + 16 * e + cs_];
                  cc[e] = t; }
              bf16* kc = (bf16*)(ws + WS_KC) + (size_t)bg * 1024 * 128; bf16* vct = (bf16*)(ws + WS_VCT) + (size_t)bg * 16 * 8192;
              const int n = 32 * np + 16 * i + 4 * gs + ii; const bool ok = n < 1023;
              if (kv == 0) { const int mt = b * SEQ + (ok ? 16 * n + 31 : 0);
#pragma unroll
                  for (int e = 0; e < 4; ++e) { const int f = 16 * e + cs_; const float x1 = val[e] + cc[e], x2 = val[e + 4] + cc[e + 4], cs = COS[(size_t)mt * 64 + f], sn = SIN[(size_t)mt * 64 + f];
                      kc[(size_t)n * 128 + f] = (bf16)f2bf(ok ? x1 * cs - x2 * sn : 0.f); kc[(size_t)n * 128 + f + 64] = (bf16)f2bf(ok ? x2 * cs + x1 * sn : 0.f); } }
              else {
#pragma unroll
                  for (int e = 0; e < 8; ++e) { const int f = 16 * e + cs_; vct[(size_t)(n >> 6) * 8192 + f * 64 + kpos_of(n & 63)] = (bf16)f2bf(ok ? val[e] + cc[e] : 0.f); } } }
            __syncthreads();
        } else {
            const int pu = u - NCU, b = pu >> 8, kb = pu & 255; const size_t m0 = (size_t)b * SEQ + 64 * kb;
#pragma unroll
            for (int bt = 0; bt < 2; ++bt) { v4u x1[4], x2[4]; f32x4 cs[4][2], sn[4][2];
#pragma unroll
                for (int k = 0; k < 4; ++k) { const int it = tid + NTHR * (4 * bt + k), tk = it >> 6, h = (it >> 3) & 7, ch = it & 7;
                    const bf16* p = proj + (m0 + tk) * NP1 + h * 128 + 8 * ch; x1[k] = *(const v4u*)p; x2[k] = *(const v4u*)(p + 64);
                    const float* cp = COS + (m0 + tk) * 64 + 8 * ch; const float* sp = SIN + (m0 + tk) * 64 + 8 * ch;
                    cs[k][0] = *(const f32x4*)cp; cs[k][1] = *(const f32x4*)(cp + 4); sn[k][0] = *(const f32x4*)sp; sn[k][1] = *(const f32x4*)(sp + 4); }
#pragma unroll
                for (int k = 0; k < 4; ++k) { const int it = tid + NTHR * (4 * bt + k), tk = it >> 6, h = (it >> 3) & 7, ch = it & 7; v4u o1, o2;
                    v2u e1, e2; rope8rf(x1[k], x2[k], cs[k][0], cs[k][1], sn[k][0], sn[k][1], o1, o2, e1, e2, 8.0f * C2); bf16* q = (bf16*)(ws + WS_QR) + (m0 + tk) * 1024 + h * 128 + 8 * ch; *(v4u*)q = o1; *(v4u*)(q + 64) = o2;
                    unsigned char* q8 = ws + WS_Q8 + (m0 + tk) * 1024 + h * 128 + 8 * ch; *(v2u*)q8 = e1; *(v2u*)(q8 + 64) = e2; } }
            { v4u x1[4], x2[4]; f32x4 cs[4][2], sn[4][2];
#pragma unroll
                for (int k = 0; k < 4; ++k) { const int it = tid + NTHR * k, tk = it >> 5, wh = (it >> 4) & 1, gk = (it >> 3) & 1, ch = it & 7;
                    const bf16* p = proj + (m0 + tk) * NP1 + (wh ? COL_KWIN : COL_KSEL) + gk * 128 + 8 * ch; x1[k] = *(const v4u*)p; x2[k] = *(const v4u*)(p + 64);
                    const float* cp = COS + (m0 + tk) * 64 + 8 * ch; const float* sp = SIN + (m0 + tk) * 64 + 8 * ch;
                    cs[k][0] = *(const f32x4*)cp; cs[k][1] = *(const f32x4*)(cp + 4); sn[k][0] = *(const f32x4*)sp; sn[k][1] = *(const f32x4*)(sp + 4); }
#pragma unroll
                for (int k = 0; k < 4; ++k) { const int it = tid + NTHR * k, tk = it >> 5, wh = (it >> 4) & 1, gk = (it >> 3) & 1, ch = it & 7; v4u o1, o2;
                    v2u e1, e2; rope8rf(x1[k], x2[k], cs[k][0], cs[k][1], sn[k][0], sn[k][1], o1, o2, e1, e2, 1.0f);
                    unsigned char* d = ws + (wh ? WS_KWIN : WS_KSEL) + ((size_t)(b * 2 + gk) * SEQ + 64 * kb + tk) * 128 + 8 * ch; *(v2u*)d = e1; *(v2u*)(d + 64) = e2; } }
            LAS unsigned char* T8 = lds;
            { v4u v[8];
#pragma unroll
                for (int k = 0; k < 8; ++k) { const int it = tid + NTHR * k, q = it >> 10, tk = (it >> 4) & 63, ch = it & 15, wh = q >> 1, gk = q & 1;
                    v[k] = *(const v4u*)(proj + (m0 + tk) * NP1 + (wh ? COL_VWIN : COL_VSEL) + gk * 128 + 8 * ch); }
#pragma unroll
                for (int k = 0; k < 8; ++k) { const int it = tid + NTHR * k, q = it >> 10, tk = (it >> 4) & 63, ch = it & 15;
                    LAS unsigned char* t = T8 + q * (128 * 80) + (8 * ch) * 80 + (kpos8_of(tk) ^ ((ch >> 1) << 3));
                    const unsigned w0 = pg8::pk4_fp8(bflo(v[k][0]), bfhi(v[k][0]), bflo(v[k][1]), bfhi(v[k][1])), w1 = pg8::pk4_fp8(bflo(v[k][2]), bfhi(v[k][2]), bflo(v[k][3]), bfhi(v[k][3]));
#pragma unroll
                    for (int j = 0; j < 4; ++j) { t[j * 80] = (unsigned char)(w0 >> (8 * j)); t[(4 + j) * 80] = (unsigned char)(w1 >> (8 * j)); } } }
            __syncthreads();
#pragma unroll
            for (int k = 0; k < 4; ++k) { const int it = tid + NTHR * k, q = it >> 9, d = (it >> 2) & 127, ch = it & 3, wh = q >> 1, gk = q & 1;
                const int sw = (d >> 4) & 7; v4u r = *(const LAS v4u*)(T8 + q * (128 * 80) + d * 80 + 16 * (ch ^ (sw >> 1))); if (sw & 1) r = (v4u){r.z, r.w, r.x, r.y};
                *(v4u*)(ws + (wh ? WS_VWINT : WS_VSELT) + ((size_t)(b * 2 + gk) * 256 + kb) * 8192 + d * 64 + 16 * ch) = r; }
            __syncthreads();
        }
    }
}

constexpr int KL_STRIDE = 272, VL_STRIDE = 144, KL_BYTES = 64 * KL_STRIDE, VL_BYTES = 128 * VL_STRIDE;
__device__ __forceinline__ void stage_load(const bf16* src, v4u (&r)[2]) {
#pragma unroll
    for (int i = 0; i < 2; ++i) r[i] = *(const v4u*)((const char*)src + (size_t)(threadIdx.x + 512 * i) * 16);
}
__device__ __forceinline__ void stage_write_k(LAS unsigned char* Kl, const v4u (&r)[2]) {
#pragma unroll
    for (int i = 0; i < 2; ++i) { const int id = threadIdx.x + 512 * i; *(LAS v4u*)(Kl + (id >> 4) * KL_STRIDE + (id & 15) * 16) = r[i]; }
}
__device__ __forceinline__ void stage_write_v(LAS unsigned char* Vl, const v4u (&r)[2]) {
#pragma unroll
    for (int i = 0; i < 2; ++i) { const int id = threadIdx.x + 512 * i; *(LAS v4u*)(Vl + (id >> 3) * VL_STRIDE + (id & 7) * 16) = r[i]; }
}
__device__ __forceinline__ void qk_tile(const LAS unsigned char* Kl, const bf16x8 (&qf)[4], f32x4 (&s)[4], int c, int g) {
#pragma unroll
    for (int kt = 0; kt < 4; ++kt) { s[kt] = (f32x4){0.f, 0.f, 0.f, 0.f};
#pragma unroll
        for (int ks = 0; ks < 4; ++ks) { const bf16x8 kf = *(const LAS bf16x8*)(Kl + (16 * kt + c) * KL_STRIDE + (32 * ks + 8 * g) * 2); s[kt] = mfma16(kf, qf[ks], s[kt]); } }
}
__device__ __forceinline__ void pv_tile(const LAS unsigned char* Vl, const f32x4 (&p)[4], f32x4 (&o)[8], int c, int g) {
#pragma unroll
    for (int s2 = 0; s2 < 2; ++s2) { const bf16x8 pf = pack8(p[2 * s2], p[2 * s2 + 1]);
#pragma unroll
        for (int dt = 0; dt < 8; ++dt) { const bf16x8 vf = *(const LAS bf16x8*)(Vl + (16 * dt + c) * VL_STRIDE + (32 * s2 + 8 * g) * 2); o[dt] = mfma16(vf, pf, o[dt]); } }
}
__device__ __forceinline__ void online_sm(f32x4 (&s)[4], float& m, float& l, float& alpha) {
    float tm = fmaxf(fmaxf(s[0][0], s[0][1]), fmaxf(s[0][2], s[0][3]));
#pragma unroll
    for (int kt = 1; kt < 4; ++kt) tm = fmaxf(tm, fmaxf(fmaxf(s[kt][0], s[kt][1]), fmaxf(s[kt][2], s[kt][3])));
    tm = fmaxf(tm, __shfl_xor(tm, 16)); tm = fmaxf(tm, __shfl_xor(tm, 32));
    const float mn = fmaxf(m, tm); alpha = __builtin_amdgcn_exp2f((m - mn) * C2); m = mn; float ls = 0.f;
#pragma unroll
    for (int kt = 0; kt < 4; ++kt)
#pragma unroll
        for (int i = 0; i < 4; ++i) { const float p = __builtin_amdgcn_exp2f((s[kt][i] - mn) * C2); s[kt][i] = p; ls += p; }
    l = l * alpha + ls;
}
__device__ __forceinline__ void load_qf(const bf16* qr, size_t mrow, int head, int g, bf16x8 (&qf)[4]) {
#pragma unroll
    for (int ks = 0; ks < 4; ++ks) qf[ks] = *(const bf16x8*)(qr + mrow * 1024 + head * 128 + 32 * ks + 8 * g);
}
__device__ __forceinline__ void pin_qf(bf16x8 (&qf)[2][4]) {
#pragma unroll
    for (int cs = 0; cs < 2; ++cs)
#pragma unroll
        for (int ks = 0; ks < 4; ++ks) asm volatile("" : "+v"(qf[cs][ks]));
}
__device__ __forceinline__ void store_o(bf16* O, size_t mrow, int head, int g, const f32x4 (&o)[8], float inv) {
    bf16* rowp = O + mrow * 1024 + head * 128 + 16 * (g & 1) + 8 * (g >> 1);
#pragma unroll
    for (int k = 0; k < 8; k += 2) { unsigned ax = pk2(o[k][0] * inv, o[k][1] * inv), ay = pk2(o[k][2] * inv, o[k][3] * inv), bx = pk2(o[k + 1][0] * inv, o[k + 1][1] * inv), by = pk2(o[k + 1][2] * inv, o[k + 1][3] * inv);
        auto rx = __builtin_amdgcn_permlane16_swap(ax, bx, false, false); unsigned ax2 = rx[0], bx2 = rx[1]; asm volatile("" : "+v"(ax2), "+v"(bx2));
        auto ry = __builtin_amdgcn_permlane16_swap(ay, by, false, false); unsigned ay2 = ry[0], by2 = ry[1]; asm volatile("" : "+v"(ay2), "+v"(by2));
        *(v4u*)(rowp + 16 * k) = (v4u){ax2, ay2, bx2, by2}; }
}
__device__ __forceinline__ void unit_bq(int u, int& bg, int& qt) { bg = u >> 8; const int x = u & 255; qt = (bg & 1) ? 255 - x : x; }


constexpr int SLOT_BYTES = 32768, TMK_OFF = 132096;
#define WAITV(n) asm volatile("s_waitcnt vmcnt(" #n ")" ::: "memory")
#define RAWBAR() do { asm volatile("" ::: "memory"); __builtin_amdgcn_s_barrier(); asm volatile("" ::: "memory"); } while (0)
__device__ __forceinline__ void dma_k(LAS unsigned char* slot, const bf16* ksrc, int wave, int lane) {
#pragma unroll
    for (int r = 0; r < 2; ++r) { const int row = 4 * wave + (lane >> 4) + 32 * r, pos = lane & 15;
        __builtin_amdgcn_global_load_lds((const unsigned*)(ksrc + row * 128 + ((pos ^ (row & 15)) * 8)), (LAS unsigned*)(slot + wave * 1024 + r * 8192), 16, 0, 0); }
}
__device__ __forceinline__ void dma_v(LAS unsigned char* slot, const bf16* vsrc, int wave, int lane) {
#pragma unroll
    for (int r = 0; r < 2; ++r) { const int d = 8 * wave + (lane >> 3) + 64 * r, pos = lane & 7;
        __builtin_amdgcn_global_load_lds((const unsigned*)(vsrc + d * 64 + ((pos ^ ((d >> 1) & 7)) * 8)), (LAS unsigned*)(slot + 16384 + wave * 1024 + r * 8192), 16, 0, 0); }
}
__device__ __forceinline__ void qk_tile_sw(const LAS unsigned char* slot, const bf16x8 (&qf)[4], f32x4 (&s)[4], const int (&kx)[4]) {
#pragma unroll
    for (int kt = 0; kt < 4; ++kt) { s[kt] = (f32x4){0.f, 0.f, 0.f, 0.f};
#pragma unroll
        for (int ks = 0; ks < 4; ++ks) { const bf16x8 kf = *(const LAS bf16x8*)(slot + kt * 4096 + kx[ks]); s[kt] = mfma16(kf, qf[ks], s[kt]); } }
}
__device__ __forceinline__ void pv_tile_sw(const LAS unsigned char* slot, const f32x4 (&p)[4], f32x4 (&o)[8], const int (&vx)[2]) {
#pragma unroll
    for (int s2 = 0; s2 < 2; ++s2) { const bf16x8 pf = pack8(p[2 * s2], p[2 * s2 + 1]);
#pragma unroll
        for (int dt = 0; dt < 8; ++dt) { const bf16x8 vf = *(const LAS bf16x8*)(slot + 16384 + dt * 2048 + vx[s2]); o[dt] = mfma16(vf, pf, o[dt]); } }
}
__device__ __forceinline__ float lmax16(float x) { const unsigned u = __builtin_bit_cast(unsigned, x); auto r = __builtin_amdgcn_permlane16_swap(u, u, false, false); unsigned r0 = r[0], r1 = r[1]; asm volatile("" : "+v"(r1)); return fmaxf(__builtin_bit_cast(float, r0), __builtin_bit_cast(float, r1)); }
__device__ __forceinline__ float lmax32(float x) { const unsigned u = __builtin_bit_cast(unsigned, x); auto r = __builtin_amdgcn_permlane32_swap(u, u, false, false); unsigned r0 = r[0], r1 = r[1]; asm volatile("" : "+v"(r1)); return fmaxf(__builtin_bit_cast(float, r0), __builtin_bit_cast(float, r1)); }
__device__ __forceinline__ float ladd16(float x) { const unsigned u = __builtin_bit_cast(unsigned, x); auto r = __builtin_amdgcn_permlane16_swap(u, u, false, false); unsigned r0 = r[0], r1 = r[1]; asm volatile("" : "+v"(r1)); return __builtin_bit_cast(float, r0) + __builtin_bit_cast(float, r1); }
__device__ __forceinline__ float ladd32(float x) { const unsigned u = __builtin_bit_cast(unsigned, x); auto r = __builtin_amdgcn_permlane32_swap(u, u, false, false); unsigned r0 = r[0], r1 = r[1]; asm volatile("" : "+v"(r1)); return __builtin_bit_cast(float, r0) + __builtin_bit_cast(float, r1); }
__device__ __forceinline__ void online_sm2(f32x4 (&s)[4], float& m, float& l, float& alpha) {
    float tm = fmaxf(fmaxf(s[0][0], s[0][1]), fmaxf(s[0][2], s[0][3]));
#pragma unroll
    for (int kt = 1; kt < 4; ++kt) tm = fmaxf(tm, fmaxf(fmaxf(s[kt][0], s[kt][1]), fmaxf(s[kt][2], s[kt][3])));
    tm = lmax16(tm); tm = lmax32(tm);
    const float mn = fmaxf(m, tm); alpha = __builtin_amdgcn_exp2f((m - mn) * C2); m = mn; float ls = 0.f;
#pragma unroll
    for (int kt = 0; kt < 4; ++kt)
#pragma unroll
        for (int i = 0; i < 4; ++i) { const float p = __builtin_amdgcn_exp2f((s[kt][i] - mn) * C2); s[kt][i] = p; ls += p; }
    l = l * alpha + ls;
}

__device__ __forceinline__ void qk2(const LAS unsigned char* slot, const bf16x8 (&qf)[2][4], f32x4 (&s)[2][4], const int (&kx)[4]) {
    bf16x8 kf[4][4];
#pragma unroll
    for (int kt = 0; kt < 4; ++kt)
#pragma unroll
        for (int ks = 0; ks < 4; ++ks) kf[kt][ks] = *(const LAS bf16x8*)(slot + kt * 4096 + kx[ks]);
    __builtin_amdgcn_sched_barrier(0);
#pragma unroll
    for (int kt = 0; kt < 4; ++kt) { s[0][kt] = (f32x4){0.f, 0.f, 0.f, 0.f}; s[1][kt] = (f32x4){0.f, 0.f, 0.f, 0.f};
#pragma unroll
        for (int ks = 0; ks < 4; ++ks) { s[0][kt] = mfma16(kf[kt][ks], qf[0][ks], s[0][kt]); s[1][kt] = mfma16(kf[kt][ks], qf[1][ks], s[1][kt]); } }
}
__device__ __forceinline__ void pv2(const LAS unsigned char* slot, const f32x4 (&p)[2][4], f32x4 (&o)[2][8], const int (&vx)[2]) {
#pragma unroll
    for (int s2 = 0; s2 < 2; ++s2) { const bf16x8 pf0 = pack8(p[0][2 * s2], p[0][2 * s2 + 1]), pf1 = pack8(p[1][2 * s2], p[1][2 * s2 + 1]);
#pragma unroll
        for (int dt = 0; dt < 8; ++dt) { const bf16x8 vf = *(const LAS bf16x8*)(slot + 16384 + dt * 2048 + vx[s2]); o[0][dt] = mfma16(vf, pf0, o[0][dt]); o[1][dt] = mfma16(vf, pf1, o[1][dt]); } }
}
__device__ __forceinline__ void pv2l(const LAS unsigned char* slot, const f32x4 (&p)[2][4], f32x4 (&o)[2][8], f32x4 (&lacc)[2], const int (&vx)[2]) {
    const bf16x8 ones8 = __builtin_bit_cast(bf16x8, (v4u){0x3f803f80u, 0x3f803f80u, 0x3f803f80u, 0x3f803f80u});
#pragma unroll
    for (int s2 = 0; s2 < 2; ++s2) { const bf16x8 pf0 = pack8(p[0][2 * s2], p[0][2 * s2 + 1]), pf1 = pack8(p[1][2 * s2], p[1][2 * s2 + 1]);
        lacc[0] = mfma16(ones8, pf0, lacc[0]); lacc[1] = mfma16(ones8, pf1, lacc[1]);
#pragma unroll
        for (int dt = 0; dt < 8; ++dt) { const bf16x8 vf = *(const LAS bf16x8*)(slot + 16384 + dt * 2048 + vx[s2]); o[0][dt] = mfma16(vf, pf0, o[0][dt]); o[1][dt] = mfma16(vf, pf1, o[1][dt]); } }
}
__device__ __forceinline__ float quad_sum(float x) {
    const float y = x + __builtin_bit_cast(float, __builtin_amdgcn_mov_dpp(__builtin_bit_cast(int, x), 0xB1, 0xf, 0xf, true));
    return y + __builtin_bit_cast(float, __builtin_amdgcn_mov_dpp(__builtin_bit_cast(int, y), 0x4E, 0xf, 0xf, true));
}
template <bool HAS_O> __device__ __forceinline__ void sm_lean(f32x4 (&s)[4], float& m, float& l, f32x4 (&o)[8], bool rowok) {
    float tm = fmaxf(fmaxf(s[0][0], s[0][1]), fmaxf(s[0][2], s[0][3]));
#pragma unroll
    for (int kt = 1; kt < 4; ++kt) tm = fmaxf(tm, fmaxf(fmaxf(s[kt][0], s[kt][1]), fmaxf(s[kt][2], s[kt][3])));
    tm = lmax16(tm); tm = lmax32(tm);
    tm = rowok ? tm : -__builtin_inff();
    const float mn = fmaxf(m, tm), alpha = __builtin_amdgcn_exp2f((m - mn) * C2); m = mn;
    const float mb = rowok ? mn * C2 : __builtin_inff(); float ls = 0.f;
#pragma unroll
    for (int kt = 0; kt < 4; ++kt)
#pragma unroll
        for (int i = 0; i < 4; ++i) { const float p = __builtin_amdgcn_exp2f(__builtin_fmaf(s[kt][i], C2, -mb)); s[kt][i] = p; ls += p; }
    l = l * alpha + ls;
    if (HAS_O) { if (!__all(alpha == 1.0f)) {
#pragma unroll
        for (int dt = 0; dt < 8; ++dt) o[dt] = o[dt] * alpha; } }
}
__device__ __forceinline__ float row16_sum(float x) {
    x = quad_sum(x);
    x += __builtin_bit_cast(float, __builtin_amdgcn_mov_dpp(__builtin_bit_cast(int, x), 0x141, 0xf, 0xf, true));
    x += __builtin_bit_cast(float, __builtin_amdgcn_mov_dpp(__builtin_bit_cast(int, x), 0x140, 0xf, 0xf, true));
    return x;
}
__device__ __forceinline__ float wave_sum_v(float x) { return ladd32(ladd16(row16_sum(x))); }
__device__ __forceinline__ float amax3(float a, float b, float c) { float r; asm("v_max3_f32 %0, %1, %2, %3" : "=v"(r) : "v"(a), "v"(b), "v"(c)); return r; }
__device__ __forceinline__ float amax2(float a, float b) { float r; asm("v_max_f32 %0, %1, %2" : "=v"(r) : "v"(a), "v"(b)); return r; }
__device__ __forceinline__ float xmax16(float x) { const unsigned u = __builtin_bit_cast(unsigned, x); auto r = __builtin_amdgcn_permlane16_swap(u, u, false, false); unsigned r0 = r[0], r1 = r[1]; asm volatile("" : "+v"(r1)); return amax2(__builtin_bit_cast(float, r0), __builtin_bit_cast(float, r1)); }
__device__ __forceinline__ float xmax32(float x) { const unsigned u = __builtin_bit_cast(unsigned, x); auto r = __builtin_amdgcn_permlane32_swap(u, u, false, false); unsigned r0 = r[0], r1 = r[1]; asm volatile("" : "+v"(r1)); return amax2(__builtin_bit_cast(float, r0), __builtin_bit_cast(float, r1)); }
constexpr float SM_THR = 10.0f;
__device__ __forceinline__ void sm_fast(f32x4 (&s)[4], float& m, f32x4& lacc, f32x4 (&o)[8], bool rowok) {
    float tm = amax3(amax3(s[0][0], s[0][1], s[0][2]), amax3(s[0][3], s[1][0], s[1][1]), amax3(s[1][2], s[1][3], s[2][0]));
    tm = amax3(tm, amax3(s[2][1], s[2][2], s[2][3]), amax3(s[3][0], s[3][1], s[3][2])); tm = amax2(tm, s[3][3]);
    tm = xmax16(tm); tm = xmax32(tm);
    tm = rowok ? tm : -__builtin_inff();
    if (__any((tm - m) * C2 > SM_THR)) { const float mn = amax2(m, tm), alpha = __builtin_amdgcn_exp2f((m - mn) * C2); m = mn; lacc = lacc * alpha;
#pragma unroll
        for (int dt = 0; dt < 8; ++dt) o[dt] = o[dt] * alpha; }
    const float mb = rowok ? m * C2 : __builtin_inff();
#pragma unroll
    for (int kt = 0; kt < 4; ++kt)
#pragma unroll
        for (int i = 0; i < 4; ++i) s[kt][i] = __builtin_amdgcn_exp2f(__builtin_fmaf(s[kt][i], C2, -mb));
}
#define SWZ_OFFSETS() int kx[4], vx[2]; \
    _Pragma("unroll") for (int ks_ = 0; ks_ < 4; ++ks_) kx[ks_] = c * 256 + ((((g ^ c) & 15) << 4) ^ (ks_ << 6)); \
    _Pragma("unroll") for (int s2_ = 0; s2_ < 2; ++s2_) vx[s2_] = c * 128 + ((((g ^ (c >> 1)) & 7) << 4) ^ (s2_ << 6))

__device__ __forceinline__ void unit_sel(int wg, int r, int G, int& bg, int& qt) {
    if (G == 256) { const int x = wg & 7, i = wg >> 3, k = (r & 1) ? (96 - 32 * r + i) : (127 - 32 * r - i); bg = x >> 1; qt = (x & 1) + 2 * k; }
    else unit_bq(wg + r * G, bg, qt);
}

using pg8::v8i32; using pg8::f32x2;
constexpr int TOPK_LSB = 10; constexpr unsigned TOPK_LOWMASK = (1u << TOPK_LSB) - 1u;
constexpr int IMP_OFF = 65536;
static_assert(IMP_OFF + 64 * 260 * 4 <= TMK_OFF && TMK_OFF + 2048 <= MISC_OFF, "cmp LDS map");
template <int CM  > __device__ __forceinline__ void p3_cmp(const Args& a, LAS unsigned char* lds, int wg, int G) {
    const int tid = threadIdx.x, lane = tid & 63, wave = __builtin_amdgcn_readfirstlane(tid >> 6), c = lane & 15, g = lane >> 4;
    unsigned char* ws = a.ws; const bf16* qr = (const bf16*)(ws + WS_QR); bf16* OC = (bf16*)(ws + WS_OC);
    LAS float* imp = (LAS float*)(lds + IMP_OFF); LAS unsigned* tmk = (LAS unsigned*)(lds + TMK_OFF);
    SWZ_OFFSETS();
    bool pref = false;
    for (int u = wg; u < 1024; u += G) { const bool had = pref;
        int bg, qt; unit_bq(u, bg, qt); const int b = bg >> 1, gk = bg & 1, t0 = 64 * qt;
        const bf16* kc = (const bf16*)(ws + WS_KC) + (size_t)bg * 1024 * 128; const bf16* vct = (const bf16*)(ws + WS_VCT) + (size_t)bg * 16 * 8192;
        const int ntile = (4 * qt + 66) >> 6;
        __syncthreads();
        tmk[tid] = 0u;
        bf16x8 qf[2][4]; int nmax[2]; float m[2]; f32x2 lp[2];
#pragma unroll
        for (int cs = 0; cs < 2; ++cs) { const int ql = 8 * wave + 4 * cs + (c >> 2), t = t0 + ql; load_qf(qr, (size_t)b * SEQ + t, 4 * gk + (c & 3), g, qf[cs]);
            nmax[cs] = t >= 31 ? (t - 31) >> 4 : -1; m[cs] = -1e30f; lp[cs] = (f32x2){0.f, 0.f}; }
        pin_qf(qf);
        __syncthreads();
        if (CM != 2 && !had) dma_k(lds, kc, wave, lane);
        for (int i = 0; i < (CM == 2 ? 0 : ntile); ++i) {
            WAITV(0); RAWBAR();
            if (i + 1 < ntile) dma_k(lds + ((i + 1) & 1) * SLOT_BYTES, kc + (size_t)(i + 1) * 64 * 128, wave, lane);
            const LAS unsigned char* slot = lds + (i & 1) * SLOT_BYTES;
            bf16x8 kf[4][4];
#pragma unroll
            for (int kt = 0; kt < 4; ++kt)
#pragma unroll
                for (int ks = 0; ks < 4; ++ks) kf[kt][ks] = *(const LAS bf16x8*)(slot + kt * 4096 + kx[ks]);
            __builtin_amdgcn_sched_barrier(0);
            f32x4 s0[4], s1[4];
#pragma unroll
            for (int kt = 0; kt < 4; ++kt) { s0[kt] = (f32x4){0.f, 0.f, 0.f, 0.f};
#pragma unroll
                for (int ks = 0; ks < 4; ++ks) s0[kt] = mfma16(kf[kt][ks], qf[0][ks], s0[kt]); }
            __builtin_amdgcn_sched_barrier(0);
            const bool bnd1 = 64 * i + 63 > 4 * qt - 2;
#define CMP_QK1(kt_) do { s1[kt_] = (f32x4){0.f, 0.f, 0.f, 0.f}; _Pragma("unroll") for (int ks_ = 0; ks_ < 4; ++ks_) s1[kt_] = mfma16(kf[kt_][ks_], qf[1][ks_], s1[kt_]); } while (0)
#define CMP_MASK(S, CS) do { if (bnd1) { _Pragma("unroll") for (int kt_ = 0; kt_ < 4; ++kt_) _Pragma("unroll") for (int ii_ = 0; ii_ < 4; ++ii_) { const int n_ = 64 * i + 16 * kt_ + 4 * g + ii_; S[kt_][ii_] = n_ <= nmax[CS] ? S[kt_][ii_] : -__builtin_inff(); } } } while (0)
#define CMP_MAXCHK(S, CS) do { float tm_ = fmaxf(fmaxf(fmaxf(S[0][0], S[0][1]), fmaxf(S[0][2], S[0][3])), fmaxf(fmaxf(S[1][0], S[1][1]), fmaxf(S[1][2], S[1][3]))); \
        tm_ = fmaxf(tm_, fmaxf(fmaxf(fmaxf(S[2][0], S[2][1]), fmaxf(S[2][2], S[2][3])), fmaxf(fmaxf(S[3][0], S[3][1]), fmaxf(S[3][2], S[3][3])))); \
        if (__any((tm_ - m[CS]) * C2 > 8.0f)) { tm_ = lmax32(lmax16(tm_)); const float mn_ = fmaxf(m[CS], tm_), al_ = __builtin_amdgcn_exp2f((m[CS] - mn_) * C2); m[CS] = mn_; lp[CS] = lp[CS] * al_; } } while (0)
#define CMP_EXPSUM(S, CS, kt_) do { const float mbv_ = m[CS] * C2; _Pragma("unroll") for (int ii_ = 0; ii_ < 4; ++ii_) S[kt_][ii_] = __builtin_amdgcn_exp2f(__builtin_fmaf(S[kt_][ii_], C2, -mbv_)); \
        lp[CS] += (f32x2){S[kt_][0], S[kt_][1]}; lp[CS] += (f32x2){S[kt_][2], S[kt_][3]}; } while (0)
            CMP_QK1(0); CMP_MASK(s0, 0); CMP_MAXCHK(s0, 0); __builtin_amdgcn_sched_barrier(0);
            CMP_QK1(1); CMP_EXPSUM(s0, 0, 0); CMP_EXPSUM(s0, 0, 1); __builtin_amdgcn_sched_barrier(0);
            CMP_QK1(2); CMP_EXPSUM(s0, 0, 2); __builtin_amdgcn_sched_barrier(0);
            CMP_QK1(3); CMP_EXPSUM(s0, 0, 3); __builtin_amdgcn_sched_barrier(0);
            CMP_MASK(s1, 1); CMP_MAXCHK(s1, 1);
#pragma unroll
            for (int kt = 0; kt < 4; ++kt) CMP_EXPSUM(s1, 1, kt);
        }
        float mb[2];
#pragma unroll
        for (int cs = 0; cs < 2; ++cs) { float lt = lp[cs].x + lp[cs].y; lt = ladd16(lt); lt = ladd32(lt); mb[cs] = lt > 0.f ? m[cs] * C2 + __builtin_amdgcn_logf(lt) : __builtin_inff(); }
        __syncthreads();
        f32x4 o[2][8];
#pragma unroll
        for (int cs = 0; cs < 2; ++cs)
#pragma unroll
            for (int dt = 0; dt < 8; ++dt) o[cs][dt] = (f32x4){0.f, 0.f, 0.f, 0.f};
        float wrap[2] = {0.f, 0.f};
        if (CM < 2) { dma_k(lds, kc, wave, lane); dma_v(lds, vct, wave, lane); }
        for (int i = 0; i < (CM >= 2 ? 0 : ntile); ++i) {
            WAITV(0); RAWBAR();
            if (i + 1 < ntile) { LAS unsigned char* sl = lds + ((i + 1) & 1) * SLOT_BYTES; dma_k(sl, kc + (size_t)(i + 1) * 64 * 128, wave, lane); dma_v(sl, vct + (size_t)(i + 1) * 8192, wave, lane); }
            const LAS unsigned char* slot = lds + (i & 1) * SLOT_BYTES;
            const bool bnd = 64 * i + 63 > 4 * qt - 2;
            f32x4 s0[4], s1[4];
            { bf16x8 kf[4][4];
#pragma unroll
              for (int kt = 0; kt < 4; ++kt)
#pragma unroll
                  for (int ks = 0; ks < 4; ++ks) kf[kt][ks] = *(const LAS bf16x8*)(slot + kt * 4096 + kx[ks]);
              __builtin_amdgcn_sched_barrier(0);
#pragma unroll
              for (int kt = 0; kt < 4; ++kt) { s0[kt] = (f32x4){0.f, 0.f, 0.f, 0.f};
#pragma unroll
                  for (int ks = 0; ks < 4; ++ks) s0[kt] = mfma16(kf[kt][ks], qf[0][ks], s0[kt]); }
              __builtin_amdgcn_sched_barrier(0);
#define CMP_PIMP(S, CS, kt_) do { const int ql_ = 8 * wave + 4 * CS + (c >> 2); \
        _Pragma("unroll") for (int ii_ = 0; ii_ < 4; ++ii_) { const int n_ = 64 * i + 16 * kt_ + 4 * g + ii_; const float p_ = __builtin_amdgcn_exp2f(__builtin_fmaf(S[kt_][ii_], C2, -mb[CS])); S[kt_][ii_] = (!bnd || n_ <= nmax[CS]) ? p_ : 0.f; } \
        const float s4_ = quad_sum((S[kt_][0] + S[kt_][1]) + (S[kt_][2] + S[kt_][3])), p3_ = quad_sum(S[kt_][3]); \
        const float up_ = __shfl(p3_, (lane + 48) & 63); const float cin_ = g > 0 ? up_ : wrap[CS]; wrap[CS] = up_; \
        if ((c & 3) == 0) imp[ql_ * 260 + 16 * i + 4 * kt_ + g] = s4_ + cin_; } while (0)
#define CMP_QK1B(kt_) do { s1[kt_] = (f32x4){0.f, 0.f, 0.f, 0.f}; _Pragma("unroll") for (int ks_ = 0; ks_ < 4; ++ks_) s1[kt_] = mfma16(kf[kt_][ks_], qf[1][ks_], s1[kt_]); } while (0)
              CMP_QK1B(0); CMP_PIMP(s0, 0, 0); __builtin_amdgcn_sched_barrier(0);
              CMP_QK1B(1); CMP_PIMP(s0, 0, 1); __builtin_amdgcn_sched_barrier(0);
              CMP_QK1B(2); CMP_PIMP(s0, 0, 2); __builtin_amdgcn_sched_barrier(0);
              CMP_QK1B(3); CMP_PIMP(s0, 0, 3); __builtin_amdgcn_sched_barrier(0); }
            { const bf16x8 pa = pack8(s0[0], s0[1]), pb = pack8(s0[2], s0[3]); bf16x8 vf[8];
#pragma unroll
              for (int dt = 0; dt < 8; ++dt) vf[dt] = *(const LAS bf16x8*)(slot + 16384 + dt * 2048 + vx[0]);
              __builtin_amdgcn_sched_barrier(0);
#pragma unroll
              for (int dt = 0; dt < 4; ++dt) o[0][dt] = mfma16(vf[dt], pa, o[0][dt]);
              CMP_PIMP(s1, 1, 0); __builtin_amdgcn_sched_barrier(0);
#pragma unroll
              for (int dt = 4; dt < 8; ++dt) o[0][dt] = mfma16(vf[dt], pa, o[0][dt]);
              CMP_PIMP(s1, 1, 1); __builtin_amdgcn_sched_barrier(0);
#pragma unroll
              for (int dt = 0; dt < 8; ++dt) vf[dt] = *(const LAS bf16x8*)(slot + 16384 + dt * 2048 + vx[1]);
              __builtin_amdgcn_sched_barrier(0);
#pragma unroll
              for (int dt = 0; dt < 4; ++dt) o[0][dt] = mfma16(vf[dt], pb, o[0][dt]);
              CMP_PIMP(s1, 1, 2); __builtin_amdgcn_sched_barrier(0);
#pragma unroll
              for (int dt = 4; dt < 8; ++dt) o[0][dt] = mfma16(vf[dt], pb, o[0][dt]);
              CMP_PIMP(s1, 1, 3); __builtin_amdgcn_sched_barrier(0);
              const bf16x8 qa = pack8(s1[0], s1[1]), qb = pack8(s1[2], s1[3]);
#pragma unroll
              for (int dt = 0; dt < 8; ++dt) o[1][dt] = mfma16(vf[dt], qb, o[1][dt]);
              __builtin_amdgcn_sched_barrier(0);
#pragma unroll
              for (int dt = 0; dt < 8; ++dt) vf[dt] = *(const LAS bf16x8*)(slot + 16384 + dt * 2048 + vx[0]);
#pragma unroll
              for (int dt = 0; dt < 8; ++dt) o[1][dt] = mfma16(vf[dt], qa, o[1][dt]); }
        }
#pragma unroll
        for (int cs = 0; cs < 2; ++cs) { const int ql = 8 * wave + 4 * cs + (c >> 2); store_o(OC, (size_t)b * SEQ + t0 + ql, 4 * gk + (c & 3), g, o[cs], 1.0f); }
        __syncthreads();
        pref = false;
        if (CM == 0 && u + G < 1024) { int bgn, qtn; unit_bq(u + G, bgn, qtn);
            dma_k(lds, (const bf16*)(ws + WS_KC) + (size_t)bgn * 1024 * 128, wave, lane); pref = true; }
        const int cur = qt;
        for (int q0 = 0; q0 < ((CM == 1 || CM == 3) ? 0 : 8); q0 += 4) { unsigned key[4][4], prefix[4] = {0u, 0u, 0u, 0u};
#pragma unroll
            for (int u4 = 0; u4 < 4; ++u4) { const int ql = 8 * wave + q0 + u4;
#pragma unroll
                for (int k = 0; k < 4; ++k) { const int j = 64 * k + lane; const bool forced = (j == 0) | (j == cur) | (j == cur - 1);
                    key[u4][k] = forced ? 0xffffffffu : (j <= cur ? __builtin_bit_cast(unsigned, imp[ql * 260 + j]) + 1u : 0u); } }
            const int nk = (cur >> 6) + 1;
#define TOPK_SEARCH(NK) for (int bit = 30; bit >= TOPK_LSB; --bit) { \
                _Pragma("unroll") for (int u4 = 0; u4 < 4; ++u4) { const unsigned trial = prefix[u4] | (1u << bit); int cnt = 0; \
                    _Pragma("unroll") for (int k = 0; k < NK; ++k) cnt += __popcll(__ballot(key[u4][k] >= trial)); \
                    if (cnt >= 16) prefix[u4] = trial; } }
            if (nk == 1) { TOPK_SEARCH(1) } else if (nk == 2) { TOPK_SEARCH(2) } else if (nk == 3) { TOPK_SEARCH(3) } else { TOPK_SEARCH(4) }
#undef TOPK_SEARCH
#pragma unroll
            for (int u4 = 0; u4 < 4; ++u4) { const int ql = 8 * wave + q0 + u4; int cgt = 0; const unsigned hi = prefix[u4] | TOPK_LOWMASK;
#pragma unroll
                for (int k = 0; k < 4; ++k) cgt += __popcll(__ballot(key[u4][k] > hi));
                int need = 16 - cgt, before = 0;
#pragma unroll
                for (int k = 0; k < 4; ++k) { const bool ineq = key[u4][k] >= prefix[u4] && key[u4][k] <= hi; const unsigned long long eq = __ballot(ineq); const int rank = before + __popcll(eq & ((1ull << lane) - 1ull)); before += __popcll(eq);
                    const bool sel = (key[u4][k] > hi) || (ineq && rank < need); const int j = 64 * k + lane;
                    if (sel && j <= cur) __hip_atomic_fetch_or(tmk + 2 * j + (ql >> 5), 1u << (ql & 31), __ATOMIC_RELAXED, __HIP_MEMORY_SCOPE_WORKGROUP); } }
        }
        __syncthreads();
        if (tid < 256) { v2u w; w.x = tmk[2 * tid]; w.y = tmk[2 * tid + 1]; *((v2u*)(ws + WS_TMASK) + ((size_t)(bg * 256 + qt) * 256 + tid)) = w; }
    }
}

constexpr int SLOT8 = 16384, SELB = 4;
static_assert(2 * SELB * SLOT8 <= TMK_OFF, "sel ring");
constexpr float SM_THR8 = 8.0f;
__device__ __forceinline__ void dma_k8(LAS unsigned char* slot, const unsigned char* ksrc, int wave, int lane) {
    const unsigned row = 8u * wave + (lane >> 3), pos = lane & 7, off = row * 128u + ((pos ^ ((row ^ (row >> 1)) & 7u)) * 16u);
    __builtin_amdgcn_global_load_lds((const unsigned*)(ksrc + off), (LAS unsigned*)(slot + wave * 1024), 16, 0, 0);
}
__device__ __forceinline__ void dma_v8(LAS unsigned char* slot, const unsigned char* vsrc, int wave, int lane) {
    const unsigned d = 16u * wave + (lane >> 2), pos = lane & 3, off = d * 64u + ((pos ^ (((d >> 2) & 1u) << 1)) * 16u);
    __builtin_amdgcn_global_load_lds((const unsigned*)(vsrc + off), (LAS unsigned*)(slot + 8192 + wave * 1024), 16, 0, 0);
}
#define MFMA8_B(acc, A, B) acc = __builtin_amdgcn_mfma_scale_f32_16x16x128_f8f6f4(A, B, acc, 0, 0, 0, 0x7f7f7f7f, 0, 0x7f7f7f7f)
#define SEL_GAP() __builtin_amdgcn_sched_barrier(0)
#define MFMA8_ACC(acc, A, B) asm volatile("v_mfma_scale_f32_16x16x128_f8f6f4 %0, %1, %2, %0, %3, %3 op_sel_hi:[0,0,0]" : "+v"(acc) : "v"(A), "v"(B), "v"(0x7f7f7f7f))
__device__ __forceinline__ float max16(const f32x4 (&s)[4]) {
    float t0, t1, t2;
    asm("v_max3_f32 %0, %3, %4, %5\n v_max3_f32 %1, %6, %7, %8\n v_max3_f32 %2, %9, %10, %11\n v_max3_f32 %0, %0, %1, %2\n v_max3_f32 %1, %12, %13, %14\n v_max3_f32 %2, %15, %16, %17\n v_max3_f32 %0, %0, %1, %2\n v_max_f32 %0, %0, %18"
        : "=&v"(t0), "=&v"(t1), "=&v"(t2)
        : "v"(s[0][0]), "v"(s[0][1]), "v"(s[0][2]), "v"(s[0][3]), "v"(s[1][0]), "v"(s[1][1]), "v"(s[1][2]), "v"(s[1][3]), "v"(s[2][0]), "v"(s[2][1]), "v"(s[2][2]), "v"(s[2][3]), "v"(s[3][0]), "v"(s[3][1]), "v"(s[3][2]), "v"(s[3][3]));
    return t0;
}
template <int MODE  > __device__ __forceinline__ void p4_sel(const Args& a, LAS unsigned char* lds, int wg, int G) {
    const int tid = threadIdx.x, lane = tid & 63, wave = __builtin_amdgcn_readfirstlane(tid >> 6), c = lane & 15, g = lane >> 4;
    unsigned char* ws = a.ws; const unsigned char* q8 = ws + WS_Q8; bf16* OS = (bf16*)(ws + WS_OS);
    LAS unsigned* tmk = (LAS unsigned*)(lds + TMK_OFF);
    const int ky = (c ^ (c >> 1)) & 7, kxa = c * 128 + (((2 * g) ^ ky) << 4), kxb = c * 128 + (((2 * g + 1) ^ ky) << 4), vxo = c * 64 + ((g ^ (((c >> 2) & 1) << 1)) << 4);
    const float NINF = -__builtin_inff();
    for (int r = 0; r * G + wg < 1024; ++r) {
        int bg, qt; unit_sel(wg, r, G, bg, qt); const int b = bg >> 1, gk = bg & 1, t0 = 64 * qt, cur = qt;
        const unsigned char* ks = ws + WS_KSEL + (size_t)bg * SEQ * 128; const unsigned char* vst = ws + WS_VSELT + (size_t)bg * 256 * 8192;
        __syncthreads();
        tmk[tid] = *((const unsigned*)(ws + WS_TMASK) + ((size_t)(bg * 256 + qt) * 512 + tid));
        v8i32 qf[2]; float nmb[2], thr[2]; f32x2 lsum[2]; f32x4 o[2][8]; int tq[2];
        v8i32 pLo = {0, 0, 0, 0, 0, 0, 0, 0}, pHi = {0, 0, 0, 0, 0, 0, 0, 0}; asm volatile("" : "+v"(pLo), "+v"(pHi));
#pragma unroll
        for (int cs = 0; cs < 2; ++cs) { const int ql = 8 * wave + 4 * cs + (c >> 2); tq[cs] = t0 + ql; qf[cs] = *(const v8i32*)(q8 + ((size_t)b * SEQ + tq[cs]) * 1024 + (4 * gk + (c & 3)) * 128 + 32 * g); nmb[cs] = 0.f; thr[cs] = NINF; lsum[cs] = (f32x2){0.f, 0.f};
#pragma unroll
            for (int dt = 0; dt < 8; ++dt) o[cs][dt] = (f32x4){0.f, 0.f, 0.f, 0.f}; }
        asm volatile("" : "+v"(qf[0])); asm volatile("" : "+v"(qf[1]));
        __syncthreads();
#pragma unroll
        for (int jp = 0; jp < SELB; ++jp) if (MODE != 2 && jp <= cur) { dma_k8(lds + jp * SLOT8, ks + (size_t)jp * 64 * 128, wave, lane); dma_v8(lds + jp * SLOT8, vst + (size_t)jp * 8192, wave, lane); }
        for (int js = 0; js <= cur; js += SELB) {
            WAITV(0); RAWBAR();
#pragma unroll
            for (int jp = SELB; jp < 2 * SELB; ++jp) if (MODE != 2 && js + jp <= cur) { LAS unsigned char* sl = lds + ((js + jp) & (2 * SELB - 1)) * SLOT8; dma_k8(sl, ks + (size_t)(js + jp) * 64 * 128, wave, lane); dma_v8(sl, vst + (size_t)(js + jp) * 8192, wave, lane); }
            unsigned mws[SELB];
#pragma unroll
            for (int jj = 0; jj < SELB; ++jj) mws[jj] = tmk[2 * (js + jj) + (wave >> 2)];
            unsigned m8s[SELB];
#pragma unroll
            for (int jj = 0; jj < SELB; ++jj) { const unsigned mw = __builtin_amdgcn_readfirstlane(mws[jj]); m8s[jj] = (MODE == 1 || js + jj > cur) ? 0u : ((mw >> (8 * (wave & 3))) & 0xffu); }
#pragma unroll
          for (int jj = 0; jj < SELB; ++jj) { const int j = js + jj;
            if (m8s[jj] != 0u) {
            const LAS unsigned char* slot = lds + (j & (2 * SELB - 1)) * SLOT8; const unsigned m8 = m8s[jj];
            v8i32 kf[4];
#pragma unroll
            for (int kt = 0; kt < 4; ++kt) kf[kt] = pg8::cat8(*(const LAS bf16x8*)(slot + kt * 2048 + kxa), *(const LAS bf16x8*)(slot + kt * 2048 + kxb));
#pragma unroll
            for (int cs = 0; cs < 2; ++cs) { const unsigned nib = (m8 >> (4 * cs)) & 0xfu;
                if (nib != 0u) {
                    const bool selq = (nib >> (c >> 2)) & 1u; f32x4 s[4];
                    { const float cv = selq ? nmb[cs] : NINF; const f32x4 cacc = {cv, cv, cv, cv};
#pragma unroll
                      for (int kt = 0; kt < 4; ++kt) s[kt] = __builtin_amdgcn_mfma_scale_f32_16x16x128_f8f6f4(kf[kt], qf[cs], cacc, 0, 0, 0, 0x7f7f7f7f, 0, 0x7c7c7c7c); }
                    v8i32 vf[4];
#pragma unroll
                    for (int j2 = 0; j2 < 4; ++j2) vf[j2] = pg8::cat8(*(const LAS bf16x8*)(slot + 8192 + j2 * 2048 + vxo), *(const LAS bf16x8*)(slot + 8192 + j2 * 2048 + 1024 + vxo));
                    __builtin_amdgcn_sched_barrier(0);
                    if (j == cur) {
#pragma unroll
                        for (int kt = 0; kt < 4; ++kt)
#pragma unroll
                            for (int ii = 0; ii < 4; ++ii) { const int kp = 64 * j + 16 * kt + 4 * g + ii; s[kt][ii] = kp <= tq[cs] ? s[kt][ii] : NINF; } }
                    const float tm = max16(s);
                    if (__any(tm > thr[cs])) {
                        const float tr = xmax32(xmax16(tm)); const bool un = thr[cs] == NINF, live = tr > NINF;
                        const float d = un ? (live ? tr : 0.f) : fmaxf(tr, 0.f), alpha = __builtin_amdgcn_exp2f(-d);
                        thr[cs] = (un && !live) ? NINF : SM_THR8; nmb[cs] -= d; lsum[cs] = lsum[cs] * alpha;
#pragma unroll
                        for (int dt = 0; dt < 8; ++dt) o[cs][dt] = o[cs][dt] * alpha;
#pragma unroll
                        for (int kt = 0; kt < 4; ++kt)
#pragma unroll
                            for (int i = 0; i < 4; ++i) s[kt][i] -= d; }
#pragma unroll
                    for (int kt = 0; kt < 4; ++kt) {
#pragma unroll
                        for (int i = 0; i < 4; ++i) s[kt][i] = __builtin_amdgcn_exp2f(s[kt][i]);
                        lsum[cs] += (f32x2){s[kt][0], s[kt][1]}; lsum[cs] += (f32x2){s[kt][2], s[kt][3]};
                        int w = pLo[kt]; w = __builtin_amdgcn_cvt_pk_fp8_f32(s[kt][0], s[kt][1], w, false); w = __builtin_amdgcn_cvt_pk_fp8_f32(s[kt][2], s[kt][3], w, true); pLo[kt] = w; pHi[4 + kt] = w; }
#pragma unroll
                    for (int j2 = 0; j2 < 4; ++j2) { MFMA8_ACC(o[cs][2 * j2], vf[j2], pLo); MFMA8_ACC(o[cs][2 * j2 + 1], vf[j2], pHi); } } }
          } }
        }
        asm volatile("s_nop 15\n s_nop 15" ::: "memory");
#pragma unroll
        for (int cs = 0; cs < 2; ++cs) { const float lt = ladd32(ladd16(lsum[cs].x + lsum[cs].y)); const float inv = lt > 0.f ? 1.0f / lt : 0.f;
            if (MODE == 0) store_o(OS, (size_t)b * SEQ + tq[cs], 4 * gk + (c & 3), g, o[cs], inv); else { asm volatile("" :: "v"(inv), "v"(o[cs][0]), "v"(o[cs][7])); } }
    }
}

__device__ __forceinline__ void waitv_dyn(int n) {
    switch (n) { case 0: WAITV(0); break; case 2: WAITV(2); break; case 4: WAITV(4); break; case 6: WAITV(6); break; case 8: WAITV(8); break; case 10: WAITV(10); break; case 12: WAITV(12); break; default: WAITV(14); break; }
}
#define WIN_EXP2(S, kt_, h_) do { S[kt_][2 * (h_)] = __builtin_amdgcn_exp2f(S[kt_][2 * (h_)]); S[kt_][2 * (h_) + 1] = __builtin_amdgcn_exp2f(S[kt_][2 * (h_) + 1]); } while (0)
#define WIN_CVT(S, PN, LS, kt_, h_) do { PN[kt_] = __builtin_amdgcn_cvt_pk_fp8_f32(S[kt_][2 * (h_)], S[kt_][2 * (h_) + 1], PN[kt_], (h_) != 0); LS += (f32x2){S[kt_][2 * (h_)], S[kt_][2 * (h_) + 1]}; } while (0)
#define WIN_RARE(S, TM, CS) do { const float tr_ = xmax32(xmax16(TM)); const bool un_ = thr[CS] == NINF, live_ = tr_ > NINF; \
    const float d_ = un_ ? (live_ ? tr_ : 0.f) : fmaxf(tr_, 0.f), alpha_ = __builtin_amdgcn_exp2f(-d_); thr[CS] = (un_ && !live_) ? NINF : SM_THR8; nmb[CS] -= d_; lsum[CS] = lsum[CS] * alpha_; \
    _Pragma("unroll") for (int dt_ = 0; dt_ < 8; ++dt_) o[CS][dt_] = o[CS][dt_] * alpha_; \
    _Pragma("unroll") for (int kt_ = 0; kt_ < 4; ++kt_) _Pragma("unroll") for (int i_ = 0; i_ < 4; ++i_) S[kt_][i_] -= d_; } while (0)
__device__ __forceinline__ void p5_win(const Args& a, LAS unsigned char* lds, int wg, int G) {
    const int tid = threadIdx.x, lane = tid & 63, wave = __builtin_amdgcn_readfirstlane(tid >> 6), c = lane & 15, g = lane >> 4;
    unsigned char* ws = a.ws; const unsigned char* q8 = ws + WS_Q8; bf16* OW = (bf16*)(ws + WS_OW);
    const int ky = (c ^ (c >> 1)) & 7, kxa = c * 128 + (((2 * g) ^ ky) << 4), kxb = c * 128 + (((2 * g + 1) ^ ky) << 4), vxo = c * 64 + ((g ^ (((c >> 2) & 1) << 1)) << 4);
    const float NINF = -__builtin_inff();
    for (int u = wg; u < 1024; u += G) {
        const int bg = u >> 8, x = u & 255, qt = (G == 256) ? ((x & 7) * 32 + (x >> 3)) : x, b = bg >> 1, gk = bg & 1, t0 = 64 * qt;
        const unsigned char* kw = ws + WS_KWIN + (size_t)bg * SEQ * 128; const unsigned char* vwt = ws + WS_VWINT + (size_t)bg * 256 * 8192;
        v8i32 qf[2]; float nmb[2], thr[2]; f32x2 lsum[2]; f32x4 o[2][8]; int tq[2];
        v8i32 pLo0 = {0, 0, 0, 0, 0, 0, 0, 0}, pHi0 = {0, 0, 0, 0, 0, 0, 0, 0}, pLo1 = {0, 0, 0, 0, 0, 0, 0, 0}, pHi1 = {0, 0, 0, 0, 0, 0, 0, 0};
        asm volatile("" : "+v"(pLo0), "+v"(pHi0)); asm volatile("" : "+v"(pLo1), "+v"(pHi1));
#pragma unroll
        for (int cs = 0; cs < 2; ++cs) { const int ql = 8 * wave + 4 * cs + (c >> 2); tq[cs] = t0 + ql; qf[cs] = *(const v8i32*)(q8 + ((size_t)b * SEQ + tq[cs]) * 1024 + (4 * gk + (c & 3)) * 128 + 32 * g); nmb[cs] = 0.f; thr[cs] = NINF; lsum[cs] = (f32x2){0.f, 0.f};
#pragma unroll
            for (int dt = 0; dt < 8; ++dt) o[cs][dt] = (f32x4){0.f, 0.f, 0.f, 0.f}; }
        const int j0 = qt >= 8 ? qt - 8 : 0, nb = qt - j0 + 1, nfirst = nb < 8 ? nb : 8;
        asm volatile("" : "+v"(qf[0])); asm volatile("" : "+v"(qf[1]));
        __syncthreads();
        for (int i = 0; i < nfirst; ++i) { LAS unsigned char* sl = lds + ((j0 + i) & 7) * SLOT8; dma_k8(sl, kw + (size_t)(j0 + i) * 64 * 128, wave, lane); dma_v8(sl, vwt + (size_t)(j0 + i) * 8192, wave, lane); }
        int nissued = nfirst;
        for (int i0 = 0; i0 < nb; i0 += 3) {
            const int iend = i0 + 3 < nb ? i0 + 3 : nb, left = nissued - iend;
            waitv_dyn(left > 0 ? 2 * left : 0); RAWBAR();
            if (i0 == 3 && nb == 9) { LAS unsigned char* sl = lds + ((j0 + 8) & 7) * SLOT8; dma_k8(sl, kw + (size_t)(j0 + 8) * 64 * 128, wave, lane); dma_v8(sl, vwt + (size_t)(j0 + 8) * 8192, wave, lane); nissued = 9; }
            for (int i = i0; i < iend; ++i) { const int j = j0 + i;
                const LAS unsigned char* slot = lds + (j & 7) * SLOT8;
                f32x4 s0[4], s1[4];
                { v8i32 kf[4];
#pragma unroll
                  for (int kt = 0; kt < 4; ++kt) kf[kt] = pg8::cat8(*(const LAS bf16x8*)(slot + kt * 2048 + kxa), *(const LAS bf16x8*)(slot + kt * 2048 + kxb));
                  const f32x4 c0 = {nmb[0], nmb[0], nmb[0], nmb[0]}, c1 = {nmb[1], nmb[1], nmb[1], nmb[1]};
                  __builtin_amdgcn_sched_barrier(0);
#pragma unroll
                  for (int kt = 0; kt < 4; ++kt) s0[kt] = __builtin_amdgcn_mfma_scale_f32_16x16x128_f8f6f4(kf[kt], qf[0], c0, 0, 0, 0, 0x7f7f7f7f, 0, 0x7c7c7c7c);
#pragma unroll
                  for (int kt = 0; kt < 4; ++kt) s1[kt] = __builtin_amdgcn_mfma_scale_f32_16x16x128_f8f6f4(kf[kt], qf[1], c1, 0, 0, 0, 0x7f7f7f7f, 0, 0x7c7c7c7c); }
                v8i32 vf[4];
#pragma unroll
                for (int j2 = 0; j2 < 4; ++j2) vf[j2] = pg8::cat8(*(const LAS bf16x8*)(slot + 8192 + j2 * 2048 + vxo), *(const LAS bf16x8*)(slot + 8192 + j2 * 2048 + 1024 + vxo));
                __builtin_amdgcn_sched_barrier(0);
                if (j == qt || j + 8 == qt) {
                    int l0 = tq[0] - 64 * j - 4 * g, l1 = tq[1] - 64 * j - 4 * g; asm volatile("" : "+v"(l0), "+v"(l1));
#pragma unroll
                    for (int kt = 0; kt < 4; ++kt)
#pragma unroll
                        for (int ii = 0; ii < 4; ++ii) { s0[kt][ii] = ((unsigned)(l0 - (16 * kt + ii)) < 512u) ? s0[kt][ii] : NINF; s1[kt][ii] = ((unsigned)(l1 - (16 * kt + ii)) < 512u) ? s1[kt][ii] : NINF; } }
                int pn0[4] = {0, 0, 0, 0}, pn1[4] = {0, 0, 0, 0}; f32x2 ls0 = {0.f, 0.f}, ls1 = {0.f, 0.f};
                { const float tm = __builtin_fmaxf(__builtin_fmaxf(__builtin_fmaxf(__builtin_fmaxf(s0[0][0], s0[0][1]), __builtin_fmaxf(s0[0][2], s0[0][3])), __builtin_fmaxf(__builtin_fmaxf(s0[1][0], s0[1][1]), __builtin_fmaxf(s0[1][2], s0[1][3]))),
                                                     __builtin_fmaxf(__builtin_fmaxf(__builtin_fmaxf(s0[2][0], s0[2][1]), __builtin_fmaxf(s0[2][2], s0[2][3])), __builtin_fmaxf(__builtin_fmaxf(s0[3][0], s0[3][1]), __builtin_fmaxf(s0[3][2], s0[3][3]))));
                  if (__any(tm > thr[0])) WIN_RARE(s0, tm, 0); }
#pragma unroll
                for (int kt = 0; kt < 4; ++kt) { WIN_EXP2(s0, kt, 0); WIN_EXP2(s0, kt, 1); WIN_CVT(s0, pn0, ls0, kt, 0); WIN_CVT(s0, pn0, ls0, kt, 1); }
#pragma unroll
                for (int kt = 0; kt < 4; ++kt) { pLo0[kt] = pn0[kt]; pHi0[4 + kt] = pn0[kt]; }
                lsum[0] += ls0;
                { const float tm = __builtin_fmaxf(__builtin_fmaxf(__builtin_fmaxf(__builtin_fmaxf(s1[0][0], s1[0][1]), __builtin_fmaxf(s1[0][2], s1[0][3])), __builtin_fmaxf(__builtin_fmaxf(s1[1][0], s1[1][1]), __builtin_fmaxf(s1[1][2], s1[1][3]))),
                                                     __builtin_fmaxf(__builtin_fmaxf(__builtin_fmaxf(s1[2][0], s1[2][1]), __builtin_fmaxf(s1[2][2], s1[2][3])), __builtin_fmaxf(__builtin_fmaxf(s1[3][0], s1[3][1]), __builtin_fmaxf(s1[3][2], s1[3][3]))));
                  if (__any(tm > thr[1])) WIN_RARE(s1, tm, 1); }
                __builtin_amdgcn_sched_barrier(0);
                MFMA8_B(o[0][0], vf[0], pLo0); WIN_EXP2(s1, 0, 0); SEL_GAP();
                MFMA8_B(o[0][1], vf[0], pHi0); WIN_EXP2(s1, 0, 1); WIN_CVT(s1, pn1, ls1, 0, 0); SEL_GAP();
                MFMA8_B(o[0][2], vf[1], pLo0); WIN_EXP2(s1, 1, 0); WIN_CVT(s1, pn1, ls1, 0, 1); SEL_GAP();
                MFMA8_B(o[0][3], vf[1], pHi0); WIN_EXP2(s1, 1, 1); WIN_CVT(s1, pn1, ls1, 1, 0); SEL_GAP();
                MFMA8_B(o[0][4], vf[2], pLo0); WIN_EXP2(s1, 2, 0); WIN_CVT(s1, pn1, ls1, 1, 1); SEL_GAP();
                MFMA8_B(o[0][5], vf[2], pHi0); WIN_EXP2(s1, 2, 1); WIN_CVT(s1, pn1, ls1, 2, 0); SEL_GAP();
                MFMA8_B(o[0][6], vf[3], pLo0); WIN_EXP2(s1, 3, 0); WIN_CVT(s1, pn1, ls1, 2, 1); SEL_GAP();
                MFMA8_B(o[0][7], vf[3], pHi0); WIN_EXP2(s1, 3, 1); WIN_CVT(s1, pn1, ls1, 3, 0); SEL_GAP();
                WIN_CVT(s1, pn1, ls1, 3, 1);
#pragma unroll
                for (int kt = 0; kt < 4; ++kt) { pLo1[kt] = pn1[kt]; pHi1[4 + kt] = pn1[kt]; }
                lsum[1] += ls1;
#pragma unroll
                for (int j2 = 0; j2 < 4; ++j2) { MFMA8_B(o[1][2 * j2], vf[j2], pLo1); MFMA8_B(o[1][2 * j2 + 1], vf[j2], pHi1); }
            }
        }
#pragma unroll
        for (int cs = 0; cs < 2; ++cs) { const float lt = ladd32(ladd16(lsum[cs].x + lsum[cs].y)); const float inv = lt > 0.f ? 1.0f / lt : 0.f;
            store_o(OW, (size_t)b * SEQ + tq[cs], 4 * gk + (c & 3), g, o[cs], inv); }
    }
}

__device__ __forceinline__ void gelu4(v2u w, float (&o)[4]) {
    const pg8::f32x2 a = pg8::gelu_pk((pg8::f32x2){bflo(w.x), bfhi(w.x)}), b = pg8::gelu_pk((pg8::f32x2){bflo(w.y), bfhi(w.y)}); o[0] = a.x; o[1] = a.y; o[2] = b.x; o[3] = b.y;
}
__device__ __forceinline__ void p6_mix(const Args& a, LAS unsigned char* lds, int wg, int G) {
    const int tid = threadIdx.x, lane = tid & 63, wave = __builtin_amdgcn_readfirstlane(tid >> 6), c = lane & 15, g = lane >> 4;
    unsigned char* ws = a.ws; const bf16* proj = (const bf16*)(ws + WS_PROJ); bf16* STG = (bf16*)(ws + WS_XN)  ; unsigned char* MIX = (unsigned char*)(ws + WS_QR)  ;
    { const float* gn = (const float*)a.in[8]; const float* bs = (const float*)a.in[10]; const float* og = (const float*)a.in[12]; const bf16* wm = (const bf16*)(ws + WS_WM);
      for (int u = wg; u < 256; u += G) { const size_t m0 = (size_t)(u >> 7) * SEQ + 128 * (u & 127); const int t = 16 * wave + c; float ssum = 0.f;
        const int sr = tid >> 4, c0 = 8 * (tid & 15);
        v4u vv[4];
#pragma unroll
        for (int ps = 0; ps < 4; ++ps) vv[ps] = *(const v4u*)(proj + (m0 + 32 * ps + sr) * NP1 + COL_V + c0);
        for (int hg = 0; hg < 8; ++hg) { LAS bf16* buf = (LAS bf16*)lds + (hg & 1) * (128 * 136);
            const f32x4 gna = *(const f32x4*)(gn + hg * 128 + c0), gnb = *(const f32x4*)(gn + hg * 128 + c0 + 4);
            v4u uq[4]; bf16x8 bfr[4];
#pragma unroll
            for (int q = 0; q < 4; ++q) uq[q] = *(const v4u*)(proj + (m0 + t) * NP1 + COL_U + hg * 128 + 32 * g + 8 * q);
#pragma unroll
            for (int ks = 0; ks < 4; ++ks) bfr[ks] = *(const bf16x8*)(wm + ((size_t)hg * 128 + t) * 128 + 32 * ks + 8 * g);
            const float bst = bs[hg * 128 + t];
#pragma unroll
            for (int ps = 0; ps < 4; ++ps) { const int s = 32 * ps + sr; float x[8]; float xa[4], xb[4];
                gelu4((v2u){vv[ps].x, vv[ps].y}, xa); gelu4((v2u){vv[ps].z, vv[ps].w}, xb);
#pragma unroll
                for (int j = 0; j < 4; ++j) { x[j] = xa[j]; x[4 + j] = xb[j]; }
                float ss = 0.f;
#pragma unroll
                for (int j = 0; j < 8; ++j) ss += x[j] * x[j];
                ss = row16_sum(ss);
                const float rs = __builtin_amdgcn_rsqf(ss * (1.0f / 128.0f) + EPS);
#pragma unroll
                for (int j = 0; j < 8; ++j) buf[(c0 + j) * 136 + (s ^ c0)] = (bf16)f2bf(x[j] * rs * (j < 4 ? gna[j] : gnb[j - 4])); }
            if (hg < 7) {
#pragma unroll
                for (int ps = 0; ps < 4; ++ps) vv[ps] = *(const v4u*)(proj + (m0 + 32 * ps + sr) * NP1 + COL_V + (hg + 1) * 128 + c0); }
            __syncthreads();
            f32x4 acc[8];
#pragma unroll
            for (int ct = 0; ct < 8; ++ct) acc[ct] = (f32x4){0.f, 0.f, 0.f, 0.f};
#pragma unroll
            for (int ks = 0; ks < 4; ++ks) { if (ks <= (wave >> 1)) {
#pragma unroll
                for (int ct = 0; ct < 8; ++ct) { const int row = 32 * (c >> 2) + 4 * ct + (c & 3); const bf16x8 af = *(const LAS bf16x8*)(buf + row * 136 + ((32 * ks + 8 * g) ^ (8 * ((row >> 3) & 15)))); acc[ct] = mfma16(af, bfr[ks], acc[ct]); } } }
#pragma unroll
            for (int q = 0; q < 4; ++q) { v4u w4;
#pragma unroll
                for (int hf = 0; hf < 2; ++hf) { const int ct = 2 * q + hf; float gu[4]; gelu4(hf ? (v2u){uq[q].z, uq[q].w} : (v2u){uq[q].x, uq[q].y}, gu);
                    const float o0 = gu[0] * (acc[ct][0] + bst), o1 = gu[1] * (acc[ct][1] + bst), o2 = gu[2] * (acc[ct][2] + bst), o3 = gu[3] * (acc[ct][3] + bst);
                    ssum += (o0 * o0 + o1 * o1) + (o2 * o2 + o3 * o3); if (hf) { w4.z = pk2(o0, o1); w4.w = pk2(o2, o3); } else { w4.x = pk2(o0, o1); w4.y = pk2(o2, o3); } }
                *(v4u*)(STG + (m0 + t) * 1024 + hg * 128 + 32 * g + 8 * q) = w4; } }
        ssum = ladd32(ladd16(ssum));
        LAS float* rsl = (LAS float*)lds + 2 * 128 * 136 / 2;
        if (g == 0) rsl[t] = __builtin_amdgcn_rsqf(ssum * (1.0f / 1024.0f) + EPS);
        asm volatile("s_waitcnt vmcnt(0)" ::: "memory");
        __syncthreads();
        { const int tr = tid >> 2, q4 = tid & 3; const float rs = rsl[tr];
#pragma unroll 4
          for (int st = 0; st < 16; ++st) { const int ch = 64 * st + 16 * q4; const bf16* sp = STG + (m0 + tr) * 1024 + ch; const v4u xa = *(const v4u*)sp, xb = *(const v4u*)(sp + 8);
              const f32x4 g0 = *(const f32x4*)(og + ch), g1 = *(const f32x4*)(og + ch + 4), g2 = *(const f32x4*)(og + ch + 8), g3 = *(const f32x4*)(og + ch + 12); v4u w;
              w.x = pg8::pk4_fp8(bflo(xa.x) * rs * g0[0], bfhi(xa.x) * rs * g0[1], bflo(xa.y) * rs * g0[2], bfhi(xa.y) * rs * g0[3]); w.y = pg8::pk4_fp8(bflo(xa.z) * rs * g1[0], bfhi(xa.z) * rs * g1[1], bflo(xa.w) * rs * g1[2], bfhi(xa.w) * rs * g1[3]);
              w.z = pg8::pk4_fp8(bflo(xb.x) * rs * g2[0], bfhi(xb.x) * rs * g2[1], bflo(xb.y) * rs * g2[2], bfhi(xb.y) * rs * g2[3]); w.w = pg8::pk4_fp8(bflo(xb.z) * rs * g3[0], bfhi(xb.z) * rs * g3[1], bflo(xb.w) * rs * g3[2], bfhi(xb.w) * rs * g3[3]);
              *(v4u*)(MIX + (m0 + tr) * DM + 1024 + ch) = w; } }
        __syncthreads(); } }
    { const bf16* OC = (const bf16*)(ws + WS_OC); const bf16* OS = (const bf16*)(ws + WS_OS); const bf16* OW = (const bf16*)(ws + WS_OW); const float* ng = (const float*)a.in[11];
      const int c0 = 8 * lane, hA = lane >> 4;
      f32x4 gn[2][2];
#pragma unroll
      for (int hf = 0; hf < 2; ++hf) { gn[hf][0] = *(const f32x4*)(ng + c0 + 512 * hf); gn[hf][1] = *(const f32x4*)(ng + c0 + 512 * hf + 4); }
      const int NW2 = G * NWAVES;
      for (int m = wg * NWAVES + wave; m < MTOK; m += 2 * NW2) { v4u x[2][2], y[2][2], z[2][2]; unsigned gw[2][2][3];
#pragma unroll
        for (int q = 0; q < 2; ++q) { const int mm = m + q * NW2; const size_t off = (size_t)mm * 1024 + c0;
#pragma unroll
            for (int hf = 0; hf < 2; ++hf) { const bf16* gp = (const bf16*)(ws + WS_GATES) + (size_t)mm * 32 + (hA + 4 * hf) * 3; gw[q][hf][0] = gp[0]; gw[q][hf][1] = gp[1]; gw[q][hf][2] = gp[2];
                x[q][hf] = *(const v4u*)(OC + off + 512 * hf); y[q][hf] = *(const v4u*)(OS + off + 512 * hf); z[q][hf] = *(const v4u*)(OW + off + 512 * hf); } }
#pragma unroll
        for (int q = 0; q < 2; ++q) { const int mm = m + q * NW2; float o[16]; float ss = 0.f;
#pragma unroll
            for (int hf = 0; hf < 2; ++hf) { const float g0 = sigmoidf(bf2f(gw[q][hf][0])), g1 = sigmoidf(bf2f(gw[q][hf][1])), g2 = sigmoidf(bf2f(gw[q][hf][2]));
#pragma unroll
                for (int j = 0; j < 4; ++j) { const float lo = g0 * bflo(x[q][hf][j]) + g1 * bflo(y[q][hf][j]) + g2 * bflo(z[q][hf][j]), hi = g0 * bfhi(x[q][hf][j]) + g1 * bfhi(y[q][hf][j]) + g2 * bfhi(z[q][hf][j]); o[8 * hf + 2 * j] = lo; o[8 * hf + 2 * j + 1] = hi; ss += lo * lo + hi * hi; } }
            const float rs = __builtin_amdgcn_rsqf(wave_sum_v(ss) * (1.0f / 1024.0f) + EPS);
#pragma unroll
            for (int hf = 0; hf < 2; ++hf) { v2u w8; w8.x = pg8::pk4_fp8(o[8 * hf] * rs * gn[hf][0][0], o[8 * hf + 1] * rs * gn[hf][0][1], o[8 * hf + 2] * rs * gn[hf][0][2], o[8 * hf + 3] * rs * gn[hf][0][3]);
                w8.y = pg8::pk4_fp8(o[8 * hf + 4] * rs * gn[hf][1][0], o[8 * hf + 5] * rs * gn[hf][1][1], o[8 * hf + 6] * rs * gn[hf][1][2], o[8 * hf + 7] * rs * gn[hf][1][3]);
                *(v2u*)(MIX + (size_t)mm * DM + c0 + 512 * hf) = w8; } } } }
}

__device__ __forceinline__ void unpack8_fp8(v2u x, float (&o)[8]) {
#pragma unroll
    for (int h = 0; h < 2; ++h) { const int w = (int)(h ? x.y : x.x); const auto lo = __builtin_amdgcn_cvt_pk_f32_fp8(w, false), hi = __builtin_amdgcn_cvt_pk_f32_fp8(w, true); o[4 * h] = lo[0]; o[4 * h + 1] = lo[1]; o[4 * h + 2] = hi[0]; o[4 * h + 3] = hi[1]; }
}
__device__ __forceinline__ void p_conv(const Args& a, int wg, int G) {
    unsigned char* ws = a.ws; const unsigned char* AH = (const unsigned char*)(ws + WS_AH); unsigned char* HM = (unsigned char*)(ws + WS_HMID);
    const float* cw = (const float*)a.in[16]; const float* cb = (const float*)a.in[17];
    constexpr int TB = 32, NCG = DFF / 8, NIT = (MTOK / TB) * NCG;
    for (int it = wg * NTHR + threadIdx.x; it < NIT; it += G * NTHR) { const int tb = it / NCG, cg = it - tb * NCG, n0 = 8 * cg, t0 = tb * TB;
        f32x2 w0[2][4], w1[2][4], w2[2][4], bb[2][4], p2[2][4], p1[2][4];
#pragma unroll
        for (int hf = 0; hf < 2; ++hf)
#pragma unroll
            for (int q = 0; q < 2; ++q) { const int n = n0 + hf * DFF + 4 * q; const f32x4 a0 = *(const f32x4*)(cw + n), a1 = *(const f32x4*)(cw + DFF2 + n), a2 = *(const f32x4*)(cw + 2 * DFF2 + n), ab = *(const f32x4*)(cb + n);
                w0[hf][2 * q] = (f32x2){a0[0], a0[1]}; w0[hf][2 * q + 1] = (f32x2){a0[2], a0[3]}; w1[hf][2 * q] = (f32x2){a1[0], a1[1]}; w1[hf][2 * q + 1] = (f32x2){a1[2], a1[3]};
                w2[hf][2 * q] = (f32x2){a2[0], a2[1]}; w2[hf][2 * q + 1] = (f32x2){a2[2], a2[3]}; bb[hf][2 * q] = (f32x2){ab[0], ab[1]}; bb[hf][2 * q + 1] = (f32x2){ab[2], ab[3]}; }
#pragma unroll
        for (int hf = 0; hf < 2; ++hf) { v2u x2 = (v2u){0u, 0u}, x1 = x2;
            if ((t0 & (SEQ - 1)) >= 2) { x2 = *(const v2u*)(AH + (size_t)(t0 - 2) * DFF2 + n0 + hf * DFF); x1 = *(const v2u*)(AH + (size_t)(t0 - 1) * DFF2 + n0 + hf * DFF); }
            p2[hf][0] = __builtin_amdgcn_cvt_pk_f32_fp8((int)x2.x, false); p2[hf][1] = __builtin_amdgcn_cvt_pk_f32_fp8((int)x2.x, true); p2[hf][2] = __builtin_amdgcn_cvt_pk_f32_fp8((int)x2.y, false); p2[hf][3] = __builtin_amdgcn_cvt_pk_f32_fp8((int)x2.y, true);
            p1[hf][0] = __builtin_amdgcn_cvt_pk_f32_fp8((int)x1.x, false); p1[hf][1] = __builtin_amdgcn_cvt_pk_f32_fp8((int)x1.x, true); p1[hf][2] = __builtin_amdgcn_cvt_pk_f32_fp8((int)x1.y, false); p1[hf][3] = __builtin_amdgcn_cvt_pk_f32_fp8((int)x1.y, true); }
        for (int tbb = t0; tbb < t0 + TB; tbb += 8) {
            v2u raw[8][2];
#pragma unroll
            for (int k = 0; k < 8; ++k)
#pragma unroll
                for (int hf = 0; hf < 2; ++hf) raw[k][hf] = *(const v2u*)(AH + (size_t)(tbb + k) * DFF2 + n0 + hf * DFF);
#pragma unroll
            for (int k = 0; k < 8; ++k) { f32x2 cu[2][4], acc[2][4];
#pragma unroll
                for (int hf = 0; hf < 2; ++hf) { cu[hf][0] = __builtin_amdgcn_cvt_pk_f32_fp8((int)raw[k][hf].x, false); cu[hf][1] = __builtin_amdgcn_cvt_pk_f32_fp8((int)raw[k][hf].x, true);
                    cu[hf][2] = __builtin_amdgcn_cvt_pk_f32_fp8((int)raw[k][hf].y, false); cu[hf][3] = __builtin_amdgcn_cvt_pk_f32_fp8((int)raw[k][hf].y, true);
#pragma unroll
                    for (int p = 0; p < 4; ++p) acc[hf][p] = __builtin_elementwise_fma(w2[hf][p], cu[hf][p], __builtin_elementwise_fma(w1[hf][p], p1[hf][p], __builtin_elementwise_fma(w0[hf][p], p2[hf][p], bb[hf][p]))); }
                f32x2 r[4];
                f32x2 d[4], gu[4];
#pragma unroll
                for (int p = 0; p < 4; ++p) { const f32x2 e = acc[0][p] * -1.4426950408889634f; d[p].x = __builtin_amdgcn_exp2f(e.x); d[p].y = __builtin_amdgcn_exp2f(e.y); gu[p] = acc[0][p] * acc[1][p]; }
#pragma unroll
                for (int p = 0; p < 4; ++p) { d[p] = d[p] + 1.0f; }
#pragma unroll
                for (int p = 0; p < 4; ++p) { f32x2 sg; sg.x = __builtin_amdgcn_rcpf(d[p].x); sg.y = __builtin_amdgcn_rcpf(d[p].y); r[p] = gu[p] * sg; }
                v2u w; w.x = pg8::pk4_fp8(r[0].x, r[0].y, r[1].x, r[1].y); w.y = pg8::pk4_fp8(r[2].x, r[2].y, r[3].x, r[3].y); *(v2u*)(HM + (size_t)(tbb + k) * DFF + n0) = w;
#pragma unroll
                for (int hf = 0; hf < 2; ++hf)
#pragma unroll
                    for (int p = 0; p < 4; ++p) { p2[hf][p] = p1[hf][p]; p1[hf][p] = cu[hf][p]; } } } }
}

__device__ __forceinline__ void p_final(const Args& a, int wg, int G) {
    const int lane = threadIdx.x & 63, wave = threadIdx.x >> 6; const float* fg = (const float*)a.in[19]; const bf16* h2 = (const bf16*)(a.ws + WS_H2BF);
    const int NW = G * NWAVES;
    for (int m = wg * NWAVES + wave; m < MTOK; m += 2 * NW) {
        v2u r[2][8]; const bool two = m + NW < MTOK;
#pragma unroll
        for (int q = 0; q < 2; ++q) { const v2u* xr = (const v2u*)(h2 + (size_t)(q && two ? m + NW : m) * DM) + lane;
#pragma unroll
            for (int j = 0; j < 8; ++j) r[q][j] = xr[64 * j]; }
#pragma unroll
        for (int q = 0; q < 2; ++q) { if (q && !two) break; const int mm = m + q * NW; f32x4 v[8]; float s = 0.f;
#pragma unroll
            for (int j = 0; j < 8; ++j) { v[j] = (f32x4){bflo(r[q][j].x), bfhi(r[q][j].x), bflo(r[q][j].y), bfhi(r[q][j].y)}; s += (v[j][0] * v[j][0] + v[j][1] * v[j][1]) + (v[j][2] * v[j][2] + v[j][3] * v[j][3]); }
            const float rs = 1.0f / sqrtf(wave_sum(s) * (1.0f / DM) + EPS); f32x4* o = (f32x4*)(a.out + (size_t)mm * DM) + lane;
#pragma unroll
            for (int j = 0; j < 8; ++j) { const f32x4 gg = *((const f32x4*)fg + lane + 64 * j); o[64 * j] = (f32x4){v[j][0] * rs * gg[0], v[j][1] * rs * gg[1], v[j][2] * rs * gg[2], v[j][3] * rs * gg[3]}; } } }
}

constexpr int NPHASE = 14;
#ifndef PROBE_DUP
#define PROBE_DUP 0
#endif
#ifndef PROBE_SEL
#define PROBE_P3 0
#define PROBE_SEL 0
#endif
#ifndef PROBE_G3
#define PROBE_G3 0
#endif
__global__ void __launch_bounds__(NTHR, 2) nsa_layer_fwd(Args a) {
    extern __shared__ __attribute__((aligned(16))) unsigned char lds_raw[];
    LAS unsigned char* lds = (LAS unsigned char*)lds_raw;
    volatile LAS unsigned* MISC = (volatile LAS unsigned*)(lds + MISC_OFF);
    const int tid = threadIdx.x, G = gridDim.x, wg = blockIdx.x;
    if (tid < 32) MISC[tid] = 0u;
    __syncthreads();
    unsigned char* ws = a.ws; unsigned* ctl = (unsigned*)(ws + WS_CTL);
    const int lo = a.ph_lo, hi = a.ph_hi;
    XcdBarrier bar; bar.bar = ctl + CW_BAR + a.li * XCD_BAR_WORDS; bar.x = 0; bar.st = MISC + 8;
    if (hi - lo > 1) bar = xcd_barrier_post(ctl + CW_BAR + a.li * XCD_BAR_WORDS, MISC + 8);
#define IN(k) (lo <= (k) && (k) < hi)
#define SEAM(k) do { if ((k) != 4 && (k) != 10 && (k) != 11 && IN(k) && IN((k) + 1)) xcd_barrier(bar); } while (0)
    bf16* XN = (bf16*)(ws + WS_XN); bf16* PROJ = (bf16*)(ws + WS_PROJ); bf16* H1B = (bf16*)(ws + WS_H1B); bf16* AH = (bf16*)(ws + WS_AH); bf16* HMID = (bf16*)(ws + WS_HMID);
    float* rowss = (float*)ctl + CW_ROWSS;

#define PH(k, ...) do { if (IN(k)) { __VA_ARGS__ if ((PROBE_DUP >> (k)) & 1) { __VA_ARGS__ } } SEAM(k); } while (0)
    PH(0, { p0_prologue(a, lds, wg, G); });
    PH(1, { { pg8::Gemm gm{XN, (const bf16*)(ws + WS_WIN), MTOK, NP1A, DM}; pg8::StaticOrder S; S.init(MTOK, NP1A, G, wg);
              pg8::EpiBf16<0, true> E{PROJ, NP1, nullptr, 0, 0, 1.f}; pg8::gemm_phase<pg8::EpiBf16<0, true>, pg8::StaticOrder, true, true>(lds, gm, S, E); }
            { pg8::Gemm gm{(const bf16*)(ws + WS_XN8), (const bf16*)(ws + WS_WIN8), MTOK, NP1 - NP1A, DM / 2}; pg8::StaticOrder S; S.init(MTOK, NP1 - NP1A, G, wg);
              pg8::EpiBf16<0, true> E{PROJ + NP1A, NP1, nullptr, NP1 - NP1A, 0, 1.0f / W8SCALE}; pg8::gemm_phase<pg8::EpiBf16<0, true>, pg8::StaticOrder, true, true, true>(lds, gm, S, E); }
            p1_gates(a, wg, G); });
    PH(2, { p2_prep(a, lds, wg, G); });
    if (IN(3) && PROBE_P3) { if (PROBE_P3 == 1) p3_cmp<1>(a, lds, wg, G); else if (PROBE_P3 == 2) p3_cmp<2>(a, lds, wg, G); else if (PROBE_P3 == 3) p3_cmp<3>(a, lds, wg, G); else p5_win(a, lds, wg, G); xcd_barrier(bar); }
    PH(3, { p3_cmp<0>(a, lds, wg, G); p5_win(a, lds, wg, G); });
    PH(4, { p4_sel<0>(a, lds, wg, G); });
    if (IN(4) && PROBE_SEL) { xcd_barrier(bar); if (PROBE_SEL == 1) p4_sel<1>(a, lds, wg, G); else p4_sel<2>(a, lds, wg, G); xcd_barrier(bar); }
    if (IN(4) && IN(6)) xcd_barrier(bar);
    PH(6, { p6_mix(a, lds, wg, G); });
    PH(7, { pg8::Gemm gm{(const bf16*)(ws + WS_QR), (const bf16*)(ws + WS_WOUT), MTOK, DM, DM / 2}; pg8::StaticOrder S; S.init(MTOK, DM, G, wg);
        pg8::EpiStream<true, true, true> E{(const float*)a.in[0], nullptr, (bf16*)(ws + WS_H1BF), (unsigned char*)H1B, rowss, DM, 1.0f / W8SCALE};
        pg8::gemm_phase<pg8::EpiStream<true, true, true>, pg8::StaticOrder, true, true, true>(lds, gm, S, E); });
    PH(8, { pg8::Gemm gm{H1B, (const bf16*)(ws + WS_WUP), MTOK, DFF2, DM / 2}; pg8::StaticOrder S; S.init(MTOK, DFF2, G, wg);
        pg8::EpiScaleT<true> E{AH, DFF2, rowss, 1.0f / DM, EPS, 1.0f / W8SCALE}; pg8::gemm_phase<pg8::EpiScaleT<true>, pg8::StaticOrder, true, true, true>(lds, gm, S, E); });
    if (IN(8) && PROBE_G3) { xcd_barrier(bar); pg8::Gemm gm{H1B, (const bf16*)(ws + WS_WUP), MTOK, DFF2, DM / 2}; pg8::StaticOrder S; S.init(MTOK, DFF2, G, wg); pg8::EpiNull E{nullptr}; pg8::gemm_phase<pg8::EpiNull, pg8::StaticOrder, true, true, true>(lds, gm, S, E); xcd_barrier(bar); }
    PH(9, { p_conv(a, wg, G); });
    PH(12, { pg8::Gemm gm{HMID, (const bf16*)(ws + WS_WDN), MTOK, DM, DFF / 2}; pg8::StaticOrder S; S.init(MTOK, DM, G, wg);
        pg8::EpiStream<false, false, false> E{nullptr, (const bf16*)(ws + WS_H1BF), (bf16*)(ws + WS_H2BF), nullptr, nullptr, DM, 1.0f / W8SCALE};
        pg8::gemm_phase<pg8::EpiStream<false, false, false>, pg8::StaticOrder, true, true, true>(lds, gm, S, E); });
    PH(13, { p_final(a, wg, G); });
#undef PH
#undef IN
#undef SEAM
}

#ifndef MK_N_LAUNCHES
#define MK_N_LAUNCHES 1
#endif
extern "C" void kernel_launch(void* const* d_in, const int* in_sizes, int n_in, void* d_out, int out_size, void* d_ws, size_t ws_size, hipStream_t stream) {
    static int grid = 0;
    if (grid == 0) {
        if (n_in != 20 || out_size != MTOK * DM || ws_size < WS_END2) { fprintf(stderr, "kernel_launch: unexpected shapes (n_in %d, out %d, ws %zu)\n", n_in, out_size, ws_size); grid = -1; return; }
        int dev = 0, cus = 0, per_cu = 0;
        if (hipGetDevice(&dev) != hipSuccess || hipDeviceGetAttribute(&cus, hipDeviceAttributeMultiprocessorCount, dev) != hipSuccess) { grid = -1; return; }
        if (hipFuncSetAttribute((const void*)nsa_layer_fwd, hipFuncAttributeMaxDynamicSharedMemorySize, LDS_BYTES) != hipSuccess) { fprintf(stderr, "kernel_launch: hipFuncSetAttribute failed\n"); grid = -1; return; }
        if (hipOccupancyMaxActiveBlocksPerMultiprocessor(&per_cu, (const void*)nsa_layer_fwd, NTHR, LDS_BYTES) != hipSuccess || per_cu < 1) { fprintf(stderr, "kernel_launch: occupancy query says %d blocks per CU\n", per_cu); }
        (void)hipGetLastError();
        grid = cus;
    }
    if (grid < 0) return;
    if (hipMemsetAsync((char*)d_ws + WS_CTL, 0, CTL_ZERO_BYTES, stream) != hipSuccess) return;
    Args a{};
    for (int i = 0; i < 20; ++i) a.in[i] = d_in[i];
    a.out = (float*)d_out; a.ws = (unsigned char*)d_ws;
    constexpr int NL = MK_N_LAUNCHES;
    for (int li = 0; li < NL; ++li) {
        a.ph_lo = (NL == NPHASE) ? li : (li * NPHASE) / NL; a.ph_hi = (NL == NPHASE) ? li + 1 : ((li + 1) * NPHASE) / NL; a.li = li; a.pad = 0;
        hipLaunchKernelGGL(nsa_layer_fwd, dim3(grid), dim3(NTHR), LDS_BYTES, stream, a);
    }
}
```
